# Optimizing an MI355X kernel written in HIP

```python
import jax, jax.numpy as jnp
from jax import lax
import numpy as np

D_MODEL = 2048
BATCH = 4
SEQ = 2048
DEPTH = 4

MIX_WIDTH = D_MODEL
N_MIXERS = 4
GW = MIX_WIDTH // N_MIXERS
HEAD_DIM = 128
HEADS_PER_GROUP = GW // HEAD_DIM
CHUNK = 128
POOL_WINDOWS = (2, 4, 8, 16)
POOL_CH = GW // len(POOL_WINDOWS)
CONV_WIDTH = 31
N_MEM = 256
MEM_HEADS = HEADS_PER_GROUP
N_EXPERTS = 64
N_EXPERT_GROUPS = 8
TOPK_GROUPS = 4
TOP_K = 8
D_EXPERT = 256
D_SHARED = 256
ROUTED_SCALE = 2.5
EXPERT_BLOCK = 128
LN_EPS = 1e-5
DEEPNORM_ALPHA = (2.0 * DEPTH) ** 0.25
DEEPNORM_BETA = (8.0 * DEPTH) ** -0.25
END_A = 2 * GW
END_B = 3 * GW
END_C = 5 * GW
IN_WIDTH = 6 * GW

kernel_name = "hybrid_sgu_pool_conv_memattn_moe_deepnorm"


def layer_norm(x, g, b):
    xf = x.astype(jnp.float32)
    mu = xf.mean(-1, keepdims=True)
    var = jnp.square(xf - mu).mean(-1, keepdims=True)
    y = (xf - mu) * lax.rsqrt(var + LN_EPS)
    return (y * g.astype(jnp.float32) + b.astype(jnp.float32)).astype(x.dtype)


def group_norm(x, g, b, n_groups):
    shp = x.shape
    xg = x.reshape(shp[:-1] + (n_groups, shp[-1] // n_groups))
    return layer_norm(xg, g.reshape(n_groups, -1), b.reshape(n_groups, -1)).reshape(shp)


def sgu_mixer(h, ln_g, ln_b, w_s, b_s):
    z = jax.nn.gelu(h)
    u, v = z[..., :GW], z[..., GW:]
    v = group_norm(v, ln_g, ln_b, HEADS_PER_GROUP)
    B, S, _ = v.shape
    vc = v.reshape(B, S // CHUNK, CHUNK, HEADS_PER_GROUP, HEAD_DIM)
    causal = jnp.tril(jnp.ones((CHUNK, CHUNK), dtype=bool))
    wm = jnp.where(causal[None], w_s, 0)
    mixed = jnp.einsum('hts,bcshd->bcthd', wm, vc) + b_s[:, :, None]
    return u * mixed.reshape(B, S, GW)


def pool_mixer(p, w_pool, scale):
    B, S, _ = p.shape
    pg = p.reshape(B, S, len(POOL_WINDOWS), POOL_CH)
    pos = jnp.arange(1, S + 1, dtype=jnp.float32)
    outs = []
    for g, win in enumerate(POOL_WINDOWS):
        xg = pg[:, :, g].astype(jnp.float32)
        cs = lax.cumsum(xg, axis=1)
        lagged = jnp.pad(cs, ((0, 0), (win, 0), (0, 0)))[:, :S]
        cnt = jnp.minimum(pos, float(win))[None, :, None]
        outs.append((cs - lagged) / cnt - xg)
    pooled = jnp.stack(outs, axis=2).astype(p.dtype)
    y = jnp.einsum('bsgc,gcd->bsgd', pooled, w_pool).reshape(B, S, GW)
    return y * scale


def conv_mixer(c, w_conv, b_conv, ln_g, ln_b):
    glu = c[..., :GW] * jax.nn.sigmoid(c[..., GW:])
    y = lax.conv_general_dilated(
        glu, w_conv[:, None, :], window_strides=(1,), padding=[(CONV_WIDTH - 1, 0)],
        dimension_numbers=('NWC', 'WIO', 'NWC'), feature_group_count=GW) + b_conv
    y = group_norm(y, ln_g, ln_b, HEADS_PER_GROUP)
    return jax.nn.silu(y)


def memory_attention(q, memn, w_kv):
    B, S, _ = q.shape
    M = memn.shape[1]
    kv = memn @ w_kv
    k = kv[..., :GW].reshape(B, M, MEM_HEADS, HEAD_DIM)
    v = kv[..., GW:].reshape(B, M, MEM_HEADS, HEAD_DIM)
    qh = q.reshape(B, S, MEM_HEADS, HEAD_DIM)
    s = jnp.einsum('bshd,bmhd->bhsm', qh.astype(jnp.float32), k.astype(jnp.float32)) * (HEAD_DIM ** -0.5)
    pr = jax.nn.softmax(s, axis=-1)
    o = jnp.einsum('bhsm,bmhd->bshd', pr, v.astype(jnp.float32))
    return o.reshape(B, S, GW).astype(q.dtype)


def route(xf, w_router, bias):
    N = xf.shape[0]
    scores = jax.nn.sigmoid(xf.astype(jnp.float32) @ w_router.astype(jnp.float32))
    choice = scores + bias.astype(jnp.float32)
    grp = choice.reshape(N, N_EXPERT_GROUPS, N_EXPERTS // N_EXPERT_GROUPS)
    grp_score = lax.top_k(grp, 2)[0].sum(-1)
    _, top_g = lax.top_k(grp_score, TOPK_GROUPS)
    gmask = jax.nn.one_hot(top_g, N_EXPERT_GROUPS, dtype=jnp.float32).sum(1) > 0
    emask = jnp.repeat(gmask, N_EXPERTS // N_EXPERT_GROUPS, axis=1)
    _, idx = lax.top_k(jnp.where(emask, choice, -jnp.inf), TOP_K)
    w = jnp.take_along_axis(scores, idx, axis=-1)
    w = w / (w.sum(-1, keepdims=True) + 1e-20) * ROUTED_SCALE
    return idx, w


def swiglu(x, wg, wu, wd):
    return (jax.nn.silu(x @ wg) * (x @ wu)) @ wd


def routed_experts(xf, idx, wts, w_gate, w_up, w_down):
    N, D = xf.shape
    A = N * TOP_K
    flat_e = idx.reshape(A)
    flat_tok = jnp.repeat(jnp.arange(N, dtype=jnp.int32), TOP_K)
    flat_w = wts.reshape(A)
    order = jnp.argsort(flat_e)
    e_sorted = flat_e[order]
    counts = jnp.bincount(flat_e, length=N_EXPERTS)
    padded = (counts + EXPERT_BLOCK - 1) // EXPERT_BLOCK * EXPERT_BLOCK
    pad_end = jnp.cumsum(padded)
    pad_start = pad_end - padded
    start = jnp.cumsum(counts) - counts
    dest = pad_start[e_sorted] + (jnp.arange(A, dtype=jnp.int32) - start[e_sorted])
    nb = -(-A // EXPERT_BLOCK) + N_EXPERTS
    slot_tok = jnp.full((nb * EXPERT_BLOCK,), N, jnp.int32).at[dest].set(flat_tok[order])
    slot_w = jnp.zeros((nb * EXPERT_BLOCK,), jnp.float32).at[dest].set(flat_w[order])
    blk_e = jnp.minimum(jnp.searchsorted(pad_end, jnp.arange(nb) * EXPERT_BLOCK, side='right'), N_EXPERTS - 1)
    x_pad = jnp.concatenate([xf, jnp.zeros((1, D), xf.dtype)], axis=0)

    def body(y, blk):
        tok, w, e = blk
        xb = x_pad[tok]
        yb = swiglu(xb, w_gate[e], w_up[e], w_down[e]) * w.astype(xf.dtype)[:, None]
        return y.at[tok].add(yb), None

    y, _ = lax.scan(body, jnp.zeros((N + 1, D), xf.dtype),
                    (slot_tok.reshape(nb, EXPERT_BLOCK), slot_w.reshape(nb, EXPERT_BLOCK), blk_e))
    return y[:N]


def setup_inputs(seed: int = 0) -> dict:
    key = jax.random.key(seed)
    ks = jax.random.split(key, 40)
    f32 = jnp.float32

    def nrm(k, shape, scale):
        return jax.random.normal(k, shape, f32) * scale

    L, D, H = DEPTH, D_MODEL, HEADS_PER_GROUP
    w_mem_kv = jnp.concatenate([nrm(ks[14], (L, D, GW), D ** -0.5),
                                nrm(ks[15], (L, D, GW), D ** -0.5 * DEEPNORM_BETA)], axis=-1)
    return {
        'x': nrm(ks[0], (BATCH, SEQ, D), 1.0),
        'mem': nrm(ks[1], (BATCH, N_MEM, D), 1.0),
        'mem_ln_g': 1.0 + nrm(ks[2], (D,), 0.01),
        'mem_ln_b': nrm(ks[3], (D,), 0.01),
        'w_in': nrm(ks[4], (L, D, IN_WIDTH), D ** -0.5),
        'sgu_ln_g': 1.0 + nrm(ks[5], (L, GW), 0.01),
        'sgu_ln_b': nrm(ks[6], (L, GW), 0.01),
        'sgu_w': nrm(ks[7], (L, H, CHUNK, CHUNK), CHUNK ** -0.5),
        'sgu_b': 1.0 + nrm(ks[8], (L, CHUNK, H), 0.01),
        'pool_w': nrm(ks[9], (L, len(POOL_WINDOWS), POOL_CH, POOL_CH), POOL_CH ** -0.5),
        'pool_scale': 1.0 + nrm(ks[10], (L, GW), 0.01),
        'conv_w': nrm(ks[11], (L, CONV_WIDTH, GW), CONV_WIDTH ** -0.5),
        'conv_b': nrm(ks[12], (L, GW), 0.01),
        'conv_ln_g': 1.0 + nrm(ks[13], (L, GW), 0.01),
        'conv_ln_b': nrm(ks[16], (L, GW), 0.01),
        'w_mem_kv': w_mem_kv,
        'w_out': nrm(ks[17], (L, MIX_WIDTH, D), MIX_WIDTH ** -0.5 * DEEPNORM_BETA),
        'ln1_g': 1.0 + nrm(ks[18], (L, D), 0.01),
        'ln1_b': nrm(ks[19], (L, D), 0.01),
        'w_router': nrm(ks[20], (L, D, N_EXPERTS), D ** -0.5),
        'router_bias': nrm(ks[21], (L, N_EXPERTS), 0.01),
        'exp_w_gate': nrm(ks[22], (L, N_EXPERTS, D, D_EXPERT), D ** -0.5),
        'exp_w_up': nrm(ks[23], (L, N_EXPERTS, D, D_EXPERT), D ** -0.5),
        'exp_w_down': nrm(ks[24], (L, N_EXPERTS, D_EXPERT, D), D_EXPERT ** -0.5 * DEEPNORM_BETA),
        'sh_w_gate': nrm(ks[25], (L, D, D_SHARED), D ** -0.5),
        'sh_w_up': nrm(ks[26], (L, D, D_SHARED), D ** -0.5),
        'sh_w_down': nrm(ks[27], (L, D_SHARED, D), D_SHARED ** -0.5 * DEEPNORM_BETA),
        'ln2_g': 1.0 + nrm(ks[28], (L, D), 0.01),
        'ln2_b': nrm(ks[29], (L, D), 0.01),
    }


def reference(x, mem, mem_ln_g, mem_ln_b, w_in, sgu_ln_g, sgu_ln_b, sgu_w, sgu_b, pool_w, pool_scale,
              conv_w, conv_b, conv_ln_g, conv_ln_b, w_mem_kv, w_out, ln1_g, ln1_b, w_router, router_bias,
              exp_w_gate, exp_w_up, exp_w_down, sh_w_gate, sh_w_up, sh_w_down, ln2_g, ln2_b):
    B, S, D = x.shape
    memn = layer_norm(mem, mem_ln_g, mem_ln_b)
    for l in range(DEPTH):
        h = x @ w_in[l]
        a = sgu_mixer(h[..., :END_A], sgu_ln_g[l], sgu_ln_b[l], sgu_w[l], sgu_b[l])
        p = pool_mixer(h[..., END_A:END_B], pool_w[l], pool_scale[l])
        c = conv_mixer(h[..., END_B:END_C], conv_w[l], conv_b[l], conv_ln_g[l], conv_ln_b[l])
        m = memory_attention(h[..., END_C:], memn, w_mem_kv[l])
        mix = jnp.concatenate([a, p, c, m], axis=-1) @ w_out[l]
        x = layer_norm(DEEPNORM_ALPHA * x + mix, ln1_g[l], ln1_b[l])
        xf = x.reshape(B * S, D)
        idx, wts = route(xf, w_router[l], router_bias[l])
        shared = swiglu(xf, sh_w_gate[l], sh_w_up[l], sh_w_down[l])
        routed = routed_experts(xf, idx, wts, exp_w_gate[l], exp_w_up[l], exp_w_down[l])
        x = layer_norm(DEEPNORM_ALPHA * x + (shared + routed).reshape(B, S, D), ln2_g[l], ln2_b[l])
    return x
```

```cpp
#include <hip/hip_runtime.h>
#include <cstdio>
#include <cstdint>

#define LAS __attribute__((address_space(3)))
#define GAS __attribute__((address_space(1)))
typedef unsigned short bf16_t;
typedef short bf16x8 __attribute__((ext_vector_type(8)));
typedef float f32x4 __attribute__((ext_vector_type(4)));
typedef float f32x2 __attribute__((ext_vector_type(2)));
typedef unsigned u32x4 __attribute__((ext_vector_type(4)));
typedef unsigned u32x2 __attribute__((ext_vector_type(2)));

#ifndef REP_P0
#define REP_P0 1
#endif
#ifndef REP_B
#define REP_B 1
#endif
#ifndef REP_E
#define REP_E 1
#endif
#ifndef REP_F
#define REP_F 1
#endif
#ifndef REP_A
#define REP_A 1
#endif
#ifndef REP_C
#define REP_C 1
#endif
#ifndef REP_D1
#define REP_D1 1
#endif
#ifndef REP_D2
#define REP_D2 1
#endif
#ifndef REP_D3
#define REP_D3 1
#endif
#ifndef REP_G
#define REP_G 1
#endif
#define REP_LOOP(n) _Pragma("unroll 1") for (int rep_ = 0; rep_ < (n); ++rep_)
#ifndef FILL_P1
#define FILL_P1 2
#endif
#ifndef FILL_A
#define FILL_A 1
#endif
#ifndef FILL_E
#define FILL_E 1
#endif
#ifndef MK_ONE_LAUNCH
#define MK_ONE_LAUNCH 1
#endif

constexpr int D = 2048, NTOK = 8192, SEQ = 2048, NL = 4, INW = 3072, GW = 512, HD = 128, NMEMTOK = 1024, NE = 64, NE1 = 65, DE = 256, TOPK = 8;
constexpr float LN_EPS = 1e-5f;
constexpr float ALPHA = 1.6817928305074290861f;
constexpr int SLOT_CAP = 90112;

constexpr size_t MiB = 1u << 20;
constexpr size_t WS_CTL = 0, CTL_ZERO_BYTES = 2 * MiB;
constexpr size_t WS_WT_IN  = 2 * MiB;
constexpr size_t WS_WT_OUT = WS_WT_IN + 48 * MiB;
constexpr size_t WS_WT_K   = WS_WT_OUT + 32 * MiB;
constexpr size_t WS_WT_V   = WS_WT_K + 8 * MiB;
constexpr size_t WS_WT_GU  = WS_WT_V + 8 * MiB;
constexpr size_t WS_WT_D   = WS_WT_GU + 520 * MiB;
constexpr size_t WS_WPT    = WS_WT_D + 260 * MiB;
constexpr size_t WS_SGUW   = WS_WPT + 1 * MiB;
constexpr size_t WS_WR_HI  = WS_SGUW + 1 * MiB;
constexpr size_t WS_WR_LO  = WS_WR_HI + 1 * MiB;
constexpr size_t WS_MEMN   = WS_WR_LO + 1 * MiB;
constexpr size_t WS_KBUF   = WS_MEMN + 4 * MiB;
constexpr size_t WS_VT     = WS_KBUF + 4 * MiB;
constexpr size_t WS_XF     = WS_VT + 4 * MiB;
constexpr size_t WS_OSH    = WS_XF;
constexpr size_t WS_XB     = WS_XF + 64 * MiB;
constexpr size_t WS_HB     = WS_XB + 32 * MiB;
constexpr size_t WS_MIX    = WS_HB + 48 * MiB;
constexpr size_t WS_Y1     = WS_MIX + 32 * MiB;
constexpr size_t WS_X1F    = WS_Y1 + 64 * MiB;
constexpr size_t WS_X1B    = WS_X1F + 64 * MiB;
constexpr size_t WS_HE     = WS_X1B + 33 * MiB;
constexpr size_t WS_OB     = WS_HE + 44 * MiB;
constexpr size_t WS_LIST   = WS_OB + 352 * MiB;
constexpr size_t WS_ASG_EP = WS_LIST + 2 * MiB;
constexpr size_t WS_ASG_W  = WS_ASG_EP + 1 * MiB;
constexpr size_t WS_END    = WS_ASG_W + 1 * MiB;
constexpr int CW_BAR = 4096;
constexpr int CW_CNT = 16384, CNT_STRIDE = 1024;
static_assert((CW_CNT + 256 * CNT_STRIDE) * 4 <= (int)CTL_ZERO_BYTES, "ctl");

constexpr int RING_BYTES = 131072;
constexpr int LDS_MISC = RING_BYTES;
constexpr int LDS_ETAB = LDS_MISC + 512;
constexpr int LDS_UDESC = LDS_ETAB + 1024;
constexpr int LDS_ROWTAB = LDS_UDESC + 512;
constexpr int LDS_BYTES = 147456;
static_assert(LDS_ROWTAB + 4096 <= LDS_BYTES, "lds");

#define LDS_WAIT() asm volatile("s_waitcnt lgkmcnt(0)" ::: "memory")
#define VM_WAIT() asm volatile("s_waitcnt vmcnt(0)" ::: "memory")

__device__ __forceinline__ unsigned cvt_pk_bf16(float lo, float hi) { unsigned r; asm volatile("v_cvt_pk_bf16_f32 %0, %1, %2" : "=v"(r) : "v"(lo), "v"(hi)); return r; }
__device__ __forceinline__ float bf_lo(unsigned w) { return __uint_as_float(w << 16); }
__device__ __forceinline__ float bf_hi(unsigned w) { return __uint_as_float(w & 0xffff0000u); }
__device__ __forceinline__ float fast_sigmoid(float x) { return __builtin_amdgcn_rcpf(1.0f + __builtin_amdgcn_exp2f(-1.4426950408889634f * x)); }
__device__ __forceinline__ float silu_f(float x) { return x * fast_sigmoid(x); }
__device__ __forceinline__ float gelu_tanh_f(float x) { const float t = x + 0.044715f * x * x * x; return x * fast_sigmoid(1.5957691216057308f * t); }
__device__ __forceinline__ float wave_sum(float v) {
#pragma unroll
    for (int o = 1; o < 64; o <<= 1) v += __shfl_xor(v, o);
    return v;
}
__device__ __forceinline__ float g16_sum(float v) { v += __shfl_xor(v, 1); v += __shfl_xor(v, 2); v += __shfl_xor(v, 4); v += __shfl_xor(v, 8); return v; }

namespace pg8 {
constexpr int BM = 256, BK = 64, HALF = 128, HTB = HALF * BK * 2, STAGE_BYTES = 8 * HTB, NXCD = 8, WGM = 8;
__host__ __device__ __forceinline__ int lds_byte(int r, int c) { const int st = (r >> 4) * 2 + (c >> 5), rr = r & 15, cc = c & 31, ob = rr * 64 + cc * 2; return st * 1024 + (ob ^ (((ob >> 9) & 1) << 5)); }
__host__ __device__ __forceinline__ void stage_rc(int b, int& R, int& C) { const int st = b / 1024, sb = b % 1024, swz = sb ^ (((sb >> 9) & 1) << 5); R = (st >> 1) * 16 + swz / 64; C = (st & 1) * 32 + (swz % 64) / 2; }
__host__ __device__ __forceinline__ int perm32(int rho) { const int n = rho >> 4, i = rho & 15; return 8 * (i >> 2) + 4 * n + (i & 3); }

struct Unit { const char* A; const char* B; int row0, col0, nvalid, aux; };

struct StaticOrder {
    int nM, nN, nwg, G, c;
    __device__ void init(int M, int N, int G_, int c_) { nM = M / BM; nN = N / BM; nwg = nM * nN; G = G_; c = c_; }
    __device__ bool next(int i, int& pm, int& pn) const {
        const long L = (long)i * G + c; if (L >= nwg || c < 0) return false;
        int wgid = (int)L; { const int q = nwg / NXCD, r = nwg % NXCD, xcd = wgid % NXCD, off = wgid / NXCD; wgid = (xcd < r ? xcd * (q + 1) : r * (q + 1) + (xcd - r) * q) + off; }
        const int nig = WGM * nN, gid = wgid / nig, fm = gid * WGM, gsz = (nM - fm) < WGM ? (nM - fm) : WGM;
        pm = fm + ((wgid % nig) % gsz); pn = (wgid % nig) / gsz; return true;
    }
};
struct DenseSched {
    StaticOrder so; const char* A; const char* B; size_t tstep;
    __device__ void init(const bf16_t* A_, const bf16_t* B_, int M, int N, int K, int G, int c) { so.init(M, N, G, c); A = (const char*)A_; B = (const char*)B_; tstep = (size_t)BM * K * 2; }
    __device__ __forceinline__ bool next(int i, Unit& u) const { int pm, pn; if (!so.next(i, pm, pn)) return false; u.A = A + (size_t)pm * tstep; u.B = B + (size_t)pn * tstep; u.row0 = pm * BM; u.col0 = pn * BM; u.nvalid = BM; u.aux = 0; return true; }
    __device__ __forceinline__ unsigned rowoff(int, int) const { return 0u; }
};

struct EpiStoreBf16 {
    static constexpr bool PERM = true;
    bf16_t* O; int ldc;
    __device__ __forceinline__ void operator()(const f32x4 (&acc)[2][2][4][2], const Unit& u, int wr, int wc, int fr, int fq) const {
#pragma unroll
        for (int ai = 0; ai < 2; ++ai)
#pragma unroll
            for (int m = 0; m < 4; ++m) { const int lr = ai * HALF + wr * 64 + m * 16 + fr;
                if (lr < u.nvalid) { bf16_t* rowp = O + (size_t)(u.row0 + lr) * ldc + u.col0 + wc * 32 + 8 * fq;
#pragma unroll
                    for (int bj = 0; bj < 2; ++bj) { const f32x4 v0 = acc[ai][bj][m][0], v1 = acc[ai][bj][m][1];
                        u32x4 w; w.x = cvt_pk_bf16(v0[0], v0[1]); w.y = cvt_pk_bf16(v0[2], v0[3]); w.z = cvt_pk_bf16(v1[0], v1[1]); w.w = cvt_pk_bf16(v1[2], v1[3]);
                        *(u32x4*)(rowp + bj * HALF) = w; } } }
    }
};
constexpr float O8_SCALE = 16.0f;
struct EpiStoreFp8 {
    static constexpr bool PERM = true;
    unsigned char* O; int ldc; bf16_t* OS; int sh_e, sh_base;
    __device__ __forceinline__ void operator()(const f32x4 (&acc)[2][2][4][2], const Unit& u, int wr, int wc, int fr, int fq) const {
        if (u.aux == sh_e) {
#pragma unroll
            for (int ai = 0; ai < 2; ++ai)
#pragma unroll
                for (int m = 0; m < 4; ++m) { const int lr = ai * HALF + wr * 64 + m * 16 + fr; bf16_t* rowp = OS + (size_t)(u.row0 - sh_base + lr) * ldc + u.col0 + wc * 32 + 8 * fq;
#pragma unroll
                    for (int bj = 0; bj < 2; ++bj) { const f32x4 v0 = acc[ai][bj][m][0], v1 = acc[ai][bj][m][1];
                        *(u32x4*)(rowp + bj * HALF) = (u32x4){cvt_pk_bf16(v0[0], v0[1]), cvt_pk_bf16(v0[2], v0[3]), cvt_pk_bf16(v1[0], v1[1]), cvt_pk_bf16(v1[2], v1[3])}; } }
            return; }
#pragma unroll
        for (int ai = 0; ai < 2; ++ai)
#pragma unroll
            for (int m = 0; m < 4; ++m) { const int lr = ai * HALF + wr * 64 + m * 16 + fr;
                unsigned pk[2][2];
#pragma unroll
                for (int bj = 0; bj < 2; ++bj) { const f32x4 v0 = acc[ai][bj][m][0] * O8_SCALE, v1 = acc[ai][bj][m][1] * O8_SCALE;
                    int p = __builtin_amdgcn_cvt_pk_fp8_f32(v0[0], v0[1], 0, false); p = __builtin_amdgcn_cvt_pk_fp8_f32(v0[2], v0[3], p, true);
                    int q = __builtin_amdgcn_cvt_pk_fp8_f32(v1[0], v1[1], 0, false); q = __builtin_amdgcn_cvt_pk_fp8_f32(v1[2], v1[3], q, true);
                    pk[bj][0] = (unsigned)p; pk[bj][1] = (unsigned)q; }
                const auto s0 = __builtin_amdgcn_permlane16_swap(pk[0][0], pk[1][0], false, false), s1 = __builtin_amdgcn_permlane16_swap(pk[0][1], pk[1][1], false, false);
                if (lr < u.nvalid) *(u32x4*)(O + (size_t)(u.row0 + lr) * ldc + u.col0 + wc * 32 + (fq & 1) * HALF + (fq >> 1) * 16) = (u32x4){s0[0], s1[0], s0[1], s1[1]}; }
    }
};
struct EpiResidBf16 {
    static constexpr bool PERM = true;
    bf16_t* Y; const float* X; const bf16_t* XBp; int ldc; float alpha;
    __device__ __forceinline__ void operator()(const f32x4 (&acc)[2][2][4][2], const Unit& u, int wr, int wc, int fr, int fq) const {
#pragma unroll
        for (int ai = 0; ai < 2; ++ai)
#pragma unroll
            for (int m = 0; m < 4; ++m) { const size_t off = (size_t)(u.row0 + ai * HALF + wr * 64 + m * 16 + fr) * ldc + u.col0 + wc * 32 + 8 * fq;
#pragma unroll
                for (int bj = 0; bj < 2; ++bj) { f32x4 x0, x1;
                    if (X) { x0 = *(const f32x4*)(X + off + bj * HALF); x1 = *(const f32x4*)(X + off + bj * HALF + 4); }
                    else { const u32x4 r = *(const u32x4*)(XBp + off + bj * HALF); x0 = (f32x4){bf_lo(r.x), bf_hi(r.x), bf_lo(r.y), bf_hi(r.y)}; x1 = (f32x4){bf_lo(r.z), bf_hi(r.z), bf_lo(r.w), bf_hi(r.w)}; }
                    const f32x4 v0 = acc[ai][bj][m][0] + alpha * x0, v1 = acc[ai][bj][m][1] + alpha * x1;
                    *(u32x4*)(Y + off + bj * HALF) = (u32x4){cvt_pk_bf16(v0[0], v0[1]), cvt_pk_bf16(v0[2], v0[3]), cvt_pk_bf16(v1[0], v1[1]), cvt_pk_bf16(v1[2], v1[3])}; } }
    }
};
struct EpiSwiglu {
    static constexpr bool PERM = true;
    bf16_t* H;
    __device__ __forceinline__ void operator()(const f32x4 (&acc)[2][2][4][2], const Unit& u, int wr, int wc, int fr, int fq) const {
#pragma unroll
        for (int ai = 0; ai < 2; ++ai)
#pragma unroll
            for (int m = 0; m < 4; ++m) { const int lr = ai * HALF + wr * 64 + m * 16 + fr;
                if (lr < u.nvalid) { const f32x4 g0 = acc[ai][0][m][0], g1 = acc[ai][0][m][1], u0 = acc[ai][1][m][0], u1 = acc[ai][1][m][1];
                    u32x4 w; w.x = cvt_pk_bf16(silu_f(g0[0]) * u0[0], silu_f(g0[1]) * u0[1]); w.y = cvt_pk_bf16(silu_f(g0[2]) * u0[2], silu_f(g0[3]) * u0[3]);
                    w.z = cvt_pk_bf16(silu_f(g1[0]) * u1[0], silu_f(g1[1]) * u1[1]); w.w = cvt_pk_bf16(silu_f(g1[2]) * u1[2], silu_f(g1[3]) * u1[3]);
                    *(u32x4*)(H + (size_t)(u.row0 + lr) * DE + u.col0 + wc * 32 + 8 * fq) = w; } }
    }
};

template <class Epi, class Sched, bool GATHER>
__device__ __forceinline__ void gemm_phase(LAS unsigned char* lds, const int K, const Sched& S, const Epi& E) {
    int tid = threadIdx.x; asm volatile("" : "+v"(tid));
    const int wid = __builtin_amdgcn_readfirstlane(tid >> 6), lane = tid & 63, wr = wid >> 2, wc = wid & 3;
    const int nt = K / BK;
    unsigned voffB[2], oc[2][2];
#pragma unroll
    for (int i = 0; i < 2; ++i) { int R, C; stage_rc(tid * 16 + i * 8192, R, C); const int Rb = Epi::PERM ? ((R & ~31) + perm32(R & 31)) : R;
        voffB[i] = (unsigned)(Rb * K + C) * 2u; oc[0][i] = (unsigned)(R * K + C) * 2u; oc[1][i] = oc[0][i]; }
    const size_t kstep = (size_t)(BK * 2);
    const size_t hstep = (size_t)HALF * K * 2;
    const size_t ahstep = GATHER ? (size_t)0 : hstep;
    const unsigned ldsw = (unsigned)wid * 1024u;
    const int aoff = lds_byte(wr * 64 + (lane & 15), (lane >> 4) * 8), boff = lds_byte(wc * 32 + (lane & 15), (lane >> 4) * 8);
#define PG8_SA(b, h) (((b) * 2 + (h)) * HTB)
#define PG8_SB(b, h) ((4 + (b) * 2 + (h)) * HTB)
#define PG8_STAGE(bufoff, gbase, voff) do { _Pragma("unroll") for (int _i = 0; _i < 2; ++_i) \
        __builtin_amdgcn_global_load_lds((const unsigned*)((const char*)(gbase) + (voff)[_i]), (LAS unsigned*)(lds + (bufoff) + ldsw + _i * 8192), 16, 0, 0); } while (0)
#define PG8_STAGE_A(bufoff, gbase, h) PG8_STAGE(bufoff, (gbase) + (h) * ahstep, oc[GATHER ? (h) : 0])
#define PG8_LDA(dst, b, h) do { _Pragma("unroll") for (int m = 0; m < 4; ++m) _Pragma("unroll") for (int k = 0; k < 2; ++k) dst[m][k] = *(const LAS bf16x8*)(lds + PG8_SA(b, h) + aoff + m * 2048 + k * 1024); } while (0)
#define PG8_LDB(dst, b, h) do { _Pragma("unroll") for (int n = 0; n < 2; ++n) _Pragma("unroll") for (int k = 0; k < 2; ++k) dst[n][k] = *(const LAS bf16x8*)(lds + PG8_SB(b, h) + boff + n * 2048 + k * 1024); } while (0)
#define PG8_MMA(ai, bj, At, Bt) do { __builtin_amdgcn_s_setprio(1); _Pragma("unroll") for (int m = 0; m < 4; ++m) _Pragma("unroll") for (int n = 0; n < 2; ++n) _Pragma("unroll") for (int k = 0; k < 2; ++k) \
        acc[ai][bj][m][n] = __builtin_amdgcn_mfma_f32_16x16x32_bf16(Bt[n][k], At[m][k], acc[ai][bj][m][n], 0, 0, 0); __builtin_amdgcn_s_setprio(0); } while (0)
#define PG8_WAIT_V(n) asm volatile("s_waitcnt vmcnt(" #n ")" ::: "memory")
#define PG8_WAIT_L(n) asm volatile("s_waitcnt lgkmcnt(" #n ")" ::: "memory")
#define PG8_BAR __builtin_amdgcn_s_barrier()
#define PG8_SCHED __builtin_amdgcn_sched_barrier(0)
#define PG8_LOAD_ROWOFFS(uidx) do { int tz_ = threadIdx.x; asm volatile("" : "+v"(tz_)); _Pragma("unroll") for (int _i = 0; _i < 2; ++_i) { int R_, C_; stage_rc(tz_ * 16 + _i * 8192, R_, C_); \
        oc[0][_i] = S.rowoff((uidx), R_) + (unsigned)C_ * 2u; oc[1][_i] = S.rowoff((uidx), HALF + R_) + (unsigned)C_ * 2u; } } while (0)
    Unit cur, nxt; int ui = 0;
    if (!S.next(0, cur)) return;
    if constexpr (GATHER) { PG8_LOAD_ROWOFFS(0); }
    f32x4 acc[2][2][4][2];
#pragma unroll
    for (int a = 0; a < 2; ++a)
#pragma unroll
        for (int b = 0; b < 2; ++b)
#pragma unroll
            for (int m = 0; m < 4; ++m)
#pragma unroll
                for (int n = 0; n < 2; ++n) acc[a][b][m][n] = (f32x4){0.f, 0.f, 0.f, 0.f};
    bf16x8 At[4][2], B0[2][2], B1[2][2];
    const char* cA = cur.A; const char* cB = cur.B;
    LDS_WAIT();
    PG8_STAGE(PG8_SB(0, 0), cB, voffB); PG8_STAGE(PG8_SB(0, 1), cB + hstep, voffB); PG8_STAGE_A(PG8_SA(0, 0), cA, 0); PG8_STAGE_A(PG8_SA(0, 1), cA, 1);
    if (wr == 1) PG8_BAR;
    PG8_WAIT_V(2); PG8_BAR;
    PG8_STAGE(PG8_SB(1, 0), cB + kstep, voffB); PG8_STAGE_A(PG8_SA(1, 0), cA + kstep, 0); PG8_STAGE(PG8_SB(1, 1), cB + hstep + kstep, voffB);
    PG8_WAIT_V(6); PG8_BAR;
    for (;;) {
        const bool has_next = S.next(ui + 1, nxt);
        const char* nA = has_next ? nxt.A : cA; const char* nB = has_next ? nxt.B : cB;
#pragma unroll 1
        for (int t = 0; t < nt; t += 2) {
            const bool last = (t == nt - 2);
            const char* a1 = cA + (size_t)(t + 1) * kstep;
            const char* a2 = last ? nA : cA + (size_t)(t + 2) * kstep; const char* b2 = last ? nB : cB + (size_t)(t + 2) * kstep;
            const char* a3 = a2 + kstep; const char* b3 = b2 + kstep;
            PG8_LDB(B0, 0, 0); PG8_LDB(B1, 0, 1); PG8_SCHED; PG8_LDA(At, 0, 0); PG8_STAGE_A(PG8_SA(1, 1), a1, 1);
            if constexpr (GATHER) { if (last && has_next) { PG8_LOAD_ROWOFFS(ui + 1); } }
            PG8_WAIT_V(8); PG8_WAIT_L(0); PG8_BAR; PG8_MMA(0, 0, At, B0); PG8_MMA(0, 1, At, B1); PG8_BAR; PG8_SCHED;
            PG8_LDA(At, 0, 1); PG8_STAGE(PG8_SB(0, 0), b2, voffB); PG8_STAGE(PG8_SB(0, 1), b2 + hstep, voffB); PG8_STAGE_A(PG8_SA(0, 0), a2, 0);
            PG8_WAIT_V(8); PG8_WAIT_L(0); PG8_BAR; PG8_MMA(1, 0, At, B0); PG8_MMA(1, 1, At, B1); PG8_BAR; PG8_SCHED;
            PG8_LDB(B0, 1, 0); PG8_LDB(B1, 1, 1); PG8_SCHED; PG8_LDA(At, 1, 0); PG8_STAGE_A(PG8_SA(0, 1), a2, 1);
            PG8_WAIT_V(8); PG8_WAIT_L(0); PG8_BAR; PG8_MMA(0, 0, At, B0); PG8_MMA(0, 1, At, B1); PG8_BAR; PG8_SCHED;
            PG8_LDA(At, 1, 1); PG8_STAGE(PG8_SB(1, 0), b3, voffB); PG8_STAGE(PG8_SB(1, 1), b3 + hstep, voffB); PG8_STAGE_A(PG8_SA(1, 0), a3, 0);
            PG8_WAIT_V(8); PG8_WAIT_L(0); PG8_BAR; PG8_MMA(1, 0, At, B0); PG8_MMA(1, 1, At, B1); PG8_BAR; PG8_SCHED;
        }
        if (wr == 0) PG8_BAR;
        { int tz = threadIdx.x; asm volatile("" : "+v"(tz)); E(acc, cur, wr, wc, tz & 15, (tz & 63) >> 4); }
        if (!has_next) break;
#pragma unroll
        for (int a = 0; a < 2; ++a)
#pragma unroll
            for (int b = 0; b < 2; ++b)
#pragma unroll
                for (int m = 0; m < 4; ++m)
#pragma unroll
                    for (int n = 0; n < 2; ++n) acc[a][b][m][n] = (f32x4){0.f, 0.f, 0.f, 0.f};
        cur = nxt; cA = nA; cB = nB; ++ui;
        if (wr == 1) PG8_BAR;
    }
    PG8_WAIT_V(0);
    PG8_BAR;
#undef PG8_SA
#undef PG8_SB
#undef PG8_STAGE
#undef PG8_STAGE_A
#undef PG8_LOAD_ROWOFFS
#undef PG8_LDA
#undef PG8_LDB
#undef PG8_MMA
#undef PG8_WAIT_V
#undef PG8_WAIT_L
#undef PG8_BAR
#undef PG8_SCHED
}
}

#define XB_TMO      128
#define XB_XCNT(j)  (256  + 64 * (j))
#define XB_XSUB(j)  (1280 + 64 * (j))
#define XB_XGEN(j)  (2304 + 64 * (j))
#define XB_TOP      3328
#define XB_TOPGEN   3392
#define XCD_BAR_WORDS 3456
#define XB_SPIN_CAP (1u << 18)
__device__ __forceinline__ unsigned xb_ld(unsigned* p)              { return __hip_atomic_load(p, __ATOMIC_RELAXED, __HIP_MEMORY_SCOPE_AGENT); }
__device__ __forceinline__ unsigned xb_add(unsigned* p, unsigned v) { return __hip_atomic_fetch_add(p, v, __ATOMIC_RELAXED, __HIP_MEMORY_SCOPE_AGENT); }
__device__ __forceinline__ unsigned xb_xcc_id() { return (unsigned)__builtin_amdgcn_s_getreg((3 << 11) | 20) & 0xFu; }
#define XB_SPIN(cond, bar) do { unsigned _sp = 0; while (cond) { __builtin_amdgcn_s_sleep(1); \
    if ((++_sp & 255u) == 0u) { if (xb_ld(&(bar)[XB_TMO])) break; if (_sp > XB_SPIN_CAP) { atomicAdd(&(bar)[XB_TMO], 1u); break; } } } } while (0)
struct XcdBarrier { unsigned* bar; unsigned x; volatile LAS unsigned* st; };
__device__ __forceinline__ XcdBarrier xcd_barrier_post(unsigned* bar, volatile LAS unsigned* st) {
    XcdBarrier b; b.bar = bar; b.x = xb_xcc_id(); b.st = st;
    if (threadIdx.x == 0) (void)xb_add(&bar[XB_XCNT(b.x)], 1u);
    return b;
}
__device__ __forceinline__ void xcd_barrier_complete(unsigned* bar, unsigned x, unsigned& nloc, unsigned& nx) {
    const unsigned G = gridDim.x * gridDim.y * gridDim.z;
    unsigned sum, cnt, mine, sp = 0u;
    for (;;) {
        sum = 0u; cnt = 0u; mine = 0u;
#pragma unroll 1
        for (unsigned j = 0; j < 16; ++j) { const unsigned c = xb_ld(&bar[XB_XCNT(j)]); sum += c; cnt += (c > 0u) ? 1u : 0u; mine = (j == x) ? c : mine; }
        if (sum == G) break;
        __builtin_amdgcn_s_sleep(1);
        if ((++sp & 255u) == 0u) { if (xb_ld(&bar[XB_TMO])) break; if (sp > XB_SPIN_CAP) { atomicAdd(&bar[XB_TMO], 1u); break; } }
    }
    nloc = mine > 0u ? mine : 1u; nx = cnt > 0u ? cnt : 1u;
}
__device__ __forceinline__ void xcd_barrier(const XcdBarrier& b) {
    asm volatile("s_waitcnt vmcnt(0)" ::: "memory");
    __syncthreads();
    if (threadIdx.x == 0) {
        unsigned* bar = b.bar;
        __builtin_amdgcn_s_waitcnt(0);
        unsigned nloc = b.st[0], nx = b.st[1];
        if (nloc == 0u) { xcd_barrier_complete(bar, b.x, nloc, nx); b.st[0] = nloc; b.st[1] = nx; }
        const unsigned old = xb_add(&bar[XB_XSUB(b.x)], 1u);
        const unsigned gen = old / nloc;
        if (old + 1u == (gen + 1u) * nloc) {
            __builtin_amdgcn_fence(__ATOMIC_RELEASE, "agent");
            asm volatile("s_waitcnt vmcnt(0)" ::: "memory");
            const unsigned og = xb_add(&bar[XB_TOP], 1u);
            const unsigned tg = og / nx;
            if (og + 1u == (tg + 1u) * nx) xb_add(&bar[XB_TOPGEN], 1u);
            else XB_SPIN(xb_ld(&bar[XB_TOPGEN]) == tg, bar);
            __builtin_amdgcn_fence(__ATOMIC_ACQUIRE, "agent");
            xb_add(&bar[XB_XGEN(b.x)], 1u);
            asm volatile("s_waitcnt vmcnt(0)" ::: "memory");
        } else {
            XB_SPIN(xb_ld(&bar[XB_XGEN(b.x)]) == gen, bar);
            __builtin_amdgcn_fence(__ATOMIC_ACQUIRE, "agent");
            asm volatile("s_waitcnt vmcnt(0)" ::: "memory");
        }
    }
    __syncthreads();
}

struct Args { const float* in[29]; float* out; unsigned char* ws; int ph_lo, ph_hi; };
enum { I_X = 0, I_MEM, I_MEM_G, I_MEM_B, I_W_IN, I_SGU_G, I_SGU_B, I_SGU_W, I_SGU_BS, I_POOL_W, I_POOL_S, I_CONV_W, I_CONV_B, I_CONV_G, I_CONV_LB, I_W_KV, I_W_OUT, I_LN1_G, I_LN1_B,
       I_W_R, I_R_BIAS, I_E_G, I_E_U, I_E_D, I_S_G, I_S_U, I_S_D, I_LN2_G, I_LN2_B };

struct Frame {
    LAS unsigned char* lds;
    int tid, lane, wave, vcu, G;
    const Args* a;
    unsigned char* ws;
};

struct ItemDesc { const float* W; bf16_t* WT; bf16_t* WL; int ldw, ldt, k0, n0, drow0; };
constexpr int LI_IN = 3072, LI_OUT = 2048, LI_EX = 64 * 256, LI_SH = 256, LI_PW = 4 * 8, LI_RT = 64;
constexpr int L_ITEMS = LI_IN + LI_OUT + 3 * LI_EX + 3 * LI_SH + LI_PW + LI_RT;
constexpr int KV_ITEMS = 4 * 1024;
constexpr int LI_X = 3 * LI_EX + 3 * LI_SH, LI_S = L_ITEMS - LI_X;
constexpr int Q_TOTAL = NL * L_ITEMS - LI_S;
constexpr int CW_Q = 8192;
constexpr int Q_CH = 8;
__device__ __forceinline__ ItemDesc item_desc(const Args& A, unsigned char* ws, int l, int r) {
    bf16_t* WT_IN = (bf16_t*)(ws + WS_WT_IN); bf16_t* WT_OUT = (bf16_t*)(ws + WS_WT_OUT);
    bf16_t* WT_GU = (bf16_t*)(ws + WS_WT_GU); bf16_t* WT_D = (bf16_t*)(ws + WS_WT_D); bf16_t* WPT = (bf16_t*)(ws + WS_WPT);
    ItemDesc d; d.WL = nullptr;
    if (r < LI_IN) { const int kb = r / 96, nb = r % 96; d.W = A.in[I_W_IN] + (size_t)l * D * INW; d.ldw = INW; d.WT = WT_IN + (size_t)l * INW * D; d.ldt = D; d.k0 = kb * 64; d.n0 = nb * 32; d.drow0 = nb * 32; return d; } r -= LI_IN;
    if (r < LI_OUT) { const int kb = r / 64, nb = r % 64; d.W = A.in[I_W_OUT] + (size_t)l * D * D; d.ldw = D; d.WT = WT_OUT + (size_t)l * D * D; d.ldt = D; d.k0 = kb * 64; d.n0 = nb * 32; d.drow0 = nb * 32; return d; } r -= LI_OUT;
    if (r < 2 * LI_EX) { const int up = r >= LI_EX; if (up) r -= LI_EX; const int e = r / 256, rem = r % 256, kb = rem / 8, nb = rem % 8, n0 = nb * 32;
        d.W = A.in[up ? I_E_U : I_E_G] + (size_t)(l * NE + e) * D * DE; d.ldw = DE; d.WT = WT_GU + (size_t)(l * NE1 + e) * 512 * D; d.ldt = D; d.k0 = kb * 64; d.n0 = n0; d.drow0 = (n0 >> 7) * 256 + up * 128 + (n0 & 127); return d; } r -= 2 * LI_EX;
    if (r < LI_EX) { const int e = r / 256, rem = r % 256, kb = rem / 64, nb = rem % 64;
        d.W = A.in[I_E_D] + (size_t)(l * NE + e) * DE * D; d.ldw = D; d.WT = WT_D + (size_t)(l * NE1 + e) * D * DE; d.ldt = DE; d.k0 = kb * 64; d.n0 = nb * 32; d.drow0 = nb * 32; return d; } r -= LI_EX;
    if (r < 2 * LI_SH) { const int up = r >= LI_SH; if (up) r -= LI_SH; const int kb = r / 8, nb = r % 8, n0 = nb * 32;
        d.W = A.in[up ? I_S_U : I_S_G] + (size_t)l * D * DE; d.ldw = DE; d.WT = WT_GU + (size_t)(l * NE1 + 64) * 512 * D; d.ldt = D; d.k0 = kb * 64; d.n0 = n0; d.drow0 = (n0 >> 7) * 256 + up * 128 + (n0 & 127); return d; } r -= 2 * LI_SH;
    if (r < LI_SH) { const int kb = r / 64, nb = r % 64; d.W = A.in[I_S_D] + (size_t)l * DE * D; d.ldw = D; d.WT = WT_D + (size_t)(l * NE1 + 64) * D * DE; d.ldt = DE; d.k0 = kb * 64; d.n0 = nb * 32; d.drow0 = nb * 32; return d; } r -= LI_SH;
    if (r < LI_PW) { const int g = r / 8, rem = r % 8, kb = rem / 4, nb = rem % 4; d.W = A.in[I_POOL_W] + (size_t)(l * 4 + g) * 128 * 128; d.ldw = 128; d.WT = WPT + (size_t)(l * 4 + g) * 128 * 128; d.ldt = 128; d.k0 = kb * 64; d.n0 = nb * 32; d.drow0 = nb * 32; return d; } r -= LI_PW;
    { const int kb = r / 2, nb = r % 2; d.W = A.in[I_W_R] + (size_t)l * D * NE; d.ldw = NE; d.WT = (bf16_t*)(ws + WS_WR_HI) + (size_t)l * NE * D; d.WL = (bf16_t*)(ws + WS_WR_LO) + (size_t)l * NE * D; d.ldt = D; d.k0 = kb * 64; d.n0 = nb * 32; d.drow0 = nb * 32; return d; }
}
__device__ __forceinline__ ItemDesc kv_desc(const Args& A, unsigned char* ws, int r) {
    const int mat = r / 1024, rem = r % 1024, kb = rem / 32, nb = rem % 32, n0 = nb * 32; ItemDesc d; d.WL = nullptr;
    d.W = A.in[I_W_KV] + (size_t)mat * D * 1024; d.ldw = 1024; d.WT = (bf16_t*)(ws + (n0 < 512 ? WS_WT_K : WS_WT_V)); d.ldt = D; d.k0 = kb * 64; d.n0 = n0; d.drow0 = mat * 512 + (n0 & 511); return d;
}
__device__ __forceinline__ void item_load(const ItemDesc& d, f32x4 (&v)[8], int lane) {
#pragma unroll
    for (int i = 0; i < 8; ++i) v[i] = __builtin_nontemporal_load((const f32x4*)(d.W + (size_t)(d.k0 + 8 * i + (lane >> 3)) * d.ldw + d.n0 + 4 * (lane & 7)));
}
__device__ __forceinline__ void item_finish(const ItemDesc& d, const f32x4 (&v)[8], LAS float* scr, int lane) {
#pragma unroll
    for (int i = 0; i < 8; ++i) { LAS float* p = scr + (8 * i + (lane >> 3)) * 33 + 4 * (lane & 7); p[0] = v[i][0]; p[1] = v[i][1]; p[2] = v[i][2]; p[3] = v[i][3]; }
    LDS_WAIT(); asm volatile("" ::: "memory");
    const int c = lane & 7;
#pragma unroll
    for (int j = 0; j < 4; ++j) { const int n = (lane >> 3) + 8 * j; const LAS float* s = scr + (8 * c) * 33 + n;
        float x[8]; unsigned h[4];
#pragma unroll
        for (int q = 0; q < 8; ++q) x[q] = s[q * 33];
#pragma unroll
        for (int q = 0; q < 4; ++q) h[q] = cvt_pk_bf16(x[2 * q], x[2 * q + 1]);
        __builtin_nontemporal_store((u32x4){h[0], h[1], h[2], h[3]}, (u32x4*)(d.WT + (size_t)(d.drow0 + n) * d.ldt + d.k0 + 8 * c));
        if (d.WL) { unsigned lo[4];
#pragma unroll
            for (int q = 0; q < 4; ++q) lo[q] = cvt_pk_bf16(x[2 * q] - bf_lo(h[q]), x[2 * q + 1] - bf_hi(h[q]));
            *(u32x4*)(d.WL + (size_t)(d.drow0 + n) * d.ldt + d.k0 + 8 * c) = (u32x4){lo[0], lo[1], lo[2], lo[3]}; } }
    LDS_WAIT(); asm volatile("" ::: "memory");
}
__device__ __forceinline__ int s_item(int s) { return s < LI_IN + LI_OUT ? s : s + LI_X; }
struct GenPrologue { __device__ __forceinline__ ItemDesc operator()(const Args& A, unsigned char* ws, int id) const { return id < LI_S ? item_desc(A, ws, 0, s_item(id)) : kv_desc(A, ws, id - LI_S); } };
struct GenQueue    { __device__ __forceinline__ ItemDesc operator()(const Args& A, unsigned char* ws, int id) const { const int l = id / L_ITEMS, j = id % L_ITEMS;
    return j < LI_X ? item_desc(A, ws, l, LI_IN + LI_OUT + j) : item_desc(A, ws, l + 1, s_item(j - LI_X)); } };
template <class Gen> __device__ __forceinline__ void convert_seq(const Args& A, unsigned char* ws, int first, int end, int stride, LAS float* scr, int lane) {
    if (first >= end) return;
    const Gen gen; ItemDesc d0 = gen(A, ws, first); f32x4 v0[8]; item_load(d0, v0, lane);
#pragma unroll 1
    for (int id = first + stride; id < end; id += stride) { const ItemDesc d1 = gen(A, ws, id); f32x4 v1[8]; item_load(d1, v1, lane); item_finish(d0, v0, scr, lane); d0 = d1;
#pragma unroll
        for (int i = 0; i < 8; ++i) v0[i] = v1[i]; }
    item_finish(d0, v0, scr, lane);
}
__device__ __forceinline__ void convert_fill(Frame& F, int floor, int budget) {
    const Args& A = *F.a; LAS float* scr = (LAS float*)(F.lds + F.wave * 16384);
    unsigned* qh = (unsigned*)(F.ws + WS_CTL) + CW_Q;
#pragma unroll 1
    for (int b = 0; b < budget; ++b) {
        unsigned st = 0u; if (F.lane == 0) st = __hip_atomic_fetch_add(qh, (unsigned)Q_CH, __ATOMIC_RELAXED, __HIP_MEMORY_SCOPE_AGENT);
        const int s0 = __builtin_amdgcn_readfirstlane((int)st);
        if (s0 >= Q_TOTAL) break;
        const int lo = s0 > floor ? s0 : floor, hi = (s0 + Q_CH) < Q_TOTAL ? (s0 + Q_CH) : Q_TOTAL;
        if (lo >= hi) { ++budget; if (budget > (1 << 20)) break; continue; }
        convert_seq<GenQueue>(A, F.ws, lo, hi, 1, scr, F.lane);
    }
}
__device__ __forceinline__ void convert_cleanup(Frame& F, int from, int upto) {
    const Args& A = *F.a; LAS float* scr = (LAS float*)(F.lds + F.wave * 16384);
    unsigned* qh = (unsigned*)(F.ws + WS_CTL) + CW_Q;
    int head = __builtin_amdgcn_readfirstlane((int)__hip_atomic_load(qh, __ATOMIC_RELAXED, __HIP_MEMORY_SCOPE_AGENT)); head = head > from ? head : from;
    convert_seq<GenQueue>(A, F.ws, head + F.vcu * 8 + F.wave, upto, F.G * 8, scr, F.lane);
}

__device__ __forceinline__ void convert_beside_d(Frame& F, int from, int upto) {
    const Args& A = *F.a; LAS float* scr = (LAS float*)(F.lds + 81920 + (F.wave - 4) * 8704);
    unsigned* qh = (unsigned*)(F.ws + WS_CTL) + CW_Q;
    int head = __builtin_amdgcn_readfirstlane((int)__hip_atomic_load(qh, __ATOMIC_RELAXED, __HIP_MEMORY_SCOPE_AGENT)); head = head > from ? head : from;
    convert_seq<GenQueue>(A, F.ws, head + F.vcu * 4 + (F.wave - 4), upto, F.G * 4, scr, F.lane);
}
__device__ __forceinline__ void p0_prologue(Frame& F) {
    const Args& A = *F.a; unsigned char* ws = F.ws;
    LAS float* scr = (LAS float*)(F.lds + F.wave * 16384);
    const int gw = F.vcu * 8 + F.wave, NGW = F.G * 8, lane = F.lane;
    convert_seq<GenPrologue>(A, ws, gw, LI_S + KV_ITEMS, NGW, scr, lane);
    { const int gt = F.vcu * 512 + F.tid, NGT = F.G * 512; bf16_t* SW = (bf16_t*)(ws + WS_SGUW);
      for (int i = gt; i < NL * 4 * 128 * 128 / 8; i += NGT) { const int t = (i >> 4) & 127, s0 = (i & 15) * 8; const f32x4* p = (const f32x4*)(A.in[I_SGU_W] + (size_t)i * 8); const f32x4 a = p[0], b = p[1];
          float v[8] = {a[0], a[1], a[2], a[3], b[0], b[1], b[2], b[3]};
#pragma unroll
          for (int q = 0; q < 8; ++q) v[q] = (s0 + q <= t) ? v[q] : 0.f;
          *(u32x4*)(SW + (size_t)i * 8) = (u32x4){cvt_pk_bf16(v[0], v[1]), cvt_pk_bf16(v[2], v[3]), cvt_pk_bf16(v[4], v[5]), cvt_pk_bf16(v[6], v[7])}; }
      bf16_t* XB = (bf16_t*)(ws + WS_XB);
      for (int i = gt; i < NTOK * D / 8; i += NGT) { const f32x4* p = (const f32x4*)(A.in[I_X] + (size_t)i * 8); const f32x4 a = p[0], b = p[1];
          *(u32x4*)(XB + (size_t)i * 8) = (u32x4){cvt_pk_bf16(a[0], a[1]), cvt_pk_bf16(a[2], a[3]), cvt_pk_bf16(b[0], b[1]), cvt_pk_bf16(b[2], b[3])}; } }
    if (F.vcu == 0 && F.tid < 256) *(u32x4*)((bf16_t*)(ws + WS_X1B) + (size_t)NTOK * D + F.tid * 8) = (u32x4){0u, 0u, 0u, 0u};
    { bf16_t* MN = (bf16_t*)(ws + WS_MEMN);
      for (int m = gw; m < NMEMTOK; m += NGW) { const f32x4* xr = (const f32x4*)(A.in[I_MEM] + (size_t)m * D) + lane; f32x4 v[8]; float s = 0.f;
#pragma unroll
          for (int j = 0; j < 8; ++j) { v[j] = xr[64 * j]; s += (v[j][0] + v[j][1]) + (v[j][2] + v[j][3]); }
          const float mean = wave_sum(s) * (1.f / D); float s2 = 0.f;
#pragma unroll
          for (int j = 0; j < 8; ++j) { v[j] = v[j] - mean; s2 += (v[j][0] * v[j][0] + v[j][1] * v[j][1]) + (v[j][2] * v[j][2] + v[j][3] * v[j][3]); }
          const float rstd = 1.f / sqrtf(wave_sum(s2) * (1.f / D) + LN_EPS);
#pragma unroll
          for (int j = 0; j < 8; ++j) { const f32x4 g = ((const f32x4*)A.in[I_MEM_G])[lane + 64 * j], b = ((const f32x4*)A.in[I_MEM_B])[lane + 64 * j]; const f32x4 o = v[j] * rstd * g + b;
              *(u32x2*)(MN + (size_t)m * D + 4 * lane + 256 * j) = (u32x2){cvt_pk_bf16(o[0], o[1]), cvt_pk_bf16(o[2], o[3])}; } } }
}

typedef f32x4 acc8_t[8];
__device__ __forceinline__ void mixer_sgu(Frame& F, int l, int chunk, int h) {
    const Args& A = *F.a; const int lane = F.lane, w = F.wave, fr = lane & 15, g = lane >> 4, t0 = chunk * 128;
    const bf16_t* HB = (const bf16_t*)(F.ws + WS_HB); bf16_t* MIX = (bf16_t*)(F.ws + WS_MIX); const bf16_t* SW = (const bf16_t*)(F.ws + WS_SGUW) + (size_t)(l * 4 + h) * 128 * 128;
    LAS unsigned char* VT = F.lds;
    const int t = 16 * w + fr;
    bf16x8 af[4]; u32x2 uraw[8];
#pragma unroll
    for (int ks = 0; ks < 4; ++ks) af[ks] = *(const bf16x8*)(SW + (size_t)t * 128 + 32 * ks + 8 * g);
#pragma unroll
    for (int j = 0; j < 8; ++j) uraw[j] = *(const u32x2*)(HB + (size_t)(t0 + t) * INW + h * 128 + 16 * j + 4 * g);
    const float bs = A.in[I_SGU_BS][(size_t)(l * 128 + t) * 4 + h];
    { const float* gp = A.in[I_SGU_G] + l * GW + h * 128 + 8 * fr; const float* bp = A.in[I_SGU_B] + l * GW + h * 128 + 8 * fr;
      const f32x4 g0 = *(const f32x4*)gp, g1 = *(const f32x4*)(gp + 4), b0 = *(const f32x4*)bp, b1 = *(const f32x4*)(bp + 4);
      const float gg[8] = {g0[0], g0[1], g0[2], g0[3], g1[0], g1[1], g1[2], g1[3]}, bb[8] = {b0[0], b0[1], b0[2], b0[3], b1[0], b1[1], b1[2], b1[3]};
      u32x4 raw[4];
#pragma unroll
      for (int p = 0; p < 4; ++p) raw[p] = *(const u32x4*)(HB + (size_t)(t0 + 16 * w + 4 * p + g) * INW + 512 + h * 128 + 8 * fr);
#pragma unroll
      for (int p = 0; p < 4; ++p) { const int tok = 16 * w + 4 * p + g;
          float v[8] = {bf_lo(raw[p].x), bf_hi(raw[p].x), bf_lo(raw[p].y), bf_hi(raw[p].y), bf_lo(raw[p].z), bf_hi(raw[p].z), bf_lo(raw[p].w), bf_hi(raw[p].w)}; float s = 0.f;
#pragma unroll
          for (int q = 0; q < 8; ++q) { v[q] = gelu_tanh_f(v[q]); s += v[q]; }
          const float mean = g16_sum(s) * (1.f / 128.f); float s2 = 0.f;
#pragma unroll
          for (int q = 0; q < 8; ++q) { v[q] -= mean; s2 += v[q] * v[q]; }
          const float rstd = 1.f / sqrtf(g16_sum(s2) * (1.f / 128.f) + LN_EPS);
#pragma unroll
          for (int q = 0; q < 8; q += 2) { const unsigned pk = cvt_pk_bf16(v[q] * rstd * gg[q] + bb[q], v[q + 1] * rstd * gg[q + 1] + bb[q + 1]);
              const int d0 = 8 * fr + q, d1 = d0 + 1;
              *(LAS bf16_t*)(VT + d0 * 256 + ((((tok >> 3) ^ d0 ^ (d0 >> 3)) & 15) << 4) + (tok & 7) * 2) = (bf16_t)(pk & 0xffffu);
              *(LAS bf16_t*)(VT + d1 * 256 + ((((tok >> 3) ^ d1 ^ (d1 >> 3)) & 15) << 4) + (tok & 7) * 2) = (bf16_t)(pk >> 16); } } }
    __syncthreads();
    f32x4 acc[8];
#pragma unroll
    for (int j = 0; j < 8; ++j) acc[j] = (f32x4){0.f, 0.f, 0.f, 0.f};
    const int nks = (w >> 1) + 1;
#pragma unroll
    for (int ks = 0; ks < 4; ++ks) if (ks < nks) {
#pragma unroll
        for (int j = 0; j < 8; ++j) { const int d = 16 * j + fr; const bf16x8 bfr = *(const LAS bf16x8*)(VT + d * 256 + ((((4 * ks + g) ^ d ^ (d >> 3)) & 15) << 4));
            acc[j] = __builtin_amdgcn_mfma_f32_16x16x32_bf16(bfr, af[ks], acc[j], 0, 0, 0); }
    }
#pragma unroll
    for (int j = 0; j < 8; ++j) { const u32x2 raw = uraw[j];
        const float u0 = gelu_tanh_f(bf_lo(raw.x)), u1 = gelu_tanh_f(bf_hi(raw.x)), u2 = gelu_tanh_f(bf_lo(raw.y)), u3 = gelu_tanh_f(bf_hi(raw.y));
        *(u32x2*)(MIX + (size_t)(t0 + t) * D + h * 128 + 16 * j + 4 * g) = (u32x2){cvt_pk_bf16(u0 * (acc[j][0] + bs), u1 * (acc[j][1] + bs)), cvt_pk_bf16(u2 * (acc[j][2] + bs), u3 * (acc[j][3] + bs))}; }
    __syncthreads();
}
__device__ __forceinline__ void mixer_pool(Frame& F, int l, int chunk, int grp) {
    const Args& A = *F.a; const int lane = F.lane, w = F.wave, fr = lane & 15, g = lane >> 4, t0 = chunk * 128, tid = F.tid;
    const bf16_t* HB = (const bf16_t*)(F.ws + WS_HB); bf16_t* MIX = (bf16_t*)(F.ws + WS_MIX); const bf16_t* WP = (const bf16_t*)(F.ws + WS_WPT) + (size_t)(l * 4 + grp) * 128 * 128;
    constexpr int PST = 272;
    LAS unsigned char* PT = F.lds;
    LAS unsigned char* PA = F.lds + 144 * PST;
    const int win = 2 << grp, pos0 = t0 & (SEQ - 1);
    LAS unsigned char* WS = F.lds + 144 * PST + 128 * PST;
    { u32x4 wv4[4];
#pragma unroll
      for (int i = 0; i < 4; ++i) wv4[i] = *(const u32x4*)(WP + (size_t)(tid + 512 * i) * 8);
      for (int i = tid; i < 144 * 16; i += 512) { const int r = i >> 4, cc = i & 15; const int trow = t0 - 16 + r; u32x4 v = (u32x4){0u, 0u, 0u, 0u};
          if (pos0 - 16 + r >= 0) v = *(const u32x4*)(HB + (size_t)trow * INW + 1024 + grp * 128 + 8 * cc);
          *(LAS u32x4*)(PT + r * PST + cc * 16) = v; }
#pragma unroll
      for (int i = 0; i < 4; ++i) { const int id = tid + 512 * i, d = id >> 4, cc = id & 15; *(LAS u32x4*)(WS + d * 256 + ((cc ^ (d & 15)) << 4)) = wv4[i]; } }
    f32x4 scv[8];
#pragma unroll
    for (int j = 0; j < 8; ++j) scv[j] = *(const f32x4*)(A.in[I_POOL_S] + l * GW + grp * 128 + 16 * j + 4 * g);
    __syncthreads();
    for (int i = tid; i < 128 * 16; i += 512) { const int t = i >> 4, cc = i & 15; float s[8] = {0.f, 0.f, 0.f, 0.f, 0.f, 0.f, 0.f, 0.f}; u32x4 cur = (u32x4){0u, 0u, 0u, 0u};
        for (int j = 0; j < win; ++j) { cur = *(const LAS u32x4*)(PT + (t + 16 - win + 1 + j) * PST + cc * 16);
            s[0] += bf_lo(cur.x); s[1] += bf_hi(cur.x); s[2] += bf_lo(cur.y); s[3] += bf_hi(cur.y); s[4] += bf_lo(cur.z); s[5] += bf_hi(cur.z); s[6] += bf_lo(cur.w); s[7] += bf_hi(cur.w); }
        const int pos = pos0 + t; const float inv = 1.0f / (float)((pos + 1) < win ? (pos + 1) : win);
        const float x[8] = {bf_lo(cur.x), bf_hi(cur.x), bf_lo(cur.y), bf_hi(cur.y), bf_lo(cur.z), bf_hi(cur.z), bf_lo(cur.w), bf_hi(cur.w)};
        *(LAS u32x4*)(PA + t * PST + cc * 16) = (u32x4){cvt_pk_bf16(s[0] * inv - x[0], s[1] * inv - x[1]), cvt_pk_bf16(s[2] * inv - x[2], s[3] * inv - x[3]),
                                                        cvt_pk_bf16(s[4] * inv - x[4], s[5] * inv - x[5]), cvt_pk_bf16(s[6] * inv - x[6], s[7] * inv - x[7])}; }
    __syncthreads();
    f32x4 acc[8];
#pragma unroll
    for (int j = 0; j < 8; ++j) acc[j] = (f32x4){0.f, 0.f, 0.f, 0.f};
#pragma unroll
    for (int ks = 0; ks < 4; ++ks) { const bf16x8 af = *(const LAS bf16x8*)(PA + (16 * w + fr) * PST + (32 * ks + 8 * g) * 2);
#pragma unroll
        for (int j = 0; j < 8; ++j) { const bf16x8 bfr = *(const LAS bf16x8*)(WS + (16 * j + fr) * 256 + (((4 * ks + g) ^ fr) << 4));
            acc[j] = __builtin_amdgcn_mfma_f32_16x16x32_bf16(bfr, af, acc[j], 0, 0, 0); } }
    { const int t = 16 * w + fr;
#pragma unroll
      for (int j = 0; j < 8; ++j) { const f32x4 sc = scv[j];
          *(u32x2*)(MIX + (size_t)(t0 + t) * D + 512 + grp * 128 + 16 * j + 4 * g) = (u32x2){cvt_pk_bf16(acc[j][0] * sc[0], acc[j][1] * sc[1]), cvt_pk_bf16(acc[j][2] * sc[2], acc[j][3] * sc[3])}; } }
    __syncthreads();
}
__device__ __forceinline__ void mixer_conv(Frame& F, int l, int chunk, int grp) {
    const Args& A = *F.a; const int lane = F.lane, w = F.wave, fr = lane & 15, g = lane >> 4, t0 = chunk * 128, tid = F.tid;
    const bf16_t* HB = (const bf16_t*)(F.ws + WS_HB); bf16_t* MIX = (bf16_t*)(F.ws + WS_MIX);
    LAS float* GT = (LAS float*)F.lds;
    const int pos0 = t0 & (SEQ - 1);
    for (int i = tid; i < 158 * 16; i += 512) { const int r = i >> 4, cc = i & 15; float o[8] = {0.f, 0.f, 0.f, 0.f, 0.f, 0.f, 0.f, 0.f};
        if (pos0 - 30 + r >= 0) { const bf16_t* rowp = HB + (size_t)(t0 - 30 + r) * INW + grp * 128 + 8 * cc; const u32x4 v = *(const u32x4*)(rowp + 1536), gt = *(const u32x4*)(rowp + 2048);
            o[0] = bf_lo(v.x) * fast_sigmoid(bf_lo(gt.x)); o[1] = bf_hi(v.x) * fast_sigmoid(bf_hi(gt.x)); o[2] = bf_lo(v.y) * fast_sigmoid(bf_lo(gt.y)); o[3] = bf_hi(v.y) * fast_sigmoid(bf_hi(gt.y));
            o[4] = bf_lo(v.z) * fast_sigmoid(bf_lo(gt.z)); o[5] = bf_hi(v.z) * fast_sigmoid(bf_hi(gt.z)); o[6] = bf_lo(v.w) * fast_sigmoid(bf_lo(gt.w)); o[7] = bf_hi(v.w) * fast_sigmoid(bf_hi(gt.w)); }
        *(LAS f32x4*)(GT + r * 128 + 8 * cc) = (f32x4){o[0], o[1], o[2], o[3]}; *(LAS f32x4*)(GT + r * 128 + 8 * cc + 4) = (f32x4){o[4], o[5], o[6], o[7]}; }
    __syncthreads();
    float y[32];
    { const int ch = tid & 127, tg = tid >> 7; float wv[31];
#pragma unroll
      for (int j = 0; j < 31; ++j) wv[j] = A.in[I_CONV_W][(size_t)(l * 31 + j) * GW + grp * 128 + ch];
      const float bias = A.in[I_CONV_B][l * GW + grp * 128 + ch];
      float xin[62];
#pragma unroll
      for (int j = 0; j < 62; ++j) xin[j] = GT[(tg * 32 + j) * 128 + ch];
#pragma unroll
      for (int t = 0; t < 32; ++t) { float s = bias;
#pragma unroll
          for (int j = 0; j < 31; ++j) s += wv[j] * xin[t + j];
          y[t] = s; }
      __syncthreads();
#pragma unroll
      for (int t = 0; t < 32; ++t) GT[(tg * 32 + t) * 128 + ch] = y[t]; }
    __syncthreads();
    { const float* gp = A.in[I_CONV_G] + l * GW + grp * 128 + 8 * fr; const float* bp = A.in[I_CONV_LB] + l * GW + grp * 128 + 8 * fr;
      const f32x4 g0 = *(const f32x4*)gp, g1 = *(const f32x4*)(gp + 4), b0 = *(const f32x4*)bp, b1 = *(const f32x4*)(bp + 4);
      const float gg[8] = {g0[0], g0[1], g0[2], g0[3], g1[0], g1[1], g1[2], g1[3]}, bb[8] = {b0[0], b0[1], b0[2], b0[3], b1[0], b1[1], b1[2], b1[3]};
#pragma unroll
      for (int p = 0; p < 4; ++p) { const int tok = 16 * w + 4 * p + g; const f32x4 a = *(const LAS f32x4*)(GT + tok * 128 + 8 * fr), b = *(const LAS f32x4*)(GT + tok * 128 + 8 * fr + 4);
          float v[8] = {a[0], a[1], a[2], a[3], b[0], b[1], b[2], b[3]}; float s = 0.f;
#pragma unroll
          for (int q = 0; q < 8; ++q) s += v[q];
          const float mean = g16_sum(s) * (1.f / 128.f); float s2 = 0.f;
#pragma unroll
          for (int q = 0; q < 8; ++q) { v[q] -= mean; s2 += v[q] * v[q]; }
          const float rstd = 1.f / sqrtf(g16_sum(s2) * (1.f / 128.f) + LN_EPS);
#pragma unroll
          for (int q = 0; q < 8; ++q) v[q] = silu_f(v[q] * rstd * gg[q] + bb[q]);
          *(u32x4*)(MIX + (size_t)(t0 + tok) * D + 1024 + grp * 128 + 8 * fr) = (u32x4){cvt_pk_bf16(v[0], v[1]), cvt_pk_bf16(v[2], v[3]), cvt_pk_bf16(v[4], v[5]), cvt_pk_bf16(v[6], v[7])}; } }
    __syncthreads();
}
__device__ __forceinline__ void mixer_attn(Frame& F, int l, int chunk, int h) {
    const int lane = F.lane, w = F.wave, fr = lane & 15, g = lane >> 4, t0 = chunk * 128, b = t0 / SEQ, tid = F.tid;
    const bf16_t* HB = (const bf16_t*)(F.ws + WS_HB); bf16_t* MIX = (bf16_t*)(F.ws + WS_MIX);
    const bf16_t* KB = (const bf16_t*)(F.ws + WS_KBUF) + (size_t)(b * 256) * D + l * 512 + h * 128;
    const bf16_t* VTp = (const bf16_t*)(F.ws + WS_VT) + (size_t)(l * 512 + h * 128) * NMEMTOK + b * 256;
    LAS unsigned char* KS = F.lds;
    LAS unsigned char* VS = F.lds + 65536;
    { u32x4 kv[8], vv[8];
#pragma unroll
      for (int i = 0; i < 8; ++i) { const int id = tid + 512 * i; kv[i] = *(const u32x4*)(KB + (size_t)(id >> 4) * D + (id & 15) * 8); vv[i] = *(const u32x4*)(VTp + (size_t)(id >> 5) * NMEMTOK + (id & 31) * 8); }
#pragma unroll
      for (int i = 0; i < 8; ++i) { const int id = tid + 512 * i; const int m = id >> 4, c = id & 15, d = id >> 5, c2 = id & 31;
          *(LAS u32x4*)(KS + m * 256 + ((c ^ (m & 15)) << 4)) = kv[i]; *(LAS u32x4*)(VS + d * 512 + ((c2 ^ (d & 15)) << 4)) = vv[i]; } }
    __syncthreads();
    const int t = 16 * w + fr;
    f32x4 sa[16];
#pragma unroll
    for (int j = 0; j < 16; ++j) sa[j] = (f32x4){0.f, 0.f, 0.f, 0.f};
    bf16x8 qf[4];
#pragma unroll
    for (int ks = 0; ks < 4; ++ks) qf[ks] = *(const bf16x8*)(HB + (size_t)(t0 + t) * INW + 2560 + h * 128 + 32 * ks + 8 * g);
#pragma unroll
    for (int ks = 0; ks < 4; ++ks)
#pragma unroll
        for (int j = 0; j < 16; ++j) { const bf16x8 kf = *(const LAS bf16x8*)(KS + (16 * j + fr) * 256 + (((4 * ks + g) ^ fr) << 4));
            sa[j] = __builtin_amdgcn_mfma_f32_16x16x32_bf16(kf, qf[ks], sa[j], 0, 0, 0); }
    float mx = -3.0e38f;
#pragma unroll
    for (int j = 0; j < 16; ++j) mx = fmaxf(mx, fmaxf(fmaxf(sa[j][0], sa[j][1]), fmaxf(sa[j][2], sa[j][3])));
    mx = fmaxf(mx, __shfl_xor(mx, 16)); mx = fmaxf(mx, __shfl_xor(mx, 32));
    const float sc = 0.08838834764831845f * 1.4426950408889634f; float sum = 0.f;
#pragma unroll
    for (int j = 0; j < 16; ++j)
#pragma unroll
        for (int r = 0; r < 4; ++r) { const float p = __builtin_amdgcn_exp2f((sa[j][r] - mx) * sc); sa[j][r] = p; sum += p; }
    sum += __shfl_xor(sum, 16); sum += __shfl_xor(sum, 32);
    const float inv = 1.0f / sum;
    f32x4 oa[8];
#pragma unroll
    for (int j = 0; j < 8; ++j) oa[j] = (f32x4){0.f, 0.f, 0.f, 0.f};
#pragma unroll
    for (int q = 0; q < 8; ++q) {
        union { bf16x8 v; unsigned u[4]; } pf; pf.u[0] = cvt_pk_bf16(sa[2 * q][0], sa[2 * q][1]); pf.u[1] = cvt_pk_bf16(sa[2 * q][2], sa[2 * q][3]);
        pf.u[2] = cvt_pk_bf16(sa[2 * q + 1][0], sa[2 * q + 1][1]); pf.u[3] = cvt_pk_bf16(sa[2 * q + 1][2], sa[2 * q + 1][3]);
#pragma unroll
        for (int jd = 0; jd < 8; ++jd) {
            const LAS unsigned char* vrow = VS + (16 * jd + fr) * 512 + ((g & 1) << 3);
            union { bf16x8 v; u32x2 u[2]; } vf; vf.u[0] = *(const LAS u32x2*)(vrow + (((4 * q + (g >> 1)) ^ fr) << 4)); vf.u[1] = *(const LAS u32x2*)(vrow + (((4 * q + 2 + (g >> 1)) ^ fr) << 4));
            oa[jd] = __builtin_amdgcn_mfma_f32_16x16x32_bf16(vf.v, pf.v, oa[jd], 0, 0, 0); } }
#pragma unroll
    for (int jd = 0; jd < 8; ++jd)
        *(u32x2*)(MIX + (size_t)(t0 + t) * D + 1536 + h * 128 + 16 * jd + 4 * g) = (u32x2){cvt_pk_bf16(oa[jd][0] * inv, oa[jd][1] * inv), cvt_pk_bf16(oa[jd][2] * inv, oa[jd][3] * inv)};
    __syncthreads();
}

template <int NW> __device__ __forceinline__ void dsync(LAS unsigned* ctr, unsigned& nb, int lane) {
    if constexpr (NW == 8) { asm volatile("s_waitcnt vmcnt(0)" ::: "memory"); __syncthreads(); }
    else { asm volatile("s_waitcnt vmcnt(0) lgkmcnt(0)" ::: "memory"); ++nb;
        if (lane == 0) __hip_atomic_fetch_add(ctr, 1u, __ATOMIC_RELAXED, __HIP_MEMORY_SCOPE_WORKGROUP);
        while (__hip_atomic_load(ctr, __ATOMIC_RELAXED, __HIP_MEMORY_SCOPE_WORKGROUP) < (unsigned)NW * nb) __builtin_amdgcn_s_sleep(1);
        asm volatile("" ::: "memory"); }
}
template <int NW> __device__ __forceinline__ void phase_d(Frame& F, int l) {
    constexpr int TPW = 32 / NW, KW = D / NW;
    const Args& A = *F.a; unsigned char* ws = F.ws; const int lane = F.lane, w = F.wave, tid = F.tid, fr = lane & 15, g = lane >> 4;
    const bf16_t* Y1 = (const bf16_t*)(ws + WS_Y1); bf16_t* X1L = (bf16_t*)(ws + WS_X1F); bf16_t* X1B = (bf16_t*)(ws + WS_X1B);
    const bf16_t* WRH = (const bf16_t*)(ws + WS_WR_HI) + (size_t)l * NE * D; const bf16_t* WRL = (const bf16_t*)(ws + WS_WR_LO) + (size_t)l * NE * D;
    int* LIST = (int*)(ws + WS_LIST); int* AEP = (int*)(ws + WS_ASG_EP); float* AW = (float*)(ws + WS_ASG_W);
    unsigned* CNT = (unsigned*)(ws + WS_CTL) + CW_CNT + (size_t)l * 64 * CNT_STRIDE;
    LAS float* PL = (LAS float*)F.lds;
    LAS unsigned* HIST = (LAS unsigned*)(F.lds + NW * 32 * 65 * 4);
    LAS unsigned* ctr = (LAS unsigned*)(F.lds + LDS_MISC) + 16; unsigned nb = 0u;
    for (int blk = F.vcu; blk < NTOK / 32; blk += F.G) {
        const int tok0 = blk * 32;
        if (tid < 128) HIST[tid] = 0u;
#pragma unroll 1
        for (int tt = 0; tt < TPW; tt += 2) { f32x4 v[2][8]; float mean[2], rstd[2];
#pragma unroll
            for (int u = 0; u < 2; ++u) { const u32x2* yr = (const u32x2*)(Y1 + (size_t)(tok0 + TPW * w + tt + u) * D) + lane;
#pragma unroll
                for (int j = 0; j < 8; ++j) { const u32x2 r = yr[64 * j]; v[u][j] = (f32x4){bf_lo(r.x), bf_hi(r.x), bf_lo(r.y), bf_hi(r.y)}; } }
#pragma unroll
            for (int u = 0; u < 2; ++u) { float s = 0.f;
#pragma unroll
                for (int j = 0; j < 8; ++j) s += (v[u][j][0] + v[u][j][1]) + (v[u][j][2] + v[u][j][3]);
                mean[u] = wave_sum(s) * (1.f / D); float s2 = 0.f;
#pragma unroll
                for (int j = 0; j < 8; ++j) { v[u][j] = v[u][j] - mean[u]; s2 += (v[u][j][0] * v[u][j][0] + v[u][j][1] * v[u][j][1]) + (v[u][j][2] * v[u][j][2] + v[u][j][3] * v[u][j][3]); }
                rstd[u] = 1.f / sqrtf(wave_sum(s2) * (1.f / D) + LN_EPS); }
#pragma unroll
            for (int j = 0; j < 8; ++j) { const f32x4 gg = ((const f32x4*)(A.in[I_LN1_G] + l * D))[lane + 64 * j], bb = ((const f32x4*)(A.in[I_LN1_B] + l * D))[lane + 64 * j];
#pragma unroll
                for (int u = 0; u < 2; ++u) { const int tok = tok0 + TPW * w + tt + u; const f32x4 o = v[u][j] * rstd[u] * gg + bb;
                    const unsigned h0 = cvt_pk_bf16(o[0], o[1]), h1 = cvt_pk_bf16(o[2], o[3]);
                    *(u32x2*)(X1B + (size_t)tok * D + 4 * lane + 256 * j) = (u32x2){h0, h1};
                    *(u32x2*)(X1L + (size_t)tok * D + 4 * lane + 256 * j) = (u32x2){cvt_pk_bf16(o[0] - bf_lo(h0), o[1] - bf_hi(h0)), cvt_pk_bf16(o[2] - bf_lo(h1), o[3] - bf_hi(h1))}; } } }
        dsync<NW>(ctr, nb, lane);
        { f32x4 acc[2][4];
#pragma unroll
          for (int rb = 0; rb < 2; ++rb)
#pragma unroll
              for (int cb = 0; cb < 4; ++cb) acc[rb][cb] = (f32x4){0.f, 0.f, 0.f, 0.f};
#pragma unroll 4
          for (int ks = 0; ks < KW / 32; ++ks) { const int k = KW * w + 32 * ks + 8 * g; bf16x8 ah[2], al[2];
#pragma unroll
              for (int rb = 0; rb < 2; ++rb) { ah[rb] = *(const bf16x8*)(X1B + (size_t)(tok0 + 16 * rb + fr) * D + k); al[rb] = *(const bf16x8*)(X1L + (size_t)(tok0 + 16 * rb + fr) * D + k); }
#pragma unroll
              for (int cb = 0; cb < 4; ++cb) { const bf16x8 bh = *(const bf16x8*)(WRH + (size_t)(16 * cb + fr) * D + k), bl = *(const bf16x8*)(WRL + (size_t)(16 * cb + fr) * D + k);
#pragma unroll
                  for (int rb = 0; rb < 2; ++rb) { acc[rb][cb] = __builtin_amdgcn_mfma_f32_16x16x32_bf16(ah[rb], bh, acc[rb][cb], 0, 0, 0);
                      acc[rb][cb] = __builtin_amdgcn_mfma_f32_16x16x32_bf16(ah[rb], bl, acc[rb][cb], 0, 0, 0); acc[rb][cb] = __builtin_amdgcn_mfma_f32_16x16x32_bf16(al[rb], bh, acc[rb][cb], 0, 0, 0); } } }
#pragma unroll
          for (int rb = 0; rb < 2; ++rb)
#pragma unroll
              for (int cb = 0; cb < 4; ++cb)
#pragma unroll
                  for (int r = 0; r < 4; ++r) PL[(w * 32 + 16 * rb + 4 * g + r) * 65 + 16 * cb + fr] = acc[rb][cb][r]; }
        dsync<NW>(ctr, nb, lane);
        bool selv[TPW]; unsigned locv[TPW]; float wnv[TPW]; int kv[TPW];
        const float rbias = A.in[I_R_BIAS][l * NE + lane];
#pragma unroll
        for (int tt = 0; tt < TPW; ++tt) { const int tl = TPW * w + tt; float logit = 0.f;
#pragma unroll
            for (int ww = 0; ww < NW; ++ww) logit += PL[(ww * 32 + tl) * 65 + lane];
            const float score = 1.0f / (1.0f + __expf(-logit)), choice = score + rbias;
            float m1 = choice; m1 = fmaxf(m1, __shfl_xor(m1, 1)); m1 = fmaxf(m1, __shfl_xor(m1, 2)); m1 = fmaxf(m1, __shfl_xor(m1, 4));
            int i1 = (choice == m1) ? lane : 64; i1 = min(i1, __shfl_xor(i1, 1)); i1 = min(i1, __shfl_xor(i1, 2)); i1 = min(i1, __shfl_xor(i1, 4));
            float m2 = (lane == i1) ? -INFINITY : choice; m2 = fmaxf(m2, __shfl_xor(m2, 1)); m2 = fmaxf(m2, __shfl_xor(m2, 2)); m2 = fmaxf(m2, __shfl_xor(m2, 4));
            const float gs = m1 + m2; const int myg = lane >> 3; int grank = 0;
#pragma unroll
            for (int gg = 0; gg < 8; ++gg) { const float gv = __int_as_float(__builtin_amdgcn_readlane(__float_as_int(gs), 8 * gg)); grank += (gv > gs || (gv == gs && gg < myg)) ? 1 : 0; }
            const float mc = (grank < 4) ? choice : -INFINITY; int er = 0;
#pragma unroll
            for (int e2 = 0; e2 < 64; ++e2) { const float v = __int_as_float(__builtin_amdgcn_readlane(__float_as_int(mc), e2)); er += (v > mc || (v == mc && e2 < lane)) ? 1 : 0; }
            const bool sel = er < TOPK; const float wsum = wave_sum(sel ? score : 0.f);
            const unsigned long long mask = __ballot(sel);
            selv[tt] = sel; wnv[tt] = score / (wsum + 1e-20f) * 2.5f; kv[tt] = __popcll(mask & ((1ull << lane) - 1ull)); locv[tt] = 0u;
            if (sel) locv[tt] = __hip_atomic_fetch_add(&HIST[lane], 1u, __ATOMIC_RELAXED, __HIP_MEMORY_SCOPE_WORKGROUP); }
        dsync<NW>(ctr, nb, lane);
        if (tid < 64) { const unsigned n = HIST[tid]; HIST[64 + tid] = n ? __hip_atomic_fetch_add(CNT + tid * CNT_STRIDE, n, __ATOMIC_RELAXED, __HIP_MEMORY_SCOPE_AGENT) : 0u; }
        dsync<NW>(ctr, nb, lane);
#pragma unroll
        for (int tt = 0; tt < TPW; ++tt) if (selv[tt]) { const int tok = tok0 + TPW * w + tt; const unsigned pos = HIST[64 + lane] + locv[tt];
            LIST[lane * NTOK + pos] = tok; AEP[tok * 8 + kv[tt]] = (int)((unsigned)lane << 16 | pos); AW[tok * 8 + kv[tt]] = wnv[tt]; }
        dsync<NW>(ctr, nb, lane);
    }
}

__device__ __forceinline__ void build_etab(Frame& F, int l) {
    LAS int* ET = (LAS int*)(F.lds + LDS_ETAB);
    unsigned* CNT = (unsigned*)(F.ws + WS_CTL) + CW_CNT + (size_t)l * 64 * CNT_STRIDE;
    if (F.tid < NE1) ET[F.tid] = F.tid < NE ? (int)__hip_atomic_load(CNT + F.tid * CNT_STRIDE, __ATOMIC_RELAXED, __HIP_MEMORY_SCOPE_AGENT) : NTOK;
    __syncthreads();
    if (F.tid == 0) { int ts = 0;
#pragma unroll 1
        for (int e = 0; e < NE1; ++e) { ET[68 + e] = ts; ET[136 + e] = ts * 256; ts += (ET[e] + 255) >> 8; } ET[68 + NE1] = ts; }
    __syncthreads();
}
struct ExpertSched {
    LAS const int* UD;
    LAS const unsigned* RT;
    const char* Abase; const char* Bbase; size_t bstride_e, bstride_pn; int arow_bytes, ncol; bool gather;
    __device__ __forceinline__ bool next(int i, pg8::Unit& u) const {
        if (i >= 16) return false; const int e = __builtin_amdgcn_readfirstlane(UD[4 * i]); if (e < 0) return false;
        const int row0 = __builtin_amdgcn_readfirstlane(UD[4 * i + 1]), pn = __builtin_amdgcn_readfirstlane(UD[4 * i + 2]);
        u.A = gather ? Abase : Abase + (size_t)row0 * arow_bytes; u.B = Bbase + (size_t)e * bstride_e + (size_t)pn * bstride_pn; u.row0 = row0; u.col0 = pn * ncol; u.nvalid = __builtin_amdgcn_readfirstlane(UD[4 * i + 3]); u.aux = e; return true;
    }
    __device__ __forceinline__ unsigned rowoff(int i, int r) const { return RT[i * 256 + r]; }
};
__device__ __forceinline__ void build_units(Frame& F, int npn, bool gather) {
    LAS int* ET = (LAS int*)(F.lds + LDS_ETAB); LAS int* UD = (LAS int*)(F.lds + LDS_UDESC); LAS unsigned* RT = (LAS unsigned*)(F.lds + LDS_ROWTAB);
    const int NU = ET[68 + NE1] * npn;
    if (F.tid < 16) { const int U = F.vcu + F.tid * F.G; int e = -1, row0 = 0, pn = 0, nv = 0;
        if (U < NU) { const int tile = U / npn; pn = U % npn; e = 0;
#pragma unroll 1
            while (e < NE && ET[68 + e + 1] <= tile) ++e; const int mt = tile - ET[68 + e]; row0 = ET[136 + e] + 256 * mt; nv = ET[e] - 256 * mt; nv = nv > 256 ? 256 : nv; }
        UD[4 * F.tid] = e; UD[4 * F.tid + 1] = row0; UD[4 * F.tid + 2] = pn; UD[4 * F.tid + 3] = nv; }
    __syncthreads();
    if (gather) { const int* LIST = (const int*)(F.ws + WS_LIST);
        for (int i = F.tid; i < 4 * 256; i += 512) { const int ui = i >> 8, r = i & 255; const int e = UD[4 * ui]; unsigned off = 0u;
            if (e >= 0) { const int row0 = UD[4 * ui + 1], nv = UD[4 * ui + 3]; const int lr = row0 - ET[136 + e] + r; int tok = 0;
                tok = NTOK;
                if (r < nv) tok = (e < NE) ? LIST[e * NTOK + lr] : lr;
                off = (unsigned)tok * (unsigned)(D * 2); }
            RT[i] = off; }
        __syncthreads(); }
}

__device__ __forceinline__ void phase_g(Frame& F, int l) {
    const Args& A = *F.a; unsigned char* ws = F.ws; const int lane = F.lane;
    if (l + 1 < NL) { convert_cleanup(F, l * L_ITEMS + LI_X, (l + 1) * L_ITEMS); __syncthreads(); }
    build_etab(F, l);
    LAS const int* SB = (LAS const int*)(F.lds + LDS_ETAB) + 136;
    const bf16_t* X1B = (const bf16_t*)(ws + WS_X1B); const unsigned char* OB = (const unsigned char*)(ws + WS_OB); const int* AEP = (const int*)(ws + WS_ASG_EP); const float* AW = (const float*)(ws + WS_ASG_W);
    float* XO = (l == NL - 1) ? A.out : (float*)nullptr; bf16_t* XB = (bf16_t*)(ws + WS_XB);
    const bf16_t* OSH = (const bf16_t*)(ws + WS_OSH);
    LAS float* YS = (LAS float*)(F.lds + F.wave * 8192);
    int ep_n = 0; float w_n = 0.f;
    { const int tok0 = F.vcu * 8 + F.wave; if (tok0 < NTOK && lane < 8) { ep_n = AEP[tok0 * 8 + lane]; w_n = AW[tok0 * 8 + lane]; } }
    for (int tok = F.vcu * 8 + F.wave; tok < NTOK; tok += F.G * 8) {
        int slot = 0; const float wv = w_n;
        if (lane < 8) slot = SB[ep_n >> 16] + (ep_n & 0xffff);
        { const int tn = tok + F.G * 8; if (tn < NTOK && lane < 8) { ep_n = AEP[tn * 8 + lane]; w_n = AW[tn * 8 + lane]; } }
        float s = 0.f;
        u32x2 ovA[8], ovB[8]; u32x4 xrA, xrB, osA, osB;
#define G_LOADS(ov, xr, os, j) do { xr = *(const u32x4*)(X1B + (size_t)tok * D + 512 * (j) + 8 * lane); os = *(const u32x4*)(OSH + (size_t)tok * D + 512 * (j) + 8 * lane); \
            _Pragma("unroll") for (int k = 0; k < 8; ++k) { const int sl = __builtin_amdgcn_readlane(slot, k); ov[k] = *(const u32x2*)(OB + (size_t)sl * D + 512 * (j) + 8 * lane); } } while (0)
#define G_COMBINE(ov, xr, os, j) do { \
            float y[8] = {ALPHA * bf_lo(xr.x) + bf_lo(os.x), ALPHA * bf_hi(xr.x) + bf_hi(os.x), ALPHA * bf_lo(xr.y) + bf_lo(os.y), ALPHA * bf_hi(xr.y) + bf_hi(os.y), \
                          ALPHA * bf_lo(xr.z) + bf_lo(os.z), ALPHA * bf_hi(xr.z) + bf_hi(os.z), ALPHA * bf_lo(xr.w) + bf_lo(os.w), ALPHA * bf_hi(xr.w) + bf_hi(os.w)}; \
            _Pragma("unroll") for (int k = 0; k < 8; ++k) { const float wk = __int_as_float(__builtin_amdgcn_readlane(__float_as_int(wv), k)) * (1.0f / pg8::O8_SCALE); \
                const f32x2 a = __builtin_amdgcn_cvt_pk_f32_fp8((int)ov[k].x, false), b = __builtin_amdgcn_cvt_pk_f32_fp8((int)ov[k].x, true), \
                            c2 = __builtin_amdgcn_cvt_pk_f32_fp8((int)ov[k].y, false), d2 = __builtin_amdgcn_cvt_pk_f32_fp8((int)ov[k].y, true); \
                y[0] += wk * a.x; y[1] += wk * a.y; y[2] += wk * b.x; y[3] += wk * b.y; y[4] += wk * c2.x; y[5] += wk * c2.y; y[6] += wk * d2.x; y[7] += wk * d2.y; } \
            s += ((y[0] + y[1]) + (y[2] + y[3])) + ((y[4] + y[5]) + (y[6] + y[7])); \
            *(LAS f32x4*)(YS + 512 * (j) + 8 * lane) = (f32x4){y[0], y[1], y[2], y[3]}; *(LAS f32x4*)(YS + 512 * (j) + 8 * lane + 4) = (f32x4){y[4], y[5], y[6], y[7]}; } while (0)
        G_LOADS(ovA, xrA, osA, 0); G_LOADS(ovB, xrB, osB, 1);
        G_COMBINE(ovA, xrA, osA, 0); G_LOADS(ovA, xrA, osA, 2);
        G_COMBINE(ovB, xrB, osB, 1); G_LOADS(ovB, xrB, osB, 3);
        G_COMBINE(ovA, xrA, osA, 2);
        G_COMBINE(ovB, xrB, osB, 3);
#undef G_LOADS
#undef G_COMBINE
        const float mean = wave_sum(s) * (1.f / D); float s2 = 0.f;
#pragma unroll 1
        for (int j = 0; j < 4; ++j) { const f32x4 a = *(const LAS f32x4*)(YS + 512 * j + 8 * lane) - mean, b = *(const LAS f32x4*)(YS + 512 * j + 8 * lane + 4) - mean;
            s2 += ((a[0] * a[0] + a[1] * a[1]) + (a[2] * a[2] + a[3] * a[3])) + ((b[0] * b[0] + b[1] * b[1]) + (b[2] * b[2] + b[3] * b[3])); }
        const float rstd = 1.f / sqrtf(wave_sum(s2) * (1.f / D) + LN_EPS);
#pragma unroll 1
        for (int j = 0; j < 4; ++j) { const f32x4* gp = (const f32x4*)(A.in[I_LN2_G] + l * D + 512 * j + 8 * lane); const f32x4* bp = (const f32x4*)(A.in[I_LN2_B] + l * D + 512 * j + 8 * lane);
            const f32x4 a = *(const LAS f32x4*)(YS + 512 * j + 8 * lane) - mean, b = *(const LAS f32x4*)(YS + 512 * j + 8 * lane + 4) - mean;
            const f32x4 o0 = a * rstd * gp[0] + bp[0], o1 = b * rstd * gp[1] + bp[1];
            if (XO) { f32x4* op = (f32x4*)(XO + (size_t)tok * D + 512 * j + 8 * lane); op[0] = o0; op[1] = o1; }
            if (!XO) *(u32x4*)(XB + (size_t)tok * D + 512 * j + 8 * lane) = (u32x4){cvt_pk_bf16(o0[0], o0[1]), cvt_pk_bf16(o0[2], o0[3]), cvt_pk_bf16(o1[0], o1[1]), cvt_pk_bf16(o1[2], o1[3])}; }
    }
}

constexpr int NPHASE = 2 + 7 * NL;
__global__ void __launch_bounds__(512, 2) mk_fwd(Args args) {
    extern __shared__ __attribute__((aligned(16))) unsigned char lds[];
#define PHASE_FRAME() Frame F; { int tz_ = threadIdx.x; asm volatile("" : "+v"(tz_)); int bz_ = blockIdx.x; asm volatile("" : "+s"(bz_)); size_t zo_ = 0; asm volatile("" : "+s"(zo_)); unsigned char* wz_ = args.ws + zo_;   \
        F.lds = (LAS unsigned char*)lds; F.tid = tz_; F.lane = tz_ & 63; F.wave = __builtin_amdgcn_readfirstlane(tz_ >> 6); F.G = gridDim.x; F.vcu = (F.G % 8 == 0) ? (bz_ % 8) * (F.G / 8) + bz_ / 8 : bz_; F.a = &args; F.ws = wz_; } \
        unsigned char* ws = F.ws; const int c = F.vcu; (void)ws; (void)c
    volatile LAS unsigned* MISC = (volatile LAS unsigned*)((LAS unsigned char*)lds + LDS_MISC);
    if (threadIdx.x < 128) MISC[threadIdx.x] = 0u;
    __syncthreads();
    unsigned* ctl = (unsigned*)(args.ws + WS_CTL);
    XcdBarrier bar; bar.bar = ctl + CW_BAR; bar.x = 0; bar.st = nullptr;
    const int lo = args.ph_lo, hi = args.ph_hi;
    if (hi - lo > 1) bar = xcd_barrier_post(ctl + CW_BAR, MISC + 8);
#define IN(k) (lo <= (k) && (k) < hi)
#define SEAM(k) do { if (IN(k) && IN((k) + 1)) xcd_barrier(bar); } while (0)

    if (IN(0)) { REP_LOOP(REP_P0) { PHASE_FRAME(); p0_prologue(F); } if (IN(2)) xcd_barrier(bar); }
#pragma unroll 1
    for (int l_ = 0; l_ < NL; ++l_) {
        const int pb = 2 + 7 * l_;
        if (IN(pb + 0)) {
            REP_LOOP(REP_A) {
            PHASE_FRAME(); int l = l_; asm volatile("" : "+s"(l));
            pg8::DenseSched S; S.init((const bf16_t*)(ws + WS_XB), (const bf16_t*)(ws + WS_WT_IN) + (size_t)l * INW * D, NTOK, INW, D, F.G, c);
            pg8::EpiStoreBf16 E{(bf16_t*)(ws + WS_HB), INW};
            pg8::gemm_phase<pg8::EpiStoreBf16, pg8::DenseSched, false>(F.lds, D, S, E); __syncthreads();
            if (l == 0) {
                { pg8::DenseSched S2; S2.init((const bf16_t*)(ws + WS_MEMN), (const bf16_t*)(ws + WS_WT_K), NMEMTOK, NL * 512, D, F.G, c - 128);
                  pg8::EpiStoreBf16 E2{(bf16_t*)(ws + WS_KBUF), NL * 512};
                  pg8::gemm_phase<pg8::EpiStoreBf16, pg8::DenseSched, false>(F.lds, D, S2, E2); }
                { pg8::DenseSched S2; S2.init((const bf16_t*)(ws + WS_WT_V), (const bf16_t*)(ws + WS_MEMN), NL * 512, NMEMTOK, D, F.G, c - 160);
                  pg8::EpiStoreBf16 E2{(bf16_t*)(ws + WS_VT), NMEMTOK};
                  pg8::gemm_phase<pg8::EpiStoreBf16, pg8::DenseSched, false>(F.lds, D, S2, E2); }
                __syncthreads();
            }
            if (c + F.G >= (NTOK / 256) * (INW / 256) && (l != 0 || c >= 192)) convert_fill(F, l * L_ITEMS, FILL_A); }
            SEAM(pb + 0);
        }
        if (IN(pb + 1)) {
            REP_LOOP(REP_B) { PHASE_FRAME(); int l = l_; asm volatile("" : "+s"(l));
            for (int it = c; it < 256; it += F.G) mixer_sgu(F, l, it >> 2, it & 3);
            for (int it = c; it < 256; it += F.G) mixer_pool(F, l, it >> 2, it & 3);
            for (int it = c; it < 256; it += F.G) mixer_conv(F, l, it >> 2, it & 3);
            for (int it = c; it < 256; it += F.G) mixer_attn(F, l, it >> 2, it & 3); }
            SEAM(pb + 1);
        }
        if (IN(pb + 2)) {
            REP_LOOP(REP_C) {
            PHASE_FRAME(); int l = l_; asm volatile("" : "+s"(l));
            pg8::DenseSched S; S.init((const bf16_t*)(ws + WS_MIX), (const bf16_t*)(ws + WS_WT_OUT) + (size_t)l * D * D, NTOK, D, D, F.G, c);
            pg8::EpiResidBf16 E{(bf16_t*)(ws + WS_Y1), l == 0 ? args.in[I_X] : (const float*)nullptr, (const bf16_t*)(ws + WS_XB), D, ALPHA};
            pg8::gemm_phase<pg8::EpiResidBf16, pg8::DenseSched, false>(F.lds, D, S, E); __syncthreads(); }
            SEAM(pb + 2);
        }
        if (IN(pb + 3)) { PHASE_FRAME(); int l = l_; asm volatile("" : "+s"(l));
            if (F.G * 32 == NTOK) {
                if (F.tid == 0) ((LAS unsigned*)(F.lds + LDS_MISC))[16] = 0u;
                __syncthreads();
                if (F.wave < 4) phase_d<4>(F, l); else convert_beside_d(F, l * L_ITEMS, l * L_ITEMS + LI_X);
            } else { convert_cleanup(F, l * L_ITEMS, l * L_ITEMS + LI_X); __syncthreads(); phase_d<8>(F, l); }
            SEAM(pb + 3); }
        if (IN(pb + 4)) {
            REP_LOOP(REP_E) {
            PHASE_FRAME(); int l = l_; asm volatile("" : "+s"(l));
            if (c == 0 && F.tid == 0) __hip_atomic_fetch_max((unsigned*)(ws + WS_CTL) + CW_Q, (unsigned)(l * L_ITEMS + LI_X), __ATOMIC_RELAXED, __HIP_MEMORY_SCOPE_AGENT);
            build_etab(F, l); build_units(F, 2, true);
            ExpertSched S; S.UD = (LAS const int*)(F.lds + LDS_UDESC); S.RT = (LAS const unsigned*)(F.lds + LDS_ROWTAB);
            S.Abase = (const char*)(ws + WS_X1B); S.Bbase = (const char*)(ws + WS_WT_GU) + (size_t)l * NE1 * 512 * D * 2; S.bstride_e = (size_t)512 * D * 2; S.bstride_pn = (size_t)256 * D * 2; S.arow_bytes = D * 2; S.ncol = 128; S.gather = true;
            pg8::EpiSwiglu E{(bf16_t*)(ws + WS_HE)};
            pg8::gemm_phase<pg8::EpiSwiglu, ExpertSched, true>(F.lds, D, S, E); __syncthreads();
            { const int NU = ((LAS const int*)(F.lds + LDS_ETAB))[68 + NE1] * 2; const int mine = c < NU ? (NU - c + F.G - 1) / F.G : 0, maxu = (NU + F.G - 1) / F.G;
              if (mine < maxu) convert_fill(F, l * L_ITEMS + LI_X, FILL_E); } }
            SEAM(pb + 4);
        }
        if (IN(pb + 5)) {
            REP_LOOP(REP_F) {
            PHASE_FRAME(); int l = l_; asm volatile("" : "+s"(l));
            build_etab(F, l); build_units(F, 8, false);
            ExpertSched S; S.UD = (LAS const int*)(F.lds + LDS_UDESC); S.RT = (LAS const unsigned*)(F.lds + LDS_ROWTAB);
            S.Abase = (const char*)(ws + WS_HE); S.Bbase = (const char*)(ws + WS_WT_D) + (size_t)l * NE1 * D * DE * 2; S.bstride_e = (size_t)D * DE * 2; S.bstride_pn = (size_t)256 * DE * 2; S.arow_bytes = DE * 2; S.ncol = 256; S.gather = false;
            pg8::EpiStoreFp8 E{(unsigned char*)(ws + WS_OB), D, (bf16_t*)(ws + WS_OSH), NE, __builtin_amdgcn_readfirstlane(((LAS const int*)(F.lds + LDS_ETAB))[136 + NE])};
            pg8::gemm_phase<pg8::EpiStoreFp8, ExpertSched, false>(F.lds, DE, S, E); __syncthreads(); }
            SEAM(pb + 5);
        }
        if (IN(pb + 6)) { REP_LOOP(REP_G) { PHASE_FRAME(); int l = l_; asm volatile("" : "+s"(l)); phase_g(F, l); __syncthreads(); } SEAM(pb + 6); }
    }
#undef IN
#undef SEAM
}

extern "C" void kernel_launch(void* const* d_in, const int* in_sizes, int n_in, void* d_out, int out_size, void* d_ws, size_t ws_size, hipStream_t stream) {
    static int grid = 0;
    if (grid == 0) {
        if (n_in != 29 || out_size != NTOK * D || ws_size < WS_END) { fprintf(stderr, "kernel_launch: unexpected shapes (n_in %d out %d ws %zu need %zu)\n", n_in, out_size, ws_size, (size_t)WS_END); grid = -1; return; }
        int dev = 0, cus = 0, per_cu = 0;
        if (hipGetDevice(&dev) != hipSuccess || hipDeviceGetAttribute(&cus, hipDeviceAttributeMultiprocessorCount, dev) != hipSuccess) { grid = -1; return; }
        if (hipFuncSetAttribute((const void*)mk_fwd, hipFuncAttributeMaxDynamicSharedMemorySize, LDS_BYTES) != hipSuccess) { fprintf(stderr, "kernel_launch: hipFuncSetAttribute failed\n"); grid = -1; return; }
        if (hipOccupancyMaxActiveBlocksPerMultiprocessor(&per_cu, (const void*)mk_fwd, 512, LDS_BYTES) != hipSuccess || per_cu < 1) fprintf(stderr, "kernel_launch: occupancy query reports %d\n", per_cu);
        (void)hipGetLastError();
        grid = cus;
    }
    if (grid < 0) return;
    (void)hipMemsetAsync((char*)d_ws + WS_CTL, 0, CTL_ZERO_BYTES, stream);
    Args a{};
    for (int i = 0; i < 29; ++i) a.in[i] = (const float*)d_in[i];
    a.out = (float*)d_out; a.ws = (unsigned char*)d_ws;
#if MK_ONE_LAUNCH
    a.ph_lo = 0; a.ph_hi = NPHASE;
    hipLaunchKernelGGL(mk_fwd, dim3(grid), dim3(512), LDS_BYTES, stream, a);
#else
    for (int p = 0; p < NPHASE; ++p) { a.ph_lo = p; a.ph_hi = p + 1; hipLaunchKernelGGL(mk_fwd, dim3(grid), dim3(512), LDS_BYTES, stream, a); }
#endif
}
```

```cpp
#include <hip/hip_runtime.h>
#include <cstdio>
#include <cstdint>

#define LAS __attribute__((address_space(3)))
#define GAS __attribute__((address_space(1)))
typedef unsigned short bf16_t;
typedef short bf16x8 __attribute__((ext_vector_type(8)));
typedef float f32x4 __attribute__((ext_vector_type(4)));
typedef float f32x2 __attribute__((ext_vector_type(2)));
typedef unsigned u32x4 __attribute__((ext_vector_type(4)));
typedef unsigned u32x2 __attribute__((ext_vector_type(2)));

#ifndef REP_P0
#define REP_P0 1
#endif
#ifndef REP_B
#define REP_B 1
#endif
#ifndef REP_E
#define REP_E 1
#endif
#ifndef REP_F
#define REP_F 1
#endif
#ifndef REP_A
#define REP_A 1
#endif
#ifndef REP_C
#define REP_C 1
#endif
#ifndef REP_D1
#define REP_D1 1
#endif
#ifndef REP_D2
#define REP_D2 1
#endif
#ifndef REP_D3
#define REP_D3 1
#endif
#ifndef REP_G
#define REP_G 1
#endif
#define REP_LOOP(n) _Pragma("unroll 1") for (int rep_ = 0; rep_ < (n); ++rep_)
#ifndef FILL_P1
#define FILL_P1 2
#endif
#ifndef FILL_A
#define FILL_A 1
#endif
#ifndef FILL_E
#define FILL_E 1
#endif
#ifndef MK_ONE_LAUNCH
#define MK_ONE_LAUNCH 1
#endif

constexpr int D = 2048, NTOK = 8192, SEQ = 2048, NL = 4, INW = 3072, GW = 512, HD = 128, NMEMTOK = 1024, NE = 64, NE1 = 65, DE = 256, TOPK = 8;
constexpr float LN_EPS = 1e-5f;
constexpr float ALPHA = 1.6817928305074290861f;
constexpr int SLOT_CAP = 90112;

constexpr size_t MiB = 1u << 20;
constexpr size_t WS_CTL = 0, CTL_ZERO_BYTES = 2 * MiB;
constexpr size_t WS_WT_IN  = 2 * MiB;
constexpr size_t WS_WT_OUT = WS_WT_IN + 48 * MiB;
constexpr size_t WS_WT_K   = WS_WT_OUT + 32 * MiB;
constexpr size_t WS_WT_V   = WS_WT_K + 8 * MiB;
constexpr size_t WS_WT_GU  = WS_WT_V + 8 * MiB;
constexpr size_t WS_WT_D   = WS_WT_GU + 520 * MiB;
constexpr size_t WS_WPT    = WS_WT_D + 260 * MiB;
constexpr size_t WS_SGUW   = WS_WPT + 1 * MiB;
constexpr size_t WS_WR_HI  = WS_SGUW + 1 * MiB;
constexpr size_t WS_WR_LO  = WS_WR_HI + 1 * MiB;
constexpr size_t WS_MEMN   = WS_WR_LO + 1 * MiB;
constexpr size_t WS_KBUF   = WS_MEMN + 4 * MiB;
constexpr size_t WS_VT     = WS_KBUF + 4 * MiB;
constexpr size_t WS_XF     = WS_VT + 4 * MiB;
constexpr size_t WS_OSH    = WS_XF;
constexpr size_t WS_XB     = WS_XF + 64 * MiB;
constexpr size_t WS_HB     = WS_XB + 32 * MiB;
constexpr size_t WS_MIX    = WS_HB + 48 * MiB;
constexpr size_t WS_Y1     = WS_MIX + 32 * MiB;
constexpr size_t WS_X1F    = WS_Y1 + 64 * MiB;
constexpr size_t WS_X1B    = WS_X1F + 64 * MiB;
constexpr size_t WS_HE     = WS_X1B + 33 * MiB;
constexpr size_t WS_OB     = WS_HE + 44 * MiB;
constexpr size_t WS_LIST   = WS_OB + 352 * MiB;
constexpr size_t WS_ASG_EP = WS_LIST + 2 * MiB;
constexpr size_t WS_ASG_W  = WS_ASG_EP + 1 * MiB;
constexpr size_t WS_END    = WS_ASG_W + 1 * MiB;
constexpr int CW_BAR = 4096;
constexpr int CW_CNT = 16384, CNT_STRIDE = 1024;
static_assert((CW_CNT + 256 * CNT_STRIDE) * 4 <= (int)CTL_ZERO_BYTES, "ctl");

constexpr int RING_BYTES = 131072;
constexpr int LDS_MISC = RING_BYTES;
constexpr int LDS_ETAB = LDS_MISC + 512;
constexpr int LDS_UDESC = LDS_ETAB + 1024;
constexpr int LDS_ROWTAB = LDS_UDESC + 512;
constexpr int LDS_BYTES = 147456;
static_assert(LDS_ROWTAB + 4096 <= LDS_BYTES, "lds");

#define LDS_WAIT() asm volatile("s_waitcnt lgkmcnt(0)" ::: "memory")
#define VM_WAIT() asm volatile("s_waitcnt vmcnt(0)" ::: "memory")

__device__ __forceinline__ unsigned cvt_pk_bf16(float lo, float hi) { unsigned r; asm volatile("v_cvt_pk_bf16_f32 %0, %1, %2" : "=v"(r) : "v"(lo), "v"(hi)); return r; }
__device__ __forceinline__ float bf_lo(unsigned w) { return __uint_as_float(w << 16); }
__device__ __forceinline__ float bf_hi(unsigned w) { return __uint_as_float(w & 0xffff0000u); }
__device__ __forceinline__ float fast_sigmoid(float x) { return __builtin_amdgcn_rcpf(1.0f + __builtin_amdgcn_exp2f(-1.4426950408889634f * x)); }
__device__ __forceinline__ float silu_f(float x) { return x * fast_sigmoid(x); }
__device__ __forceinline__ float gelu_tanh_f(float x) { const float t = x + 0.044715f * x * x * x; return x * fast_sigmoid(1.5957691216057308f * t); }
__device__ __forceinline__ float wave_sum(float v) {
#pragma unroll
    for (int o = 1; o < 64; o <<= 1) v += __shfl_xor(v, o);
    return v;
}
__device__ __forceinline__ float g16_sum(float v) { v += __shfl_xor(v, 1); v += __shfl_xor(v, 2); v += __shfl_xor(v, 4); v += __shfl_xor(v, 8); return v; }

namespace pg8 {
constexpr int BM = 256, BK = 64, HALF = 128, HTB = HALF * BK * 2, STAGE_BYTES = 8 * HTB, NXCD = 8, WGM = 8;
__host__ __device__ __forceinline__ int lds_byte(int r, int c) { const int st = (r >> 4) * 2 + (c >> 5), rr = r & 15, cc = c & 31, ob = rr * 64 + cc * 2; return st * 1024 + (ob ^ (((ob >> 9) & 1) << 5)); }
__host__ __device__ __forceinline__ void stage_rc(int b, int& R, int& C) { const int st = b / 1024, sb = b % 1024, swz = sb ^ (((sb >> 9) & 1) << 5); R = (st >> 1) * 16 + swz / 64; C = (st & 1) * 32 + (swz % 64) / 2; }
__host__ __device__ __forceinline__ int perm32(int rho) { const int n = rho >> 4, i = rho & 15; return 8 * (i >> 2) + 4 * n + (i & 3); }

struct Unit { const char* A; const char* B; int row0, col0, nvalid, aux; };

struct StaticOrder {
    int nM, nN, nwg, G, c;
    __device__ void init(int M, int N, int G_, int c_) { nM = M / BM; nN = N / BM; nwg = nM * nN; G = G_; c = c_; }
    __device__ bool next(int i, int& pm, int& pn) const {
        const long L = (long)i * G + c; if (L >= nwg || c < 0) return false;
        int wgid = (int)L; { const int q = nwg / NXCD, r = nwg % NXCD, xcd = wgid % NXCD, off = wgid / NXCD; wgid = (xcd < r ? xcd * (q + 1) : r * (q + 1) + (xcd - r) * q) + off; }
        const int nig = WGM * nN, gid = wgid / nig, fm = gid * WGM, gsz = (nM - fm) < WGM ? (nM - fm) : WGM;
        pm = fm + ((wgid % nig) % gsz); pn = (wgid % nig) / gsz; return true;
    }
};
struct DenseSched {
    StaticOrder so; const char* A; const char* B; size_t tstep;
    __device__ void init(const bf16_t* A_, const bf16_t* B_, int M, int N, int K, int G, int c) { so.init(M, N, G, c); A = (const char*)A_; B = (const char*)B_; tstep = (size_t)BM * K * 2; }
    __device__ __forceinline__ bool next(int i, Unit& u) const { int pm, pn; if (!so.next(i, pm, pn)) return false; u.A = A + (size_t)pm * tstep; u.B = B + (size_t)pn * tstep; u.row0 = pm * BM; u.col0 = pn * BM; u.nvalid = BM; u.aux = 0; return true; }
    __device__ __forceinline__ unsigned rowoff(int, int) const { return 0u; }
};

struct EpiStoreBf16 {
    static constexpr bool PERM = true;
    bf16_t* O; int ldc;
    __device__ __forceinline__ void operator()(const f32x4 (&acc)[2][2][4][2], const Unit& u, int wr, int wc, int fr, int fq) const {
#pragma unroll
        for (int ai = 0; ai < 2; ++ai)
#pragma unroll
            for (int m = 0; m < 4; ++m) { const int lr = ai * HALF + wr * 64 + m * 16 + fr;
                if (lr < u.nvalid) { bf16_t* rowp = O + (size_t)(u.row0 + lr) * ldc + u.col0 + wc * 32 + 8 * fq;
#pragma unroll
                    for (int bj = 0; bj < 2; ++bj) { const f32x4 v0 = acc[ai][bj][m][0], v1 = acc[ai][bj][m][1];
                        u32x4 w; w.x = cvt_pk_bf16(v0[0], v0[1]); w.y = cvt_pk_bf16(v0[2], v0[3]); w.z = cvt_pk_bf16(v1[0], v1[1]); w.w = cvt_pk_bf16(v1[2], v1[3]);
                        *(u32x4*)(rowp + bj * HALF) = w; } } }
    }
};
constexpr float O8_SCALE = 16.0f;
struct EpiStoreFp8 {
    static constexpr bool PERM = true;
    unsigned char* O; int ldc; bf16_t* OS; int sh_e, sh_base;
    __device__ __forceinline__ void operator()(const f32x4 (&acc)[2][2][4][2], const Unit& u, int wr, int wc, int fr, int fq) const {
        if (u.aux == sh_e) {
#pragma unroll
            for (int ai = 0; ai < 2; ++ai)
#pragma unroll
                for (int m = 0; m < 4; ++m) { const int lr = ai * HALF + wr * 64 + m * 16 + fr; bf16_t* rowp = OS + (size_t)(u.row0 - sh_base + lr) * ldc + u.col0 + wc * 32 + 8 * fq;
#pragma unroll
                    for (int bj = 0; bj < 2; ++bj) { const f32x4 v0 = acc[ai][bj][m][0], v1 = acc[ai][bj][m][1];
                        *(u32x4*)(rowp + bj * HALF) = (u32x4){cvt_pk_bf16(v0[0], v0[1]), cvt_pk_bf16(v0[2], v0[3]), cvt_pk_bf16(v1[0], v1[1]), cvt_pk_bf16(v1[2], v1[3])}; } }
            return; }
#pragma unroll
        for (int ai = 0; ai < 2; ++ai)
#pragma unroll
            for (int m = 0; m < 4; ++m) { const int lr = ai * HALF + wr * 64 + m * 16 + fr;
                unsigned pk[2][2];
#pragma unroll
                for (int bj = 0; bj < 2; ++bj) { const f32x4 v0 = acc[ai][bj][m][0] * O8_SCALE, v1 = acc[ai][bj][m][1] * O8_SCALE;
                    int p = __builtin_amdgcn_cvt_pk_fp8_f32(v0[0], v0[1], 0, false); p = __builtin_amdgcn_cvt_pk_fp8_f32(v0[2], v0[3], p, true);
                    int q = __builtin_amdgcn_cvt_pk_fp8_f32(v1[0], v1[1], 0, false); q = __builtin_amdgcn_cvt_pk_fp8_f32(v1[2], v1[3], q, true);
                    pk[bj][0] = (unsigned)p; pk[bj][1] = (unsigned)q; }
                const auto s0 = __builtin_amdgcn_permlane16_swap(pk[0][0], pk[1][0], false, false), s1 = __builtin_amdgcn_permlane16_swap(pk[0][1], pk[1][1], false, false);
                if (lr < u.nvalid) *(u32x4*)(O + (size_t)(u.row0 + lr) * ldc + u.col0 + wc * 32 + (fq & 1) * HALF + (fq >> 1) * 16) = (u32x4){s0[0], s1[0], s0[1], s1[1]}; }
    }
};
struct EpiResidBf16 {
    static constexpr bool PERM = true;
    bf16_t* Y; const float* X; const bf16_t* XBp; int ldc; float alpha;
    __device__ __forceinline__ void operator()(const f32x4 (&acc)[2][2][4][2], const Unit& u, int wr, int wc, int fr, int fq) const {
#pragma unroll
        for (int ai = 0; ai < 2; ++ai)
#pragma unroll
            for (int m = 0; m < 4; ++m) { const size_t off = (size_t)(u.row0 + ai * HALF + wr * 64 + m * 16 + fr) * ldc + u.col0 + wc * 32 + 8 * fq;
#pragma unroll
                for (int bj = 0; bj < 2; ++bj) { f32x4 x0, x1;
                    if (X) { x0 = *(const f32x4*)(X + off + bj * HALF); x1 = *(const f32x4*)(X + off + bj * HALF + 4); }
                    else { const u32x4 r = *(const u32x4*)(XBp + off + bj * HALF); x0 = (f32x4){bf_lo(r.x), bf_hi(r.x), bf_lo(r.y), bf_hi(r.y)}; x1 = (f32x4){bf_lo(r.z), bf_hi(r.z), bf_lo(r.w), bf_hi(r.w)}; }
                    const f32x4 v0 = acc[ai][bj][m][0] + alpha * x0, v1 = acc[ai][bj][m][1] + alpha * x1;
                    *(u32x4*)(Y + off + bj * HALF) = (u32x4){cvt_pk_bf16(v0[0], v0[1]), cvt_pk_bf16(v0[2], v0[3]), cvt_pk_bf16(v1[0], v1[1]), cvt_pk_bf16(v1[2], v1[3])}; } }
    }
};
struct EpiSwiglu {
    static constexpr bool PERM = true;
    bf16_t* H;
    __device__ __forceinline__ void operator()(const f32x4 (&acc)[2][2][4][2], const Unit& u, int wr, int wc, int fr, int fq) const {
#pragma unroll
        for (int ai = 0; ai < 2; ++ai)
#pragma unroll
            for (int m = 0; m < 4; ++m) { const int lr = ai * HALF + wr * 64 + m * 16 + fr;
                if (lr < u.nvalid) { const f32x4 g0 = acc[ai][0][m][0], g1 = acc[ai][0][m][1], u0 = acc[ai][1][m][0], u1 = acc[ai][1][m][1];
                    u32x4 w; w.x = cvt_pk_bf16(silu_f(g0[0]) * u0[0], silu_f(g0[1]) * u0[1]); w.y = cvt_pk_bf16(silu_f(g0[2]) * u0[2], silu_f(g0[3]) * u0[3]);
                    w.z = cvt_pk_bf16(silu_f(g1[0]) * u1[0], silu_f(g1[1]) * u1[1]); w.w = cvt_pk_bf16(silu_f(g1[2]) * u1[2], silu_f(g1[3]) * u1[3]);
                    *(u32x4*)(H + (size_t)(u.row0 + lr) * DE + u.col0 + wc * 32 + 8 * fq) = w; } }
    }
};

template <class Epi, class Sched, bool GATHER>
__device__ __forceinline__ void gemm_phase(LAS unsigned char* lds, const int K, const Sched& S, const Epi& E) {
    int tid = threadIdx.x; asm volatile("" : "+v"(tid));
    const int wid = __builtin_amdgcn_readfirstlane(tid >> 6), lane = tid & 63, wr = wid >> 2, wc = wid & 3;
    const int nt = K / BK;
    unsigned voffB[2], oc[2][2];
#pragma unroll
    for (int i = 0; i < 2; ++i) { int R, C; stage_rc(tid * 16 + i * 8192, R, C); const int Rb = Epi::PERM ? ((R & ~31) + perm32(R & 31)) : R;
        voffB[i] = (unsigned)(Rb * K + C) * 2u; oc[0][i] = (unsigned)(R * K + C) * 2u; oc[1][i] = oc[0][i]; }
    const size_t kstep = (size_t)(BK * 2);
    const size_t hstep = (size_t)HALF * K * 2;
    const size_t ahstep = GATHER ? (size_t)0 : hstep;
    const unsigned ldsw = (unsigned)wid * 1024u;
    const int aoff = lds_byte(wr * 64 + (lane & 15), (lane >> 4) * 8), boff = lds_byte(wc * 32 + (lane & 15), (lane >> 4) * 8);
#define PG8_SA(b, h) (((b) * 2 + (h)) * HTB)
#define PG8_SB(b, h) ((4 + (b) * 2 + (h)) * HTB)
#define PG8_STAGE(bufoff, gbase, voff) do { _Pragma("unroll") for (int _i = 0; _i < 2; ++_i) \
        __builtin_amdgcn_global_load_lds((const unsigned*)((const char*)(gbase) + (voff)[_i]), (LAS unsigned*)(lds + (bufoff) + ldsw + _i * 8192), 16, 0, 0); } while (0)
#define PG8_STAGE_A(bufoff, gbase, h) PG8_STAGE(bufoff, (gbase) + (h) * ahstep, oc[GATHER ? (h) : 0])
#define PG8_LDA(dst, b, h) do { _Pragma("unroll") for (int m = 0; m < 4; ++m) _Pragma("unroll") for (int k = 0; k < 2; ++k) dst[m][k] = *(const LAS bf16x8*)(lds + PG8_SA(b, h) + aoff + m * 2048 + k * 1024); } while (0)
#define PG8_LDB(dst, b, h) do { _Pragma("unroll") for (int n = 0; n < 2; ++n) _Pragma("unroll") for (int k = 0; k < 2; ++k) dst[n][k] = *(const LAS bf16x8*)(lds + PG8_SB(b, h) + boff + n * 2048 + k * 1024); } while (0)
#define PG8_MMA(ai, bj, At, Bt) do { __builtin_amdgcn_s_setprio(1); _Pragma("unroll") for (int m = 0; m < 4; ++m) _Pragma("unroll") for (int n = 0; n < 2; ++n) _Pragma("unroll") for (int k = 0; k < 2; ++k) \
        acc[ai][bj][m][n] = __builtin_amdgcn_mfma_f32_16x16x32_bf16(Bt[n][k], At[m][k], acc[ai][bj][m][n], 0, 0, 0); __builtin_amdgcn_s_setprio(0); } while (0)
#define PG8_WAIT_V(n) asm volatile("s_waitcnt vmcnt(" #n ")" ::: "memory")
#define PG8_WAIT_L(n) asm volatile("s_waitcnt lgkmcnt(" #n ")" ::: "memory")
#define PG8_BAR __builtin_amdgcn_s_barrier()
#define PG8_SCHED __builtin_amdgcn_sched_barrier(0)
#define PG8_LOAD_ROWOFFS(uidx) do { int tz_ = threadIdx.x; asm volatile("" : "+v"(tz_)); _Pragma("unroll") for (int _i = 0; _i < 2; ++_i) { int R_, C_; stage_rc(tz_ * 16 + _i * 8192, R_, C_); \
        oc[0][_i] = S.rowoff((uidx), R_) + (unsigned)C_ * 2u; oc[1][_i] = S.rowoff((uidx), HALF + R_) + (unsigned)C_ * 2u; } } while (0)
    Unit cur, nxt; int ui = 0;
    if (!S.next(0, cur)) return;
    if constexpr (GATHER) { PG8_LOAD_ROWOFFS(0); }
    f32x4 acc[2][2][4][2];
#pragma unroll
    for (int a = 0; a < 2; ++a)
#pragma unroll
        for (int b = 0; b < 2; ++b)
#pragma unroll
            for (int m = 0; m < 4; ++m)
#pragma unroll
                for (int n = 0; n < 2; ++n) acc[a][b][m][n] = (f32x4){0.f, 0.f, 0.f, 0.f};
    bf16x8 At[4][2], B0[2][2], B1[2][2];
    const char* cA = cur.A; const char* cB = cur.B;
    LDS_WAIT();
    PG8_STAGE(PG8_SB(0, 0), cB, voffB); PG8_STAGE(PG8_SB(0, 1), cB + hstep, voffB); PG8_STAGE_A(PG8_SA(0, 0), cA, 0); PG8_STAGE_A(PG8_SA(0, 1), cA, 1);
    if (wr == 1) PG8_BAR;
    PG8_WAIT_V(2); PG8_BAR;
    PG8_STAGE(PG8_SB(1, 0), cB + kstep, voffB); PG8_STAGE_A(PG8_SA(1, 0), cA + kstep, 0); PG8_STAGE(PG8_SB(1, 1), cB + hstep + kstep, voffB);
    PG8_WAIT_V(6); PG8_BAR;
    for (;;) {
        const bool has_next = S.next(ui + 1, nxt);
        const char* nA = has_next ? nxt.A : cA; const char* nB = has_next ? nxt.B : cB;
#pragma unroll 1
        for (int t = 0; t < nt; t += 2) {
            const bool last = (t == nt - 2);
            const char* a1 = cA + (size_t)(t + 1) * kstep;
            const char* a2 = last ? nA : cA + (size_t)(t + 2) * kstep; const char* b2 = last ? nB : cB + (size_t)(t + 2) * kstep;
            const char* a3 = a2 + kstep; const char* b3 = b2 + kstep;
            PG8_LDB(B0, 0, 0); PG8_LDB(B1, 0, 1); PG8_SCHED; PG8_LDA(At, 0, 0); PG8_STAGE_A(PG8_SA(1, 1), a1, 1);
            if constexpr (GATHER) { if (last && has_next) { PG8_LOAD_ROWOFFS(ui + 1); } }
            PG8_WAIT_V(8); PG8_WAIT_L(0); PG8_BAR; PG8_MMA(0, 0, At, B0); PG8_MMA(0, 1, At, B1); PG8_BAR; PG8_SCHED;
            PG8_LDA(At, 0, 1); PG8_STAGE(PG8_SB(0, 0), b2, voffB); PG8_STAGE(PG8_SB(0, 1), b2 + hstep, voffB); PG8_STAGE_A(PG8_SA(0, 0), a2, 0);
            PG8_WAIT_V(8); PG8_WAIT_L(0); PG8_BAR; PG8_MMA(1, 0, At, B0); PG8_MMA(1, 1, At, B1); PG8_BAR; PG8_SCHED;
            PG8_LDB(B0, 1, 0); PG8_LDB(B1, 1, 1); PG8_SCHED; PG8_LDA(At, 1, 0); PG8_STAGE_A(PG8_SA(0, 1), a2, 1);
            PG8_WAIT_V(8); PG8_WAIT_L(0); PG8_BAR; PG8_MMA(0, 0, At, B0); PG8_MMA(0, 1, At, B1); PG8_BAR; PG8_SCHED;
            PG8_LDA(At, 1, 1); PG8_STAGE(PG8_SB(1, 0), b3, voffB); PG8_STAGE(PG8_SB(1, 1), b3 + hstep, voffB); PG8_STAGE_A(PG8_SA(1, 0), a3, 0);
            PG8_WAIT_V(8); PG8_WAIT_L(0); PG8_BAR; PG8_MMA(1, 0, At, B0); PG8_MMA(1, 1, At, B1); PG8_BAR; PG8_SCHED;
        }
        if (wr == 0) PG8_BAR;
        { int tz = threadIdx.x; asm volatile("" : "+v"(tz)); E(acc, cur, wr, wc, tz & 15, (tz & 63) >> 4); }
        if (!has_next) break;
#pragma unroll
        for (int a = 0; a < 2; ++a)
#pragma unroll
            for (int b = 0; b < 2; ++b)
#pragma unroll
                for (int m = 0; m < 4; ++m)
#pragma unroll
                    for (int n = 0; n < 2; ++n) acc[a][b][m][n] = (f32x4){0.f, 0.f, 0.f, 0.f};
        cur = nxt; cA = nA; cB = nB; ++ui;
        if (wr == 1) PG8_BAR;
    }
    PG8_WAIT_V(0);
    PG8_BAR;
#undef PG8_SA
#undef PG8_SB
#undef PG8_STAGE
#undef PG8_STAGE_A
#undef PG8_LOAD_ROWOFFS
#undef PG8_LDA
#undef PG8_LDB
#undef PG8_MMA
#undef PG8_WAIT_V
#undef PG8_WAIT_L
#undef PG8_BAR
#undef PG8_SCHED
}
}

#define XB_TMO      128
#define XB_XCNT(j)  (256  + 64 * (j))
#define XB_XSUB(j)  (1280 + 64 * (j))
#define XB_XGEN(j)  (2304 + 64 * (j))
#define XB_TOP      3328
#define XB_TOPGEN   3392
#define XCD_BAR_WORDS 3456
#define XB_SPIN_CAP (1u << 18)
__device__ __forceinline__ unsigned xb_ld(unsigned* p)              { return __hip_atomic_load(p, __ATOMIC_RELAXED, __HIP_MEMORY_SCOPE_AGENT); }
__device__ __forceinline__ unsigned xb_add(unsigned* p, unsigned v) { return __hip_atomic_fetch_add(p, v, __ATOMIC_RELAXED, __HIP_MEMORY_SCOPE_AGENT); }
__device__ __forceinline__ unsigned xb_xcc_id() { return (unsigned)__builtin_amdgcn_s_getreg((3 << 11) | 20) & 0xFu; }
#define XB_SPIN(cond, bar) do { unsigned _sp = 0; while (cond) { __builtin_amdgcn_s_sleep(1); \
    if ((++_sp & 255u) == 0u) { if (xb_ld(&(bar)[XB_TMO])) break; if (_sp > XB_SPIN_CAP) { atomicAdd(&(bar)[XB_TMO], 1u); break; } } } } while (0)
struct XcdBarrier { unsigned* bar; unsigned x; volatile LAS unsigned* st; };
__device__ __forceinline__ XcdBarrier xcd_barrier_post(unsigned* bar, volatile LAS unsigned* st) {
    XcdBarrier b; b.bar = bar; b.x = xb_xcc_id(); b.st = st;
    if (threadIdx.x == 0) (void)xb_add(&bar[XB_XCNT(b.x)], 1u);
    return b;
}
__device__ __forceinline__ void xcd_barrier_complete(unsigned* bar, unsigned x, unsigned& nloc, unsigned& nx) {
    const unsigned G = gridDim.x * gridDim.y * gridDim.z;
    unsigned sum, cnt, mine, sp = 0u;
    for (;;) {
        sum = 0u; cnt = 0u; mine = 0u;
#pragma unroll 1
        for (unsigned j = 0; j < 16; ++j) { const unsigned c = xb_ld(&bar[XB_XCNT(j)]); sum += c; cnt += (c > 0u) ? 1u : 0u; mine = (j == x) ? c : mine; }
        if (sum == G) break;
        __builtin_amdgcn_s_sleep(1);
        if ((++sp & 255u) == 0u) { if (xb_ld(&bar[XB_TMO])) break; if (sp > XB_SPIN_CAP) { atomicAdd(&bar[XB_TMO], 1u); break; } }
    }
    nloc = mine > 0u ? mine : 1u; nx = cnt > 0u ? cnt : 1u;
}
__device__ __forceinline__ void xcd_barrier(const XcdBarrier& b) {
    asm volatile("s_waitcnt vmcnt(0)" ::: "memory");
    __syncthreads();
    if (threadIdx.x == 0) {
        unsigned* bar = b.bar;
        __builtin_amdgcn_s_waitcnt(0);
        unsigned nloc = b.st[0], nx = b.st[1];
        if (nloc == 0u) { xcd_barrier_complete(bar, b.x, nloc, nx); b.st[0] = nloc; b.st[1] = nx; }
        const unsigned old = xb_add(&bar[XB_XSUB(b.x)], 1u);
        const unsigned gen = old / nloc;
        if (old + 1u == (gen + 1u) * nloc) {
            __builtin_amdgcn_fence(__ATOMIC_RELEASE, "agent");
            asm volatile("s_waitcnt vmcnt(0)" ::: "memory");
            const unsigned og = xb_add(&bar[XB_TOP], 1u);
            const unsigned tg = og / nx;
            if (og + 1u == (tg + 1u) * nx) xb_add(&bar[XB_TOPGEN], 1u);
            else XB_SPIN(xb_ld(&bar[XB_TOPGEN]) == tg, bar);
            __builtin_amdgcn_fence(__ATOMIC_ACQUIRE, "agent");
            xb_add(&bar[XB_XGEN(b.x)], 1u);
            asm volatile("s_waitcnt vmcnt(0)" ::: "memory");
        } else {
            XB_SPIN(xb_ld(&bar[XB_XGEN(b.x)]) == gen, bar);
            __builtin_amdgcn_fence(__ATOMIC_ACQUIRE, "agent");
            asm volatile("s_waitcnt vmcnt(0)" ::: "memory");
        }
    }
    __syncthreads();
}

struct Args { const float* in[29]; float* out; unsigned char* ws; int ph_lo, ph_hi; };
enum { I_X = 0, I_MEM, I_MEM_G, I_MEM_B, I_W_IN, I_SGU_G, I_SGU_B, I_SGU_W, I_SGU_BS, I_POOL_W, I_POOL_S, I_CONV_W, I_CONV_B, I_CONV_G, I_CONV_LB, I_W_KV, I_W_OUT, I_LN1_G, I_LN1_B,
       I_W_R, I_R_BIAS, I_E_G, I_E_U, I_E_D, I_S_G, I_S_U, I_S_D, I_LN2_G, I_LN2_B };

struct Frame {
    LAS unsigned char* lds;
    int tid, lane, wave, vcu, G;
    const Args* a;
    unsigned char* ws;
};

struct ItemDesc { const float* W; bf16_t* WT; bf16_t* WL; int ldw, ldt, k0, n0, drow0; };
constexpr int LI_IN = 3072, LI_OUT = 2048, LI_EX = 64 * 256, LI_SH = 256, LI_PW = 4 * 8, LI_RT = 64;
constexpr int L_ITEMS = LI_IN + LI_OUT + 3 * LI_EX + 3 * LI_SH + LI_PW + LI_RT;
constexpr int KV_ITEMS = 4 * 1024;
constexpr int LI_X = 3 * LI_EX + 3 * LI_SH, LI_S = L_ITEMS - LI_X;
constexpr int Q_TOTAL = NL * L_ITEMS - LI_S;
constexpr int CW_Q = 8192;
constexpr int Q_CH = 8;
__device__ __forceinline__ ItemDesc item_desc(const Args& A, unsigned char* ws, int l, int r) {
    bf16_t* WT_IN = (bf16_t*)(ws + WS_WT_IN); bf16_t* WT_OUT = (bf16_t*)(ws + WS_WT_OUT);
    bf16_t* WT_GU = (bf16_t*)(ws + WS_WT_GU); bf16_t* WT_D = (bf16_t*)(ws + WS_WT_D); bf16_t* WPT = (bf16_t*)(ws + WS_WPT);
    ItemDesc d; d.WL = nullptr;
    if (r < LI_IN) { const int kb = r / 96, nb = r % 96; d.W = A.in[I_W_IN] + (size_t)l * D * INW; d.ldw = INW; d.WT = WT_IN + (size_t)l * INW * D; d.ldt = D; d.k0 = kb * 64; d.n0 = nb * 32; d.drow0 = nb * 32; return d; } r -= LI_IN;
    if (r < LI_OUT) { const int kb = r / 64, nb = r % 64; d.W = A.in[I_W_OUT] + (size_t)l * D * D; d.ldw = D; d.WT = WT_OUT + (size_t)l * D * D; d.ldt = D; d.k0 = kb * 64; d.n0 = nb * 32; d.drow0 = nb * 32; return d; } r -= LI_OUT;
    if (r < 2 * LI_EX) { const int up = r >= LI_EX; if (up) r -= LI_EX; const int e = r / 256, rem = r % 256, kb = rem / 8, nb = rem % 8, n0 = nb * 32;
        d.W = A.in[up ? I_E_U : I_E_G] + (size_t)(l * NE + e) * D * DE; d.ldw = DE; d.WT = WT_GU + (size_t)(l * NE1 + e) * 512 * D; d.ldt = D; d.k0 = kb * 64; d.n0 = n0; d.drow0 = (n0 >> 7) * 256 + up * 128 + (n0 & 127); return d; } r -= 2 * LI_EX;
    if (r < LI_EX) { const int e = r / 256, rem = r % 256, kb = rem / 64, nb = rem % 64;
        d.W = A.in[I_E_D] + (size_t)(l * NE + e) * DE * D; d.ldw = D; d.WT = WT_D + (size_t)(l * NE1 + e) * D * DE; d.ldt = DE; d.k0 = kb * 64; d.n0 = nb * 32; d.drow0 = nb * 32; return d; } r -= LI_EX;
    if (r < 2 * LI_SH) { const int up = r >= LI_SH; if (up) r -= LI_SH; const int kb = r / 8, nb = r % 8, n0 = nb * 32;
        d.W = A.in[up ? I_S_U : I_S_G] + (size_t)l * D * DE; d.ldw = DE; d.WT = WT_GU + (size_t)(l * NE1 + 64) * 512 * D; d.ldt = D; d.k0 = kb * 64; d.n0 = n0; d.drow0 = (n0 >> 7) * 256 + up * 128 + (n0 & 127); return d; } r -= 2 * LI_SH;
    if (r < LI_SH) { const int kb = r / 64, nb = r % 64; d.W = A.in[I_S_D] + (size_t)l * DE * D; d.ldw = D; d.WT = WT_D + (size_t)(l * NE1 + 64) * D * DE; d.ldt = DE; d.k0 = kb * 64; d.n0 = nb * 32; d.drow0 = nb * 32; return d; } r -= LI_SH;
    if (r < LI_PW) { const int g = r / 8, rem = r % 8, kb = rem / 4, nb = rem % 4; d.W = A.in[I_POOL_W] + (size_t)(l * 4 + g) * 128 * 128; d.ldw = 128; d.WT = WPT + (size_t)(l * 4 + g) * 128 * 128; d.ldt = 128; d.k0 = kb * 64; d.n0 = nb * 32; d.drow0 = nb * 32; return d; } r -= LI_PW;
    { const int kb = r / 2, nb = r % 2; d.W = A.in[I_W_R] + (size_t)l * D * NE; d.ldw = NE; d.WT = (bf16_t*)(ws + WS_WR_HI) + (size_t)l * NE * D; d.WL = (bf16_t*)(ws + WS_WR_LO) + (size_t)l * NE * D; d.ldt = D; d.k0 = kb * 64; d.n0 = nb * 32; d.drow0 = nb * 32; return d; }
}
__device__ __forceinline__ ItemDesc kv_desc(const Args& A, unsigned char* ws, int r) {
    const int mat = r / 1024, rem = r % 1024, kb = rem / 32, nb = rem % 32, n0 = nb * 32; ItemDesc d; d.WL = nullptr;
    d.W = A.in[I_W_KV] + (size_t)mat * D * 1024; d.ldw = 1024; d.WT = (bf16_t*)(ws + (n0 < 512 ? WS_WT_K : WS_WT_V)); d.ldt = D; d.k0 = kb * 64; d.n0 = n0; d.drow0 = mat * 512 + (n0 & 511); return d;
}
__device__ __forceinline__ void item_load(const ItemDesc& d, f32x4 (&v)[8], int lane) {
#pragma unroll
    for (int i = 0; i < 8; ++i) v[i] = __builtin_nontemporal_load((const f32x4*)(d.W + (size_t)(d.k0 + 8 * i + (lane >> 3)) * d.ldw + d.n0 + 4 * (lane & 7)));
}
__device__ __forceinline__ void item_finish(const ItemDesc& d, const f32x4 (&v)[8], LAS float* scr, int lane) {
#pragma unroll
    for (int i = 0; i < 8; ++i) { LAS float* p = scr + (8 * i + (lane >> 3)) * 33 + 4 * (lane & 7); p[0] = v[i][0]; p[1] = v[i][1]; p[2] = v[i][2]; p[3] = v[i][3]; }
    LDS_WAIT(); asm volatile("" ::: "memory");
    const int c = lane & 7;
#pragma unroll
    for (int j = 0; j < 4; ++j) { const int n = (lane >> 3) + 8 * j; const LAS float* s = scr + (8 * c) * 33 + n;
        float x[8]; unsigned h[4];
#pragma unroll
        for (int q = 0; q < 8; ++q) x[q] = s[q * 33];
#pragma unroll
        for (int q = 0; q < 4; ++q) h[q] = cvt_pk_bf16(x[2 * q], x[2 * q + 1]);
        __builtin_nontemporal_store((u32x4){h[0], h[1], h[2], h[3]}, (u32x4*)(d.WT + (size_t)(d.drow0 + n) * d.ldt + d.k0 + 8 * c));
        if (d.WL) { unsigned lo[4];
#pragma unroll
            for (int q = 0; q < 4; ++q) lo[q] = cvt_pk_bf16(x[2 * q] - bf_lo(h[q]), x[2 * q + 1] - bf_hi(h[q]));
            *(u32x4*)(d.WL + (size_t)(d.drow0 + n) * d.ldt + d.k0 + 8 * c) = (u32x4){lo[0], lo[1], lo[2], lo[3]}; } }
    LDS_WAIT(); asm volatile("" ::: "memory");
}
__device__ __forceinline__ int s_item(int s) { return s < LI_IN + LI_OUT ? s : s + LI_X; }
struct GenPrologue { __device__ __forceinline__ ItemDesc operator()(const Args& A, unsigned char* ws, int id) const { return id < LI_S ? item_desc(A, ws, 0, s_item(id)) : kv_desc(A, ws, id - LI_S); } };
struct GenQueue    { __device__ __forceinline__ ItemDesc operator()(const Args& A, unsigned char* ws, int id) const { const int l = id / L_ITEMS, j = id % L_ITEMS;
    return j < LI_X ? item_desc(A, ws, l, LI_IN + LI_OUT + j) : item_desc(A, ws, l + 1, s_item(j - LI_X)); } };
template <class Gen> __device__ __forceinline__ void convert_seq(const Args& A, unsigned char* ws, int first, int end, int stride, LAS float* scr, int lane) {
    if (first >= end) return;
    const Gen gen; ItemDesc d0 = gen(A, ws, first); f32x4 v0[8]; item_load(d0, v0, lane);
#pragma unroll 1
    for (int id = first + stride; id < end; id += stride) { const ItemDesc d1 = gen(A, ws, id); f32x4 v1[8]; item_load(d1, v1, lane); item_finish(d0, v0, scr, lane); d0 = d1;
#pragma unroll
        for (int i = 0; i < 8; ++i) v0[i] = v1[i]; }
    item_finish(d0, v0, scr, lane);
}
__device__ __forceinline__ void convert_fill(Frame& F, int floor, int budget) {
    const Args& A = *F.a; LAS float* scr = (LAS float*)(F.lds + F.wave * 16384);
    unsigned* qh = (unsigned*)(F.ws + WS_CTL) + CW_Q;
#pragma unroll 1
    for (int b = 0; b < budget; ++b) {
        unsigned st = 0u; if (F.lane == 0) st = __hip_atomic_fetch_add(qh, (unsigned)Q_CH, __ATOMIC_RELAXED, __HIP_MEMORY_SCOPE_AGENT);
        const int s0 = __builtin_amdgcn_readfirstlane((int)st);
        if (s0 >= Q_TOTAL) break;
        const int lo = s0 > floor ? s0 : floor, hi = (s0 + Q_CH) < Q_TOTAL ? (s0 + Q_CH) : Q_TOTAL;
        if (lo >= hi) { ++budget; if (budget > (1 << 20)) break; continue; }
        convert_seq<GenQueue>(A, F.ws, lo, hi, 1, scr, F.lane);
    }
}
__device__ __forceinline__ void convert_cleanup(Frame& F, int from, int upto) {
    const Args& A = *F.a; LAS float* scr = (LAS float*)(F.lds + F.wave * 16384);
    unsigned* qh = (unsigned*)(F.ws + WS_CTL) + CW_Q;
    int head = __builtin_amdgcn_readfirstlane((int)__hip_atomic_load(qh, __ATOMIC_RELAXED, __HIP_MEMORY_SCOPE_AGENT)); head = head > from ? head : from;
    convert_seq<GenQueue>(A, F.ws, head + F.vcu * 8 + F.wave, upto, F.G * 8, scr, F.lane);
}

__device__ __forceinline__ void convert_beside_d(Frame& F, int from, int upto) {
    const Args& A = *F.a; LAS float* scr = (LAS float*)(F.lds + 81920 + (F.wave - 4) * 8704);
    unsigned* qh = (unsigned*)(F.ws + WS_CTL) + CW_Q;
    int head = __builtin_amdgcn_readfirstlane((int)__hip_atomic_load(qh, __ATOMIC_RELAXED, __HIP_MEMORY_SCOPE_AGENT)); head = head > from ? head : from;
    convert_seq<GenQueue>(A, F.ws, head + F.vcu * 4 + (F.wave - 4), upto, F.G * 4, scr, F.lane);
}
__device__ __forceinline__ void p0_prologue(Frame& F) {
    const Args& A = *F.a; unsigned char* ws = F.ws;
    LAS float* scr = (LAS float*)(F.lds + F.wave * 16384);
    const int gw = F.vcu * 8 + F.wave, NGW = F.G * 8, lane = F.lane;
    convert_seq<GenPrologue>(A, ws, gw, LI_S + KV_ITEMS, NGW, scr, lane);
    { const int gt = F.vcu * 512 + F.tid, NGT = F.G * 512; bf16_t* SW = (bf16_t*)(ws + WS_SGUW);
      for (int i = gt; i < NL * 4 * 128 * 128 / 8; i += NGT) { const int t = (i >> 4) & 127, s0 = (i & 15) * 8; const f32x4* p = (const f32x4*)(A.in[I_SGU_W] + (size_t)i * 8); const f32x4 a = p[0], b = p[1];
          float v[8] = {a[0], a[1], a[2], a[3], b[0], b[1], b[2], b[3]};
#pragma unroll
          for (int q = 0; q < 8; ++q) v[q] = (s0 + q <= t) ? v[q] : 0.f;
          *(u32x4*)(SW + (size_t)i * 8) = (u32x4){cvt_pk_bf16(v[0], v[1]), cvt_pk_bf16(v[2], v[3]), cvt_pk_bf16(v[4], v[5]), cvt_pk_bf16(v[6], v[7])}; }
      bf16_t* XB = (bf16_t*)(ws + WS_XB);
      for (int i = gt; i < NTOK * D / 8; i += NGT) { const f32x4* p = (const f32x4*)(A.in[I_X] + (size_t)i * 8); const f32x4 a = p[0], b = p[1];
          *(u32x4*)(XB + (size_t)i * 8) = (u32x4){cvt_pk_bf16(a[0], a[1]), cvt_pk_bf16(a[2], a[3]), cvt_pk_bf16(b[0], b[1]), cvt_pk_bf16(b[2], b[3])}; } }
    if (F.vcu == 0 && F.tid < 256) *(u32x4*)((bf16_t*)(ws + WS_X1B) + (size_t)NTOK * D + F.tid * 8) = (u32x4){0u, 0u, 0u, 0u};
    { bf16_t* MN = (bf16_t*)(ws + WS_MEMN);
      for (int m = gw; m < NMEMTOK; m += NGW) { const f32x4* xr = (const f32x4*)(A.in[I_MEM] + (size_t)m * D) + lane; f32x4 v[8]; float s = 0.f;
#pragma unroll
          for (int j = 0; j < 8; ++j) { v[j] = xr[64 * j]; s += (v[j][0] + v[j][1]) + (v[j][2] + v[j][3]); }
          const float mean = wave_sum(s) * (1.f / D); float s2 = 0.f;
#pragma unroll
          for (int j = 0; j < 8; ++j) { v[j] = v[j] - mean; s2 += (v[j][0] * v[j][0] + v[j][1] * v[j][1]) + (v[j][2] * v[j][2] + v[j][3] * v[j][3]); }
          const float rstd = 1.f / sqrtf(wave_sum(s2) * (1.f / D) + LN_EPS);
#pragma unroll
          for (int j = 0; j < 8; ++j) { const f32x4 g = ((const f32x4*)A.in[I_MEM_G])[lane + 64 * j], b = ((const f32x4*)A.in[I_MEM_B])[lane + 64 * j]; const f32x4 o = v[j] * rstd * g + b;
              *(u32x2*)(MN + (size_t)m * D + 4 * lane + 256 * j) = (u32x2){cvt_pk_bf16(o[0], o[1]), cvt_pk_bf16(o[2], o[3])}; } } }
}

typedef f32x4 acc8_t[8];
__device__ __forceinline__ void mixer_sgu(Frame& F, int l, int chunk, int h) {
    const Args& A = *F.a; const int lane = F.lane, w = F.wave, fr = lane & 15, g = lane >> 4, t0 = chunk * 128;
    const bf16_t* HB = (const bf16_t*)(F.ws + WS_HB); bf16_t* MIX = (bf16_t*)(F.ws + WS_MIX); const bf16_t* SW = (const bf16_t*)(F.ws + WS_SGUW) + (size_t)(l * 4 + h) * 128 * 128;
    LAS unsigned char* VT = F.lds;
    const int t = 16 * w + fr;
    bf16x8 af[4]; u32x2 uraw[8];
#pragma unroll
    for (int ks = 0; ks < 4; ++ks) af[ks] = *(const bf16x8*)(SW + (size_t)t * 128 + 32 * ks + 8 * g);
#pragma unroll
    for (int j = 0; j < 8; ++j) uraw[j] = *(const u32x2*)(HB + (size_t)(t0 + t) * INW + h * 128 + 16 * j + 4 * g);
    const float bs = A.in[I_SGU_BS][(size_t)(l * 128 + t) * 4 + h];
    { const float* gp = A.in[I_SGU_G] + l * GW + h * 128 + 8 * fr; const float* bp = A.in[I_SGU_B] + l * GW + h * 128 + 8 * fr;
      const f32x4 g0 = *(const f32x4*)gp, g1 = *(const f32x4*)(gp + 4), b0 = *(const f32x4*)bp, b1 = *(const f32x4*)(bp + 4);
      const float gg[8] = {g0[0], g0[1], g0[2], g0[3], g1[0], g1[1], g1[2], g1[3]}, bb[8] = {b0[0], b0[1], b0[2], b0[3], b1[0], b1[1], b1[2], b1[3]};
      u32x4 raw[4];
#pragma unroll
      for (int p = 0; p < 4; ++p) raw[p] = *(const u32x4*)(HB + (size_t)(t0 + 16 * w + 4 * p + g) * INW + 512 + h * 128 + 8 * fr);
#pragma unroll
      for (int p = 0; p < 4; ++p) { const int tok = 16 * w + 4 * p + g;
          float v[8] = {bf_lo(raw[p].x), bf_hi(raw[p].x), bf_lo(raw[p].y), bf_hi(raw[p].y), bf_lo(raw[p].z), bf_hi(raw[p].z), bf_lo(raw[p].w), bf_hi(raw[p].w)}; float s = 0.f;
#pragma unroll
          for (int q = 0; q < 8; ++q) { v[q] = gelu_tanh_f(v[q]); s += v[q]; }
          const float mean = g16_sum(s) * (1.f / 128.f); float s2 = 0.f;
#pragma unroll
          for (int q = 0; q < 8; ++q) { v[q] -= mean; s2 += v[q] * v[q]; }
          const float rstd = 1.f / sqrtf(g16_sum(s2) * (1.f / 128.f) + LN_EPS);
#pragma unroll
          for (int q = 0; q < 8; q += 2) { const unsigned pk = cvt_pk_bf16(v[q] * rstd * gg[q] + bb[q], v[q + 1] * rstd * gg[q + 1] + bb[q + 1]);
              const int d0 = 8 * fr + q, d1 = d0 + 1;
              *(LAS bf16_t*)(VT + d0 * 256 + ((((tok >> 3) ^ d0 ^ (d0 >> 3)) & 15) << 4) + (tok & 7) * 2) = (bf16_t)(pk & 0xffffu);
              *(LAS bf16_t*)(VT + d1 * 256 + ((((tok >> 3) ^ d1 ^ (d1 >> 3)) & 15) << 4) + (tok & 7) * 2) = (bf16_t)(pk >> 16); } } }
    __syncthreads();
    f32x4 acc[8];
#pragma unroll
    for (int j = 0; j < 8; ++j) acc[j] = (f32x4){0.f, 0.f, 0.f, 0.f};
    const int nks = (w >> 1) + 1;
#pragma unroll
    for (int ks = 0; ks < 4; ++ks) if (ks < nks) {
#pragma unroll
        for (int j = 0; j < 8; ++j) { const int d = 16 * j + fr; const bf16x8 bfr = *(const LAS bf16x8*)(VT + d * 256 + ((((4 * ks + g) ^ d ^ (d >> 3)) & 15) << 4));
            acc[j] = __builtin_amdgcn_mfma_f32_16x16x32_bf16(bfr, af[ks], acc[j], 0, 0, 0); }
    }
#pragma unroll
    for (int j = 0; j < 8; ++j) { const u32x2 raw = uraw[j];
        const float u0 = gelu_tanh_f(bf_lo(raw.x)), u1 = gelu_tanh_f(bf_hi(raw.x)), u2 = gelu_tanh_f(bf_lo(raw.y)), u3 = gelu_tanh_f(bf_hi(raw.y));
        *(u32x2*)(MIX + (size_t)(t0 + t) * D + h * 128 + 16 * j + 4 * g) = (u32x2){cvt_pk_bf16(u0 * (acc[j][0] + bs), u1 * (acc[j][1] + bs)), cvt_pk_bf16(u2 * (acc[j][2] + bs), u3 * (acc[j][3] + bs))}; }
    __syncthreads();
}
__device__ __forceinline__ void mixer_pool(Frame& F, int l, int chunk, int grp) {
    const Args& A = *F.a; const int lane = F.lane, w = F.wave, fr = lane & 15, g = lane >> 4, t0 = chunk * 128, tid = F.tid;
    const bf16_t* HB = (const bf16_t*)(F.ws + WS_HB); bf16_t* MIX = (bf16_t*)(F.ws + WS_MIX); const bf16_t* WP = (const bf16_t*)(F.ws + WS_WPT) + (size_t)(l * 4 + grp) * 128 * 128;
    constexpr int PST = 272;
    LAS unsigned char* PT = F.lds;
    LAS unsigned char* PA = F.lds + 144 * PST;
    const int win = 2 << grp, pos0 = t0 & (SEQ - 1);
    LAS unsigned char* WS = F.lds + 144 * PST + 128 * PST;
    { u32x4 wv4[4];
#pragma unroll
      for (int i = 0; i < 4; ++i) wv4[i] = *(const u32x4*)(WP + (size_t)(tid + 512 * i) * 8);
      for (int i = tid; i < 144 * 16; i += 512) { const int r = i >> 4, cc = i & 15; const int trow = t0 - 16 + r; u32x4 v = (u32x4){0u, 0u, 0u, 0u};
          if (pos0 - 16 + r >= 0) v = *(const u32x4*)(HB + (size_t)trow * INW + 1024 + grp * 128 + 8 * cc);
          *(LAS u32x4*)(PT + r * PST + cc * 16) = v; }
#pragma unroll
      for (int i = 0; i < 4; ++i) { const int id = tid + 512 * i, d = id >> 4, cc = id & 15; *(LAS u32x4*)(WS + d * 256 + ((cc ^ (d & 15)) << 4)) = wv4[i]; } }
    f32x4 scv[8];
#pragma unroll
    for (int j = 0; j < 8; ++j) scv[j] = *(const f32x4*)(A.in[I_POOL_S] + l * GW + grp * 128 + 16 * j + 4 * g);
    __syncthreads();
    for (int i = tid; i < 128 * 16; i += 512) { const int t = i >> 4, cc = i & 15; float s[8] = {0.f, 0.f, 0.f, 0.f, 0.f, 0.f, 0.f, 0.f}; u32x4 cur = (u32x4){0u, 0u, 0u, 0u};
        for (int j = 0; j < win; ++j) { cur = *(const LAS u32x4*)(PT + (t + 16 - win + 1 + j) * PST + cc * 16);
            s[0] += bf_lo(cur.x); s[1] += bf_hi(cur.x); s[2] += bf_lo(cur.y); s[3] += bf_hi(cur.y); s[4] += bf_lo(cur.z); s[5] += bf_hi(cur.z); s[6] += bf_lo(cur.w); s[7] += bf_hi(cur.w); }
        const int pos = pos0 + t; const float inv = 1.0f / (float)((pos + 1) < win ? (pos + 1) : win);
        const float x[8] = {bf_lo(cur.x), bf_hi(cur.x), bf_lo(cur.y), bf_hi(cur.y), bf_lo(cur.z), bf_hi(cur.z), bf_lo(cur.w), bf_hi(cur.w)};
        *(LAS u32x4*)(PA + t * PST + cc * 16) = (u32x4){cvt_pk_bf16(s[0] * inv - x[0], s[1] * inv - x[1]), cvt_pk_bf16(s[2] * inv - x[2], s[3] * inv - x[3]),
                                                        cvt_pk_bf16(s[4] * inv - x[4], s[5] * inv - x[5]), cvt_pk_bf16(s[6] * inv - x[6], s[7] * inv - x[7])}; }
    __syncthreads();
    f32x4 acc[8];
#pragma unroll
    for (int j = 0; j < 8; ++j) acc[j] = (f32x4){0.f, 0.f, 0.f, 0.f};
#pragma unroll
    for (int ks = 0; ks < 4; ++ks) { const bf16x8 af = *(const LAS bf16x8*)(PA + (16 * w + fr) * PST + (32 * ks + 8 * g) * 2);
#pragma unroll
        for (int j = 0; j < 8; ++j) { const bf16x8 bfr = *(const LAS bf16x8*)(WS + (16 * j + fr) * 256 + (((4 * ks + g) ^ fr) << 4));
            acc[j] = __builtin_amdgcn_mfma_f32_16x16x32_bf16(bfr, af, acc[j], 0, 0, 0); } }
    { const int t = 16 * w + fr;
#pragma unroll
      for (int j = 0; j < 8; ++j) { const f32x4 sc = scv[j];
          *(u32x2*)(MIX + (size_t)(t0 + t) * D + 512 + grp * 128 + 16 * j + 4 * g) = (u32x2){cvt_pk_bf16(acc[j][0] * sc[0], acc[j][1] * sc[1]), cvt_pk_bf16(acc[j][2] * sc[2], acc[j][3] * sc[3])}; } }
    __syncthreads();
}
__device__ __forceinline__ void mixer_conv(Frame& F, int l, int chunk, int grp) {
    const Args& A = *F.a; const int lane = F.lane, w = F.wave, fr = lane & 15, g = lane >> 4, t0 = chunk * 128, tid = F.tid;
    const bf16_t* HB = (const bf16_t*)(F.ws + WS_HB); bf16_t* MIX = (bf16_t*)(F.ws + WS_MIX);
    LAS float* GT = (LAS float*)F.lds;
    const int pos0 = t0 & (SEQ - 1);
    for (int i = tid; i < 158 * 16; i += 512) { const int r = i >> 4, cc = i & 15; float o[8] = {0.f, 0.f, 0.f, 0.f, 0.f, 0.f, 0.f, 0.f};
        if (pos0 - 30 + r >= 0) { const bf16_t* rowp = HB + (size_t)(t0 - 30 + r) * INW + grp * 128 + 8 * cc; const u32x4 v = *(const u32x4*)(rowp + 1536), gt = *(const u32x4*)(rowp + 2048);
            o[0] = bf_lo(v.x) * fast_sigmoid(bf_lo(gt.x)); o[1] = bf_hi(v.x) * fast_sigmoid(bf_hi(gt.x)); o[2] = bf_lo(v.y) * fast_sigmoid(bf_lo(gt.y)); o[3] = bf_hi(v.y) * fast_sigmoid(bf_hi(gt.y));
            o[4] = bf_lo(v.z) * fast_sigmoid(bf_lo(gt.z)); o[5] = bf_hi(v.z) * fast_sigmoid(bf_hi(gt.z)); o[6] = bf_lo(v.w) * fast_sigmoid(bf_lo(gt.w)); o[7] = bf_hi(v.w) * fast_sigmoid(bf_hi(gt.w)); }
        *(LAS f32x4*)(GT + r * 128 + 8 * cc) = (f32x4){o[0], o[1], o[2], o[3]}; *(LAS f32x4*)(GT + r * 128 + 8 * cc + 4) = (f32x4){o[4], o[5], o[6], o[7]}; }
    __syncthreads();
    float y[32];
    { const int ch = tid & 127, tg = tid >> 7; float wv[31];
#pragma unroll
      for (int j = 0; j < 31; ++j) wv[j] = A.in[I_CONV_W][(size_t)(l * 31 + j) * GW + grp * 128 + ch];
      const float bias = A.in[I_CONV_B][l * GW + grp * 128 + ch];
      float xin[62];
#pragma unroll
      for (int j = 0; j < 62; ++j) xin[j] = GT[(tg * 32 + j) * 128 + ch];
#pragma unroll
      for (int t = 0; t < 32; ++t) { float s = bias;
#pragma unroll
          for (int j = 0; j < 31; ++j) s += wv[j] * xin[t + j];
          y[t] = s; }
      __syncthreads();
#pragma unroll
      for (int t = 0; t < 32; ++t) GT[(tg * 32 + t) * 128 + ch] = y[t]; }
    __syncthreads();
    { const float* gp = A.in[I_CONV_G] + l * GW + grp * 128 + 8 * fr; const float* bp = A.in[I_CONV_LB] + l * GW + grp * 128 + 8 * fr;
      const f32x4 g0 = *(const f32x4*)gp, g1 = *(const f32x4*)(gp + 4), b0 = *(const f32x4*)bp, b1 = *(const f32x4*)(bp + 4);
      const float gg[8] = {g0[0], g0[1], g0[2], g0[3], g1[0], g1[1], g1[2], g1[3]}, bb[8] = {b0[0], b0[1], b0[2], b0[3], b1[0], b1[1], b1[2], b1[3]};
#pragma unroll
      for (int p = 0; p < 4; ++p) { const int tok = 16 * w + 4 * p + g; const f32x4 a = *(const LAS f32x4*)(GT + tok * 128 + 8 * fr), b = *(const LAS f32x4*)(GT + tok * 128 + 8 * fr + 4);
          float v[8] = {a[0], a[1], a[2], a[3], b[0], b[1], b[2], b[3]}; float s = 0.f;
#pragma unroll
          for (int q = 0; q < 8; ++q) s += v[q];
          const float mean = g16_sum(s) * (1.f / 128.f); float s2 = 0.f;
#pragma unroll
          for (int q = 0; q < 8; ++q) { v[q] -= mean; s2 += v[q] * v[q]; }
          const float rstd = 1.f / sqrtf(g16_sum(s2) * (1.f / 128.f) + LN_EPS);
#pragma unroll
          for (int q = 0; q < 8; ++q) v[q] = silu_f(v[q] * rstd * gg[q] + bb[q]);
          *(u32x4*)(MIX + (size_t)(t0 + tok) * D + 1024 + grp * 128 + 8 * fr) = (u32x4){cvt_pk_bf16(v[0], v[1]), cvt_pk_bf16(v[2], v[3]), cvt_pk_bf16(v[4], v[5]), cvt_pk_bf16(v[6], v[7])}; } }
    __syncthreads();
}
__device__ __forceinline__ void mixer_attn(Frame& F, int l, int chunk, int h) {
    const int lane = F.lane, w = F.wave, fr = lane & 15, g = lane >> 4, t0 = chunk * 128, b = t0 / SEQ, tid = F.tid;
    const bf16_t* HB = (const bf16_t*)(F.ws + WS_HB); bf16_t* MIX = (bf16_t*)(F.ws + WS_MIX);
    const bf16_t* KB = (const bf16_t*)(F.ws + WS_KBUF) + (size_t)(b * 256) * D + l * 512 + h * 128;
    const bf16_t* VTp = (const bf16_t*)(F.ws + WS_VT) + (size_t)(l * 512 + h * 128) * NMEMTOK + b * 256;
    LAS unsigned char* KS = F.lds;
    LAS unsigned char* VS = F.lds + 65536;
    { u32x4 kv[8], vv[8];
#pragma unroll
      for (int i = 0; i < 8; ++i) { const int id = tid + 512 * i; kv[i] = *(const u32x4*)(KB + (size_t)(id >> 4) * D + (id & 15) * 8); vv[i] = *(const u32x4*)(VTp + (size_t)(id >> 5) * NMEMTOK + (id & 31) * 8); }
#pragma unroll
      for (int i = 0; i < 8; ++i) { const int id = tid + 512 * i; const int m = id >> 4, c = id & 15, d = id >> 5, c2 = id & 31;
          *(LAS u32x4*)(KS + m * 256 + ((c ^ (m & 15)) << 4)) = kv[i]; *(LAS u32x4*)(VS + d * 512 + ((c2 ^ (d & 15)) << 4)) = vv[i]; } }
    __syncthreads();
    const int t = 16 * w + fr;
    f32x4 sa[16];
#pragma unroll
    for (int j = 0; j < 16; ++j) sa[j] = (f32x4){0.f, 0.f, 0.f, 0.f};
    bf16x8 qf[4];
#pragma unroll
    for (int ks = 0; ks < 4; ++ks) qf[ks] = *(const bf16x8*)(HB + (size_t)(t0 + t) * INW + 2560 + h * 128 + 32 * ks + 8 * g);
#pragma unroll
    for (int ks = 0; ks < 4; ++ks)
#pragma unroll
        for (int j = 0; j < 16; ++j) { const bf16x8 kf = *(const LAS bf16x8*)(KS + (16 * j + fr) * 256 + (((4 * ks + g) ^ fr) << 4));
            sa[j] = __builtin_amdgcn_mfma_f32_16x16x32_bf16(kf, qf[ks], sa[j], 0, 0, 0); }
    float mx = -3.0e38f;
#pragma unroll
    for (int j = 0; j < 16; ++j) mx = fmaxf(mx, fmaxf(fmaxf(sa[j][0], sa[j][1]), fmaxf(sa[j][2], sa[j][3])));
    mx = fmaxf(mx, __shfl_xor(mx, 16)); mx = fmaxf(mx, __shfl_xor(mx, 32));
    const float sc = 0.08838834764831845f * 1.4426950408889634f; float sum = 0.f;
#pragma unroll
    for (int j = 0; j < 16; ++j)
#pragma unroll
        for (int r = 0; r < 4; ++r) { const float p = __builtin_amdgcn_exp2f((sa[j][r] - mx) * sc); sa[j][r] = p; sum += p; }
    sum += __shfl_xor(sum, 16); sum += __shfl_xor(sum, 32);
    const float inv = 1.0f / sum;
    f32x4 oa[8];
#pragma unroll
    for (int j = 0; j < 8; ++j) oa[j] = (f32x4){0.f, 0.f, 0.f, 0.f};
#pragma unroll
    for (int q = 0; q < 8; ++q) {
        union { bf16x8 v; unsigned u[4]; } pf; pf.u[0] = cvt_pk_bf16(sa[2 * q][0], sa[2 * q][1]); pf.u[1] = cvt_pk_bf16(sa[2 * q][2], sa[2 * q][3]);
        pf.u[2] = cvt_pk_bf16(sa[2 * q + 1][0], sa[2 * q + 1][1]); pf.u[3] = cvt_pk_bf16(sa[2 * q + 1][2], sa[2 * q + 1][3]);
#pragma unroll
        for (int jd = 0; jd < 8; ++jd) {
            const LAS unsigned char* vrow = VS + (16 * jd + fr) * 512 + ((g & 1) << 3);
            union { bf16x8 v; u32x2 u[2]; } vf; vf.u[0] = *(const LAS u32x2*)(vrow + (((4 * q + (g >> 1)) ^ fr) << 4)); vf.u[1] = *(const LAS u32x2*)(vrow + (((4 * q + 2 + (g >> 1)) ^ fr) << 4));
            oa[jd] = __builtin_amdgcn_mfma_f32_16x16x32_bf16(vf.v, pf.v, oa[jd], 0, 0, 0); } }
#pragma unroll
    for (int jd = 0; jd < 8; ++jd)
        *(u32x2*)(MIX + (size_t)(t0 + t) * D + 1536 + h * 128 + 16 * jd + 4 * g) = (u32x2){cvt_pk_bf16(oa[jd][0] * inv, oa[jd][1] * inv), cvt_pk_bf16(oa[jd][2] * inv, oa[jd][3] * inv)};
    __syncthreads();
}

template <int NW> __device__ __forceinline__ void dsync(LAS unsigned* ctr, unsigned& nb, int lane) {
    if constexpr (NW == 8) { asm volatile("s_waitcnt vmcnt(0)" ::: "memory"); __syncthreads(); }
    else { asm volatile("s_waitcnt vmcnt(0) lgkmcnt(0)" ::: "memory"); ++nb;
        if (lane == 0) __hip_atomic_fetch_add(ctr, 1u, __ATOMIC_RELAXED, __HIP_MEMORY_SCOPE_WORKGROUP);
        while (__hip_atomic_load(ctr, __ATOMIC_RELAXED, __HIP_MEMORY_SCOPE_WORKGROUP) < (unsigned)NW * nb) __builtin_amdgcn_s_sleep(1);
        asm volatile("" ::: "memory"); }
}
template <int NW> __device__ __forceinline__ void phase_d(Frame& F, int l) {
    constexpr int TPW = 32 / NW, KW = D / NW;
    const Args& A = *F.a; unsigned char* ws = F.ws; const int lane = F.lane, w = F.wave, tid = F.tid, fr = lane & 15, g = lane >> 4;
    const bf16_t* Y1 = (const bf16_t*)(ws + WS_Y1); bf16_t* X1L = (bf16_t*)(ws + WS_X1F); bf16_t* X1B = (bf16_t*)(ws + WS_X1B);
    const bf16_t* WRH = (const bf16_t*)(ws + WS_WR_HI) + (size_t)l * NE * D; const bf16_t* WRL = (const bf16_t*)(ws + WS_WR_LO) + (size_t)l * NE * D;
    int* LIST = (int*)(ws + WS_LIST); int* AEP = (int*)(ws + WS_ASG_EP); float* AW = (float*)(ws + WS_ASG_W);
    unsigned* CNT = (unsigned*)(ws + WS_CTL) + CW_CNT + (size_t)l * 64 * CNT_STRIDE;
    LAS float* PL = (LAS float*)F.lds;
    LAS unsigned* HIST = (LAS unsigned*)(F.lds + NW * 32 * 65 * 4);
    LAS unsigned* ctr = (LAS unsigned*)(F.lds + LDS_MISC) + 16; unsigned nb = 0u;
    for (int blk = F.vcu; blk < NTOK / 32; blk += F.G) {
        const int tok0 = blk * 32;
        if (tid < 128) HIST[tid] = 0u;
#pragma unroll 1
        for (int tt = 0; tt < TPW; tt += 2) { f32x4 v[2][8]; float mean[2], rstd[2];
#pragma unroll
            for (int u = 0; u < 2; ++u) { const u32x2* yr = (const u32x2*)(Y1 + (size_t)(tok0 + TPW * w + tt + u) * D) + lane;
#pragma unroll
                for (int j = 0; j < 8; ++j) { const u32x2 r = yr[64 * j]; v[u][j] = (f32x4){bf_lo(r.x), bf_hi(r.x), bf_lo(r.y), bf_hi(r.y)}; } }
#pragma unroll
            for (int u = 0; u < 2; ++u) { float s = 0.f;
#pragma unroll
                for (int j = 0; j < 8; ++j) s += (v[u][j][0] + v[u][j][1]) + (v[u][j][2] + v[u][j][3]);
                mean[u] = wave_sum(s) * (1.f / D); float s2 = 0.f;
#pragma unroll
                for (int j = 0; j < 8; ++j) { v[u][j] = v[u][j] - mean[u]; s2 += (v[u][j][0] * v[u][j][0] + v[u][j][1] * v[u][j][1]) + (v[u][j][2] * v[u][j][2] + v[u][j][3] * v[u][j][3]); }
                rstd[u] = 1.f / sqrtf(wave_sum(s2) * (1.f / D) + LN_EPS); }
#pragma unroll
            for (int j = 0; j < 8; ++j) { const f32x4 gg = ((const f32x4*)(A.in[I_LN1_G] + l * D))[lane + 64 * j], bb = ((const f32x4*)(A.in[I_LN1_B] + l * D))[lane + 64 * j];
#pragma unroll
                for (int u = 0; u < 2; ++u) { const int tok = tok0 + TPW * w + tt + u; const f32x4 o = v[u][j] * rstd[u] * gg + bb;
                    const unsigned h0 = cvt_pk_bf16(o[0], o[1]), h1 = cvt_pk_bf16(o[2], o[3]);
                    *(u32x2*)(X1B + (size_t)tok * D + 4 * lane + 256 * j) = (u32x2){h0, h1};
                    *(u32x2*)(X1L + (size_t)tok * D + 4 * lane + 256 * j) = (u32x2){cvt_pk_bf16(o[0] - bf_lo(h0), o[1] - bf_hi(h0)), cvt_pk_bf16(o[2] - bf_lo(h1), o[3] - bf_hi(h1))}; } } }
        dsync<NW>(ctr, nb, lane);
        { f32x4 acc[2][4];
#pragma unroll
          for (int rb = 0; rb < 2; ++rb)
#pragma unroll
              for (int cb = 0; cb < 4; ++cb) acc[rb][cb] = (f32x4){0.f, 0.f, 0.f, 0.f};
#pragma unroll 4
          for (int ks = 0; ks < KW / 32; ++ks) { const int k = KW * w + 32 * ks + 8 * g; bf16x8 ah[2], al[2];
#pragma unroll
              for (int rb = 0; rb < 2; ++rb) { ah[rb] = *(const bf16x8*)(X1B + (size_t)(tok0 + 16 * rb + fr) * D + k); al[rb] = *(const bf16x8*)(X1L + (size_t)(tok0 + 16 * rb + fr) * D + k); }
#pragma unroll
              for (int cb = 0; cb < 4; ++cb) { const bf16x8 bh = *(const bf16x8*)(WRH + (size_t)(16 * cb + fr) * D + k), bl = *(const bf16x8*)(WRL + (size_t)(16 * cb + fr) * D + k);
#pragma unroll
                  for (int rb = 0; rb < 2; ++rb) { acc[rb][cb] = __builtin_amdgcn_mfma_f32_16x16x32_bf16(ah[rb], bh, acc[rb][cb], 0, 0, 0);
                      acc[rb][cb] = __builtin_amdgcn_mfma_f32_16x16x32_bf16(ah[rb], bl, acc[rb][cb], 0, 0, 0); acc[rb][cb] = __builtin_amdgcn_mfma_f32_16x16x32_bf16(al[rb], bh, acc[rb][cb], 0, 0, 0); } } }
#pragma unroll
          for (int rb = 0; rb < 2; ++rb)
#pragma unroll
              for (int cb = 0; cb < 4; ++cb)
#pragma unroll
                  for (int r = 0; r < 4; ++r) PL[(w * 32 + 16 * rb + 4 * g + r) * 65 + 16 * cb + fr] = acc[rb][cb][r]; }
        dsync<NW>(ctr, nb, lane);
        bool selv[TPW]; unsigned locv[TPW]; float wnv[TPW]; int kv[TPW];
        const float rbias = A.in[I_R_BIAS][l * NE + lane];
#pragma unroll
        for (int tt = 0; tt < TPW; ++tt) { const int tl = TPW * w + tt; float logit = 0.f;
#pragma unroll
            for (int ww = 0; ww < NW; ++ww) logit += PL[(ww * 32 + tl) * 65 + lane];
            const float score = 1.0f / (1.0f + __expf(-logit)), choice = score + rbias;
            float m1 = choice; m1 = fmaxf(m1, __shfl_xor(m1, 1)); m1 = fmaxf(m1, __shfl_xor(m1, 2)); m1 = fmaxf(m1, __shfl_xor(m1, 4));
            int i1 = (choice == m1) ? lane : 64; i1 = min(i1, __shfl_xor(i1, 1)); i1 = min(i1, __shfl_xor(i1, 2)); i1 = min(i1, __shfl_xor(i1, 4));
            float m2 = (lane == i1) ? -INFINITY : choice; m2 = fmaxf(m2, __shfl_xor(m2, 1)); m2 = fmaxf(m2, __shfl_xor(m2, 2)); m2 = fmaxf(m2, __shfl_xor(m2, 4));
            const float gs = m1 + m2; const int myg = lane >> 3; int grank = 0;
#pragma unroll
            for (int gg = 0; gg < 8; ++gg) { const float gv = __int_as_float(__builtin_amdgcn_readlane(__float_as_int(gs), 8 * gg)); grank += (gv > gs || (gv == gs && gg < myg)) ? 1 : 0; }
            const float mc = (grank < 4) ? choice : -INFINITY; int er = 0;
#pragma unroll
            for (int e2 = 0; e2 < 64; ++e2) { const float v = __int_as_float(__builtin_amdgcn_readlane(__float_as_int(mc), e2)); er += (v > mc || (v == mc && e2 < lane)) ? 1 : 0; }
            const bool sel = er < TOPK; const float wsum = wave_sum(sel ? score : 0.f);
            const unsigned long long mask = __ballot(sel);
            selv[tt] = sel; wnv[tt] = score / (wsum + 1e-20f) * 2.5f; kv[tt] = __popcll(mask & ((1ull << lane) - 1ull)); locv[tt] = 0u;
            if (sel) locv[tt] = __hip_atomic_fetch_add(&HIST[lane], 1u, __ATOMIC_RELAXED, __HIP_MEMORY_SCOPE_WORKGROUP); }
        dsync<NW>(ctr, nb, lane);
        if (tid < 64) { const unsigned n = HIST[tid]; HIST[64 + tid] = n ? __hip_atomic_fetch_add(CNT + tid * CNT_STRIDE, n, __ATOMIC_RELAXED, __HIP_MEMORY_SCOPE_AGENT) : 0u; }
        dsync<NW>(ctr, nb, lane);
#pragma unroll
        for (int tt = 0; tt < TPW; ++tt) if (selv[tt]) { const int tok = tok0 + TPW * w + tt; const unsigned pos = HIST[64 + lane] + locv[tt];
            LIST[lane * NTOK + pos] = tok; AEP[tok * 8 + kv[tt]] = (int)((unsigned)lane << 16 | pos); AW[tok * 8 + kv[tt]] = wnv[tt]; }
        dsync<NW>(ctr, nb, lane);
    }
}

__device__ __forceinline__ void build_etab(Frame& F, int l) {
    LAS int* ET = (LAS int*)(F.lds + LDS_ETAB);
    unsigned* CNT = (unsigned*)(F.ws + WS_CTL) + CW_CNT + (size_t)l * 64 * CNT_STRIDE;
    if (F.tid < NE1) ET[F.tid] = F.tid < NE ? (int)__hip_atomic_load(CNT + F.tid * CNT_STRIDE, __ATOMIC_RELAXED, __HIP_MEMORY_SCOPE_AGENT) : NTOK;
    __syncthreads();
    if (F.tid == 0) { int ts = 0;
#pragma unroll 1
        for (int e = 0; e < NE1; ++e) { ET[68 + e] = ts; ET[136 + e] = ts * 256; ts += (ET[e] + 255) >> 8; } ET[68 + NE1] = ts; }
    __syncthreads();
}
struct ExpertSched {
    LAS const int* UD;
    LAS const unsigned* RT;
    const char* Abase; const char* Bbase; size_t bstride_e, bstride_pn; int arow_bytes, ncol; bool gather;
    __device__ __forceinline__ bool next(int i, pg8::Unit& u) const {
        if (i >= 16) return false; const int e = __builtin_amdgcn_readfirstlane(UD[4 * i]); if (e < 0) return false;
        const int row0 = __builtin_amdgcn_readfirstlane(UD[4 * i + 1]), pn = __builtin_amdgcn_readfirstlane(UD[4 * i + 2]);
        u.A = gather ? Abase : Abase + (size_t)row0 * arow_bytes; u.B = Bbase + (size_t)e * bstride_e + (size_t)pn * bstride_pn; u.row0 = row0; u.col0 = pn * ncol; u.nvalid = __builtin_amdgcn_readfirstlane(UD[4 * i + 3]); u.aux = e; return true;
    }
    __device__ __forceinline__ unsigned rowoff(int i, int r) const { return RT[i * 256 + r]; }
};
__device__ __forceinline__ void build_units(Frame& F, int npn, bool gather) {
    LAS int* ET = (LAS int*)(F.lds + LDS_ETAB); LAS int* UD = (LAS int*)(F.lds + LDS_UDESC); LAS unsigned* RT = (LAS unsigned*)(F.lds + LDS_ROWTAB);
    const int NU = ET[68 + NE1] * npn;
    if (F.tid < 16) { const int U = F.vcu + F.tid * F.G; int e = -1, row0 = 0, pn = 0, nv = 0;
        if (U < NU) { const int tile = U / npn; pn = U % npn; e = 0;
#pragma unroll 1
            while (e < NE && ET[68 + e + 1] <= tile) ++e; const int mt = tile - ET[68 + e]; row0 = ET[136 + e] + 256 * mt; nv = ET[e] - 256 * mt; nv = nv > 256 ? 256 : nv; }
        UD[4 * F.tid] = e; UD[4 * F.tid + 1] = row0; UD[4 * F.tid + 2] = pn; UD[4 * F.tid + 3] = nv; }
    __syncthreads();
    if (gather) { const int* LIST = (const int*)(F.ws + WS_LIST);
        for (int i = F.tid; i < 4 * 256; i += 512) { const int ui = i >> 8, r = i & 255; const int e = UD[4 * ui]; unsigned off = 0u;
            if (e >= 0) { const int row0 = UD[4 * ui + 1], nv = UD[4 * ui + 3]; const int lr = row0 - ET[136 + e] + r; int tok = 0;
                tok = NTOK;
                if (r < nv) tok = (e < NE) ? LIST[e * NTOK + lr] : lr;
                off = (unsigned)tok * (unsigned)(D * 2); }
            RT[i] = off; }
        __syncthreads(); }
}

__device__ __forceinline__ void phase_g(Frame& F, int l) {
    const Args& A = *F.a; unsigned char* ws = F.ws; const int lane = F.lane;
    if (l + 1 < NL) { convert_cleanup(F, l * L_ITEMS + LI_X, (l + 1) * L_ITEMS); __syncthreads(); }
    build_etab(F, l);
    LAS const int* SB = (LAS const int*)(F.lds + LDS_ETAB) + 136;
    const bf16_t* X1B = (const bf16_t*)(ws + WS_X1B); const unsigned char* OB = (const unsigned char*)(ws + WS_OB); const int* AEP = (const int*)(ws + WS_ASG_EP); const float* AW = (const float*)(ws + WS_ASG_W);
    float* XO = (l == NL - 1) ? A.out : (float*)nullptr; bf16_t* XB = (bf16_t*)(ws + WS_XB);
    const bf16_t* OSH = (const bf16_t*)(ws + WS_OSH);
    LAS float* YS = (LAS float*)(F.lds + F.wave * 8192);
    int ep_n = 0; float w_n = 0.f;
    { const int tok0 = F.vcu * 8 + F.wave; if (tok0 < NTOK && lane < 8) { ep_n = AEP[tok0 * 8 + lane]; w_n = AW[tok0 * 8 + lane]; } }
    for (int tok = F.vcu * 8 + F.wave; tok < NTOK; tok += F.G * 8) {
        int slot = 0; const float wv = w_n;
        if (lane < 8) slot = SB[ep_n >> 16] + (ep_n & 0xffff);
        { const int tn = tok + F.G * 8; if (tn < NTOK && lane < 8) { ep_n = AEP[tn * 8 + lane]; w_n = AW[tn * 8 + lane]; } }
        float s = 0.f;
        u32x4 ovA[8], ovB[8], xrA[2], xrB[2], osA[2], osB[2];
#define G_LOADS(ov, xr, os, j) do { const bf16_t* xp_ = X1B + (size_t)tok * D + 1024 * (j) + 16 * lane; const bf16_t* sp_ = OSH + (size_t)tok * D + 1024 * (j) + 16 * lane; \
            xr[0] = *(const u32x4*)xp_; xr[1] = *(const u32x4*)(xp_ + 8); os[0] = *(const u32x4*)sp_; os[1] = *(const u32x4*)(sp_ + 8); \
            _Pragma("unroll") for (int k = 0; k < 8; ++k) { const int sl = __builtin_amdgcn_readlane(slot, k); ov[k] = *(const u32x4*)(OB + (size_t)sl * D + 1024 * (j) + 16 * lane); } } while (0)
#define G_UNP(v, i) (((i) & 1) ? bf_hi((i) < 2 ? v.x : (i) < 4 ? v.y : (i) < 6 ? v.z : v.w) : bf_lo((i) < 2 ? v.x : (i) < 4 ? v.y : (i) < 6 ? v.z : v.w))
#define G_COMBINE(ov, xr, os, j) do { float y[16]; \
            _Pragma("unroll") for (int i = 0; i < 8; ++i) { y[i] = ALPHA * G_UNP(xr[0], i) + G_UNP(os[0], i); y[8 + i] = ALPHA * G_UNP(xr[1], i) + G_UNP(os[1], i); } \
            _Pragma("unroll") for (int k = 0; k < 8; ++k) { const float wk = __int_as_float(__builtin_amdgcn_readlane(__float_as_int(wv), k)) * (1.0f / pg8::O8_SCALE); \
                const unsigned dw[4] = {ov[k].x, ov[k].y, ov[k].z, ov[k].w}; \
                _Pragma("unroll") for (int q = 0; q < 4; ++q) { const f32x2 a = __builtin_amdgcn_cvt_pk_f32_fp8((int)dw[q], false), b = __builtin_amdgcn_cvt_pk_f32_fp8((int)dw[q], true); \
                    y[4 * q] += wk * a.x; y[4 * q + 1] += wk * a.y; y[4 * q + 2] += wk * b.x; y[4 * q + 3] += wk * b.y; } } \
            _Pragma("unroll") for (int i = 0; i < 16; i += 4) { s += (y[i] + y[i + 1]) + (y[i + 2] + y[i + 3]); *(LAS f32x4*)(YS + 1024 * (j) + 16 * lane + i) = (f32x4){y[i], y[i + 1], y[i + 2], y[i + 3]}; } } while (0)
        G_LOADS(ovA, xrA, osA, 0); G_LOADS(ovB, xrB, osB, 1);
        G_COMBINE(ovA, xrA, osA, 0);
        G_COMBINE(ovB, xrB, osB, 1);
#undef G_LOADS
#undef G_COMBINE
#undef G_UNP
        const float mean = wave_sum(s) * (1.f / D); float s2 = 0.f;
#pragma unroll 1
        for (int j = 0; j < 2; ++j) {
#pragma unroll
            for (int i = 0; i < 16; i += 4) { const f32x4 a = *(const LAS f32x4*)(YS + 1024 * j + 16 * lane + i) - mean; s2 += (a[0] * a[0] + a[1] * a[1]) + (a[2] * a[2] + a[3] * a[3]); } }
        const float rstd = 1.f / sqrtf(wave_sum(s2) * (1.f / D) + LN_EPS);
#pragma unroll 1
        for (int j = 0; j < 2; ++j) { const f32x4* gp = (const f32x4*)(A.in[I_LN2_G] + l * D + 1024 * j + 16 * lane); const f32x4* bp = (const f32x4*)(A.in[I_LN2_B] + l * D + 1024 * j + 16 * lane);
            f32x4 o[4];
#pragma unroll
            for (int i = 0; i < 4; ++i) o[i] = (*(const LAS f32x4*)(YS + 1024 * j + 16 * lane + 4 * i) - mean) * rstd * gp[i] + bp[i];
            if (XO) { f32x4* op = (f32x4*)(XO + (size_t)tok * D + 1024 * j + 16 * lane); op[0] = o[0]; op[1] = o[1]; op[2] = o[2]; op[3] = o[3]; }
            else { u32x4* xo = (u32x4*)(XB + (size_t)tok * D + 1024 * j + 16 * lane);
                xo[0] = (u32x4){cvt_pk_bf16(o[0][0], o[0][1]), cvt_pk_bf16(o[0][2], o[0][3]), cvt_pk_bf16(o[1][0], o[1][1]), cvt_pk_bf16(o[1][2], o[1][3])};
                xo[1] = (u32x4){cvt_pk_bf16(o[2][0], o[2][1]), cvt_pk_bf16(o[2][2], o[2][3]), cvt_pk_bf16(o[3][0], o[3][1]), cvt_pk_bf16(o[3][2], o[3][3])}; } }
    }
}

constexpr int NPHASE = 2 + 7 * NL;
__global__ void __launch_bounds__(512, 2) mk_fwd(Args args) {
    extern __shared__ __attribute__((aligned(16))) unsigned char lds[];
#define PHASE_FRAME() Frame F; { int tz_ = threadIdx.x; asm volatile("" : "+v"(tz_)); int bz_ = blockIdx.x; asm volatile("" : "+s"(bz_)); unsigned char* wz_ = args.ws; asm volatile("" : "+s"(wz_)); \
        F.lds = (LAS unsigned char*)lds; F.tid = tz_; F.lane = tz_ & 63; F.wave = __builtin_amdgcn_readfirstlane(tz_ >> 6); F.G = gridDim.x; F.vcu = (F.G % 8 == 0) ? (bz_ % 8) * (F.G / 8) + bz_ / 8 : bz_; F.a = &args; F.ws = wz_; } \
        unsigned char* ws = F.ws; const int c = F.vcu; (void)ws; (void)c
    volatile LAS unsigned* MISC = (volatile LAS unsigned*)((LAS unsigned char*)lds + LDS_MISC);
    if (threadIdx.x < 128) MISC[threadIdx.x] = 0u;
    __syncthreads();
    unsigned* ctl = (unsigned*)(args.ws + WS_CTL);
    XcdBarrier bar; bar.bar = ctl + CW_BAR; bar.x = 0; bar.st = nullptr;
    const int lo = args.ph_lo, hi = args.ph_hi;
    if (hi - lo > 1) bar = xcd_barrier_post(ctl + CW_BAR, MISC + 8);
#define IN(k) (lo <= (k) && (k) < hi)
#define SEAM(k) do { if (IN(k) && IN((k) + 1)) xcd_barrier(bar); } while (0)

    if (IN(0)) { REP_LOOP(REP_P0) { PHASE_FRAME(); p0_prologue(F); } if (IN(2)) xcd_barrier(bar); }
#pragma unroll 1
    for (int l_ = 0; l_ < NL; ++l_) {
        const int pb = 2 + 7 * l_;
        if (IN(pb + 0)) {
            REP_LOOP(REP_A) {
            PHASE_FRAME(); int l = l_; asm volatile("" : "+s"(l));
            pg8::DenseSched S; S.init((const bf16_t*)(ws + WS_XB), (const bf16_t*)(ws + WS_WT_IN) + (size_t)l * INW * D, NTOK, INW, D, F.G, c);
            pg8::EpiStoreBf16 E{(bf16_t*)(ws + WS_HB), INW};
            pg8::gemm_phase<pg8::EpiStoreBf16, pg8::DenseSched, false>(F.lds, D, S, E); __syncthreads();
            if (l == 0) {
                { pg8::DenseSched S2; S2.init((const bf16_t*)(ws + WS_MEMN), (const bf16_t*)(ws + WS_WT_K), NMEMTOK, NL * 512, D, F.G, c - 128);
                  pg8::EpiStoreBf16 E2{(bf16_t*)(ws + WS_KBUF), NL * 512};
                  pg8::gemm_phase<pg8::EpiStoreBf16, pg8::DenseSched, false>(F.lds, D, S2, E2); }
                { pg8::DenseSched S2; S2.init((const bf16_t*)(ws + WS_WT_V), (const bf16_t*)(ws + WS_MEMN), NL * 512, NMEMTOK, D, F.G, c - 160);
                  pg8::EpiStoreBf16 E2{(bf16_t*)(ws + WS_VT), NMEMTOK};
                  pg8::gemm_phase<pg8::EpiStoreBf16, pg8::DenseSched, false>(F.lds, D, S2, E2); }
                __syncthreads();
            }
            if (c + F.G >= (NTOK / 256) * (INW / 256) && (l != 0 || c >= 192)) convert_fill(F, l * L_ITEMS, FILL_A); }
            SEAM(pb + 0);
        }
        if (IN(pb + 1)) {
            REP_LOOP(REP_B) { PHASE_FRAME(); int l = l_; asm volatile("" : "+s"(l));
            for (int it = c; it < 256; it += F.G) mixer_sgu(F, l, it >> 2, it & 3);
            for (int it = c; it < 256; it += F.G) mixer_pool(F, l, it >> 2, it & 3);
            for (int it = c; it < 256; it += F.G) mixer_conv(F, l, it >> 2, it & 3);
            for (int it = c; it < 256; it += F.G) mixer_attn(F, l, it >> 2, it & 3); }
            SEAM(pb + 1);
        }
        if (IN(pb + 2)) {
            REP_LOOP(REP_C) {
            PHASE_FRAME(); int l = l_; asm volatile("" : "+s"(l));
            pg8::DenseSched S; S.init((const bf16_t*)(ws + WS_MIX), (const bf16_t*)(ws + WS_WT_OUT) + (size_t)l * D * D, NTOK, D, D, F.G, c);
            pg8::EpiResidBf16 E{(bf16_t*)(ws + WS_Y1), l == 0 ? args.in[I_X] : (const float*)nullptr, (const bf16_t*)(ws + WS_XB), D, ALPHA};
            pg8::gemm_phase<pg8::EpiResidBf16, pg8::DenseSched, false>(F.lds, D, S, E); __syncthreads(); }
            SEAM(pb + 2);
        }
        if (IN(pb + 3)) { PHASE_FRAME(); int l = l_; asm volatile("" : "+s"(l));
            if (F.G * 32 == NTOK) {
                if (F.tid == 0) ((LAS unsigned*)(F.lds + LDS_MISC))[16] = 0u;
                __syncthreads();
                if (F.wave < 4) phase_d<4>(F, l); else convert_beside_d(F, l * L_ITEMS, l * L_ITEMS + LI_X);
            } else { convert_cleanup(F, l * L_ITEMS, l * L_ITEMS + LI_X); __syncthreads(); phase_d<8>(F, l); }
            SEAM(pb + 3); }
        if (IN(pb + 4)) {
            REP_LOOP(REP_E) {
            PHASE_FRAME(); int l = l_; asm volatile("" : "+s"(l));
            if (c == 0 && F.tid == 0) __hip_atomic_fetch_max((unsigned*)(ws + WS_CTL) + CW_Q, (unsigned)(l * L_ITEMS + LI_X), __ATOMIC_RELAXED, __HIP_MEMORY_SCOPE_AGENT);
            build_etab(F, l); build_units(F, 2, true);
            ExpertSched S; S.UD = (LAS const int*)(F.lds + LDS_UDESC); S.RT = (LAS const unsigned*)(F.lds + LDS_ROWTAB);
            S.Abase = (const char*)(ws + WS_X1B); S.Bbase = (const char*)(ws + WS_WT_GU) + (size_t)l * NE1 * 512 * D * 2; S.bstride_e = (size_t)512 * D * 2; S.bstride_pn = (size_t)256 * D * 2; S.arow_bytes = D * 2; S.ncol = 128; S.gather = true;
            pg8::EpiSwiglu E{(bf16_t*)(ws + WS_HE)};
            pg8::gemm_phase<pg8::EpiSwiglu, ExpertSched, true>(F.lds, D, S, E); __syncthreads();
            { const int NU = ((LAS const int*)(F.lds + LDS_ETAB))[68 + NE1] * 2; const int mine = c < NU ? (NU - c + F.G - 1) / F.G : 0, maxu = (NU + F.G - 1) / F.G;
              if (mine < maxu) convert_fill(F, l * L_ITEMS + LI_X, FILL_E); } }
            SEAM(pb + 4);
        }
        if (IN(pb + 5)) {
            REP_LOOP(REP_F) {
            PHASE_FRAME(); int l = l_; asm volatile("" : "+s"(l));
            build_etab(F, l); build_units(F, 8, false);
            ExpertSched S; S.UD = (LAS const int*)(F.lds + LDS_UDESC); S.RT = (LAS const unsigned*)(F.lds + LDS_ROWTAB);
            S.Abase = (const char*)(ws + WS_HE); S.Bbase = (const char*)(ws + WS_WT_D) + (size_t)l * NE1 * D * DE * 2; S.bstride_e = (size_t)D * DE * 2; S.bstride_pn = (size_t)256 * DE * 2; S.arow_bytes = DE * 2; S.ncol = 256; S.gather = false;
            pg8::EpiStoreFp8 E{(unsigned char*)(ws + WS_OB), D, (bf16_t*)(ws + WS_OSH), NE, __builtin_amdgcn_readfirstlane(((LAS const int*)(F.lds + LDS_ETAB))[136 + NE])};
            pg8::gemm_phase<pg8::EpiStoreFp8, ExpertSched, false>(F.lds, DE, S, E); __syncthreads(); }
            SEAM(pb + 5);
        }
        if (IN(pb + 6)) { REP_LOOP(REP_G) { PHASE_FRAME(); int l = l_; asm volatile("" : "+s"(l)); phase_g(F, l); __syncthreads(); } SEAM(pb + 6); }
    }
#undef IN
#undef SEAM
}

extern "C" void kernel_launch(void* const* d_in, const int* in_sizes, int n_in, void* d_out, int out_size, void* d_ws, size_t ws_size, hipStream_t stream) {
    static int grid = 0;
    if (grid == 0) {
        if (n_in != 29 || out_size != NTOK * D || ws_size < WS_END) { fprintf(stderr, "kernel_launch: unexpected shapes (n_in %d out %d ws %zu need %zu)\n", n_in, out_size, ws_size, (size_t)WS_END); grid = -1; return; }
        int dev = 0, cus = 0, per_cu = 0;
        if (hipGetDevice(&dev) != hipSuccess || hipDeviceGetAttribute(&cus, hipDeviceAttributeMultiprocessorCount, dev) != hipSuccess) { grid = -1; return; }
        if (hipFuncSetAttribute((const void*)mk_fwd, hipFuncAttributeMaxDynamicSharedMemorySize, LDS_BYTES) != hipSuccess) { fprintf(stderr, "kernel_launch: hipFuncSetAttribute failed\n"); grid = -1; return; }
        if (hipOccupancyMaxActiveBlocksPerMultiprocessor(&per_cu, (const void*)mk_fwd, 512, LDS_BYTES) != hipSuccess || per_cu < 1) fprintf(stderr, "kernel_launch: occupancy query reports %d\n", per_cu);
        (void)hipGetLastError();
        grid = cus;
    }
    if (grid < 0) return;
    (void)hipMemsetAsync((char*)d_ws + WS_CTL, 0, CTL_ZERO_BYTES, stream);
    Args a{};
    for (int i = 0; i < 29; ++i) a.in[i] = (const float*)d_in[i];
    a.out = (float*)d_out; a.ws = (unsigned char*)d_ws;
#if MK_ONE_LAUNCH
    a.ph_lo = 0; a.ph_hi = NPHASE;
    hipLaunchKernelGGL(mk_fwd, dim3(grid), dim3(512), LDS_BYTES, stream, a);
#else
    for (int p = 0; p < NPHASE; ++p) { a.ph_lo = p; a.ph_hi = p + 1; hipLaunchKernelGGL(mk_fwd, dim3(grid), dim3(512), LDS_BYTES, stream, a); }
#endif
}
```

```cpp
#include <hip/hip_runtime.h>
#include <cstdio>
#include <cstdint>

#define LAS __attribute__((address_space(3)))
#define GAS __attribute__((address_space(1)))
typedef unsigned short bf16_t;
typedef short bf16x8 __attribute__((ext_vector_type(8)));
typedef float f32x4 __attribute__((ext_vector_type(4)));
typedef float f32x2 __attribute__((ext_vector_type(2)));
typedef unsigned u32x4 __attribute__((ext_vector_type(4)));
typedef unsigned u32x2 __attribute__((ext_vector_type(2)));

#ifndef REP_P0
#define REP_P0 1
#endif
#ifndef REP_B
#define REP_B 1
#endif
#ifndef REP_E
#define REP_E 1
#endif
#ifndef REP_F
#define REP_F 1
#endif
#ifndef REP_A
#define REP_A 1
#endif
#ifndef REP_C
#define REP_C 1
#endif
#ifndef REP_D1
#define REP_D1 1
#endif
#ifndef REP_D2
#define REP_D2 1
#endif
#ifndef REP_D3
#define REP_D3 1
#endif
#ifndef REP_G
#define REP_G 1
#endif
#define REP_LOOP(n) _Pragma("unroll 1") for (int rep_ = 0; rep_ < (n); ++rep_)
#ifndef FILL_P1
#define FILL_P1 2
#endif
#ifndef FILL_A
#define FILL_A 4
#endif
#ifndef FILL_A0
#define FILL_A0 2
#endif
#ifndef FILL_F
#define FILL_F 5
#endif
#ifndef FILL_E
#define FILL_E 6
#endif
#ifndef MK_ONE_LAUNCH
#define MK_ONE_LAUNCH 1
#endif

constexpr int D = 2048, NTOK = 8192, SEQ = 2048, NL = 4, INW = 3072, GW = 512, HD = 128, NMEMTOK = 1024, NE = 64, NE1 = 65, DE = 256, TOPK = 8;
constexpr float LN_EPS = 1e-5f;
constexpr float ALPHA = 1.6817928305074290861f;
constexpr int SLOT_CAP = 90112;

constexpr size_t MiB = 1u << 20;
constexpr size_t WS_CTL = 0, CTL_ZERO_BYTES = 2 * MiB;
constexpr size_t WS_WT_IN  = 2 * MiB;
constexpr size_t WS_WT_OUT = WS_WT_IN + 48 * MiB;
constexpr size_t WS_WT_K   = WS_WT_OUT + 32 * MiB;
constexpr size_t WS_WT_V   = WS_WT_K + 8 * MiB;
constexpr size_t WS_WT_GU  = WS_WT_V + 8 * MiB;
constexpr size_t WS_WT_D   = WS_WT_GU + 520 * MiB;
constexpr size_t WS_WPT    = WS_WT_D + 260 * MiB;
constexpr size_t WS_SGUW   = WS_WPT + 1 * MiB;
constexpr size_t WS_WR_HI  = WS_SGUW + 1 * MiB;
constexpr size_t WS_WR_LO  = WS_WR_HI + 1 * MiB;
constexpr size_t WS_MEMN   = WS_WR_LO + 1 * MiB;
constexpr size_t WS_KBUF   = WS_MEMN + 4 * MiB;
constexpr size_t WS_VT     = WS_KBUF + 4 * MiB;
constexpr size_t WS_XF     = WS_VT + 4 * MiB;
constexpr size_t WS_OSH    = WS_XF;
constexpr size_t WS_XB     = WS_XF + 64 * MiB;
constexpr size_t WS_HB     = WS_XB + 32 * MiB;
constexpr size_t WS_MIX    = WS_HB + 48 * MiB;
constexpr size_t WS_Y1     = WS_MIX + 32 * MiB;
constexpr size_t WS_X1F    = WS_Y1 + 64 * MiB;
constexpr size_t WS_X1B    = WS_X1F + 64 * MiB;
constexpr size_t WS_HE     = WS_X1B + 33 * MiB;
constexpr size_t WS_OB     = WS_HE + 44 * MiB;
constexpr size_t WS_LIST   = WS_OB + 352 * MiB;
constexpr size_t WS_ASG_EP = WS_LIST + 2 * MiB;
constexpr size_t WS_ASG_W  = WS_ASG_EP + 1 * MiB;
constexpr size_t WS_END    = WS_ASG_W + 1 * MiB;
constexpr int CW_BAR = 4096;
constexpr int CW_CNT = 16384, CNT_STRIDE = 1024;
static_assert((CW_CNT + 256 * CNT_STRIDE) * 4 <= (int)CTL_ZERO_BYTES, "ctl");

constexpr int RING_BYTES = 131072;
constexpr int LDS_MISC = RING_BYTES;
constexpr int LDS_ETAB = LDS_MISC + 512;
constexpr int LDS_UDESC = LDS_ETAB + 1024;
constexpr int LDS_ROWTAB = LDS_UDESC + 512;
constexpr int LDS_BYTES = 147456;
static_assert(LDS_ROWTAB + 4096 <= LDS_BYTES, "lds");

#define LDS_WAIT() asm volatile("s_waitcnt lgkmcnt(0)" ::: "memory")
#define VM_WAIT() asm volatile("s_waitcnt vmcnt(0)" ::: "memory")

__device__ __forceinline__ unsigned cvt_pk_bf16(float lo, float hi) { unsigned r; asm volatile("v_cvt_pk_bf16_f32 %0, %1, %2" : "=v"(r) : "v"(lo), "v"(hi)); return r; }
__device__ __forceinline__ float bf_lo(unsigned w) { return __uint_as_float(w << 16); }
__device__ __forceinline__ float bf_hi(unsigned w) { return __uint_as_float(w & 0xffff0000u); }
__device__ __forceinline__ float fast_sigmoid(float x) { return __builtin_amdgcn_rcpf(1.0f + __builtin_amdgcn_exp2f(-1.4426950408889634f * x)); }
__device__ __forceinline__ float silu_f(float x) { return x * fast_sigmoid(x); }
__device__ __forceinline__ float gelu_tanh_f(float x) { const float t = x + 0.044715f * x * x * x; return x * fast_sigmoid(1.5957691216057308f * t); }
__device__ __forceinline__ float wave_sum(float v) {
#pragma unroll
    for (int o = 1; o < 64; o <<= 1) v += __shfl_xor(v, o);
    return v;
}
__device__ __forceinline__ float g16_sum(float v) { v += __shfl_xor(v, 1); v += __shfl_xor(v, 2); v += __shfl_xor(v, 4); v += __shfl_xor(v, 8); return v; }

namespace pg8 {
constexpr int BM = 256, BK = 64, HALF = 128, HTB = HALF * BK * 2, STAGE_BYTES = 8 * HTB, NXCD = 8, WGM = 8;
__host__ __device__ __forceinline__ int lds_byte(int r, int c) { const int st = (r >> 4) * 2 + (c >> 5), rr = r & 15, cc = c & 31, ob = rr * 64 + cc * 2; return st * 1024 + (ob ^ (((ob >> 9) & 1) << 5)); }
__host__ __device__ __forceinline__ void stage_rc(int b, int& R, int& C) { const int st = b / 1024, sb = b % 1024, swz = sb ^ (((sb >> 9) & 1) << 5); R = (st >> 1) * 16 + swz / 64; C = (st & 1) * 32 + (swz % 64) / 2; }
__host__ __device__ __forceinline__ int perm32(int rho) { const int n = rho >> 4, i = rho & 15; return 8 * (i >> 2) + 4 * n + (i & 3); }

struct Unit { const char* A; const char* B; int row0, col0, nvalid, aux; };

struct StaticOrder {
    int nM, nN, nwg, G, c;
    __device__ void init(int M, int N, int G_, int c_) { nM = M / BM; nN = N / BM; nwg = nM * nN; G = G_; c = c_; }
    __device__ bool next(int i, int& pm, int& pn) const {
        const long L = (long)i * G + c; if (L >= nwg || c < 0) return false;
        int wgid = (int)L; { const int q = nwg / NXCD, r = nwg % NXCD, xcd = wgid % NXCD, off = wgid / NXCD; wgid = (xcd < r ? xcd * (q + 1) : r * (q + 1) + (xcd - r) * q) + off; }
        const int nig = WGM * nN, gid = wgid / nig, fm = gid * WGM, gsz = (nM - fm) < WGM ? (nM - fm) : WGM;
        pm = fm + ((wgid % nig) % gsz); pn = (wgid % nig) / gsz; return true;
    }
};
struct DenseSched {
    StaticOrder so; const char* A; const char* B; size_t tstep;
    __device__ void init(const bf16_t* A_, const bf16_t* B_, int M, int N, int K, int G, int c) { so.init(M, N, G, c); A = (const char*)A_; B = (const char*)B_; tstep = (size_t)BM * K * 2; }
    __device__ __forceinline__ bool next(int i, Unit& u) const { int pm, pn; if (!so.next(i, pm, pn)) return false; u.A = A + (size_t)pm * tstep; u.B = B + (size_t)pn * tstep; u.row0 = pm * BM; u.col0 = pn * BM; u.nvalid = BM; u.aux = 0; return true; }
    __device__ __forceinline__ unsigned rowoff(int, int) const { return 0u; }
};

struct EpiStoreBf16 {
    static constexpr bool PERM = true;
    bf16_t* O; int ldc;
    __device__ __forceinline__ void operator()(const f32x4 (&acc)[2][2][4][2], const Unit& u, int wr, int wc, int fr, int fq) const {
#pragma unroll
        for (int ai = 0; ai < 2; ++ai)
#pragma unroll
            for (int m = 0; m < 4; ++m) { const int lr = ai * HALF + wr * 64 + m * 16 + fr;
                if (lr < u.nvalid) { bf16_t* rowp = O + (size_t)(u.row0 + lr) * ldc + u.col0 + wc * 32 + 8 * fq;
#pragma unroll
                    for (int bj = 0; bj < 2; ++bj) { const f32x4 v0 = acc[ai][bj][m][0], v1 = acc[ai][bj][m][1];
                        u32x4 w; w.x = cvt_pk_bf16(v0[0], v0[1]); w.y = cvt_pk_bf16(v0[2], v0[3]); w.z = cvt_pk_bf16(v1[0], v1[1]); w.w = cvt_pk_bf16(v1[2], v1[3]);
                        *(u32x4*)(rowp + bj * HALF) = w; } } }
    }
};
constexpr float O8_SCALE = 16.0f;
struct EpiStoreFp8 {
    static constexpr bool PERM = true;
    unsigned char* O; int ldc; bf16_t* OS; int sh_e, sh_base;
    __device__ __forceinline__ void operator()(const f32x4 (&acc)[2][2][4][2], const Unit& u, int wr, int wc, int fr, int fq) const {
        if (u.aux == sh_e) {
#pragma unroll
            for (int ai = 0; ai < 2; ++ai)
#pragma unroll
                for (int m = 0; m < 4; ++m) { const int lr = ai * HALF + wr * 64 + m * 16 + fr; bf16_t* rowp = OS + (size_t)(u.row0 - sh_base + lr) * ldc + u.col0 + wc * 32 + 8 * fq;
#pragma unroll
                    for (int bj = 0; bj < 2; ++bj) { const f32x4 v0 = acc[ai][bj][m][0], v1 = acc[ai][bj][m][1];
                        *(u32x4*)(rowp + bj * HALF) = (u32x4){cvt_pk_bf16(v0[0], v0[1]), cvt_pk_bf16(v0[2], v0[3]), cvt_pk_bf16(v1[0], v1[1]), cvt_pk_bf16(v1[2], v1[3])}; } }
            return; }
#pragma unroll
        for (int ai = 0; ai < 2; ++ai)
#pragma unroll
            for (int m = 0; m < 4; ++m) { const int lr = ai * HALF + wr * 64 + m * 16 + fr;
                unsigned pk[2][2];
#pragma unroll
                for (int bj = 0; bj < 2; ++bj) { const f32x4 v0 = acc[ai][bj][m][0] * O8_SCALE, v1 = acc[ai][bj][m][1] * O8_SCALE;
                    int p = __builtin_amdgcn_cvt_pk_fp8_f32(v0[0], v0[1], 0, false); p = __builtin_amdgcn_cvt_pk_fp8_f32(v0[2], v0[3], p, true);
                    int q = __builtin_amdgcn_cvt_pk_fp8_f32(v1[0], v1[1], 0, false); q = __builtin_amdgcn_cvt_pk_fp8_f32(v1[2], v1[3], q, true);
                    pk[bj][0] = (unsigned)p; pk[bj][1] = (unsigned)q; }
                const auto s0 = __builtin_amdgcn_permlane16_swap(pk[0][0], pk[1][0], false, false), s1 = __builtin_amdgcn_permlane16_swap(pk[0][1], pk[1][1], false, false);
                if (lr < u.nvalid) *(u32x4*)(O + (size_t)(u.row0 + lr) * ldc + u.col0 + wc * 32 + (fq & 1) * HALF + (fq >> 1) * 16) = (u32x4){s0[0], s1[0], s0[1], s1[1]}; }
    }
};
struct EpiResidBf16 {
    static constexpr bool PERM = true;
    bf16_t* Y; const float* X; const bf16_t* XBp; int ldc; float alpha;
    __device__ __forceinline__ void operator()(const f32x4 (&acc)[2][2][4][2], const Unit& u, int wr, int wc, int fr, int fq) const {
#pragma unroll
        for (int ai = 0; ai < 2; ++ai)
#pragma unroll
            for (int m = 0; m < 4; ++m) { const size_t off = (size_t)(u.row0 + ai * HALF + wr * 64 + m * 16 + fr) * ldc + u.col0 + wc * 32 + 8 * fq;
#pragma unroll
                for (int bj = 0; bj < 2; ++bj) { f32x4 x0, x1;
                    if (X) { x0 = *(const f32x4*)(X + off + bj * HALF); x1 = *(const f32x4*)(X + off + bj * HALF + 4); }
                    else { const u32x4 r = *(const u32x4*)(XBp + off + bj * HALF); x0 = (f32x4){bf_lo(r.x), bf_hi(r.x), bf_lo(r.y), bf_hi(r.y)}; x1 = (f32x4){bf_lo(r.z), bf_hi(r.z), bf_lo(r.w), bf_hi(r.w)}; }
                    const f32x4 v0 = acc[ai][bj][m][0] + alpha * x0, v1 = acc[ai][bj][m][1] + alpha * x1;
                    *(u32x4*)(Y + off + bj * HALF) = (u32x4){cvt_pk_bf16(v0[0], v0[1]), cvt_pk_bf16(v0[2], v0[3]), cvt_pk_bf16(v1[0], v1[1]), cvt_pk_bf16(v1[2], v1[3])}; } }
    }
};
struct EpiSwiglu {
    static constexpr bool PERM = true;
    bf16_t* H;
    __device__ __forceinline__ void operator()(const f32x4 (&acc)[2][2][4][2], const Unit& u, int wr, int wc, int fr, int fq) const {
#pragma unroll
        for (int ai = 0; ai < 2; ++ai)
#pragma unroll
            for (int m = 0; m < 4; ++m) { const int lr = ai * HALF + wr * 64 + m * 16 + fr;
                if (lr < u.nvalid) { const f32x4 g0 = acc[ai][0][m][0], g1 = acc[ai][0][m][1], u0 = acc[ai][1][m][0], u1 = acc[ai][1][m][1];
                    u32x4 w; w.x = cvt_pk_bf16(silu_f(g0[0]) * u0[0], silu_f(g0[1]) * u0[1]); w.y = cvt_pk_bf16(silu_f(g0[2]) * u0[2], silu_f(g0[3]) * u0[3]);
                    w.z = cvt_pk_bf16(silu_f(g1[0]) * u1[0], silu_f(g1[1]) * u1[1]); w.w = cvt_pk_bf16(silu_f(g1[2]) * u1[2], silu_f(g1[3]) * u1[3]);
                    *(u32x4*)(H + (size_t)(u.row0 + lr) * DE + u.col0 + wc * 32 + 8 * fq) = w; } }
    }
};

template <class Epi, class Sched, bool GATHER>
__device__ __forceinline__ void gemm_phase(LAS unsigned char* lds, const int K, const Sched& S, const Epi& E) {
    int tid = threadIdx.x; asm volatile("" : "+v"(tid));
    const int wid = __builtin_amdgcn_readfirstlane(tid >> 6), lane = tid & 63, wr = wid >> 2, wc = wid & 3;
    const int nt = K / BK;
    unsigned voffB[2], oc[2][2];
#pragma unroll
    for (int i = 0; i < 2; ++i) { int R, C; stage_rc(tid * 16 + i * 8192, R, C); const int Rb = Epi::PERM ? ((R & ~31) + perm32(R & 31)) : R;
        voffB[i] = (unsigned)(Rb * K + C) * 2u; oc[0][i] = (unsigned)(R * K + C) * 2u; oc[1][i] = oc[0][i]; }
    const size_t kstep = (size_t)(BK * 2);
    const size_t hstep = (size_t)HALF * K * 2;
    const size_t ahstep = GATHER ? (size_t)0 : hstep;
    const unsigned ldsw = (unsigned)wid * 1024u;
    const int aoff = lds_byte(wr * 64 + (lane & 15), (lane >> 4) * 8), boff = lds_byte(wc * 32 + (lane & 15), (lane >> 4) * 8);
#define PG8_SA(b, h) (((b) * 2 + (h)) * HTB)
#define PG8_SB(b, h) ((4 + (b) * 2 + (h)) * HTB)
#define PG8_STAGE(bufoff, gbase, voff) do { _Pragma("unroll") for (int _i = 0; _i < 2; ++_i) \
        __builtin_amdgcn_global_load_lds((const unsigned*)((const char*)(gbase) + (voff)[_i]), (LAS unsigned*)(lds + (bufoff) + ldsw + _i * 8192), 16, 0, 0); } while (0)
#define PG8_STAGE_A(bufoff, gbase, h) PG8_STAGE(bufoff, (gbase) + (h) * ahstep, oc[GATHER ? (h) : 0])
#define PG8_LDA(dst, b, h) do { _Pragma("unroll") for (int m = 0; m < 4; ++m) _Pragma("unroll") for (int k = 0; k < 2; ++k) dst[m][k] = *(const LAS bf16x8*)(lds + PG8_SA(b, h) + aoff + m * 2048 + k * 1024); } while (0)
#define PG8_LDB(dst, b, h) do { _Pragma("unroll") for (int n = 0; n < 2; ++n) _Pragma("unroll") for (int k = 0; k < 2; ++k) dst[n][k] = *(const LAS bf16x8*)(lds + PG8_SB(b, h) + boff + n * 2048 + k * 1024); } while (0)
#define PG8_MMA(ai, bj, At, Bt) do { __builtin_amdgcn_s_setprio(1); _Pragma("unroll") for (int m = 0; m < 4; ++m) _Pragma("unroll") for (int n = 0; n < 2; ++n) _Pragma("unroll") for (int k = 0; k < 2; ++k) \
        acc[ai][bj][m][n] = __builtin_amdgcn_mfma_f32_16x16x32_bf16(Bt[n][k], At[m][k], acc[ai][bj][m][n], 0, 0, 0); __builtin_amdgcn_s_setprio(0); } while (0)
#define PG8_WAIT_V(n) asm volatile("s_waitcnt vmcnt(" #n ")" ::: "memory")
#define PG8_WAIT_L(n) asm volatile("s_waitcnt lgkmcnt(" #n ")" ::: "memory")
#define PG8_BAR __builtin_amdgcn_s_barrier()
#define PG8_SCHED __builtin_amdgcn_sched_barrier(0)
#define PG8_LOAD_ROWOFFS(uidx) do { int tz_ = threadIdx.x; asm volatile("" : "+v"(tz_)); _Pragma("unroll") for (int _i = 0; _i < 2; ++_i) { int R_, C_; stage_rc(tz_ * 16 + _i * 8192, R_, C_); \
        oc[0][_i] = S.rowoff((uidx), R_) + (unsigned)C_ * 2u; oc[1][_i] = S.rowoff((uidx), HALF + R_) + (unsigned)C_ * 2u; } } while (0)
    Unit cur, nxt; int ui = 0;
    if (!S.next(0, cur)) return;
    if constexpr (GATHER) { PG8_LOAD_ROWOFFS(0); }
    f32x4 acc[2][2][4][2];
#pragma unroll
    for (int a = 0; a < 2; ++a)
#pragma unroll
        for (int b = 0; b < 2; ++b)
#pragma unroll
            for (int m = 0; m < 4; ++m)
#pragma unroll
                for (int n = 0; n < 2; ++n) acc[a][b][m][n] = (f32x4){0.f, 0.f, 0.f, 0.f};
    bf16x8 At[4][2], B0[2][2], B1[2][2];
    const char* cA = cur.A; const char* cB = cur.B;
    LDS_WAIT();
    PG8_STAGE(PG8_SB(0, 0), cB, voffB); PG8_STAGE(PG8_SB(0, 1), cB + hstep, voffB); PG8_STAGE_A(PG8_SA(0, 0), cA, 0); PG8_STAGE_A(PG8_SA(0, 1), cA, 1);
    if (wr == 1) PG8_BAR;
    PG8_WAIT_V(2); PG8_BAR;
    PG8_STAGE(PG8_SB(1, 0), cB + kstep, voffB); PG8_STAGE_A(PG8_SA(1, 0), cA + kstep, 0); PG8_STAGE(PG8_SB(1, 1), cB + hstep + kstep, voffB);
    PG8_WAIT_V(6); PG8_BAR;
    for (;;) {
        const bool has_next = S.next(ui + 1, nxt);
        const char* nA = has_next ? nxt.A : cA; const char* nB = has_next ? nxt.B : cB;
#pragma unroll 1
        for (int t = 0; t < nt; t += 2) {
            const bool last = (t == nt - 2);
            const char* a1 = cA + (size_t)(t + 1) * kstep;
            const char* a2 = last ? nA : cA + (size_t)(t + 2) * kstep; const char* b2 = last ? nB : cB + (size_t)(t + 2) * kstep;
            const char* a3 = a2 + kstep; const char* b3 = b2 + kstep;
            PG8_LDB(B0, 0, 0); PG8_LDB(B1, 0, 1); PG8_SCHED; PG8_LDA(At, 0, 0); PG8_STAGE_A(PG8_SA(1, 1), a1, 1);
            if constexpr (GATHER) { if (last && has_next) { PG8_LOAD_ROWOFFS(ui + 1); } }
            PG8_WAIT_V(8); PG8_WAIT_L(0); PG8_BAR; PG8_MMA(0, 0, At, B0); PG8_MMA(0, 1, At, B1); PG8_BAR; PG8_SCHED;
            PG8_LDA(At, 0, 1); PG8_STAGE(PG8_SB(0, 0), b2, voffB); PG8_STAGE(PG8_SB(0, 1), b2 + hstep, voffB); PG8_STAGE_A(PG8_SA(0, 0), a2, 0);
            PG8_WAIT_V(8); PG8_WAIT_L(0); PG8_BAR; PG8_MMA(1, 0, At, B0); PG8_MMA(1, 1, At, B1); PG8_BAR; PG8_SCHED;
            PG8_LDB(B0, 1, 0); PG8_LDB(B1, 1, 1); PG8_SCHED; PG8_LDA(At, 1, 0); PG8_STAGE_A(PG8_SA(0, 1), a2, 1);
            PG8_WAIT_V(8); PG8_WAIT_L(0); PG8_BAR; PG8_MMA(0, 0, At, B0); PG8_MMA(0, 1, At, B1); PG8_BAR; PG8_SCHED;
            PG8_LDA(At, 1, 1); PG8_STAGE(PG8_SB(1, 0), b3, voffB); PG8_STAGE(PG8_SB(1, 1), b3 + hstep, voffB); PG8_STAGE_A(PG8_SA(1, 0), a3, 0);
            PG8_WAIT_V(8); PG8_WAIT_L(0); PG8_BAR; PG8_MMA(1, 0, At, B0); PG8_MMA(1, 1, At, B1); PG8_BAR; PG8_SCHED;
        }
        if (wr == 0) PG8_BAR;
        { int tz = threadIdx.x; asm volatile("" : "+v"(tz)); E(acc, cur, wr, wc, tz & 15, (tz & 63) >> 4); }
        if (!has_next) break;
#pragma unroll
        for (int a = 0; a < 2; ++a)
#pragma unroll
            for (int b = 0; b < 2; ++b)
#pragma unroll
                for (int m = 0; m < 4; ++m)
#pragma unroll
                    for (int n = 0; n < 2; ++n) acc[a][b][m][n] = (f32x4){0.f, 0.f, 0.f, 0.f};
        cur = nxt; cA = nA; cB = nB; ++ui;
        if (wr == 1) PG8_BAR;
    }
    PG8_WAIT_V(0);
    PG8_BAR;
#undef PG8_SA
#undef PG8_SB
#undef PG8_STAGE
#undef PG8_STAGE_A
#undef PG8_LOAD_ROWOFFS
#undef PG8_LDA
#undef PG8_LDB
#undef PG8_MMA
#undef PG8_WAIT_V
#undef PG8_WAIT_L
#undef PG8_BAR
#undef PG8_SCHED
}
}

#define XB_TMO      128
#define XB_XCNT(j)  (256  + 64 * (j))
#define XB_XSUB(j)  (1280 + 64 * (j))
#define XB_XGEN(j)  (2304 + 64 * (j))
#define XB_TOP      3328
#define XB_TOPGEN   3392
#define XCD_BAR_WORDS 3456
#define XB_SPIN_CAP (1u << 18)
__device__ __forceinline__ unsigned xb_ld(unsigned* p)              { return __hip_atomic_load(p, __ATOMIC_RELAXED, __HIP_MEMORY_SCOPE_AGENT); }
__device__ __forceinline__ unsigned xb_add(unsigned* p, unsigned v) { return __hip_atomic_fetch_add(p, v, __ATOMIC_RELAXED, __HIP_MEMORY_SCOPE_AGENT); }
__device__ __forceinline__ unsigned xb_xcc_id() { return (unsigned)__builtin_amdgcn_s_getreg((3 << 11) | 20) & 0xFu; }
#define XB_SPIN(cond, bar) do { unsigned _sp = 0; while (cond) { __builtin_amdgcn_s_sleep(1); \
    if ((++_sp & 255u) == 0u) { if (xb_ld(&(bar)[XB_TMO])) break; if (_sp > XB_SPIN_CAP) { atomicAdd(&(bar)[XB_TMO], 1u); break; } } } } while (0)
struct XcdBarrier { unsigned* bar; unsigned x; volatile LAS unsigned* st; };
__device__ __forceinline__ XcdBarrier xcd_barrier_post(unsigned* bar, volatile LAS unsigned* st) {
    XcdBarrier b; b.bar = bar; b.x = xb_xcc_id(); b.st = st;
    if (threadIdx.x == 0) (void)xb_add(&bar[XB_XCNT(b.x)], 1u);
    return b;
}
__device__ __forceinline__ void xcd_barrier_complete(unsigned* bar, unsigned x, unsigned& nloc, unsigned& nx) {
    const unsigned G = gridDim.x * gridDim.y * gridDim.z;
    unsigned sum, cnt, mine, sp = 0u;
    for (;;) {
        sum = 0u; cnt = 0u; mine = 0u;
#pragma unroll 1
        for (unsigned j = 0; j < 16; ++j) { const unsigned c = xb_ld(&bar[XB_XCNT(j)]); sum += c; cnt += (c > 0u) ? 1u : 0u; mine = (j == x) ? c : mine; }
        if (sum == G) break;
        __builtin_amdgcn_s_sleep(1);
        if ((++sp & 255u) == 0u) { if (xb_ld(&bar[XB_TMO])) break; if (sp > XB_SPIN_CAP) { atomicAdd(&bar[XB_TMO], 1u); break; } }
    }
    nloc = mine > 0u ? mine : 1u; nx = cnt > 0u ? cnt : 1u;
}
__device__ __forceinline__ void xcd_barrier(const XcdBarrier& b) {
    asm volatile("s_waitcnt vmcnt(0)" ::: "memory");
    __syncthreads();
    if (threadIdx.x == 0) {
        unsigned* bar = b.bar;
        __builtin_amdgcn_s_waitcnt(0);
        unsigned nloc = b.st[0], nx = b.st[1];
        if (nloc == 0u) { xcd_barrier_complete(bar, b.x, nloc, nx); b.st[0] = nloc; b.st[1] = nx; }
        const unsigned old = xb_add(&bar[XB_XSUB(b.x)], 1u);
        const unsigned gen = old / nloc;
        if (old + 1u == (gen + 1u) * nloc) {
            __builtin_amdgcn_fence(__ATOMIC_RELEASE, "agent");
            asm volatile("s_waitcnt vmcnt(0)" ::: "memory");
            const unsigned og = xb_add(&bar[XB_TOP], 1u);
            const unsigned tg = og / nx;
            if (og + 1u == (tg + 1u) * nx) xb_add(&bar[XB_TOPGEN], 1u);
            else XB_SPIN(xb_ld(&bar[XB_TOPGEN]) == tg, bar);
            __builtin_amdgcn_fence(__ATOMIC_ACQUIRE, "agent");
            xb_add(&bar[XB_XGEN(b.x)], 1u);
            asm volatile("s_waitcnt vmcnt(0)" ::: "memory");
        } else {
            XB_SPIN(xb_ld(&bar[XB_XGEN(b.x)]) == gen, bar);
            __builtin_amdgcn_fence(__ATOMIC_ACQUIRE, "agent");
            asm volatile("s_waitcnt vmcnt(0)" ::: "memory");
        }
    }
    __syncthreads();
}

struct Args { const float* in[29]; float* out; unsigned char* ws; int ph_lo, ph_hi; };
enum { I_X = 0, I_MEM, I_MEM_G, I_MEM_B, I_W_IN, I_SGU_G, I_SGU_B, I_SGU_W, I_SGU_BS, I_POOL_W, I_POOL_S, I_CONV_W, I_CONV_B, I_CONV_G, I_CONV_LB, I_W_KV, I_W_OUT, I_LN1_G, I_LN1_B,
       I_W_R, I_R_BIAS, I_E_G, I_E_U, I_E_D, I_S_G, I_S_U, I_S_D, I_LN2_G, I_LN2_B };

struct Frame {
    LAS unsigned char* lds;
    int tid, lane, wave, vcu, G;
    const Args* a;
    unsigned char* ws;
};

struct ItemDesc { const float* W; bf16_t* WT; bf16_t* WL; int ldw, ldt, k0, n0, drow0; };
constexpr int LI_IN = 3072, LI_OUT = 2048, LI_EX = 64 * 256, LI_SH = 256, LI_PW = 4 * 8, LI_RT = 64;
constexpr int L_ITEMS = LI_IN + LI_OUT + 3 * LI_EX + 3 * LI_SH + LI_PW + LI_RT;
constexpr int KV_ITEMS = 4 * 1024;
constexpr int LI_X = 3 * LI_EX + 3 * LI_SH, LI_S = L_ITEMS - LI_X;
constexpr int Q_TOTAL = NL * L_ITEMS - LI_S;
constexpr int CW_Q = 8192;
constexpr int Q_CH = 8;
__device__ __forceinline__ ItemDesc item_desc(const Args& A, unsigned char* ws, int l, int r) {
    bf16_t* WT_IN = (bf16_t*)(ws + WS_WT_IN); bf16_t* WT_OUT = (bf16_t*)(ws + WS_WT_OUT);
    bf16_t* WT_GU = (bf16_t*)(ws + WS_WT_GU); bf16_t* WT_D = (bf16_t*)(ws + WS_WT_D); bf16_t* WPT = (bf16_t*)(ws + WS_WPT);
    ItemDesc d; d.WL = nullptr;
    if (r < LI_IN) { const int kb = r / 96, nb = r % 96; d.W = A.in[I_W_IN] + (size_t)l * D * INW; d.ldw = INW; d.WT = WT_IN + (size_t)l * INW * D; d.ldt = D; d.k0 = kb * 64; d.n0 = nb * 32; d.drow0 = nb * 32; return d; } r -= LI_IN;
    if (r < LI_OUT) { const int kb = r / 64, nb = r % 64; d.W = A.in[I_W_OUT] + (size_t)l * D * D; d.ldw = D; d.WT = WT_OUT + (size_t)l * D * D; d.ldt = D; d.k0 = kb * 64; d.n0 = nb * 32; d.drow0 = nb * 32; return d; } r -= LI_OUT;
    if (r < 2 * LI_EX) { const int up = r >= LI_EX; if (up) r -= LI_EX; const int e = r / 256, rem = r % 256, kb = rem / 8, nb = rem % 8, n0 = nb * 32;
        d.W = A.in[up ? I_E_U : I_E_G] + (size_t)(l * NE + e) * D * DE; d.ldw = DE; d.WT = WT_GU + (size_t)(l * NE1 + e) * 512 * D; d.ldt = D; d.k0 = kb * 64; d.n0 = n0; d.drow0 = (n0 >> 7) * 256 + up * 128 + (n0 & 127); return d; } r -= 2 * LI_EX;
    if (r < LI_EX) { const int e = r / 256, rem = r % 256, kb = rem / 64, nb = rem % 64;
        d.W = A.in[I_E_D] + (size_t)(l * NE + e) * DE * D; d.ldw = D; d.WT = WT_D + (size_t)(l * NE1 + e) * D * DE; d.ldt = DE; d.k0 = kb * 64; d.n0 = nb * 32; d.drow0 = nb * 32; return d; } r -= LI_EX;
    if (r < 2 * LI_SH) { const int up = r >= LI_SH; if (up) r -= LI_SH; const int kb = r / 8, nb = r % 8, n0 = nb * 32;
        d.W = A.in[up ? I_S_U : I_S_G] + (size_t)l * D * DE; d.ldw = DE; d.WT = WT_GU + (size_t)(l * NE1 + 64) * 512 * D; d.ldt = D; d.k0 = kb * 64; d.n0 = n0; d.drow0 = (n0 >> 7) * 256 + up * 128 + (n0 & 127); return d; } r -= 2 * LI_SH;
    if (r < LI_SH) { const int kb = r / 64, nb = r % 64; d.W = A.in[I_S_D] + (size_t)l * DE * D; d.ldw = D; d.WT = WT_D + (size_t)(l * NE1 + 64) * D * DE; d.ldt = DE; d.k0 = kb * 64; d.n0 = nb * 32; d.drow0 = nb * 32; return d; } r -= LI_SH;
    if (r < LI_PW) { const int g = r / 8, rem = r % 8, kb = rem / 4, nb = rem % 4; d.W = A.in[I_POOL_W] + (size_t)(l * 4 + g) * 128 * 128; d.ldw = 128; d.WT = WPT + (size_t)(l * 4 + g) * 128 * 128; d.ldt = 128; d.k0 = kb * 64; d.n0 = nb * 32; d.drow0 = nb * 32; return d; } r -= LI_PW;
    { const int kb = r / 2, nb = r % 2; d.W = A.in[I_W_R] + (size_t)l * D * NE; d.ldw = NE; d.WT = (bf16_t*)(ws + WS_WR_HI) + (size_t)l * NE * D; d.WL = (bf16_t*)(ws + WS_WR_LO) + (size_t)l * NE * D; d.ldt = D; d.k0 = kb * 64; d.n0 = nb * 32; d.drow0 = nb * 32; return d; }
}
__device__ __forceinline__ ItemDesc kv_desc(const Args& A, unsigned char* ws, int r) {
    const int mat = r / 1024, rem = r % 1024, kb = rem / 32, nb = rem % 32, n0 = nb * 32; ItemDesc d; d.WL = nullptr;
    d.W = A.in[I_W_KV] + (size_t)mat * D * 1024; d.ldw = 1024; d.WT = (bf16_t*)(ws + (n0 < 512 ? WS_WT_K : WS_WT_V)); d.ldt = D; d.k0 = kb * 64; d.n0 = n0; d.drow0 = mat * 512 + (n0 & 511); return d;
}
__device__ __forceinline__ void item_load(const ItemDesc& d, f32x4 (&v)[8], int lane) {
#pragma unroll
    for (int i = 0; i < 8; ++i) v[i] = __builtin_nontemporal_load((const f32x4*)(d.W + (size_t)(d.k0 + 8 * i + (lane >> 3)) * d.ldw + d.n0 + 4 * (lane & 7)));
}
__device__ __forceinline__ void item_finish(const ItemDesc& d, const f32x4 (&v)[8], LAS float* scr, int lane) {
#pragma unroll
    for (int i = 0; i < 8; ++i) { LAS float* p = scr + (8 * i + (lane >> 3)) * 33 + 4 * (lane & 7); p[0] = v[i][0]; p[1] = v[i][1]; p[2] = v[i][2]; p[3] = v[i][3]; }
    LDS_WAIT(); asm volatile("" ::: "memory");
    const int c = lane & 7;
#pragma unroll
    for (int j = 0; j < 4; ++j) { const int n = (lane >> 3) + 8 * j; const LAS float* s = scr + (8 * c) * 33 + n;
        float x[8]; unsigned h[4];
#pragma unroll
        for (int q = 0; q < 8; ++q) x[q] = s[q * 33];
#pragma unroll
        for (int q = 0; q < 4; ++q) h[q] = cvt_pk_bf16(x[2 * q], x[2 * q + 1]);
        __builtin_nontemporal_store((u32x4){h[0], h[1], h[2], h[3]}, (u32x4*)(d.WT + (size_t)(d.drow0 + n) * d.ldt + d.k0 + 8 * c));
        if (d.WL) { unsigned lo[4];
#pragma unroll
            for (int q = 0; q < 4; ++q) lo[q] = cvt_pk_bf16(x[2 * q] - bf_lo(h[q]), x[2 * q + 1] - bf_hi(h[q]));
            *(u32x4*)(d.WL + (size_t)(d.drow0 + n) * d.ldt + d.k0 + 8 * c) = (u32x4){lo[0], lo[1], lo[2], lo[3]}; } }
    LDS_WAIT(); asm volatile("" ::: "memory");
}
__device__ __forceinline__ int s_item(int s) { return s < LI_IN + LI_OUT ? s : s + LI_X; }
struct GenPrologue { __device__ __forceinline__ ItemDesc operator()(const Args& A, unsigned char* ws, int id) const { return id < LI_S ? item_desc(A, ws, 0, s_item(id)) : kv_desc(A, ws, id - LI_S); } };
struct GenQueue    { __device__ __forceinline__ ItemDesc operator()(const Args& A, unsigned char* ws, int id) const { const int l = id / L_ITEMS, j = id % L_ITEMS;
    return j < LI_X ? item_desc(A, ws, l, LI_IN + LI_OUT + j) : item_desc(A, ws, l + 1, s_item(j - LI_X)); } };
template <class Gen> __device__ __forceinline__ void convert_seq(const Args& A, unsigned char* ws, int first, int end, int stride, LAS float* scr, int lane) {
    if (first >= end) return;
    const Gen gen; ItemDesc d0 = gen(A, ws, first); f32x4 v0[8]; item_load(d0, v0, lane);
#pragma unroll 1
    for (int id = first + stride; id < end; id += stride) { const ItemDesc d1 = gen(A, ws, id); f32x4 v1[8]; item_load(d1, v1, lane); item_finish(d0, v0, scr, lane); d0 = d1;
#pragma unroll
        for (int i = 0; i < 8; ++i) v0[i] = v1[i]; }
    item_finish(d0, v0, scr, lane);
}
__device__ __forceinline__ void convert_fill(Frame& F, int floor, int budget) {
    const Args& A = *F.a; LAS float* scr = (LAS float*)(F.lds + F.wave * 16384);
    unsigned* qh = (unsigned*)(F.ws + WS_CTL) + CW_Q;
#pragma unroll 1
    for (int b = 0; b < budget; ++b) {
        unsigned st = 0u; if (F.lane == 0) st = __hip_atomic_fetch_add(qh, (unsigned)Q_CH, __ATOMIC_RELAXED, __HIP_MEMORY_SCOPE_AGENT);
        const int s0 = __builtin_amdgcn_readfirstlane((int)st);
        if (s0 >= Q_TOTAL) break;
        const int lo = s0 > floor ? s0 : floor, hi = (s0 + Q_CH) < Q_TOTAL ? (s0 + Q_CH) : Q_TOTAL;
        if (lo >= hi) { ++budget; if (budget > (1 << 20)) break; continue; }
        convert_seq<GenQueue>(A, F.ws, lo, hi, 1, scr, F.lane);
    }
}
__device__ __forceinline__ void convert_cleanup(Frame& F, int from, int upto) {
    const Args& A = *F.a; LAS float* scr = (LAS float*)(F.lds + F.wave * 16384);
    unsigned* qh = (unsigned*)(F.ws + WS_CTL) + CW_Q;
    int head = __builtin_amdgcn_readfirstlane((int)__hip_atomic_load(qh, __ATOMIC_RELAXED, __HIP_MEMORY_SCOPE_AGENT)); head = head > from ? head : from;
    convert_seq<GenQueue>(A, F.ws, head + F.vcu * 8 + F.wave, upto, F.G * 8, scr, F.lane);
}

__device__ __forceinline__ void convert_beside_d(Frame& F, int from, int upto) {
    const Args& A = *F.a; LAS float* scr = (LAS float*)(F.lds + 81920 + (F.wave - 4) * 8704);
    unsigned* qh = (unsigned*)(F.ws + WS_CTL) + CW_Q;
    int head = __builtin_amdgcn_readfirstlane((int)__hip_atomic_load(qh, __ATOMIC_RELAXED, __HIP_MEMORY_SCOPE_AGENT)); head = head > from ? head : from;
    convert_seq<GenQueue>(A, F.ws, head + F.vcu * 4 + (F.wave - 4), upto, F.G * 4, scr, F.lane);
}
__device__ __forceinline__ void p0_prologue(Frame& F) {
    const Args& A = *F.a; unsigned char* ws = F.ws;
    LAS float* scr = (LAS float*)(F.lds + F.wave * 16384);
    const int gw = F.vcu * 8 + F.wave, NGW = F.G * 8, lane = F.lane;
    convert_seq<GenPrologue>(A, ws, gw, LI_S + KV_ITEMS, NGW, scr, lane);
    { const int gt = F.vcu * 512 + F.tid, NGT = F.G * 512; bf16_t* SW = (bf16_t*)(ws + WS_SGUW);
      for (int i = gt; i < NL * 4 * 128 * 128 / 8; i += NGT) { const int t = (i >> 4) & 127, s0 = (i & 15) * 8; const f32x4* p = (const f32x4*)(A.in[I_SGU_W] + (size_t)i * 8); const f32x4 a = p[0], b = p[1];
          float v[8] = {a[0], a[1], a[2], a[3], b[0], b[1], b[2], b[3]};
#pragma unroll
          for (int q = 0; q < 8; ++q) v[q] = (s0 + q <= t) ? v[q] : 0.f;
          *(u32x4*)(SW + (size_t)i * 8) = (u32x4){cvt_pk_bf16(v[0], v[1]), cvt_pk_bf16(v[2], v[3]), cvt_pk_bf16(v[4], v[5]), cvt_pk_bf16(v[6], v[7])}; }
      bf16_t* XB = (bf16_t*)(ws + WS_XB);
      for (int i = gt; i < NTOK * D / 8; i += NGT) { const f32x4* p = (const f32x4*)(A.in[I_X] + (size_t)i * 8); const f32x4 a = p[0], b = p[1];
          *(u32x4*)(XB + (size_t)i * 8) = (u32x4){cvt_pk_bf16(a[0], a[1]), cvt_pk_bf16(a[2], a[3]), cvt_pk_bf16(b[0], b[1]), cvt_pk_bf16(b[2], b[3])}; } }
    if (F.vcu == 0 && F.tid < 256) *(u32x4*)((bf16_t*)(ws + WS_X1B) + (size_t)NTOK * D + F.tid * 8) = (u32x4){0u, 0u, 0u, 0u};
    { bf16_t* MN = (bf16_t*)(ws + WS_MEMN);
      for (int m = gw; m < NMEMTOK; m += NGW) { const f32x4* xr = (const f32x4*)(A.in[I_MEM] + (size_t)m * D) + lane; f32x4 v[8]; float s = 0.f;
#pragma unroll
          for (int j = 0; j < 8; ++j) { v[j] = xr[64 * j]; s += (v[j][0] + v[j][1]) + (v[j][2] + v[j][3]); }
          const float mean = wave_sum(s) * (1.f / D); float s2 = 0.f;
#pragma unroll
          for (int j = 0; j < 8; ++j) { v[j] = v[j] - mean; s2 += (v[j][0] * v[j][0] + v[j][1] * v[j][1]) + (v[j][2] * v[j][2] + v[j][3] * v[j][3]); }
          const float rstd = 1.f / sqrtf(wave_sum(s2) * (1.f / D) + LN_EPS);
#pragma unroll
          for (int j = 0; j < 8; ++j) { const f32x4 g = ((const f32x4*)A.in[I_MEM_G])[lane + 64 * j], b = ((const f32x4*)A.in[I_MEM_B])[lane + 64 * j]; const f32x4 o = v[j] * rstd * g + b;
              *(u32x2*)(MN + (size_t)m * D + 4 * lane + 256 * j) = (u32x2){cvt_pk_bf16(o[0], o[1]), cvt_pk_bf16(o[2], o[3])}; } } }
}

typedef f32x4 acc8_t[8];
__device__ __forceinline__ void mixer_sgu(Frame& F, int l, int chunk, int h) {
    const Args& A = *F.a; const int lane = F.lane, w = F.wave, fr = lane & 15, g = lane >> 4, t0 = chunk * 128;
    const bf16_t* HB = (const bf16_t*)(F.ws + WS_HB); bf16_t* MIX = (bf16_t*)(F.ws + WS_MIX); const bf16_t* SW = (const bf16_t*)(F.ws + WS_SGUW) + (size_t)(l * 4 + h) * 128 * 128;
    LAS unsigned char* VT = F.lds;
    const int t = 16 * w + fr;
    bf16x8 af[4]; u32x2 uraw[8];
#pragma unroll
    for (int ks = 0; ks < 4; ++ks) af[ks] = *(const bf16x8*)(SW + (size_t)t * 128 + 32 * ks + 8 * g);
#pragma unroll
    for (int j = 0; j < 8; ++j) uraw[j] = *(const u32x2*)(HB + (size_t)(t0 + t) * INW + h * 128 + 16 * j + 4 * g);
    const float bs = A.in[I_SGU_BS][(size_t)(l * 128 + t) * 4 + h];
    { const float* gp = A.in[I_SGU_G] + l * GW + h * 128 + 8 * fr; const float* bp = A.in[I_SGU_B] + l * GW + h * 128 + 8 * fr;
      const f32x4 g0 = *(const f32x4*)gp, g1 = *(const f32x4*)(gp + 4), b0 = *(const f32x4*)bp, b1 = *(const f32x4*)(bp + 4);
      const float gg[8] = {g0[0], g0[1], g0[2], g0[3], g1[0], g1[1], g1[2], g1[3]}, bb[8] = {b0[0], b0[1], b0[2], b0[3], b1[0], b1[1], b1[2], b1[3]};
      u32x4 raw[4];
#pragma unroll
      for (int p = 0; p < 4; ++p) raw[p] = *(const u32x4*)(HB + (size_t)(t0 + 16 * w + 4 * p + g) * INW + 512 + h * 128 + 8 * fr);
#pragma unroll
      for (int p = 0; p < 4; ++p) { const int tok = 16 * w + 4 * p + g;
          float v[8] = {bf_lo(raw[p].x), bf_hi(raw[p].x), bf_lo(raw[p].y), bf_hi(raw[p].y), bf_lo(raw[p].z), bf_hi(raw[p].z), bf_lo(raw[p].w), bf_hi(raw[p].w)}; float s = 0.f;
#pragma unroll
          for (int q = 0; q < 8; ++q) { v[q] = gelu_tanh_f(v[q]); s += v[q]; }
          const float mean = g16_sum(s) * (1.f / 128.f); float s2 = 0.f;
#pragma unroll
          for (int q = 0; q < 8; ++q) { v[q] -= mean; s2 += v[q] * v[q]; }
          const float rstd = 1.f / sqrtf(g16_sum(s2) * (1.f / 128.f) + LN_EPS);
#pragma unroll
          for (int q = 0; q < 8; q += 2) { const unsigned pk = cvt_pk_bf16(v[q] * rstd * gg[q] + bb[q], v[q + 1] * rstd * gg[q + 1] + bb[q + 1]);
              const int d0 = 8 * fr + q, d1 = d0 + 1;
              *(LAS bf16_t*)(VT + d0 * 256 + ((((tok >> 3) ^ d0 ^ (d0 >> 3)) & 15) << 4) + (tok & 7) * 2) = (bf16_t)(pk & 0xffffu);
              *(LAS bf16_t*)(VT + d1 * 256 + ((((tok >> 3) ^ d1 ^ (d1 >> 3)) & 15) << 4) + (tok & 7) * 2) = (bf16_t)(pk >> 16); } } }
    __syncthreads();
    f32x4 acc[8];
#pragma unroll
    for (int j = 0; j < 8; ++j) acc[j] = (f32x4){0.f, 0.f, 0.f, 0.f};
    const int nks = (w >> 1) + 1;
#pragma unroll
    for (int ks = 0; ks < 4; ++ks) if (ks < nks) {
#pragma unroll
        for (int j = 0; j < 8; ++j) { const int d = 16 * j + fr; const bf16x8 bfr = *(const LAS bf16x8*)(VT + d * 256 + ((((4 * ks + g) ^ d ^ (d >> 3)) & 15) << 4));
            acc[j] = __builtin_amdgcn_mfma_f32_16x16x32_bf16(bfr, af[ks], acc[j], 0, 0, 0); }
    }
#pragma unroll
    for (int j = 0; j < 8; ++j) { const u32x2 raw = uraw[j];
        const float u0 = gelu_tanh_f(bf_lo(raw.x)), u1 = gelu_tanh_f(bf_hi(raw.x)), u2 = gelu_tanh_f(bf_lo(raw.y)), u3 = gelu_tanh_f(bf_hi(raw.y));
        *(u32x2*)(MIX + (size_t)(t0 + t) * D + h * 128 + 16 * j + 4 * g) = (u32x2){cvt_pk_bf16(u0 * (acc[j][0] + bs), u1 * (acc[j][1] + bs)), cvt_pk_bf16(u2 * (acc[j][2] + bs), u3 * (acc[j][3] + bs))}; }
    __syncthreads();
}
__device__ __forceinline__ void mixer_pool(Frame& F, int l, int chunk, int grp) {
    const Args& A = *F.a; const int lane = F.lane, w = F.wave, fr = lane & 15, g = lane >> 4, t0 = chunk * 128, tid = F.tid;
    const bf16_t* HB = (const bf16_t*)(F.ws + WS_HB); bf16_t* MIX = (bf16_t*)(F.ws + WS_MIX); const bf16_t* WP = (const bf16_t*)(F.ws + WS_WPT) + (size_t)(l * 4 + grp) * 128 * 128;
    constexpr int PST = 272;
    LAS unsigned char* PT = F.lds;
    LAS unsigned char* PA = F.lds + 144 * PST;
    const int win = 2 << grp, pos0 = t0 & (SEQ - 1);
    LAS unsigned char* WS = F.lds + 144 * PST + 128 * PST;
    { u32x4 wv4[4];
#pragma unroll
      for (int i = 0; i < 4; ++i) wv4[i] = *(const u32x4*)(WP + (size_t)(tid + 512 * i) * 8);
      for (int i = tid; i < 144 * 16; i += 512) { const int r = i >> 4, cc = i & 15; const int trow = t0 - 16 + r; u32x4 v = (u32x4){0u, 0u, 0u, 0u};
          if (pos0 - 16 + r >= 0) v = *(const u32x4*)(HB + (size_t)trow * INW + 1024 + grp * 128 + 8 * cc);
          *(LAS u32x4*)(PT + r * PST + cc * 16) = v; }
#pragma unroll
      for (int i = 0; i < 4; ++i) { const int id = tid + 512 * i, d = id >> 4, cc = id & 15; *(LAS u32x4*)(WS + d * 256 + ((cc ^ (d & 15)) << 4)) = wv4[i]; } }
    f32x4 scv[8];
#pragma unroll
    for (int j = 0; j < 8; ++j) scv[j] = *(const f32x4*)(A.in[I_POOL_S] + l * GW + grp * 128 + 16 * j + 4 * g);
    __syncthreads();
    for (int i = tid; i < 128 * 16; i += 512) { const int t = i >> 4, cc = i & 15; float s[8] = {0.f, 0.f, 0.f, 0.f, 0.f, 0.f, 0.f, 0.f}; u32x4 cur = (u32x4){0u, 0u, 0u, 0u};
        for (int j = 0; j < win; ++j) { cur = *(const LAS u32x4*)(PT + (t + 16 - win + 1 + j) * PST + cc * 16);
            s[0] += bf_lo(cur.x); s[1] += bf_hi(cur.x); s[2] += bf_lo(cur.y); s[3] += bf_hi(cur.y); s[4] += bf_lo(cur.z); s[5] += bf_hi(cur.z); s[6] += bf_lo(cur.w); s[7] += bf_hi(cur.w); }
        const int pos = pos0 + t; const float inv = 1.0f / (float)((pos + 1) < win ? (pos + 1) : win);
        const float x[8] = {bf_lo(cur.x), bf_hi(cur.x), bf_lo(cur.y), bf_hi(cur.y), bf_lo(cur.z), bf_hi(cur.z), bf_lo(cur.w), bf_hi(cur.w)};
        *(LAS u32x4*)(PA + t * PST + cc * 16) = (u32x4){cvt_pk_bf16(s[0] * inv - x[0], s[1] * inv - x[1]), cvt_pk_bf16(s[2] * inv - x[2], s[3] * inv - x[3]),
                                                        cvt_pk_bf16(s[4] * inv - x[4], s[5] * inv - x[5]), cvt_pk_bf16(s[6] * inv - x[6], s[7] * inv - x[7])}; }
    __syncthreads();
    f32x4 acc[8];
#pragma unroll
    for (int j = 0; j < 8; ++j) acc[j] = (f32x4){0.f, 0.f, 0.f, 0.f};
#pragma unroll
    for (int ks = 0; ks < 4; ++ks) { const bf16x8 af = *(const LAS bf16x8*)(PA + (16 * w + fr) * PST + (32 * ks + 8 * g) * 2);
#pragma unroll
        for (int j = 0; j < 8; ++j) { const bf16x8 bfr = *(const LAS bf16x8*)(WS + (16 * j + fr) * 256 + (((4 * ks + g) ^ fr) << 4));
            acc[j] = __builtin_amdgcn_mfma_f32_16x16x32_bf16(bfr, af, acc[j], 0, 0, 0); } }
    { const int t = 16 * w + fr;
#pragma unroll
      for (int j = 0; j < 8; ++j) { const f32x4 sc = scv[j];
          *(u32x2*)(MIX + (size_t)(t0 + t) * D + 512 + grp * 128 + 16 * j + 4 * g) = (u32x2){cvt_pk_bf16(acc[j][0] * sc[0], acc[j][1] * sc[1]), cvt_pk_bf16(acc[j][2] * sc[2], acc[j][3] * sc[3])}; } }
    __syncthreads();
}
__device__ __forceinline__ void mixer_conv(Frame& F, int l, int chunk, int grp) {
    const Args& A = *F.a; const int lane = F.lane, w = F.wave, fr = lane & 15, g = lane >> 4, t0 = chunk * 128, tid = F.tid;
    const bf16_t* HB = (const bf16_t*)(F.ws + WS_HB); bf16_t* MIX = (bf16_t*)(F.ws + WS_MIX);
    LAS float* GT = (LAS float*)F.lds;
    const int pos0 = t0 & (SEQ - 1);
    for (int i = tid; i < 158 * 16; i += 512) { const int r = i >> 4, cc = i & 15; float o[8] = {0.f, 0.f, 0.f, 0.f, 0.f, 0.f, 0.f, 0.f};
        if (pos0 - 30 + r >= 0) { const bf16_t* rowp = HB + (size_t)(t0 - 30 + r) * INW + grp * 128 + 8 * cc; const u32x4 v = *(const u32x4*)(rowp + 1536), gt = *(const u32x4*)(rowp + 2048);
            o[0] = bf_lo(v.x) * fast_sigmoid(bf_lo(gt.x)); o[1] = bf_hi(v.x) * fast_sigmoid(bf_hi(gt.x)); o[2] = bf_lo(v.y) * fast_sigmoid(bf_lo(gt.y)); o[3] = bf_hi(v.y) * fast_sigmoid(bf_hi(gt.y));
            o[4] = bf_lo(v.z) * fast_sigmoid(bf_lo(gt.z)); o[5] = bf_hi(v.z) * fast_sigmoid(bf_hi(gt.z)); o[6] = bf_lo(v.w) * fast_sigmoid(bf_lo(gt.w)); o[7] = bf_hi(v.w) * fast_sigmoid(bf_hi(gt.w)); }
        *(LAS f32x4*)(GT + r * 128 + 8 * cc) = (f32x4){o[0], o[1], o[2], o[3]}; *(LAS f32x4*)(GT + r * 128 + 8 * cc + 4) = (f32x4){o[4], o[5], o[6], o[7]}; }
    __syncthreads();
    float y[32];
    { const int ch = tid & 127, tg = tid >> 7; float wv[31];
#pragma unroll
      for (int j = 0; j < 31; ++j) wv[j] = A.in[I_CONV_W][(size_t)(l * 31 + j) * GW + grp * 128 + ch];
      const float bias = A.in[I_CONV_B][l * GW + grp * 128 + ch];
      float xin[62];
#pragma unroll
      for (int j = 0; j < 62; ++j) xin[j] = GT[(tg * 32 + j) * 128 + ch];
#pragma unroll
      for (int t = 0; t < 32; ++t) { float s = bias;
#pragma unroll
          for (int j = 0; j < 31; ++j) s += wv[j] * xin[t + j];
          y[t] = s; }
      __syncthreads();
#pragma unroll
      for (int t = 0; t < 32; ++t) GT[(tg * 32 + t) * 128 + ch] = y[t]; }
    __syncthreads();
    { const float* gp = A.in[I_CONV_G] + l * GW + grp * 128 + 8 * fr; const float* bp = A.in[I_CONV_LB] + l * GW + grp * 128 + 8 * fr;
      const f32x4 g0 = *(const f32x4*)gp, g1 = *(const f32x4*)(gp + 4), b0 = *(const f32x4*)bp, b1 = *(const f32x4*)(bp + 4);
      const float gg[8] = {g0[0], g0[1], g0[2], g0[3], g1[0], g1[1], g1[2], g1[3]}, bb[8] = {b0[0], b0[1], b0[2], b0[3], b1[0], b1[1], b1[2], b1[3]};
#pragma unroll
      for (int p = 0; p < 4; ++p) { const int tok = 16 * w + 4 * p + g; const f32x4 a = *(const LAS f32x4*)(GT + tok * 128 + 8 * fr), b = *(const LAS f32x4*)(GT + tok * 128 + 8 * fr + 4);
          float v[8] = {a[0], a[1], a[2], a[3], b[0], b[1], b[2], b[3]}; float s = 0.f;
#pragma unroll
          for (int q = 0; q < 8; ++q) s += v[q];
          const float mean = g16_sum(s) * (1.f / 128.f); float s2 = 0.f;
#pragma unroll
          for (int q = 0; q < 8; ++q) { v[q] -= mean; s2 += v[q] * v[q]; }
          const float rstd = 1.f / sqrtf(g16_sum(s2) * (1.f / 128.f) + LN_EPS);
#pragma unroll
          for (int q = 0; q < 8; ++q) v[q] = silu_f(v[q] * rstd * gg[q] + bb[q]);
          *(u32x4*)(MIX + (size_t)(t0 + tok) * D + 1024 + grp * 128 + 8 * fr) = (u32x4){cvt_pk_bf16(v[0], v[1]), cvt_pk_bf16(v[2], v[3]), cvt_pk_bf16(v[4], v[5]), cvt_pk_bf16(v[6], v[7])}; } }
    __syncthreads();
}
__device__ __forceinline__ void mixer_attn(Frame& F, int l, int chunk, int h) {
    const int lane = F.lane, w = F.wave, fr = lane & 15, g = lane >> 4, t0 = chunk * 128, b = t0 / SEQ, tid = F.tid;
    const bf16_t* HB = (const bf16_t*)(F.ws + WS_HB); bf16_t* MIX = (bf16_t*)(F.ws + WS_MIX);
    const bf16_t* KB = (const bf16_t*)(F.ws + WS_KBUF) + (size_t)(b * 256) * D + l * 512 + h * 128;
    const bf16_t* VTp = (const bf16_t*)(F.ws + WS_VT) + (size_t)(l * 512 + h * 128) * NMEMTOK + b * 256;
    LAS unsigned char* KS = F.lds;
    LAS unsigned char* VS = F.lds + 65536;
    { u32x4 kv[8], vv[8];
#pragma unroll
      for (int i = 0; i < 8; ++i) { const int id = tid + 512 * i; kv[i] = *(const u32x4*)(KB + (size_t)(id >> 4) * D + (id & 15) * 8); vv[i] = *(const u32x4*)(VTp + (size_t)(id >> 5) * NMEMTOK + (id & 31) * 8); }
#pragma unroll
      for (int i = 0; i < 8; ++i) { const int id = tid + 512 * i; const int m = id >> 4, c = id & 15, d = id >> 5, c2 = id & 31;
          *(LAS u32x4*)(KS + m * 256 + ((c ^ (m & 15)) << 4)) = kv[i]; *(LAS u32x4*)(VS + d * 512 + ((c2 ^ (d & 15)) << 4)) = vv[i]; } }
    __syncthreads();
    const int t = 16 * w + fr;
    f32x4 sa[16];
#pragma unroll
    for (int j = 0; j < 16; ++j) sa[j] = (f32x4){0.f, 0.f, 0.f, 0.f};
    bf16x8 qf[4];
#pragma unroll
    for (int ks = 0; ks < 4; ++ks) qf[ks] = *(const bf16x8*)(HB + (size_t)(t0 + t) * INW + 2560 + h * 128 + 32 * ks + 8 * g);
#pragma unroll
    for (int ks = 0; ks < 4; ++ks)
#pragma unroll
        for (int j = 0; j < 16; ++j) { const bf16x8 kf = *(const LAS bf16x8*)(KS + (16 * j + fr) * 256 + (((4 * ks + g) ^ fr) << 4));
            sa[j] = __builtin_amdgcn_mfma_f32_16x16x32_bf16(kf, qf[ks], sa[j], 0, 0, 0); }
    float mx = -3.0e38f;
#pragma unroll
    for (int j = 0; j < 16; ++j) mx = fmaxf(mx, fmaxf(fmaxf(sa[j][0], sa[j][1]), fmaxf(sa[j][2], sa[j][3])));
    mx = fmaxf(mx, __shfl_xor(mx, 16)); mx = fmaxf(mx, __shfl_xor(mx, 32));
    const float sc = 0.08838834764831845f * 1.4426950408889634f; float sum = 0.f;
#pragma unroll
    for (int j = 0; j < 16; ++j)
#pragma unroll
        for (int r = 0; r < 4; ++r) { const float p = __builtin_amdgcn_exp2f((sa[j][r] - mx) * sc); sa[j][r] = p; sum += p; }
    sum += __shfl_xor(sum, 16); sum += __shfl_xor(sum, 32);
    const float inv = 1.0f / sum;
    f32x4 oa[8];
#pragma unroll
    for (int j = 0; j < 8; ++j) oa[j] = (f32x4){0.f, 0.f, 0.f, 0.f};
#pragma unroll
    for (int q = 0; q < 8; ++q) {
        union { bf16x8 v; unsigned u[4]; } pf; pf.u[0] = cvt_pk_bf16(sa[2 * q][0], sa[2 * q][1]); pf.u[1] = cvt_pk_bf16(sa[2 * q][2], sa[2 * q][3]);
        pf.u[2] = cvt_pk_bf16(sa[2 * q + 1][0], sa[2 * q + 1][1]); pf.u[3] = cvt_pk_bf16(sa[2 * q + 1][2], sa[2 * q + 1][3]);
#pragma unroll
        for (int jd = 0; jd < 8; ++jd) {
            const LAS unsigned char* vrow = VS + (16 * jd + fr) * 512 + ((g & 1) << 3);
            union { bf16x8 v; u32x2 u[2]; } vf; vf.u[0] = *(const LAS u32x2*)(vrow + (((4 * q + (g >> 1)) ^ fr) << 4)); vf.u[1] = *(const LAS u32x2*)(vrow + (((4 * q + 2 + (g >> 1)) ^ fr) << 4));
            oa[jd] = __builtin_amdgcn_mfma_f32_16x16x32_bf16(vf.v, pf.v, oa[jd], 0, 0, 0); } }
#pragma unroll
    for (int jd = 0; jd < 8; ++jd)
        *(u32x2*)(MIX + (size_t)(t0 + t) * D + 1536 + h * 128 + 16 * jd + 4 * g) = (u32x2){cvt_pk_bf16(oa[jd][0] * inv, oa[jd][1] * inv), cvt_pk_bf16(oa[jd][2] * inv, oa[jd][3] * inv)};
    __syncthreads();
}

template <int NW> __device__ __forceinline__ void dsync(LAS unsigned* ctr, unsigned& nb, int lane) {
    if constexpr (NW == 8) { asm volatile("s_waitcnt vmcnt(0)" ::: "memory"); __syncthreads(); }
    else { asm volatile("s_waitcnt vmcnt(0) lgkmcnt(0)" ::: "memory"); ++nb;
        if (lane == 0) __hip_atomic_fetch_add(ctr, 1u, __ATOMIC_RELAXED, __HIP_MEMORY_SCOPE_WORKGROUP);
        while (__hip_atomic_load(ctr, __ATOMIC_RELAXED, __HIP_MEMORY_SCOPE_WORKGROUP) < (unsigned)NW * nb) __builtin_amdgcn_s_sleep(1);
        asm volatile("" ::: "memory"); }
}
template <int NW> __device__ __forceinline__ void phase_d(Frame& F, int l) {
    constexpr int TPW = 32 / NW, KW = D / NW;
    const Args& A = *F.a; unsigned char* ws = F.ws; const int lane = F.lane, w = F.wave, tid = F.tid, fr = lane & 15, g = lane >> 4;
    const bf16_t* Y1 = (const bf16_t*)(ws + WS_Y1); bf16_t* X1L = (bf16_t*)(ws + WS_X1F); bf16_t* X1B = (bf16_t*)(ws + WS_X1B);
    const bf16_t* WRH = (const bf16_t*)(ws + WS_WR_HI) + (size_t)l * NE * D; const bf16_t* WRL = (const bf16_t*)(ws + WS_WR_LO) + (size_t)l * NE * D;
    int* LIST = (int*)(ws + WS_LIST); int* AEP = (int*)(ws + WS_ASG_EP); float* AW = (float*)(ws + WS_ASG_W);
    unsigned* CNT = (unsigned*)(ws + WS_CTL) + CW_CNT + (size_t)l * 64 * CNT_STRIDE;
    LAS float* PL = (LAS float*)F.lds;
    LAS unsigned* HIST = (LAS unsigned*)(F.lds + NW * 32 * 65 * 4);
    LAS unsigned* ctr = (LAS unsigned*)(F.lds + LDS_MISC) + 16; unsigned nb = 0u;
    for (int blk = F.vcu; blk < NTOK / 32; blk += F.G) {
        const int tok0 = blk * 32;
        if (tid < 128) HIST[tid] = 0u;
#pragma unroll 1
        for (int tt = 0; tt < TPW; tt += 2) { f32x4 v[2][8]; float mean[2], rstd[2];
#pragma unroll
            for (int u = 0; u < 2; ++u) { const u32x2* yr = (const u32x2*)(Y1 + (size_t)(tok0 + TPW * w + tt + u) * D) + lane;
#pragma unroll
                for (int j = 0; j < 8; ++j) { const u32x2 r = yr[64 * j]; v[u][j] = (f32x4){bf_lo(r.x), bf_hi(r.x), bf_lo(r.y), bf_hi(r.y)}; } }
#pragma unroll
            for (int u = 0; u < 2; ++u) { float s = 0.f;
#pragma unroll
                for (int j = 0; j < 8; ++j) s += (v[u][j][0] + v[u][j][1]) + (v[u][j][2] + v[u][j][3]);
                mean[u] = wave_sum(s) * (1.f / D); float s2 = 0.f;
#pragma unroll
                for (int j = 0; j < 8; ++j) { v[u][j] = v[u][j] - mean[u]; s2 += (v[u][j][0] * v[u][j][0] + v[u][j][1] * v[u][j][1]) + (v[u][j][2] * v[u][j][2] + v[u][j][3] * v[u][j][3]); }
                rstd[u] = 1.f / sqrtf(wave_sum(s2) * (1.f / D) + LN_EPS); }
#pragma unroll
            for (int j = 0; j < 8; ++j) { const f32x4 gg = ((const f32x4*)(A.in[I_LN1_G] + l * D))[lane + 64 * j], bb = ((const f32x4*)(A.in[I_LN1_B] + l * D))[lane + 64 * j];
#pragma unroll
                for (int u = 0; u < 2; ++u) { const int tok = tok0 + TPW * w + tt + u; const f32x4 o = v[u][j] * rstd[u] * gg + bb;
                    const unsigned h0 = cvt_pk_bf16(o[0], o[1]), h1 = cvt_pk_bf16(o[2], o[3]);
                    *(u32x2*)(X1B + (size_t)tok * D + 4 * lane + 256 * j) = (u32x2){h0, h1};
                    *(u32x2*)(X1L + (size_t)tok * D + 4 * lane + 256 * j) = (u32x2){cvt_pk_bf16(o[0] - bf_lo(h0), o[1] - bf_hi(h0)), cvt_pk_bf16(o[2] - bf_lo(h1), o[3] - bf_hi(h1))}; } } }
        dsync<NW>(ctr, nb, lane);
        { f32x4 acc[2][4];
#pragma unroll
          for (int rb = 0; rb < 2; ++rb)
#pragma unroll
              for (int cb = 0; cb < 4; ++cb) acc[rb][cb] = (f32x4){0.f, 0.f, 0.f, 0.f};
#pragma unroll 4
          for (int ks = 0; ks < KW / 32; ++ks) { const int k = KW * w + 32 * ks + 8 * g; bf16x8 ah[2], al[2];
#pragma unroll
              for (int rb = 0; rb < 2; ++rb) { ah[rb] = *(const bf16x8*)(X1B + (size_t)(tok0 + 16 * rb + fr) * D + k); al[rb] = *(const bf16x8*)(X1L + (size_t)(tok0 + 16 * rb + fr) * D + k); }
#pragma unroll
              for (int cb = 0; cb < 4; ++cb) { const bf16x8 bh = *(const bf16x8*)(WRH + (size_t)(16 * cb + fr) * D + k), bl = *(const bf16x8*)(WRL + (size_t)(16 * cb + fr) * D + k);
#pragma unroll
                  for (int rb = 0; rb < 2; ++rb) { acc[rb][cb] = __builtin_amdgcn_mfma_f32_16x16x32_bf16(ah[rb], bh, acc[rb][cb], 0, 0, 0);
                      acc[rb][cb] = __builtin_amdgcn_mfma_f32_16x16x32_bf16(ah[rb], bl, acc[rb][cb], 0, 0, 0); acc[rb][cb] = __builtin_amdgcn_mfma_f32_16x16x32_bf16(al[rb], bh, acc[rb][cb], 0, 0, 0); } } }
#pragma unroll
          for (int rb = 0; rb < 2; ++rb)
#pragma unroll
              for (int cb = 0; cb < 4; ++cb)
#pragma unroll
                  for (int r = 0; r < 4; ++r) PL[(w * 32 + 16 * rb + 4 * g + r) * 65 + 16 * cb + fr] = acc[rb][cb][r]; }
        dsync<NW>(ctr, nb, lane);
        bool selv[TPW]; unsigned locv[TPW]; float wnv[TPW]; int kv[TPW];
        const float rbias = A.in[I_R_BIAS][l * NE + lane];
#pragma unroll
        for (int tt = 0; tt < TPW; ++tt) { const int tl = TPW * w + tt; float logit = 0.f;
#pragma unroll
            for (int ww = 0; ww < NW; ++ww) logit += PL[(ww * 32 + tl) * 65 + lane];
            const float score = 1.0f / (1.0f + __expf(-logit)), choice = score + rbias;
            float m1 = choice; m1 = fmaxf(m1, __shfl_xor(m1, 1)); m1 = fmaxf(m1, __shfl_xor(m1, 2)); m1 = fmaxf(m1, __shfl_xor(m1, 4));
            int i1 = (choice == m1) ? lane : 64; i1 = min(i1, __shfl_xor(i1, 1)); i1 = min(i1, __shfl_xor(i1, 2)); i1 = min(i1, __shfl_xor(i1, 4));
            float m2 = (lane == i1) ? -INFINITY : choice; m2 = fmaxf(m2, __shfl_xor(m2, 1)); m2 = fmaxf(m2, __shfl_xor(m2, 2)); m2 = fmaxf(m2, __shfl_xor(m2, 4));
            const float gs = m1 + m2; const int myg = lane >> 3; int grank = 0;
#pragma unroll
            for (int gg = 0; gg < 8; ++gg) { const float gv = __int_as_float(__builtin_amdgcn_readlane(__float_as_int(gs), 8 * gg)); grank += (gv > gs || (gv == gs && gg < myg)) ? 1 : 0; }
            const float mc = (grank < 4) ? choice : -INFINITY; int er = 0;
#pragma unroll
            for (int e2 = 0; e2 < 64; ++e2) { const float v = __int_as_float(__builtin_amdgcn_readlane(__float_as_int(mc), e2)); er += (v > mc || (v == mc && e2 < lane)) ? 1 : 0; }
            const bool sel = er < TOPK; const float wsum = wave_sum(sel ? score : 0.f);
            const unsigned long long mask = __ballot(sel);
            selv[tt] = sel; wnv[tt] = score / (wsum + 1e-20f) * 2.5f; kv[tt] = __popcll(mask & ((1ull << lane) - 1ull)); locv[tt] = 0u;
            if (sel) locv[tt] = __hip_atomic_fetch_add(&HIST[lane], 1u, __ATOMIC_RELAXED, __HIP_MEMORY_SCOPE_WORKGROUP); }
        dsync<NW>(ctr, nb, lane);
        if (tid < 64) { const unsigned n = HIST[tid]; HIST[64 + tid] = n ? __hip_atomic_fetch_add(CNT + tid * CNT_STRIDE, n, __ATOMIC_RELAXED, __HIP_MEMORY_SCOPE_AGENT) : 0u; }
        dsync<NW>(ctr, nb, lane);
#pragma unroll
        for (int tt = 0; tt < TPW; ++tt) if (selv[tt]) { const int tok = tok0 + TPW * w + tt; const unsigned pos = HIST[64 + lane] + locv[tt];
            LIST[lane * NTOK + pos] = tok; AEP[tok * 8 + kv[tt]] = (int)((unsigned)lane << 16 | pos); AW[tok * 8 + kv[tt]] = wnv[tt]; }
        dsync<NW>(ctr, nb, lane);
    }
}

__device__ __forceinline__ void build_etab(Frame& F, int l) {
    LAS int* ET = (LAS int*)(F.lds + LDS_ETAB);
    unsigned* CNT = (unsigned*)(F.ws + WS_CTL) + CW_CNT + (size_t)l * 64 * CNT_STRIDE;
    if (F.tid < NE1) ET[F.tid] = F.tid < NE ? (int)__hip_atomic_load(CNT + F.tid * CNT_STRIDE, __ATOMIC_RELAXED, __HIP_MEMORY_SCOPE_AGENT) : NTOK;
    __syncthreads();
    if (F.tid == 0) { int ts = 0;
#pragma unroll 1
        for (int e = 0; e < NE1; ++e) { ET[68 + e] = ts; ET[136 + e] = ts * 256; ts += (ET[e] + 255) >> 8; } ET[68 + NE1] = ts; }
    __syncthreads();
}
struct ExpertSched {
    LAS const int* UD;
    LAS const unsigned* RT;
    const char* Abase; const char* Bbase; size_t bstride_e, bstride_pn; int arow_bytes, ncol; bool gather;
    __device__ __forceinline__ bool next(int i, pg8::Unit& u) const {
        if (i >= 16) return false; const int e = __builtin_amdgcn_readfirstlane(UD[4 * i]); if (e < 0) return false;
        const int row0 = __builtin_amdgcn_readfirstlane(UD[4 * i + 1]), pn = __builtin_amdgcn_readfirstlane(UD[4 * i + 2]);
        u.A = gather ? Abase : Abase + (size_t)row0 * arow_bytes; u.B = Bbase + (size_t)e * bstride_e + (size_t)pn * bstride_pn; u.row0 = row0; u.col0 = pn * ncol; u.nvalid = __builtin_amdgcn_readfirstlane(UD[4 * i + 3]); u.aux = e; return true;
    }
    __device__ __forceinline__ unsigned rowoff(int i, int r) const { return RT[i * 256 + r]; }
};
__device__ __forceinline__ int phase_role(const Frame& F, int NU, int& Gp) {
    NU = __builtin_amdgcn_readfirstlane(NU);
    if (F.G != 256 || NU <= 0) { Gp = F.G; return F.vcu; }
    const int R = (NU + 255) / 256; int g = (NU + R - 1) / R; g = (g + 7) & ~7; if (g > 256) g = 256; Gp = g;
    const int per = g >> 3, x = F.vcu >> 5, r = F.vcu & 31;
    return r < per ? x * per + r : -1 - (x * (32 - per) + (r - per));
}
__device__ __forceinline__ void build_units(Frame& F, int npn, bool gather, int cp, int Gp) {
    LAS int* ET = (LAS int*)(F.lds + LDS_ETAB); LAS int* UD = (LAS int*)(F.lds + LDS_UDESC); LAS unsigned* RT = (LAS unsigned*)(F.lds + LDS_ROWTAB);
    const int NU = ET[68 + NE1] * npn;
    if (F.tid < 16) { const int U = cp + F.tid * Gp; int e = -1, row0 = 0, pn = 0, nv = 0;
        if (U < NU) { const int tile = U / npn; pn = U % npn; e = 0;
#pragma unroll 1
            while (e < NE && ET[68 + e + 1] <= tile) ++e; const int mt = tile - ET[68 + e]; row0 = ET[136 + e] + 256 * mt; nv = ET[e] - 256 * mt; nv = nv > 256 ? 256 : nv; }
        UD[4 * F.tid] = e; UD[4 * F.tid + 1] = row0; UD[4 * F.tid + 2] = pn; UD[4 * F.tid + 3] = nv; }
    __syncthreads();
    if (gather) { const int* LIST = (const int*)(F.ws + WS_LIST);
        for (int i = F.tid; i < 4 * 256; i += 512) { const int ui = i >> 8, r = i & 255; const int e = UD[4 * ui]; unsigned off = 0u;
            if (e >= 0) { const int row0 = UD[4 * ui + 1], nv = UD[4 * ui + 3]; const int lr = row0 - ET[136 + e] + r; int tok = 0;
                tok = NTOK;
                if (r < nv) tok = (e < NE) ? LIST[e * NTOK + lr] : lr;
                off = (unsigned)tok * (unsigned)(D * 2); }
            RT[i] = off; }
        __syncthreads(); }
}

__device__ __forceinline__ void phase_g(Frame& F, int l) {
    const Args& A = *F.a; unsigned char* ws = F.ws; const int lane = F.lane;
    if (l + 1 < NL) { convert_cleanup(F, l * L_ITEMS + LI_X, (l + 1) * L_ITEMS); __syncthreads(); }
    build_etab(F, l);
    LAS const int* SB = (LAS const int*)(F.lds + LDS_ETAB) + 136;
    const bf16_t* X1B = (const bf16_t*)(ws + WS_X1B); const unsigned char* OB = (const unsigned char*)(ws + WS_OB); const int* AEP = (const int*)(ws + WS_ASG_EP); const float* AW = (const float*)(ws + WS_ASG_W);
    float* XO = (l == NL - 1) ? A.out : (float*)nullptr; bf16_t* XB = (bf16_t*)(ws + WS_XB);
    const bf16_t* OSH = (const bf16_t*)(ws + WS_OSH);
    LAS float* YS = (LAS float*)(F.lds + F.wave * 8192);
    int ep_n = 0; float w_n = 0.f;
    { const int tok0 = F.vcu * 8 + F.wave; if (tok0 < NTOK && lane < 8) { ep_n = AEP[tok0 * 8 + lane]; w_n = AW[tok0 * 8 + lane]; } }
    for (int tok = F.vcu * 8 + F.wave; tok < NTOK; tok += F.G * 8) {
        int slot = 0; const float wv = w_n;
        if (lane < 8) slot = SB[ep_n >> 16] + (ep_n & 0xffff);
        { const int tn = tok + F.G * 8; if (tn < NTOK && lane < 8) { ep_n = AEP[tn * 8 + lane]; w_n = AW[tn * 8 + lane]; } }
        float s = 0.f;
        u32x2 ovA[8], ovB[8]; u32x4 xrA, xrB, osA, osB;
#define G_LOADS(ov, xr, os, j) do { xr = *(const u32x4*)(X1B + (size_t)tok * D + 512 * (j) + 8 * lane); os = *(const u32x4*)(OSH + (size_t)tok * D + 512 * (j) + 8 * lane); \
            _Pragma("unroll") for (int k = 0; k < 8; ++k) { const int sl = __builtin_amdgcn_readlane(slot, k); ov[k] = *(const u32x2*)(OB + (size_t)sl * D + 512 * (j) + 8 * lane); } } while (0)
#define G_COMBINE(ov, xr, os, j) do { \
            float y[8] = {ALPHA * bf_lo(xr.x) + bf_lo(os.x), ALPHA * bf_hi(xr.x) + bf_hi(os.x), ALPHA * bf_lo(xr.y) + bf_lo(os.y), ALPHA * bf_hi(xr.y) + bf_hi(os.y), \
                          ALPHA * bf_lo(xr.z) + bf_lo(os.z), ALPHA * bf_hi(xr.z) + bf_hi(os.z), ALPHA * bf_lo(xr.w) + bf_lo(os.w), ALPHA * bf_hi(xr.w) + bf_hi(os.w)}; \
            _Pragma("unroll") for (int k = 0; k < 8; ++k) { const float wk = __int_as_float(__builtin_amdgcn_readlane(__float_as_int(wv), k)) * (1.0f / pg8::O8_SCALE); \
                const f32x2 a = __builtin_amdgcn_cvt_pk_f32_fp8((int)ov[k].x, false), b = __builtin_amdgcn_cvt_pk_f32_fp8((int)ov[k].x, true), \
                            c2 = __builtin_amdgcn_cvt_pk_f32_fp8((int)ov[k].y, false), d2 = __builtin_amdgcn_cvt_pk_f32_fp8((int)ov[k].y, true); \
                y[0] += wk * a.x; y[1] += wk * a.y; y[2] += wk * b.x; y[3] += wk * b.y; y[4] += wk * c2.x; y[5] += wk * c2.y; y[6] += wk * d2.x; y[7] += wk * d2.y; } \
            s += ((y[0] + y[1]) + (y[2] + y[3])) + ((y[4] + y[5]) + (y[6] + y[7])); \
            *(LAS f32x4*)(YS + 512 * (j) + 8 * lane) = (f32x4){y[0], y[1], y[2], y[3]}; *(LAS f32x4*)(YS + 512 * (j) + 8 * lane + 4) = (f32x4){y[4], y[5], y[6], y[7]}; } while (0)
        G_LOADS(ovA, xrA, osA, 0); G_LOADS(ovB, xrB, osB, 1);
        G_COMBINE(ovA, xrA, osA, 0); G_LOADS(ovA, xrA, osA, 2);
        G_COMBINE(ovB, xrB, osB, 1); G_LOADS(ovB, xrB, osB, 3);
        G_COMBINE(ovA, xrA, osA, 2);
        G_COMBINE(ovB, xrB, osB, 3);
#undef G_LOADS
#undef G_COMBINE
        const float mean = wave_sum(s) * (1.f / D); float s2 = 0.f;
#pragma unroll 1
        for (int j = 0; j < 4; ++j) { const f32x4 a = *(const LAS f32x4*)(YS + 512 * j + 8 * lane) - mean, b = *(const LAS f32x4*)(YS + 512 * j + 8 * lane + 4) - mean;
            s2 += ((a[0] * a[0] + a[1] * a[1]) + (a[2] * a[2] + a[3] * a[3])) + ((b[0] * b[0] + b[1] * b[1]) + (b[2] * b[2] + b[3] * b[3])); }
        const float rstd = 1.f / sqrtf(wave_sum(s2) * (1.f / D) + LN_EPS);
#pragma unroll 1
        for (int j = 0; j < 4; ++j) { const f32x4* gp = (const f32x4*)(A.in[I_LN2_G] + l * D + 512 * j + 8 * lane); const f32x4* bp = (const f32x4*)(A.in[I_LN2_B] + l * D + 512 * j + 8 * lane);
            const f32x4 a = *(const LAS f32x4*)(YS + 512 * j + 8 * lane) - mean, b = *(const LAS f32x4*)(YS + 512 * j + 8 * lane + 4) - mean;
            const f32x4 o0 = a * rstd * gp[0] + bp[0], o1 = b * rstd * gp[1] + bp[1];
            if (XO) { f32x4* op = (f32x4*)(XO + (size_t)tok * D + 512 * j + 8 * lane); op[0] = o0; op[1] = o1; }
            if (!XO) *(u32x4*)(XB + (size_t)tok * D + 512 * j + 8 * lane) = (u32x4){cvt_pk_bf16(o0[0], o0[1]), cvt_pk_bf16(o0[2], o0[3]), cvt_pk_bf16(o1[0], o1[1]), cvt_pk_bf16(o1[2], o1[3])}; }
    }
}

constexpr int NPHASE = 2 + 7 * NL;
__global__ void __launch_bounds__(512, 2) mk_fwd(Args args) {
    extern __shared__ __attribute__((aligned(16))) unsigned char lds[];
#define PHASE_FRAME() Frame F; { int tz_ = threadIdx.x; asm volatile("" : "+v"(tz_)); int bz_ = blockIdx.x; asm volatile("" : "+s"(bz_)); unsigned char* wz_ = args.ws; asm volatile("" : "+s"(wz_)); \
        F.lds = (LAS unsigned char*)lds; F.tid = tz_; F.lane = tz_ & 63; F.wave = __builtin_amdgcn_readfirstlane(tz_ >> 6); F.G = gridDim.x; F.vcu = (F.G % 8 == 0) ? (bz_ % 8) * (F.G / 8) + bz_ / 8 : bz_; F.a = &args; F.ws = wz_; } \
        unsigned char* ws = F.ws; const int c = F.vcu; (void)ws; (void)c
    volatile LAS unsigned* MISC = (volatile LAS unsigned*)((LAS unsigned char*)lds + LDS_MISC);
    if (threadIdx.x < 128) MISC[threadIdx.x] = 0u;
    __syncthreads();
    unsigned* ctl = (unsigned*)(args.ws + WS_CTL);
    XcdBarrier bar; bar.bar = ctl + CW_BAR; bar.x = 0; bar.st = nullptr;
    const int lo = args.ph_lo, hi = args.ph_hi;
    if (hi - lo > 1) bar = xcd_barrier_post(ctl + CW_BAR, MISC + 8);
#define IN(k) (lo <= (k) && (k) < hi)
#define SEAM(k) do { if (IN(k) && IN((k) + 1)) xcd_barrier(bar); } while (0)

    if (IN(0)) { REP_LOOP(REP_P0) { PHASE_FRAME(); p0_prologue(F); } if (IN(2)) xcd_barrier(bar); }
#pragma unroll 1
    for (int l_ = 0; l_ < NL; ++l_) {
        const int pb = 2 + 7 * l_;
        if (IN(pb + 0)) {
            REP_LOOP(REP_A) {
            PHASE_FRAME(); int l = l_; asm volatile("" : "+s"(l));
            int Gp; const int role = phase_role(F, (NTOK / 256) * (INW / 256), Gp);
            if (role >= 0) {
                pg8::DenseSched S; S.init((const bf16_t*)(ws + WS_XB), (const bf16_t*)(ws + WS_WT_IN) + (size_t)l * INW * D, NTOK, INW, D, Gp, role);
                pg8::EpiStoreBf16 E{(bf16_t*)(ws + WS_HB), INW};
                pg8::gemm_phase<pg8::EpiStoreBf16, pg8::DenseSched, false>(F.lds, D, S, E);
                if (Gp == F.G && role + F.G >= (NTOK / 256) * (INW / 256)) { __syncthreads(); convert_fill(F, l * L_ITEMS, FILL_E); }
            } else {
                const int k = -1 - role;
                if (l == 0) {
                    { pg8::DenseSched S2; S2.init((const bf16_t*)(ws + WS_MEMN), (const bf16_t*)(ws + WS_WT_K), NMEMTOK, NL * 512, D, F.G, k);
                      pg8::EpiStoreBf16 E2{(bf16_t*)(ws + WS_KBUF), NL * 512};
                      pg8::gemm_phase<pg8::EpiStoreBf16, pg8::DenseSched, false>(F.lds, D, S2, E2); }
                    { pg8::DenseSched S2; S2.init((const bf16_t*)(ws + WS_WT_V), (const bf16_t*)(ws + WS_MEMN), NL * 512, NMEMTOK, D, F.G, k - 32);
                      pg8::EpiStoreBf16 E2{(bf16_t*)(ws + WS_VT), NMEMTOK};
                      pg8::gemm_phase<pg8::EpiStoreBf16, pg8::DenseSched, false>(F.lds, D, S2, E2); }
                    __syncthreads();
                }
                convert_fill(F, l * L_ITEMS, (l == 0 && k < 64) ? FILL_A0 : FILL_A);
            } }
            SEAM(pb + 0);
        }
        if (IN(pb + 1)) {
            REP_LOOP(REP_B) { PHASE_FRAME(); int l = l_; asm volatile("" : "+s"(l));
            for (int it = c; it < 256; it += F.G) mixer_sgu(F, l, it >> 2, it & 3);
            for (int it = c; it < 256; it += F.G) mixer_pool(F, l, it >> 2, it & 3);
            for (int it = c; it < 256; it += F.G) mixer_conv(F, l, it >> 2, it & 3);
            for (int it = c; it < 256; it += F.G) mixer_attn(F, l, it >> 2, it & 3); }
            SEAM(pb + 1);
        }
        if (IN(pb + 2)) {
            REP_LOOP(REP_C) {
            PHASE_FRAME(); int l = l_; asm volatile("" : "+s"(l));
            pg8::DenseSched S; S.init((const bf16_t*)(ws + WS_MIX), (const bf16_t*)(ws + WS_WT_OUT) + (size_t)l * D * D, NTOK, D, D, F.G, c);
            pg8::EpiResidBf16 E{(bf16_t*)(ws + WS_Y1), l == 0 ? args.in[I_X] : (const float*)nullptr, (const bf16_t*)(ws + WS_XB), D, ALPHA};
            pg8::gemm_phase<pg8::EpiResidBf16, pg8::DenseSched, false>(F.lds, D, S, E); __syncthreads(); }
            SEAM(pb + 2);
        }
        if (IN(pb + 3)) { PHASE_FRAME(); int l = l_; asm volatile("" : "+s"(l));
            if (F.G * 32 == NTOK) {
                if (F.tid == 0) ((LAS unsigned*)(F.lds + LDS_MISC))[16] = 0u;
                __syncthreads();
                if (F.wave < 4) phase_d<4>(F, l); else convert_beside_d(F, l * L_ITEMS, l * L_ITEMS + LI_X);
            } else { convert_cleanup(F, l * L_ITEMS, l * L_ITEMS + LI_X); __syncthreads(); phase_d<8>(F, l); }
            SEAM(pb + 3); }
        if (IN(pb + 4)) {
            REP_LOOP(REP_E) {
            PHASE_FRAME(); int l = l_; asm volatile("" : "+s"(l));
            if (c == 0 && F.tid == 0) __hip_atomic_fetch_max((unsigned*)(ws + WS_CTL) + CW_Q, (unsigned)(l * L_ITEMS + LI_X), __ATOMIC_RELAXED, __HIP_MEMORY_SCOPE_AGENT);
            build_etab(F, l);
            int Gp; const int role = phase_role(F, ((LAS const int*)(F.lds + LDS_ETAB))[68 + NE1] * 2, Gp);
            if (role >= 0) {
                build_units(F, 2, true, role, Gp);
                ExpertSched S; S.UD = (LAS const int*)(F.lds + LDS_UDESC); S.RT = (LAS const unsigned*)(F.lds + LDS_ROWTAB);
                S.Abase = (const char*)(ws + WS_X1B); S.Bbase = (const char*)(ws + WS_WT_GU) + (size_t)l * NE1 * 512 * D * 2; S.bstride_e = (size_t)512 * D * 2; S.bstride_pn = (size_t)256 * D * 2; S.arow_bytes = D * 2; S.ncol = 128; S.gather = true;
                pg8::EpiSwiglu E{(bf16_t*)(ws + WS_HE)};
                pg8::gemm_phase<pg8::EpiSwiglu, ExpertSched, true>(F.lds, D, S, E);
            } else convert_fill(F, l * L_ITEMS + LI_X, FILL_E);
            __syncthreads(); }
            SEAM(pb + 4);
        }
        if (IN(pb + 5)) {
            REP_LOOP(REP_F) {
            PHASE_FRAME(); int l = l_; asm volatile("" : "+s"(l));
            build_etab(F, l);
            int Gp; const int role = phase_role(F, ((LAS const int*)(F.lds + LDS_ETAB))[68 + NE1] * 8, Gp);
            if (role >= 0) {
                build_units(F, 8, false, role, Gp);
                ExpertSched S; S.UD = (LAS const int*)(F.lds + LDS_UDESC); S.RT = (LAS const unsigned*)(F.lds + LDS_ROWTAB);
                S.Abase = (const char*)(ws + WS_HE); S.Bbase = (const char*)(ws + WS_WT_D) + (size_t)l * NE1 * D * DE * 2; S.bstride_e = (size_t)D * DE * 2; S.bstride_pn = (size_t)256 * DE * 2; S.arow_bytes = DE * 2; S.ncol = 256; S.gather = false;
                pg8::EpiStoreFp8 E{(unsigned char*)(ws + WS_OB), D, (bf16_t*)(ws + WS_OSH), NE, __builtin_amdgcn_readfirstlane(((LAS const int*)(F.lds + LDS_ETAB))[136 + NE])};
                pg8::gemm_phase<pg8::EpiStoreFp8, ExpertSched, false>(F.lds, DE, S, E);
            } else convert_fill(F, l * L_ITEMS + LI_X, FILL_F);
            __syncthreads(); }
            SEAM(pb + 5);
        }
        if (IN(pb + 6)) { REP_LOOP(REP_G) { PHASE_FRAME(); int l = l_; asm volatile("" : "+s"(l)); phase_g(F, l); __syncthreads(); } SEAM(pb + 6); }
    }
#undef IN
#undef SEAM
}

extern "C" void kernel_launch(void* const* d_in, const int* in_sizes, int n_in, void* d_out, int out_size, void* d_ws, size_t ws_size, hipStream_t stream) {
    static int grid = 0;
    if (grid == 0) {
        if (n_in != 29 || out_size != NTOK * D || ws_size < WS_END) { fprintf(stderr, "kernel_launch: unexpected shapes (n_in %d out %d ws %zu need %zu)\n", n_in, out_size, ws_size, (size_t)WS_END); grid = -1; return; }
        int dev = 0, cus = 0, per_cu = 0;
        if (hipGetDevice(&dev) != hipSuccess || hipDeviceGetAttribute(&cus, hipDeviceAttributeMultiprocessorCount, dev) != hipSuccess) { grid = -1; return; }
        if (hipFuncSetAttribute((const void*)mk_fwd, hipFuncAttributeMaxDynamicSharedMemorySize, LDS_BYTES) != hipSuccess) { fprintf(stderr, "kernel_launch: hipFuncSetAttribute failed\n"); grid = -1; return; }
        if (hipOccupancyMaxActiveBlocksPerMultiprocessor(&per_cu, (const void*)mk_fwd, 512, LDS_BYTES) != hipSuccess || per_cu < 1) fprintf(stderr, "kernel_launch: occupancy query reports %d\n", per_cu);
        (void)hipGetLastError();
        grid = cus;
    }
    if (grid < 0) return;
    (void)hipMemsetAsync((char*)d_ws + WS_CTL, 0, CTL_ZERO_BYTES, stream);
    Args a{};
    for (int i = 0; i < 29; ++i) a.in[i] = (const float*)d_in[i];
    a.out = (float*)d_out; a.ws = (unsigned char*)d_ws;
#if MK_ONE_LAUNCH
    a.ph_lo = 0; a.ph_hi = NPHASE;
    hipLaunchKernelGGL(mk_fwd, dim3(grid), dim3(512), LDS_BYTES, stream, a);
#else
    for (int p = 0; p < NPHASE; ++p) { a.ph_lo = p; a.ph_hi = p + 1; hipLaunchKernelGGL(mk_fwd, dim3(grid), dim3(512), LDS_BYTES, stream, a); }
#endif
}
```

```cpp
#include <hip/hip_runtime.h>
#include <cstdio>
#include <cstdint>

#define LAS __attribute__((address_space(3)))
#define GAS __attribute__((address_space(1)))
typedef unsigned short bf16_t;
typedef short bf16x8 __attribute__((ext_vector_type(8)));
typedef float f32x4 __attribute__((ext_vector_type(4)));
typedef float f32x2 __attribute__((ext_vector_type(2)));
typedef unsigned u32x4 __attribute__((ext_vector_type(4)));
typedef unsigned u32x2 __attribute__((ext_vector_type(2)));

#ifndef REP_P0
#define REP_P0 1
#endif
#ifndef REP_B
#define REP_B 1
#endif
#ifndef REP_E
#define REP_E 1
#endif
#ifndef REP_F
#define REP_F 1
#endif
#ifndef REP_A
#define REP_A 1
#endif
#ifndef REP_C
#define REP_C 1
#endif
#ifndef REP_D1
#define REP_D1 1
#endif
#ifndef REP_D2
#define REP_D2 1
#endif
#ifndef REP_D3
#define REP_D3 1
#endif
#ifndef REP_G
#define REP_G 1
#endif
#define REP_LOOP(n) _Pragma("unroll 1") for (int rep_ = 0; rep_ < (n); ++rep_)
#ifndef FILL_P1
#define FILL_P1 2
#endif
#ifndef FILL_A
#define FILL_A 4
#endif
#ifndef FILL_A0
#define FILL_A0 2
#endif
#ifndef FILL_F
#define FILL_F 5
#endif
#ifndef FILL_CAP
#define FILL_CAP 64
#endif
#ifndef PROBE_CLASS
#define PROBE_CLASS -1
#endif
#ifndef PROBE_SCALE
#define PROBE_SCALE 40
#endif
#ifndef PACE
#define PACE 0
#endif
#ifndef Q_CP
#define Q_CP 4
#endif
#ifndef STOP_DIV
#define STOP_DIV 16
#endif
#ifndef FILL_E
#define FILL_E 6
#endif
#ifndef MK_ONE_LAUNCH
#define MK_ONE_LAUNCH 1
#endif

constexpr int D = 2048, NTOK = 8192, SEQ = 2048, NL = 4, INW = 3072, GW = 512, HD = 128, NMEMTOK = 1024, NE = 64, NE1 = 65, DE = 256, TOPK = 8;
constexpr float LN_EPS = 1e-5f;
constexpr float ALPHA = 1.6817928305074290861f;
constexpr int SLOT_CAP = 90112;

constexpr size_t MiB = 1u << 20;
constexpr size_t WS_CTL = 0, CTL_ZERO_BYTES = 2 * MiB;
constexpr size_t WS_WT_IN  = 2 * MiB;
constexpr size_t WS_WT_OUT = WS_WT_IN + 48 * MiB;
constexpr size_t WS_WT_K   = WS_WT_OUT + 32 * MiB;
constexpr size_t WS_WT_V   = WS_WT_K + 8 * MiB;
constexpr size_t WS_WT_GU  = WS_WT_V + 8 * MiB;
constexpr size_t WS_WT_D   = WS_WT_GU + 520 * MiB;
constexpr size_t WS_WPT    = WS_WT_D + 260 * MiB;
constexpr size_t WS_SGUW   = WS_WPT + 1 * MiB;
constexpr size_t WS_WR_HI  = WS_SGUW + 1 * MiB;
constexpr size_t WS_WR_LO  = WS_WR_HI + 1 * MiB;
constexpr size_t WS_MEMN   = WS_WR_LO + 1 * MiB;
constexpr size_t WS_KBUF   = WS_MEMN + 4 * MiB;
constexpr size_t WS_VT     = WS_KBUF + 4 * MiB;
constexpr size_t WS_XF     = WS_VT + 4 * MiB;
constexpr size_t WS_OSH    = WS_XF;
constexpr size_t WS_XB     = WS_XF + 64 * MiB;
constexpr size_t WS_HB     = WS_XB + 32 * MiB;
constexpr size_t WS_MIX    = WS_HB + 48 * MiB;
constexpr size_t WS_Y1     = WS_MIX + 32 * MiB;
constexpr size_t WS_X1F    = WS_Y1 + 64 * MiB;
constexpr size_t WS_X1B    = WS_X1F + 64 * MiB;
constexpr size_t WS_HE     = WS_X1B + 33 * MiB;
constexpr size_t WS_OB     = WS_HE + 44 * MiB;
constexpr size_t WS_LIST   = WS_OB + 352 * MiB;
constexpr size_t WS_ASG_EP = WS_LIST + 2 * MiB;
constexpr size_t WS_ASG_W  = WS_ASG_EP + 1 * MiB;
constexpr size_t WS_END    = WS_ASG_W + 1 * MiB;
constexpr int CW_BAR = 4096;
constexpr int CW_CNT = 16384, CNT_STRIDE = 1024;
static_assert((CW_CNT + 256 * CNT_STRIDE) * 4 <= (int)CTL_ZERO_BYTES, "ctl");

constexpr int RING_BYTES = 131072;
constexpr int LDS_MISC = RING_BYTES;
constexpr int LDS_ETAB = LDS_MISC + 512;
constexpr int LDS_UDESC = LDS_ETAB + 1024;
constexpr int LDS_ROWTAB = LDS_UDESC + 512;
constexpr int LDS_BYTES = 147456;
static_assert(LDS_ROWTAB + 4096 <= LDS_BYTES, "lds");

#define LDS_WAIT() asm volatile("s_waitcnt lgkmcnt(0)" ::: "memory")
#define VM_WAIT() asm volatile("s_waitcnt vmcnt(0)" ::: "memory")

__device__ __forceinline__ unsigned cvt_pk_bf16(float lo, float hi) { unsigned r; asm volatile("v_cvt_pk_bf16_f32 %0, %1, %2" : "=v"(r) : "v"(lo), "v"(hi)); return r; }
__device__ __forceinline__ float bf_lo(unsigned w) { return __uint_as_float(w << 16); }
__device__ __forceinline__ float bf_hi(unsigned w) { return __uint_as_float(w & 0xffff0000u); }
__device__ __forceinline__ float fast_sigmoid(float x) { return __builtin_amdgcn_rcpf(1.0f + __builtin_amdgcn_exp2f(-1.4426950408889634f * x)); }
__device__ __forceinline__ float silu_f(float x) { return x * fast_sigmoid(x); }
__device__ __forceinline__ float gelu_tanh_f(float x) { const float t = x + 0.044715f * x * x * x; return x * fast_sigmoid(1.5957691216057308f * t); }
__device__ __forceinline__ float wave_sum(float v) {
#pragma unroll
    for (int o = 1; o < 64; o <<= 1) v += __shfl_xor(v, o);
    return v;
}
__device__ __forceinline__ float g16_sum(float v) { v += __shfl_xor(v, 1); v += __shfl_xor(v, 2); v += __shfl_xor(v, 4); v += __shfl_xor(v, 8); return v; }

namespace pg8 {
constexpr int BM = 256, BK = 64, HALF = 128, HTB = HALF * BK * 2, STAGE_BYTES = 8 * HTB, NXCD = 8, WGM = 8;
__host__ __device__ __forceinline__ int lds_byte(int r, int c) { const int st = (r >> 4) * 2 + (c >> 5), rr = r & 15, cc = c & 31, ob = rr * 64 + cc * 2; return st * 1024 + (ob ^ (((ob >> 9) & 1) << 5)); }
__host__ __device__ __forceinline__ void stage_rc(int b, int& R, int& C) { const int st = b / 1024, sb = b % 1024, swz = sb ^ (((sb >> 9) & 1) << 5); R = (st >> 1) * 16 + swz / 64; C = (st & 1) * 32 + (swz % 64) / 2; }
__host__ __device__ __forceinline__ int perm32(int rho) { const int n = rho >> 4, i = rho & 15; return 8 * (i >> 2) + 4 * n + (i & 3); }

struct Unit { const char* A; const char* B; int row0, col0, nvalid, aux; };

struct StaticOrder {
    int nM, nN, nwg, G, c;
    __device__ void init(int M, int N, int G_, int c_) { nM = M / BM; nN = N / BM; nwg = nM * nN; G = G_; c = c_; }
    __device__ bool next(int i, int& pm, int& pn) const {
        const long L = (long)i * G + c; if (L >= nwg || c < 0) return false;
        int wgid = (int)L; { const int q = nwg / NXCD, r = nwg % NXCD, xcd = wgid % NXCD, off = wgid / NXCD; wgid = (xcd < r ? xcd * (q + 1) : r * (q + 1) + (xcd - r) * q) + off; }
        const int nig = WGM * nN, gid = wgid / nig, fm = gid * WGM, gsz = (nM - fm) < WGM ? (nM - fm) : WGM;
        pm = fm + ((wgid % nig) % gsz); pn = (wgid % nig) / gsz; return true;
    }
};
struct DenseSched {
    StaticOrder so; const char* A; const char* B; size_t tstep;
    __device__ void init(const bf16_t* A_, const bf16_t* B_, int M, int N, int K, int G, int c) { so.init(M, N, G, c); A = (const char*)A_; B = (const char*)B_; tstep = (size_t)BM * K * 2; }
    __device__ __forceinline__ bool next(int i, Unit& u) const { int pm, pn; if (!so.next(i, pm, pn)) return false; u.A = A + (size_t)pm * tstep; u.B = B + (size_t)pn * tstep; u.row0 = pm * BM; u.col0 = pn * BM; u.nvalid = BM; u.aux = 0; return true; }
    __device__ __forceinline__ unsigned rowoff(int, int) const { return 0u; }
};

struct EpiStoreBf16 {
    static constexpr bool PERM = true;
    bf16_t* O; int ldc;
    __device__ __forceinline__ void operator()(const f32x4 (&acc)[2][2][4][2], const Unit& u, int wr, int wc, int fr, int fq) const {
#pragma unroll
        for (int ai = 0; ai < 2; ++ai)
#pragma unroll
            for (int m = 0; m < 4; ++m) { const int lr = ai * HALF + wr * 64 + m * 16 + fr;
                if (lr < u.nvalid) { bf16_t* rowp = O + (size_t)(u.row0 + lr) * ldc + u.col0 + wc * 32 + 8 * fq;
#pragma unroll
                    for (int bj = 0; bj < 2; ++bj) { const f32x4 v0 = acc[ai][bj][m][0], v1 = acc[ai][bj][m][1];
                        u32x4 w; w.x = cvt_pk_bf16(v0[0], v0[1]); w.y = cvt_pk_bf16(v0[2], v0[3]); w.z = cvt_pk_bf16(v1[0], v1[1]); w.w = cvt_pk_bf16(v1[2], v1[3]);
                        *(u32x4*)(rowp + bj * HALF) = w; } } }
    }
};
constexpr float O8_SCALE = 16.0f;
struct EpiStoreFp8 {
    static constexpr bool PERM = true;
    unsigned char* O; int ldc; bf16_t* OS; int sh_e, sh_base;
    __device__ __forceinline__ void operator()(const f32x4 (&acc)[2][2][4][2], const Unit& u, int wr, int wc, int fr, int fq) const {
        if (u.aux == sh_e) {
#pragma unroll
            for (int ai = 0; ai < 2; ++ai)
#pragma unroll
                for (int m = 0; m < 4; ++m) { const int lr = ai * HALF + wr * 64 + m * 16 + fr; bf16_t* rowp = OS + (size_t)(u.row0 - sh_base + lr) * ldc + u.col0 + wc * 32 + 8 * fq;
#pragma unroll
                    for (int bj = 0; bj < 2; ++bj) { const f32x4 v0 = acc[ai][bj][m][0], v1 = acc[ai][bj][m][1];
                        *(u32x4*)(rowp + bj * HALF) = (u32x4){cvt_pk_bf16(v0[0], v0[1]), cvt_pk_bf16(v0[2], v0[3]), cvt_pk_bf16(v1[0], v1[1]), cvt_pk_bf16(v1[2], v1[3])}; } }
            return; }
#pragma unroll
        for (int ai = 0; ai < 2; ++ai)
#pragma unroll
            for (int m = 0; m < 4; ++m) { const int lr = ai * HALF + wr * 64 + m * 16 + fr;
                unsigned pk[2][2];
#pragma unroll
                for (int bj = 0; bj < 2; ++bj) { const f32x4 v0 = acc[ai][bj][m][0] * O8_SCALE, v1 = acc[ai][bj][m][1] * O8_SCALE;
                    int p = __builtin_amdgcn_cvt_pk_fp8_f32(v0[0], v0[1], 0, false); p = __builtin_amdgcn_cvt_pk_fp8_f32(v0[2], v0[3], p, true);
                    int q = __builtin_amdgcn_cvt_pk_fp8_f32(v1[0], v1[1], 0, false); q = __builtin_amdgcn_cvt_pk_fp8_f32(v1[2], v1[3], q, true);
                    pk[bj][0] = (unsigned)p; pk[bj][1] = (unsigned)q; }
                const auto s0 = __builtin_amdgcn_permlane16_swap(pk[0][0], pk[1][0], false, false), s1 = __builtin_amdgcn_permlane16_swap(pk[0][1], pk[1][1], false, false);
                if (lr < u.nvalid) *(u32x4*)(O + (size_t)(u.row0 + lr) * ldc + u.col0 + wc * 32 + (fq & 1) * HALF + (fq >> 1) * 16) = (u32x4){s0[0], s1[0], s0[1], s1[1]}; }
    }
};
struct EpiResidBf16 {
    static constexpr bool PERM = true;
    bf16_t* Y; const float* X; const bf16_t* XBp; int ldc; float alpha;
    __device__ __forceinline__ void operator()(const f32x4 (&acc)[2][2][4][2], const Unit& u, int wr, int wc, int fr, int fq) const {
#pragma unroll
        for (int ai = 0; ai < 2; ++ai)
#pragma unroll
            for (int m = 0; m < 4; ++m) { const size_t off = (size_t)(u.row0 + ai * HALF + wr * 64 + m * 16 + fr) * ldc + u.col0 + wc * 32 + 8 * fq;
#pragma unroll
                for (int bj = 0; bj < 2; ++bj) { f32x4 x0, x1;
                    if (X) { x0 = *(const f32x4*)(X + off + bj * HALF); x1 = *(const f32x4*)(X + off + bj * HALF + 4); }
                    else { const u32x4 r = *(const u32x4*)(XBp + off + bj * HALF); x0 = (f32x4){bf_lo(r.x), bf_hi(r.x), bf_lo(r.y), bf_hi(r.y)}; x1 = (f32x4){bf_lo(r.z), bf_hi(r.z), bf_lo(r.w), bf_hi(r.w)}; }
                    const f32x4 v0 = acc[ai][bj][m][0] + alpha * x0, v1 = acc[ai][bj][m][1] + alpha * x1;
                    *(u32x4*)(Y + off + bj * HALF) = (u32x4){cvt_pk_bf16(v0[0], v0[1]), cvt_pk_bf16(v0[2], v0[3]), cvt_pk_bf16(v1[0], v1[1]), cvt_pk_bf16(v1[2], v1[3])}; } }
    }
};
struct EpiSwiglu {
    static constexpr bool PERM = true;
    bf16_t* H;
    __device__ __forceinline__ void operator()(const f32x4 (&acc)[2][2][4][2], const Unit& u, int wr, int wc, int fr, int fq) const {
#pragma unroll
        for (int ai = 0; ai < 2; ++ai)
#pragma unroll
            for (int m = 0; m < 4; ++m) { const int lr = ai * HALF + wr * 64 + m * 16 + fr;
                if (lr < u.nvalid) { const f32x4 g0 = acc[ai][0][m][0], g1 = acc[ai][0][m][1], u0 = acc[ai][1][m][0], u1 = acc[ai][1][m][1];
                    u32x4 w; w.x = cvt_pk_bf16(silu_f(g0[0]) * u0[0], silu_f(g0[1]) * u0[1]); w.y = cvt_pk_bf16(silu_f(g0[2]) * u0[2], silu_f(g0[3]) * u0[3]);
                    w.z = cvt_pk_bf16(silu_f(g1[0]) * u1[0], silu_f(g1[1]) * u1[1]); w.w = cvt_pk_bf16(silu_f(g1[2]) * u1[2], silu_f(g1[3]) * u1[3]);
                    *(u32x4*)(H + (size_t)(u.row0 + lr) * DE + u.col0 + wc * 32 + 8 * fq) = w; } }
    }
};

template <class Epi, class Sched, bool GATHER>
__device__ __forceinline__ void gemm_phase(LAS unsigned char* lds, const int K, const Sched& S, const Epi& E) {
    int tid = threadIdx.x; asm volatile("" : "+v"(tid));
    const int wid = __builtin_amdgcn_readfirstlane(tid >> 6), lane = tid & 63, wr = wid >> 2, wc = wid & 3;
    const int nt = K / BK;
    unsigned voffB[2], oc[2][2];
#pragma unroll
    for (int i = 0; i < 2; ++i) { int R, C; stage_rc(tid * 16 + i * 8192, R, C); const int Rb = Epi::PERM ? ((R & ~31) + perm32(R & 31)) : R;
        voffB[i] = (unsigned)(Rb * K + C) * 2u; oc[0][i] = (unsigned)(R * K + C) * 2u; oc[1][i] = oc[0][i]; }
    const size_t kstep = (size_t)(BK * 2);
    const size_t hstep = (size_t)HALF * K * 2;
    const size_t ahstep = GATHER ? (size_t)0 : hstep;
    const unsigned ldsw = (unsigned)wid * 1024u;
    const int aoff = lds_byte(wr * 64 + (lane & 15), (lane >> 4) * 8), boff = lds_byte(wc * 32 + (lane & 15), (lane >> 4) * 8);
#define PG8_SA(b, h) (((b) * 2 + (h)) * HTB)
#define PG8_SB(b, h) ((4 + (b) * 2 + (h)) * HTB)
#define PG8_STAGE(bufoff, gbase, voff) do { _Pragma("unroll") for (int _i = 0; _i < 2; ++_i) \
        __builtin_amdgcn_global_load_lds((const unsigned*)((const char*)(gbase) + (voff)[_i]), (LAS unsigned*)(lds + (bufoff) + ldsw + _i * 8192), 16, 0, 0); } while (0)
#define PG8_STAGE_A(bufoff, gbase, h) PG8_STAGE(bufoff, (gbase) + (h) * ahstep, oc[GATHER ? (h) : 0])
#define PG8_LDA(dst, b, h) do { _Pragma("unroll") for (int m = 0; m < 4; ++m) _Pragma("unroll") for (int k = 0; k < 2; ++k) dst[m][k] = *(const LAS bf16x8*)(lds + PG8_SA(b, h) + aoff + m * 2048 + k * 1024); } while (0)
#define PG8_LDB(dst, b, h) do { _Pragma("unroll") for (int n = 0; n < 2; ++n) _Pragma("unroll") for (int k = 0; k < 2; ++k) dst[n][k] = *(const LAS bf16x8*)(lds + PG8_SB(b, h) + boff + n * 2048 + k * 1024); } while (0)
#define PG8_MMA(ai, bj, At, Bt) do { __builtin_amdgcn_s_setprio(1); _Pragma("unroll") for (int m = 0; m < 4; ++m) _Pragma("unroll") for (int n = 0; n < 2; ++n) _Pragma("unroll") for (int k = 0; k < 2; ++k) \
        acc[ai][bj][m][n] = __builtin_amdgcn_mfma_f32_16x16x32_bf16(Bt[n][k], At[m][k], acc[ai][bj][m][n], 0, 0, 0); __builtin_amdgcn_s_setprio(0); } while (0)
#define PG8_WAIT_V(n) asm volatile("s_waitcnt vmcnt(" #n ")" ::: "memory")
#define PG8_WAIT_L(n) asm volatile("s_waitcnt lgkmcnt(" #n ")" ::: "memory")
#define PG8_BAR __builtin_amdgcn_s_barrier()
#define PG8_SCHED __builtin_amdgcn_sched_barrier(0)
#define PG8_LOAD_ROWOFFS(uidx) do { int tz_ = threadIdx.x; asm volatile("" : "+v"(tz_)); _Pragma("unroll") for (int _i = 0; _i < 2; ++_i) { int R_, C_; stage_rc(tz_ * 16 + _i * 8192, R_, C_); \
        oc[0][_i] = S.rowoff((uidx), R_) + (unsigned)C_ * 2u; oc[1][_i] = S.rowoff((uidx), HALF + R_) + (unsigned)C_ * 2u; } } while (0)
    Unit cur, nxt; int ui = 0;
    if (!S.next(0, cur)) return;
    if constexpr (GATHER) { PG8_LOAD_ROWOFFS(0); }
    f32x4 acc[2][2][4][2];
#pragma unroll
    for (int a = 0; a < 2; ++a)
#pragma unroll
        for (int b = 0; b < 2; ++b)
#pragma unroll
            for (int m = 0; m < 4; ++m)
#pragma unroll
                for (int n = 0; n < 2; ++n) acc[a][b][m][n] = (f32x4){0.f, 0.f, 0.f, 0.f};
    bf16x8 At[4][2], B0[2][2], B1[2][2];
    const char* cA = cur.A; const char* cB = cur.B;
    LDS_WAIT();
    PG8_STAGE(PG8_SB(0, 0), cB, voffB); PG8_STAGE(PG8_SB(0, 1), cB + hstep, voffB); PG8_STAGE_A(PG8_SA(0, 0), cA, 0); PG8_STAGE_A(PG8_SA(0, 1), cA, 1);
    if (wr == 1) PG8_BAR;
    PG8_WAIT_V(2); PG8_BAR;
    PG8_STAGE(PG8_SB(1, 0), cB + kstep, voffB); PG8_STAGE_A(PG8_SA(1, 0), cA + kstep, 0); PG8_STAGE(PG8_SB(1, 1), cB + hstep + kstep, voffB);
    PG8_WAIT_V(6); PG8_BAR;
    for (;;) {
        const bool has_next = S.next(ui + 1, nxt);
        const char* nA = has_next ? nxt.A : cA; const char* nB = has_next ? nxt.B : cB;
#pragma unroll 1
        for (int t = 0; t < nt; t += 2) {
            const bool last = (t == nt - 2);
            const char* a1 = cA + (size_t)(t + 1) * kstep;
            const char* a2 = last ? nA : cA + (size_t)(t + 2) * kstep; const char* b2 = last ? nB : cB + (size_t)(t + 2) * kstep;
            const char* a3 = a2 + kstep; const char* b3 = b2 + kstep;
            PG8_LDB(B0, 0, 0); PG8_LDB(B1, 0, 1); PG8_SCHED; PG8_LDA(At, 0, 0); PG8_STAGE_A(PG8_SA(1, 1), a1, 1);
            if constexpr (GATHER) { if (last && has_next) { PG8_LOAD_ROWOFFS(ui + 1); } }
            PG8_WAIT_V(8); PG8_WAIT_L(0); PG8_BAR; PG8_MMA(0, 0, At, B0); PG8_MMA(0, 1, At, B1); PG8_BAR; PG8_SCHED;
            PG8_LDA(At, 0, 1); PG8_STAGE(PG8_SB(0, 0), b2, voffB); PG8_STAGE(PG8_SB(0, 1), b2 + hstep, voffB); PG8_STAGE_A(PG8_SA(0, 0), a2, 0);
            PG8_WAIT_V(8); PG8_WAIT_L(0); PG8_BAR; PG8_MMA(1, 0, At, B0); PG8_MMA(1, 1, At, B1); PG8_BAR; PG8_SCHED;
            PG8_LDB(B0, 1, 0); PG8_LDB(B1, 1, 1); PG8_SCHED; PG8_LDA(At, 1, 0); PG8_STAGE_A(PG8_SA(0, 1), a2, 1);
            PG8_WAIT_V(8); PG8_WAIT_L(0); PG8_BAR; PG8_MMA(0, 0, At, B0); PG8_MMA(0, 1, At, B1); PG8_BAR; PG8_SCHED;
            PG8_LDA(At, 1, 1); PG8_STAGE(PG8_SB(1, 0), b3, voffB); PG8_STAGE(PG8_SB(1, 1), b3 + hstep, voffB); PG8_STAGE_A(PG8_SA(1, 0), a3, 0);
            PG8_WAIT_V(8); PG8_WAIT_L(0); PG8_BAR; PG8_MMA(1, 0, At, B0); PG8_MMA(1, 1, At, B1); PG8_BAR; PG8_SCHED;
        }
        if (wr == 0) PG8_BAR;
        { int tz = threadIdx.x; asm volatile("" : "+v"(tz)); E(acc, cur, wr, wc, tz & 15, (tz & 63) >> 4); }
        if (!has_next) break;
#pragma unroll
        for (int a = 0; a < 2; ++a)
#pragma unroll
            for (int b = 0; b < 2; ++b)
#pragma unroll
                for (int m = 0; m < 4; ++m)
#pragma unroll
                    for (int n = 0; n < 2; ++n) acc[a][b][m][n] = (f32x4){0.f, 0.f, 0.f, 0.f};
        cur = nxt; cA = nA; cB = nB; ++ui;
        if (wr == 1) PG8_BAR;
    }
    PG8_WAIT_V(0);
    PG8_BAR;
#undef PG8_SA
#undef PG8_SB
#undef PG8_STAGE
#undef PG8_STAGE_A
#undef PG8_LOAD_ROWOFFS
#undef PG8_LDA
#undef PG8_LDB
#undef PG8_MMA
#undef PG8_WAIT_V
#undef PG8_WAIT_L
#undef PG8_BAR
#undef PG8_SCHED
}
}

#define XB_TMO      128
#define XB_XCNT(j)  (256  + 64 * (j))
#define XB_XSUB(j)  (1280 + 64 * (j))
#define XB_XGEN(j)  (2304 + 64 * (j))
#define XB_TOP      3328
#define XB_TOPGEN   3392
#define XCD_BAR_WORDS 3456
#define XB_SPIN_CAP (1u << 18)
__device__ __forceinline__ unsigned xb_ld(unsigned* p)              { return __hip_atomic_load(p, __ATOMIC_RELAXED, __HIP_MEMORY_SCOPE_AGENT); }
__device__ __forceinline__ unsigned xb_add(unsigned* p, unsigned v) { return __hip_atomic_fetch_add(p, v, __ATOMIC_RELAXED, __HIP_MEMORY_SCOPE_AGENT); }
__device__ __forceinline__ unsigned xb_xcc_id() { return (unsigned)__builtin_amdgcn_s_getreg((3 << 11) | 20) & 0xFu; }
#define XB_SPIN(cond, bar) do { unsigned _sp = 0; while (cond) { __builtin_amdgcn_s_sleep(1); \
    if ((++_sp & 255u) == 0u) { if (xb_ld(&(bar)[XB_TMO])) break; if (_sp > XB_SPIN_CAP) { atomicAdd(&(bar)[XB_TMO], 1u); break; } } } } while (0)
struct XcdBarrier { unsigned* bar; unsigned x; volatile LAS unsigned* st; };
__device__ __forceinline__ XcdBarrier xcd_barrier_post(unsigned* bar, volatile LAS unsigned* st) {
    XcdBarrier b; b.bar = bar; b.x = xb_xcc_id(); b.st = st;
    if (threadIdx.x == 0) (void)xb_add(&bar[XB_XCNT(b.x)], 1u);
    return b;
}
__device__ __forceinline__ void xcd_barrier_complete(unsigned* bar, unsigned x, unsigned& nloc, unsigned& nx) {
    const unsigned G = gridDim.x * gridDim.y * gridDim.z;
    unsigned sum, cnt, mine, sp = 0u;
    for (;;) {
        sum = 0u; cnt = 0u; mine = 0u;
#pragma unroll 1
        for (unsigned j = 0; j < 16; ++j) { const unsigned c = xb_ld(&bar[XB_XCNT(j)]); sum += c; cnt += (c > 0u) ? 1u : 0u; mine = (j == x) ? c : mine; }
        if (sum == G) break;
        __builtin_amdgcn_s_sleep(1);
        if ((++sp & 255u) == 0u) { if (xb_ld(&bar[XB_TMO])) break; if (sp > XB_SPIN_CAP) { atomicAdd(&bar[XB_TMO], 1u); break; } }
    }
    nloc = mine > 0u ? mine : 1u; nx = cnt > 0u ? cnt : 1u;
}
__device__ __forceinline__ void xcd_barrier(const XcdBarrier& b) {
    asm volatile("s_waitcnt vmcnt(0)" ::: "memory");
    __syncthreads();
    if (threadIdx.x == 0) {
        unsigned* bar = b.bar;
        __builtin_amdgcn_s_waitcnt(0);
        unsigned nloc = b.st[0], nx = b.st[1];
        if (nloc == 0u) { xcd_barrier_complete(bar, b.x, nloc, nx); b.st[0] = nloc; b.st[1] = nx; }
        const unsigned old = xb_add(&bar[XB_XSUB(b.x)], 1u);
        const unsigned gen = old / nloc;
        if (old + 1u == (gen + 1u) * nloc) {
            __builtin_amdgcn_fence(__ATOMIC_RELEASE, "agent");
            asm volatile("s_waitcnt vmcnt(0)" ::: "memory");
            const unsigned og = xb_add(&bar[XB_TOP], 1u);
            const unsigned tg = og / nx;
            if (og + 1u == (tg + 1u) * nx) xb_add(&bar[XB_TOPGEN], 1u);
            else XB_SPIN(xb_ld(&bar[XB_TOPGEN]) == tg, bar);
            __builtin_amdgcn_fence(__ATOMIC_ACQUIRE, "agent");
            xb_add(&bar[XB_XGEN(b.x)], 1u);
            asm volatile("s_waitcnt vmcnt(0)" ::: "memory");
        } else {
            XB_SPIN(xb_ld(&bar[XB_XGEN(b.x)]) == gen, bar);
            __builtin_amdgcn_fence(__ATOMIC_ACQUIRE, "agent");
            asm volatile("s_waitcnt vmcnt(0)" ::: "memory");
        }
    }
    __syncthreads();
}

struct Args { const float* in[29]; float* out; unsigned char* ws; int ph_lo, ph_hi; };
enum { I_X = 0, I_MEM, I_MEM_G, I_MEM_B, I_W_IN, I_SGU_G, I_SGU_B, I_SGU_W, I_SGU_BS, I_POOL_W, I_POOL_S, I_CONV_W, I_CONV_B, I_CONV_G, I_CONV_LB, I_W_KV, I_W_OUT, I_LN1_G, I_LN1_B,
       I_W_R, I_R_BIAS, I_E_G, I_E_U, I_E_D, I_S_G, I_S_U, I_S_D, I_LN2_G, I_LN2_B };

struct Frame {
    LAS unsigned char* lds;
    int tid, lane, wave, vcu, G;
    const Args* a;
    unsigned char* ws;
};

struct ItemDesc { const float* W; bf16_t* WT; bf16_t* WL; int ldw, ldt, k0, n0, drow0; };
constexpr int LI_IN = 3072, LI_OUT = 2048, LI_EX = 64 * 256, LI_SH = 256, LI_PW = 4 * 8, LI_RT = 64;
constexpr int L_ITEMS = LI_IN + LI_OUT + 3 * LI_EX + 3 * LI_SH + LI_PW + LI_RT;
constexpr int KV_ITEMS = 4 * 1024;
constexpr int LI_X = 3 * LI_EX + 3 * LI_SH, LI_S = L_ITEMS - LI_X;
constexpr int Q_TOTAL = NL * L_ITEMS - LI_S;
constexpr int CW_Q = 8192;
constexpr int CW_PD = 10240;
constexpr int Q_CH = 8;
__device__ __forceinline__ ItemDesc item_desc(const Args& A, unsigned char* ws, int l, int r) {
    bf16_t* WT_IN = (bf16_t*)(ws + WS_WT_IN); bf16_t* WT_OUT = (bf16_t*)(ws + WS_WT_OUT);
    bf16_t* WT_GU = (bf16_t*)(ws + WS_WT_GU); bf16_t* WT_D = (bf16_t*)(ws + WS_WT_D); bf16_t* WPT = (bf16_t*)(ws + WS_WPT);
    ItemDesc d; d.WL = nullptr;
    if (r < LI_IN) { const int kb = r / 96, nb = r % 96; d.W = A.in[I_W_IN] + (size_t)l * D * INW; d.ldw = INW; d.WT = WT_IN + (size_t)l * INW * D; d.ldt = D; d.k0 = kb * 64; d.n0 = nb * 32; d.drow0 = nb * 32; return d; } r -= LI_IN;
    if (r < LI_OUT) { const int kb = r / 64, nb = r % 64; d.W = A.in[I_W_OUT] + (size_t)l * D * D; d.ldw = D; d.WT = WT_OUT + (size_t)l * D * D; d.ldt = D; d.k0 = kb * 64; d.n0 = nb * 32; d.drow0 = nb * 32; return d; } r -= LI_OUT;
    if (r < 2 * LI_EX) { const int up = r >= LI_EX; if (up) r -= LI_EX; const int e = r / 256, rem = r % 256, kb = rem / 8, nb = rem % 8, n0 = nb * 32;
        d.W = A.in[up ? I_E_U : I_E_G] + (size_t)(l * NE + e) * D * DE; d.ldw = DE; d.WT = WT_GU + (size_t)(l * NE1 + e) * 512 * D; d.ldt = D; d.k0 = kb * 64; d.n0 = n0; d.drow0 = (n0 >> 7) * 256 + up * 128 + (n0 & 127); return d; } r -= 2 * LI_EX;
    if (r < LI_EX) { const int e = r / 256, rem = r % 256, kb = rem / 64, nb = rem % 64;
        d.W = A.in[I_E_D] + (size_t)(l * NE + e) * DE * D; d.ldw = D; d.WT = WT_D + (size_t)(l * NE1 + e) * D * DE; d.ldt = DE; d.k0 = kb * 64; d.n0 = nb * 32; d.drow0 = nb * 32; return d; } r -= LI_EX;
    if (r < 2 * LI_SH) { const int up = r >= LI_SH; if (up) r -= LI_SH; const int kb = r / 8, nb = r % 8, n0 = nb * 32;
        d.W = A.in[up ? I_S_U : I_S_G] + (size_t)l * D * DE; d.ldw = DE; d.WT = WT_GU + (size_t)(l * NE1 + 64) * 512 * D; d.ldt = D; d.k0 = kb * 64; d.n0 = n0; d.drow0 = (n0 >> 7) * 256 + up * 128 + (n0 & 127); return d; } r -= 2 * LI_SH;
    if (r < LI_SH) { const int kb = r / 64, nb = r % 64; d.W = A.in[I_S_D] + (size_t)l * DE * D; d.ldw = D; d.WT = WT_D + (size_t)(l * NE1 + 64) * D * DE; d.ldt = DE; d.k0 = kb * 64; d.n0 = nb * 32; d.drow0 = nb * 32; return d; } r -= LI_SH;
    if (r < LI_PW) { const int g = r / 8, rem = r % 8, kb = rem / 4, nb = rem % 4; d.W = A.in[I_POOL_W] + (size_t)(l * 4 + g) * 128 * 128; d.ldw = 128; d.WT = WPT + (size_t)(l * 4 + g) * 128 * 128; d.ldt = 128; d.k0 = kb * 64; d.n0 = nb * 32; d.drow0 = nb * 32; return d; } r -= LI_PW;
    { const int kb = r / 2, nb = r % 2; d.W = A.in[I_W_R] + (size_t)l * D * NE; d.ldw = NE; d.WT = (bf16_t*)(ws + WS_WR_HI) + (size_t)l * NE * D; d.WL = (bf16_t*)(ws + WS_WR_LO) + (size_t)l * NE * D; d.ldt = D; d.k0 = kb * 64; d.n0 = nb * 32; d.drow0 = nb * 32; return d; }
}
__device__ __forceinline__ ItemDesc kv_desc(const Args& A, unsigned char* ws, int r) {
    const int mat = r / 1024, rem = r % 1024, kb = rem / 32, nb = rem % 32, n0 = nb * 32; ItemDesc d; d.WL = nullptr;
    d.W = A.in[I_W_KV] + (size_t)mat * D * 1024; d.ldw = 1024; d.WT = (bf16_t*)(ws + (n0 < 512 ? WS_WT_K : WS_WT_V)); d.ldt = D; d.k0 = kb * 64; d.n0 = n0; d.drow0 = mat * 512 + (n0 & 511); return d;
}
__device__ __forceinline__ void item_load(const ItemDesc& d, f32x4 (&v)[8], int lane) {
#pragma unroll
    for (int i = 0; i < 8; ++i) v[i] = __builtin_nontemporal_load((const f32x4*)(d.W + (size_t)(d.k0 + 8 * i + (lane >> 3)) * d.ldw + d.n0 + 4 * (lane & 7)));
}
__device__ __forceinline__ void item_finish(const ItemDesc& d, const f32x4 (&v)[8], LAS float* scr, int lane) {
#pragma unroll
    for (int i = 0; i < 8; ++i) { LAS float* p = scr + (8 * i + (lane >> 3)) * 33 + 4 * (lane & 7); p[0] = v[i][0]; p[1] = v[i][1]; p[2] = v[i][2]; p[3] = v[i][3]; }
    LDS_WAIT(); asm volatile("" ::: "memory");
    const int c = lane & 7;
#pragma unroll
    for (int j = 0; j < 4; ++j) { const int n = (lane >> 3) + 8 * j; const LAS float* s = scr + (8 * c) * 33 + n;
        float x[8]; unsigned h[4];
#pragma unroll
        for (int q = 0; q < 8; ++q) x[q] = s[q * 33];
#pragma unroll
        for (int q = 0; q < 4; ++q) h[q] = cvt_pk_bf16(x[2 * q], x[2 * q + 1]);
        if (!d.WL) __builtin_nontemporal_store((u32x4){h[0], h[1], h[2], h[3]}, (u32x4*)(d.WT + (size_t)(d.drow0 + n) * d.ldt + d.k0 + 8 * c));
        else { unsigned lo[4];
            const int nn = d.drow0 + n, kk = d.k0 + 8 * c; const size_t off = ((size_t)((nn >> 4) * (D / 32) + (kk >> 5)) * 64 + 16 * ((kk & 31) >> 3) + (nn & 15)) * 8;
#pragma unroll
            for (int q = 0; q < 4; ++q) lo[q] = cvt_pk_bf16(x[2 * q] - bf_lo(h[q]), x[2 * q + 1] - bf_hi(h[q]));
            *(u32x4*)(d.WT + off) = (u32x4){h[0], h[1], h[2], h[3]}; *(u32x4*)(d.WL + off) = (u32x4){lo[0], lo[1], lo[2], lo[3]}; } }
    LDS_WAIT(); asm volatile("" ::: "memory");
}
__device__ __forceinline__ int s_item(int s) { return s < LI_IN + LI_OUT ? s : s + LI_X; }
struct GenPrologue { __device__ __forceinline__ ItemDesc operator()(const Args& A, unsigned char* ws, int id) const { return id < LI_S ? item_desc(A, ws, 0, s_item(id)) : kv_desc(A, ws, id - LI_S); } };
struct GenQueue    { __device__ __forceinline__ ItemDesc operator()(const Args& A, unsigned char* ws, int id) const { const int l = id / L_ITEMS, j = id % L_ITEMS;
    return j < LI_X ? item_desc(A, ws, l, LI_IN + LI_OUT + j) : item_desc(A, ws, l + 1, s_item(j - LI_X)); } };
template <class Gen> __device__ __forceinline__ void convert_seq(const Args& A, unsigned char* ws, int first, int end, int stride, LAS float* scr, int lane) {
    if (first >= end) return;
    const Gen gen; ItemDesc d0 = gen(A, ws, first); f32x4 v0[8]; item_load(d0, v0, lane);
#pragma unroll 1
    for (int id = first + stride; id < end; id += stride) { const ItemDesc d1 = gen(A, ws, id); f32x4 v1[8]; item_load(d1, v1, lane); item_finish(d0, v0, scr, lane); d0 = d1;
#pragma unroll
        for (int i = 0; i < 8; ++i) v0[i] = v1[i]; }
    item_finish(d0, v0, scr, lane);
}
__device__ __forceinline__ void convert_fill(Frame& F, int floor, int budget, unsigned* stop = nullptr, unsigned stop_at = 0u) {
    const Args& A = *F.a; LAS float* scr = (LAS float*)(F.lds + F.wave * 16384);
    unsigned* qh = (unsigned*)(F.ws + WS_CTL) + CW_Q;
#pragma unroll 1
    for (int b = 0; b < budget; ++b) {
        if (stop && __builtin_amdgcn_readfirstlane(xb_ld(stop)) >= stop_at) break;
        unsigned st = 0u; if (F.lane == 0) st = __hip_atomic_fetch_add(qh, (unsigned)Q_CH, __ATOMIC_RELAXED, __HIP_MEMORY_SCOPE_AGENT);
        const int s0 = __builtin_amdgcn_readfirstlane((int)st);
        if (s0 >= Q_TOTAL) break;
        const int lo = s0 > floor ? s0 : floor, hi = (s0 + Q_CH) < Q_TOTAL ? (s0 + Q_CH) : Q_TOTAL;
        if (lo >= hi) { ++budget; if (budget > (1 << 20)) break; continue; }
        convert_seq<GenQueue>(A, F.ws, lo, hi, 1, scr, F.lane);
    }
}
__device__ __forceinline__ void convert_paced(Frame& F, int floor, unsigned* stop, unsigned stop_at) {
    const Args& A = *F.a; LAS float* scr = (LAS float*)(F.lds + F.wave * 16384); const int lane = F.lane;
    unsigned* qh = (unsigned*)(F.ws + WS_CTL) + CW_Q;
    long long tn = (long long)wall_clock64() + F.wave * (PACE / 8); bool stopped = false;
#define PACE_WAIT() do { tn += PACE; long long now_ = (long long)wall_clock64(); if (now_ - tn > 2 * PACE) tn = now_ - 2 * PACE; \
        while (!stopped && now_ < tn) { __builtin_amdgcn_s_sleep(32); stopped = __builtin_amdgcn_readfirstlane(xb_ld(stop)) >= stop_at; now_ = (long long)wall_clock64(); } } while (0)
#pragma unroll 1
    for (int b = 0; b < FILL_CAP; ++b) {
        if (stopped || __builtin_amdgcn_readfirstlane(xb_ld(stop)) >= stop_at) break;
        unsigned st = 0u; if (lane == 0) st = __hip_atomic_fetch_add(qh, (unsigned)Q_CP, __ATOMIC_RELAXED, __HIP_MEMORY_SCOPE_AGENT);
        const int s0 = __builtin_amdgcn_readfirstlane((int)st);
        if (s0 >= Q_TOTAL) break;
        const int lo = s0 > floor ? s0 : floor, hi = (s0 + Q_CP) < Q_TOTAL ? (s0 + Q_CP) : Q_TOTAL;
        if (lo >= hi) continue;
        const GenQueue gen; ItemDesc d0 = gen(A, F.ws, lo); f32x4 v0[8]; item_load(d0, v0, lane);
#pragma unroll 1
        for (int id = lo + 1; id < hi; ++id) { PACE_WAIT(); const ItemDesc d1 = gen(A, F.ws, id); f32x4 v1[8]; item_load(d1, v1, lane); item_finish(d0, v0, scr, lane); d0 = d1;
#pragma unroll
            for (int i = 0; i < 8; ++i) v0[i] = v1[i]; }
        PACE_WAIT(); item_finish(d0, v0, scr, lane);
    }
#undef PACE_WAIT
}
__device__ __forceinline__ void convert_cleanup(Frame& F, int from, int upto) {
    const Args& A = *F.a; LAS float* scr = (LAS float*)(F.lds + F.wave * 16384);
    unsigned* qh = (unsigned*)(F.ws + WS_CTL) + CW_Q;
    int head = __builtin_amdgcn_readfirstlane((int)__hip_atomic_load(qh, __ATOMIC_RELAXED, __HIP_MEMORY_SCOPE_AGENT)); head = head > from ? head : from;
    convert_seq<GenQueue>(A, F.ws, head + F.vcu * 8 + F.wave, upto, F.G * 8, scr, F.lane);
}

__device__ __forceinline__ void convert_beside_d(Frame& F, int from, int upto) {
    const Args& A = *F.a; LAS float* scr = (LAS float*)(F.lds + 81920 + (F.wave - 4) * 8704);
    unsigned* qh = (unsigned*)(F.ws + WS_CTL) + CW_Q;
    int head = __builtin_amdgcn_readfirstlane((int)__hip_atomic_load(qh, __ATOMIC_RELAXED, __HIP_MEMORY_SCOPE_AGENT)); head = head > from ? head : from;
    convert_seq<GenQueue>(A, F.ws, head + F.vcu * 4 + (F.wave - 4), upto, F.G * 4, scr, F.lane);
}
__device__ __forceinline__ void p0_prologue(Frame& F) {
    const Args& A = *F.a; unsigned char* ws = F.ws;
    LAS float* scr = (LAS float*)(F.lds + F.wave * 16384);
    const int gw = F.vcu * 8 + F.wave, NGW = F.G * 8, lane = F.lane;
    convert_seq<GenPrologue>(A, ws, gw, LI_S + KV_ITEMS, NGW, scr, lane);
    { const int gt = F.vcu * 512 + F.tid, NGT = F.G * 512; bf16_t* SW = (bf16_t*)(ws + WS_SGUW);
      for (int i = gt; i < NL * 4 * 128 * 128 / 8; i += NGT) { const int t = (i >> 4) & 127, s0 = (i & 15) * 8; const f32x4* p = (const f32x4*)(A.in[I_SGU_W] + (size_t)i * 8); const f32x4 a = p[0], b = p[1];
          float v[8] = {a[0], a[1], a[2], a[3], b[0], b[1], b[2], b[3]};
#pragma unroll
          for (int q = 0; q < 8; ++q) v[q] = (s0 + q <= t) ? v[q] : 0.f;
          *(u32x4*)(SW + (size_t)i * 8) = (u32x4){cvt_pk_bf16(v[0], v[1]), cvt_pk_bf16(v[2], v[3]), cvt_pk_bf16(v[4], v[5]), cvt_pk_bf16(v[6], v[7])}; }
      bf16_t* XB = (bf16_t*)(ws + WS_XB);
      for (int i = gt; i < NTOK * D / 8; i += NGT) { const f32x4* p = (const f32x4*)(A.in[I_X] + (size_t)i * 8); const f32x4 a = p[0], b = p[1];
          *(u32x4*)(XB + (size_t)i * 8) = (u32x4){cvt_pk_bf16(a[0], a[1]), cvt_pk_bf16(a[2], a[3]), cvt_pk_bf16(b[0], b[1]), cvt_pk_bf16(b[2], b[3])}; } }
    if (F.vcu == 0 && F.tid < 256) *(u32x4*)((bf16_t*)(ws + WS_X1B) + (size_t)NTOK * D + F.tid * 8) = (u32x4){0u, 0u, 0u, 0u};
    { bf16_t* MN = (bf16_t*)(ws + WS_MEMN);
      for (int m = gw; m < NMEMTOK; m += NGW) { const f32x4* xr = (const f32x4*)(A.in[I_MEM] + (size_t)m * D) + lane; f32x4 v[8]; float s = 0.f;
#pragma unroll
          for (int j = 0; j < 8; ++j) { v[j] = xr[64 * j]; s += (v[j][0] + v[j][1]) + (v[j][2] + v[j][3]); }
          const float mean = wave_sum(s) * (1.f / D); float s2 = 0.f;
#pragma unroll
          for (int j = 0; j < 8; ++j) { v[j] = v[j] - mean; s2 += (v[j][0] * v[j][0] + v[j][1] * v[j][1]) + (v[j][2] * v[j][2] + v[j][3] * v[j][3]); }
          const float rstd = 1.f / sqrtf(wave_sum(s2) * (1.f / D) + LN_EPS);
#pragma unroll
          for (int j = 0; j < 8; ++j) { const f32x4 g = ((const f32x4*)A.in[I_MEM_G])[lane + 64 * j], b = ((const f32x4*)A.in[I_MEM_B])[lane + 64 * j]; const f32x4 o = v[j] * rstd * g + b;
              *(u32x2*)(MN + (size_t)m * D + 4 * lane + 256 * j) = (u32x2){cvt_pk_bf16(o[0], o[1]), cvt_pk_bf16(o[2], o[3])}; } } }
}

typedef f32x4 acc8_t[8];
__device__ __forceinline__ void mixer_sgu(Frame& F, int l, int chunk, int h) {
    const Args& A = *F.a; const int lane = F.lane, w = F.wave, fr = lane & 15, g = lane >> 4, t0 = chunk * 128;
    const bf16_t* HB = (const bf16_t*)(F.ws + WS_HB); bf16_t* MIX = (bf16_t*)(F.ws + WS_MIX); const bf16_t* SW = (const bf16_t*)(F.ws + WS_SGUW) + (size_t)(l * 4 + h) * 128 * 128;
    LAS unsigned char* VT = F.lds;
    const int t = 16 * w + fr;
    bf16x8 af[4]; u32x2 uraw[8];
#pragma unroll
    for (int ks = 0; ks < 4; ++ks) af[ks] = *(const bf16x8*)(SW + (size_t)t * 128 + 32 * ks + 8 * g);
#pragma unroll
    for (int j = 0; j < 8; ++j) uraw[j] = *(const u32x2*)(HB + (size_t)(t0 + t) * INW + h * 128 + 16 * j + 4 * g);
    const float bs = A.in[I_SGU_BS][(size_t)(l * 128 + t) * 4 + h];
    { const float* gp = A.in[I_SGU_G] + l * GW + h * 128 + 8 * fr; const float* bp = A.in[I_SGU_B] + l * GW + h * 128 + 8 * fr;
      const f32x4 g0 = *(const f32x4*)gp, g1 = *(const f32x4*)(gp + 4), b0 = *(const f32x4*)bp, b1 = *(const f32x4*)(bp + 4);
      const float gg[8] = {g0[0], g0[1], g0[2], g0[3], g1[0], g1[1], g1[2], g1[3]}, bb[8] = {b0[0], b0[1], b0[2], b0[3], b1[0], b1[1], b1[2], b1[3]};
      u32x4 raw[4];
#pragma unroll
      for (int p = 0; p < 4; ++p) raw[p] = *(const u32x4*)(HB + (size_t)(t0 + 16 * w + 4 * p + g) * INW + 512 + h * 128 + 8 * fr);
#pragma unroll
      for (int p = 0; p < 4; ++p) { const int tok = 16 * w + 4 * p + g;
          float v[8] = {bf_lo(raw[p].x), bf_hi(raw[p].x), bf_lo(raw[p].y), bf_hi(raw[p].y), bf_lo(raw[p].z), bf_hi(raw[p].z), bf_lo(raw[p].w), bf_hi(raw[p].w)}; float s = 0.f;
#pragma unroll
          for (int q = 0; q < 8; ++q) { v[q] = gelu_tanh_f(v[q]); s += v[q]; }
          const float mean = g16_sum(s) * (1.f / 128.f); float s2 = 0.f;
#pragma unroll
          for (int q = 0; q < 8; ++q) { v[q] -= mean; s2 += v[q] * v[q]; }
          const float rstd = 1.f / sqrtf(g16_sum(s2) * (1.f / 128.f) + LN_EPS);
#pragma unroll
          for (int q = 0; q < 8; q += 2) { const unsigned pk = cvt_pk_bf16(v[q] * rstd * gg[q] + bb[q], v[q + 1] * rstd * gg[q + 1] + bb[q + 1]);
              const int d0 = 8 * fr + q, d1 = d0 + 1;
              *(LAS bf16_t*)(VT + d0 * 256 + ((((tok >> 3) ^ d0 ^ (d0 >> 3)) & 15) << 4) + (tok & 7) * 2) = (bf16_t)(pk & 0xffffu);
              *(LAS bf16_t*)(VT + d1 * 256 + ((((tok >> 3) ^ d1 ^ (d1 >> 3)) & 15) << 4) + (tok & 7) * 2) = (bf16_t)(pk >> 16); } } }
    __syncthreads();
    f32x4 acc[8];
#pragma unroll
    for (int j = 0; j < 8; ++j) acc[j] = (f32x4){0.f, 0.f, 0.f, 0.f};
    const int nks = (w >> 1) + 1;
#pragma unroll
    for (int ks = 0; ks < 4; ++ks) if (ks < nks) {
#pragma unroll
        for (int j = 0; j < 8; ++j) { const int d = 16 * j + fr; const bf16x8 bfr = *(const LAS bf16x8*)(VT + d * 256 + ((((4 * ks + g) ^ d ^ (d >> 3)) & 15) << 4));
            acc[j] = __builtin_amdgcn_mfma_f32_16x16x32_bf16(bfr, af[ks], acc[j], 0, 0, 0); }
    }
#pragma unroll
    for (int j = 0; j < 8; ++j) { const u32x2 raw = uraw[j];
        const float u0 = gelu_tanh_f(bf_lo(raw.x)), u1 = gelu_tanh_f(bf_hi(raw.x)), u2 = gelu_tanh_f(bf_lo(raw.y)), u3 = gelu_tanh_f(bf_hi(raw.y));
        *(u32x2*)(MIX + (size_t)(t0 + t) * D + h * 128 + 16 * j + 4 * g) = (u32x2){cvt_pk_bf16(u0 * (acc[j][0] + bs), u1 * (acc[j][1] + bs)), cvt_pk_bf16(u2 * (acc[j][2] + bs), u3 * (acc[j][3] + bs))}; }
    __syncthreads();
}
__device__ __forceinline__ void mixer_pool(Frame& F, int l, int chunk, int grp) {
    const Args& A = *F.a; const int lane = F.lane, w = F.wave, fr = lane & 15, g = lane >> 4, t0 = chunk * 128, tid = F.tid;
    const bf16_t* HB = (const bf16_t*)(F.ws + WS_HB); bf16_t* MIX = (bf16_t*)(F.ws + WS_MIX); const bf16_t* WP = (const bf16_t*)(F.ws + WS_WPT) + (size_t)(l * 4 + grp) * 128 * 128;
    constexpr int PST = 272;
    LAS unsigned char* PT = F.lds;
    LAS unsigned char* PA = F.lds + 144 * PST;
    const int win = 2 << grp, pos0 = t0 & (SEQ - 1);
    LAS unsigned char* WS = F.lds + 144 * PST + 128 * PST;
    { u32x4 wv4[4];
#pragma unroll
      for (int i = 0; i < 4; ++i) wv4[i] = *(const u32x4*)(WP + (size_t)(tid + 512 * i) * 8);
      for (int i = tid; i < 144 * 16; i += 512) { const int r = i >> 4, cc = i & 15; const int trow = t0 - 16 + r; u32x4 v = (u32x4){0u, 0u, 0u, 0u};
          if (pos0 - 16 + r >= 0) v = *(const u32x4*)(HB + (size_t)trow * INW + 1024 + grp * 128 + 8 * cc);
          *(LAS u32x4*)(PT + r * PST + cc * 16) = v; }
#pragma unroll
      for (int i = 0; i < 4; ++i) { const int id = tid + 512 * i, d = id >> 4, cc = id & 15; *(LAS u32x4*)(WS + d * 256 + ((cc ^ (d & 15)) << 4)) = wv4[i]; } }
    f32x4 scv[8];
#pragma unroll
    for (int j = 0; j < 8; ++j) scv[j] = *(const f32x4*)(A.in[I_POOL_S] + l * GW + grp * 128 + 16 * j + 4 * g);
    __syncthreads();
    for (int i = tid; i < 128 * 16; i += 512) { const int t = i >> 4, cc = i & 15; float s[8] = {0.f, 0.f, 0.f, 0.f, 0.f, 0.f, 0.f, 0.f}; u32x4 cur = (u32x4){0u, 0u, 0u, 0u};
        for (int j = 0; j < win; ++j) { cur = *(const LAS u32x4*)(PT + (t + 16 - win + 1 + j) * PST + cc * 16);
            s[0] += bf_lo(cur.x); s[1] += bf_hi(cur.x); s[2] += bf_lo(cur.y); s[3] += bf_hi(cur.y); s[4] += bf_lo(cur.z); s[5] += bf_hi(cur.z); s[6] += bf_lo(cur.w); s[7] += bf_hi(cur.w); }
        const int pos = pos0 + t; const float inv = 1.0f / (float)((pos + 1) < win ? (pos + 1) : win);
        const float x[8] = {bf_lo(cur.x), bf_hi(cur.x), bf_lo(cur.y), bf_hi(cur.y), bf_lo(cur.z), bf_hi(cur.z), bf_lo(cur.w), bf_hi(cur.w)};
        *(LAS u32x4*)(PA + t * PST + cc * 16) = (u32x4){cvt_pk_bf16(s[0] * inv - x[0], s[1] * inv - x[1]), cvt_pk_bf16(s[2] * inv - x[2], s[3] * inv - x[3]),
                                                        cvt_pk_bf16(s[4] * inv - x[4], s[5] * inv - x[5]), cvt_pk_bf16(s[6] * inv - x[6], s[7] * inv - x[7])}; }
    __syncthreads();
    f32x4 acc[8];
#pragma unroll
    for (int j = 0; j < 8; ++j) acc[j] = (f32x4){0.f, 0.f, 0.f, 0.f};
#pragma unroll
    for (int ks = 0; ks < 4; ++ks) { const bf16x8 af = *(const LAS bf16x8*)(PA + (16 * w + fr) * PST + (32 * ks + 8 * g) * 2);
#pragma unroll
        for (int j = 0; j < 8; ++j) { const bf16x8 bfr = *(const LAS bf16x8*)(WS + (16 * j + fr) * 256 + (((4 * ks + g) ^ fr) << 4));
            acc[j] = __builtin_amdgcn_mfma_f32_16x16x32_bf16(bfr, af, acc[j], 0, 0, 0); } }
    { const int t = 16 * w + fr;
#pragma unroll
      for (int j = 0; j < 8; ++j) { const f32x4 sc = scv[j];
          *(u32x2*)(MIX + (size_t)(t0 + t) * D + 512 + grp * 128 + 16 * j + 4 * g) = (u32x2){cvt_pk_bf16(acc[j][0] * sc[0], acc[j][1] * sc[1]), cvt_pk_bf16(acc[j][2] * sc[2], acc[j][3] * sc[3])}; } }
    __syncthreads();
}
__device__ __forceinline__ void mixer_conv(Frame& F, int l, int chunk, int grp) {
    const Args& A = *F.a; const int lane = F.lane, w = F.wave, fr = lane & 15, g = lane >> 4, t0 = chunk * 128, tid = F.tid;
    const bf16_t* HB = (const bf16_t*)(F.ws + WS_HB); bf16_t* MIX = (bf16_t*)(F.ws + WS_MIX);
    LAS float* GT = (LAS float*)F.lds;
    const int pos0 = t0 & (SEQ - 1);
    for (int i = tid; i < 158 * 16; i += 512) { const int r = i >> 4, cc = i & 15; float o[8] = {0.f, 0.f, 0.f, 0.f, 0.f, 0.f, 0.f, 0.f};
        if (pos0 - 30 + r >= 0) { const bf16_t* rowp = HB + (size_t)(t0 - 30 + r) * INW + grp * 128 + 8 * cc; const u32x4 v = *(const u32x4*)(rowp + 1536), gt = *(const u32x4*)(rowp + 2048);
            o[0] = bf_lo(v.x) * fast_sigmoid(bf_lo(gt.x)); o[1] = bf_hi(v.x) * fast_sigmoid(bf_hi(gt.x)); o[2] = bf_lo(v.y) * fast_sigmoid(bf_lo(gt.y)); o[3] = bf_hi(v.y) * fast_sigmoid(bf_hi(gt.y));
            o[4] = bf_lo(v.z) * fast_sigmoid(bf_lo(gt.z)); o[5] = bf_hi(v.z) * fast_sigmoid(bf_hi(gt.z)); o[6] = bf_lo(v.w) * fast_sigmoid(bf_lo(gt.w)); o[7] = bf_hi(v.w) * fast_sigmoid(bf_hi(gt.w)); }
        *(LAS f32x4*)(GT + r * 128 + 8 * cc) = (f32x4){o[0], o[1], o[2], o[3]}; *(LAS f32x4*)(GT + r * 128 + 8 * cc + 4) = (f32x4){o[4], o[5], o[6], o[7]}; }
    __syncthreads();
    float y[32];
    { const int ch = tid & 127, tg = tid >> 7; float wv[31];
#pragma unroll
      for (int j = 0; j < 31; ++j) wv[j] = A.in[I_CONV_W][(size_t)(l * 31 + j) * GW + grp * 128 + ch];
      const float bias = A.in[I_CONV_B][l * GW + grp * 128 + ch];
      float xin[62];
#pragma unroll
      for (int j = 0; j < 62; ++j) xin[j] = GT[(tg * 32 + j) * 128 + ch];
#pragma unroll
      for (int t = 0; t < 32; ++t) { float s = bias;
#pragma unroll
          for (int j = 0; j < 31; ++j) s += wv[j] * xin[t + j];
          y[t] = s; }
      __syncthreads();
#pragma unroll
      for (int t = 0; t < 32; ++t) GT[(tg * 32 + t) * 128 + ch] = y[t]; }
    __syncthreads();
    { const float* gp = A.in[I_CONV_G] + l * GW + grp * 128 + 8 * fr; const float* bp = A.in[I_CONV_LB] + l * GW + grp * 128 + 8 * fr;
      const f32x4 g0 = *(const f32x4*)gp, g1 = *(const f32x4*)(gp + 4), b0 = *(const f32x4*)bp, b1 = *(const f32x4*)(bp + 4);
      const float gg[8] = {g0[0], g0[1], g0[2], g0[3], g1[0], g1[1], g1[2], g1[3]}, bb[8] = {b0[0], b0[1], b0[2], b0[3], b1[0], b1[1], b1[2], b1[3]};
#pragma unroll
      for (int p = 0; p < 4; ++p) { const int tok = 16 * w + 4 * p + g; const f32x4 a = *(const LAS f32x4*)(GT + tok * 128 + 8 * fr), b = *(const LAS f32x4*)(GT + tok * 128 + 8 * fr + 4);
          float v[8] = {a[0], a[1], a[2], a[3], b[0], b[1], b[2], b[3]}; float s = 0.f;
#pragma unroll
          for (int q = 0; q < 8; ++q) s += v[q];
          const float mean = g16_sum(s) * (1.f / 128.f); float s2 = 0.f;
#pragma unroll
          for (int q = 0; q < 8; ++q) { v[q] -= mean; s2 += v[q] * v[q]; }
          const float rstd = 1.f / sqrtf(g16_sum(s2) * (1.f / 128.f) + LN_EPS);
#pragma unroll
          for (int q = 0; q < 8; ++q) v[q] = silu_f(v[q] * rstd * gg[q] + bb[q]);
          *(u32x4*)(MIX + (size_t)(t0 + tok) * D + 1024 + grp * 128 + 8 * fr) = (u32x4){cvt_pk_bf16(v[0], v[1]), cvt_pk_bf16(v[2], v[3]), cvt_pk_bf16(v[4], v[5]), cvt_pk_bf16(v[6], v[7])}; } }
    __syncthreads();
}
__device__ __forceinline__ void mixer_attn(Frame& F, int l, int chunk, int h) {
    const int lane = F.lane, w = F.wave, fr = lane & 15, g = lane >> 4, t0 = chunk * 128, b = t0 / SEQ, tid = F.tid;
    const bf16_t* HB = (const bf16_t*)(F.ws + WS_HB); bf16_t* MIX = (bf16_t*)(F.ws + WS_MIX);
    const bf16_t* KB = (const bf16_t*)(F.ws + WS_KBUF) + (size_t)(b * 256) * D + l * 512 + h * 128;
    const bf16_t* VTp = (const bf16_t*)(F.ws + WS_VT) + (size_t)(l * 512 + h * 128) * NMEMTOK + b * 256;
    LAS unsigned char* KS = F.lds;
    LAS unsigned char* VS = F.lds + 65536;
    { u32x4 kv[8], vv[8];
#pragma unroll
      for (int i = 0; i < 8; ++i) { const int id = tid + 512 * i; kv[i] = *(const u32x4*)(KB + (size_t)(id >> 4) * D + (id & 15) * 8); vv[i] = *(const u32x4*)(VTp + (size_t)(id >> 5) * NMEMTOK + (id & 31) * 8); }
#pragma unroll
      for (int i = 0; i < 8; ++i) { const int id = tid + 512 * i; const int m = id >> 4, c = id & 15, d = id >> 5, c2 = id & 31;
          *(LAS u32x4*)(KS + m * 256 + ((c ^ (m & 15)) << 4)) = kv[i]; *(LAS u32x4*)(VS + d * 512 + ((c2 ^ (d & 15)) << 4)) = vv[i]; } }
    __syncthreads();
    const int t = 16 * w + fr;
    f32x4 sa[16];
#pragma unroll
    for (int j = 0; j < 16; ++j) sa[j] = (f32x4){0.f, 0.f, 0.f, 0.f};
    bf16x8 qf[4];
#pragma unroll
    for (int ks = 0; ks < 4; ++ks) qf[ks] = *(const bf16x8*)(HB + (size_t)(t0 + t) * INW + 2560 + h * 128 + 32 * ks + 8 * g);
#pragma unroll
    for (int ks = 0; ks < 4; ++ks)
#pragma unroll
        for (int j = 0; j < 16; ++j) { const bf16x8 kf = *(const LAS bf16x8*)(KS + (16 * j + fr) * 256 + (((4 * ks + g) ^ fr) << 4));
            sa[j] = __builtin_amdgcn_mfma_f32_16x16x32_bf16(kf, qf[ks], sa[j], 0, 0, 0); }
    float mx = -3.0e38f;
#pragma unroll
    for (int j = 0; j < 16; ++j) mx = fmaxf(mx, fmaxf(fmaxf(sa[j][0], sa[j][1]), fmaxf(sa[j][2], sa[j][3])));
    mx = fmaxf(mx, __shfl_xor(mx, 16)); mx = fmaxf(mx, __shfl_xor(mx, 32));
    const float sc = 0.08838834764831845f * 1.4426950408889634f; float sum = 0.f;
#pragma unroll
    for (int j = 0; j < 16; ++j)
#pragma unroll
        for (int r = 0; r < 4; ++r) { const float p = __builtin_amdgcn_exp2f((sa[j][r] - mx) * sc); sa[j][r] = p; sum += p; }
    sum += __shfl_xor(sum, 16); sum += __shfl_xor(sum, 32);
    const float inv = 1.0f / sum;
    f32x4 oa[8];
#pragma unroll
    for (int j = 0; j < 8; ++j) oa[j] = (f32x4){0.f, 0.f, 0.f, 0.f};
#pragma unroll
    for (int q = 0; q < 8; ++q) {
        union { bf16x8 v; unsigned u[4]; } pf; pf.u[0] = cvt_pk_bf16(sa[2 * q][0], sa[2 * q][1]); pf.u[1] = cvt_pk_bf16(sa[2 * q][2], sa[2 * q][3]);
        pf.u[2] = cvt_pk_bf16(sa[2 * q + 1][0], sa[2 * q + 1][1]); pf.u[3] = cvt_pk_bf16(sa[2 * q + 1][2], sa[2 * q + 1][3]);
#pragma unroll
        for (int jd = 0; jd < 8; ++jd) {
            const LAS unsigned char* vrow = VS + (16 * jd + fr) * 512 + ((g & 1) << 3);
            union { bf16x8 v; u32x2 u[2]; } vf; vf.u[0] = *(const LAS u32x2*)(vrow + (((4 * q + (g >> 1)) ^ fr) << 4)); vf.u[1] = *(const LAS u32x2*)(vrow + (((4 * q + 2 + (g >> 1)) ^ fr) << 4));
            oa[jd] = __builtin_amdgcn_mfma_f32_16x16x32_bf16(vf.v, pf.v, oa[jd], 0, 0, 0); } }
#pragma unroll
    for (int jd = 0; jd < 8; ++jd)
        *(u32x2*)(MIX + (size_t)(t0 + t) * D + 1536 + h * 128 + 16 * jd + 4 * g) = (u32x2){cvt_pk_bf16(oa[jd][0] * inv, oa[jd][1] * inv), cvt_pk_bf16(oa[jd][2] * inv, oa[jd][3] * inv)};
    __syncthreads();
}

#if PROBE_CLASS >= 0
#define PROBE_SUB(F, cls) do { if (blockIdx.x == 0 && (F).tid == 0) { volatile LAS unsigned* M_ = (volatile LAS unsigned*)((F).lds + LDS_MISC); const unsigned n_ = (unsigned)wall_clock64(); if ((cls) == PROBE_CLASS) M_[65] += n_ - M_[64]; M_[64] = n_; } } while (0)
#else
#define PROBE_SUB(F, cls) do { } while (0)
#endif
template <int NW> __device__ __forceinline__ void dsync(LAS unsigned* ctr, unsigned& nb, int lane) {
    if constexpr (NW == 8) { asm volatile("s_waitcnt vmcnt(0)" ::: "memory"); __syncthreads(); }
    else { asm volatile("s_waitcnt vmcnt(0) lgkmcnt(0)" ::: "memory"); ++nb;
        if (lane == 0) __hip_atomic_fetch_add(ctr, 1u, __ATOMIC_RELAXED, __HIP_MEMORY_SCOPE_WORKGROUP);
        while (__hip_atomic_load(ctr, __ATOMIC_RELAXED, __HIP_MEMORY_SCOPE_WORKGROUP) < (unsigned)NW * nb) __builtin_amdgcn_s_sleep(1);
        asm volatile("" ::: "memory"); }
}
template <int NW> __device__ __forceinline__ void phase_d(Frame& F, int l) {
    constexpr int TPW = 32 / NW, KW = D / NW;
    const Args& A = *F.a; unsigned char* ws = F.ws; const int lane = F.lane, w = F.wave, tid = F.tid, fr = lane & 15, g = lane >> 4;
    const bf16_t* Y1 = (const bf16_t*)(ws + WS_Y1); bf16_t* X1L = (bf16_t*)(ws + WS_X1F); bf16_t* X1B = (bf16_t*)(ws + WS_X1B);
    const bf16_t* WRH = (const bf16_t*)(ws + WS_WR_HI) + (size_t)l * NE * D; const bf16_t* WRL = (const bf16_t*)(ws + WS_WR_LO) + (size_t)l * NE * D;
    int* LIST = (int*)(ws + WS_LIST); int* AEP = (int*)(ws + WS_ASG_EP); float* AW = (float*)(ws + WS_ASG_W);
    unsigned* CNT = (unsigned*)(ws + WS_CTL) + CW_CNT + (size_t)l * 64 * CNT_STRIDE;
    LAS float* PL = (LAS float*)F.lds;
    LAS unsigned* HIST = (LAS unsigned*)(F.lds + NW * 32 * 65 * 4);
    LAS unsigned* ctr = (LAS unsigned*)(F.lds + LDS_MISC) + 16; unsigned nb = 0u;
    for (int blk = F.vcu; blk < NTOK / 32; blk += F.G) {
        const int tok0 = blk * 32;
        if (tid < 128) HIST[tid] = 0u;
        PROBE_SUB(F, 8);
        { constexpr int PF = 2;
          const GAS u32x2* yb = (const GAS u32x2*)(Y1 + (size_t)(tok0 + TPW * w) * D) + lane;
          GAS u32x2* xh = (GAS u32x2*)(X1B + (size_t)(tok0 + TPW * w) * D) + lane; GAS u32x2* xl = (GAS u32x2*)(X1L + (size_t)(tok0 + TPW * w) * D) + lane;
          u32x2 raw[PF][8]; f32x4 gg[8], bb[8];
#pragma unroll
          for (int q = 0; q < PF; ++q)
#pragma unroll
              for (int j = 0; j < 8; ++j) raw[q][j] = yb[q * (D / 4) + 64 * j];
#pragma unroll
          for (int j = 0; j < 8; ++j) { gg[j] = ((const GAS f32x4*)(A.in[I_LN1_G] + l * D))[lane + 64 * j]; bb[j] = ((const GAS f32x4*)(A.in[I_LN1_B] + l * D))[lane + 64 * j]; }
#pragma unroll
          for (int tt = 0; tt < TPW; ++tt) { f32x4 v[8]; float s = 0.f;
#pragma unroll
              for (int j = 0; j < 8; ++j) { const u32x2 r = raw[tt % PF][j]; v[j] = (f32x4){bf_lo(r.x), bf_hi(r.x), bf_lo(r.y), bf_hi(r.y)}; s += (v[j][0] + v[j][1]) + (v[j][2] + v[j][3]); }
              if (tt + PF < TPW) {
#pragma unroll
                  for (int j = 0; j < 8; ++j) raw[tt % PF][j] = yb[(tt + PF) * (D / 4) + 64 * j]; }
              const float mean = wave_sum(s) * (1.f / D); float s2 = 0.f;
#pragma unroll
              for (int j = 0; j < 8; ++j) { v[j] = v[j] - mean; s2 += (v[j][0] * v[j][0] + v[j][1] * v[j][1]) + (v[j][2] * v[j][2] + v[j][3] * v[j][3]); }
              const float rstd = 1.f / sqrtf(wave_sum(s2) * (1.f / D) + LN_EPS);
#pragma unroll
              for (int j = 0; j < 8; ++j) { const f32x4 o = v[j] * rstd * gg[j] + bb[j];
                  const unsigned h0 = cvt_pk_bf16(o[0], o[1]), h1 = cvt_pk_bf16(o[2], o[3]);
                  xh[tt * (D / 4) + 64 * j] = (u32x2){h0, h1};
                  xl[tt * (D / 4) + 64 * j] = (u32x2){cvt_pk_bf16(o[0] - bf_lo(h0), o[1] - bf_hi(h0)), cvt_pk_bf16(o[2] - bf_lo(h1), o[3] - bf_hi(h1))}; } } }
        dsync<NW>(ctr, nb, lane); PROBE_SUB(F, 9);
        { f32x4 acc[2][4];
#pragma unroll
          for (int rb = 0; rb < 2; ++rb)
#pragma unroll
              for (int cb = 0; cb < 4; ++cb) acc[rb][cb] = (f32x4){0.f, 0.f, 0.f, 0.f};
          constexpr int NS = 2, NB = KW / 32;
          const GAS bf16x8* pah = (const GAS bf16x8*)(X1B + (size_t)(tok0 + fr) * D + KW * w + 8 * g); const GAS bf16x8* pal = (const GAS bf16x8*)(X1L + (size_t)(tok0 + fr) * D + KW * w + 8 * g);
          const GAS bf16x8* pbh = (const GAS bf16x8*)WRH + (KW / 32 * w) * 64 + lane;                   const GAS bf16x8* pbl = (const GAS bf16x8*)WRL + (KW / 32 * w) * 64 + lane;
          bf16x8 ah[NS][2], al[NS][2], bh[NS][4], bl[NS][4];
#define RT_LOAD(buf, b) do { const int ko = 4 * (b); \
              _Pragma("unroll") for (int rb = 0; rb < 2; ++rb) { ah[buf][rb] = pah[rb * 2 * D + ko]; al[buf][rb] = pal[rb * 2 * D + ko]; } \
              _Pragma("unroll") for (int cb = 0; cb < 4; ++cb) { bh[buf][cb] = pbh[cb * (D / 32) * 64 + 64 * (b)]; bl[buf][cb] = pbl[cb * (D / 32) * 64 + 64 * (b)]; } } while (0)
#pragma unroll
          for (int b = 0; b < NS - 1; ++b) RT_LOAD(b, b);
#pragma unroll 1
          for (int b0 = 0; b0 < NB; b0 += NS) {
#pragma unroll
              for (int s_ = 0; s_ < NS; ++s_) { const int b = b0 + s_;
                  if (b < NB) {
                      if (b + NS - 1 < NB) RT_LOAD((s_ + NS - 1) % NS, b + NS - 1);
                      __builtin_amdgcn_sched_barrier(0);
#pragma unroll
                      for (int cb = 0; cb < 4; ++cb)
#pragma unroll
                          for (int rb = 0; rb < 2; ++rb) { acc[rb][cb] = __builtin_amdgcn_mfma_f32_16x16x32_bf16(ah[s_][rb], bh[s_][cb], acc[rb][cb], 0, 0, 0);
                              acc[rb][cb] = __builtin_amdgcn_mfma_f32_16x16x32_bf16(ah[s_][rb], bl[s_][cb], acc[rb][cb], 0, 0, 0); acc[rb][cb] = __builtin_amdgcn_mfma_f32_16x16x32_bf16(al[s_][rb], bh[s_][cb], acc[rb][cb], 0, 0, 0); }
                      __builtin_amdgcn_sched_barrier(0); } } }
#undef RT_LOAD
#pragma unroll
          for (int rb = 0; rb < 2; ++rb)
#pragma unroll
              for (int cb = 0; cb < 4; ++cb)
#pragma unroll
                  for (int r = 0; r < 4; ++r) PL[(w * 32 + 16 * rb + 4 * g + r) * 65 + 16 * cb + fr] = acc[rb][cb][r]; }
        dsync<NW>(ctr, nb, lane); PROBE_SUB(F, 10);
        bool selv[TPW]; unsigned locv[TPW]; float wnv[TPW]; int kv[TPW];
        const float rbias = A.in[I_R_BIAS][l * NE + lane];
#pragma unroll
        for (int tt = 0; tt < TPW; ++tt) { const int tl = TPW * w + tt; float logit = 0.f;
#pragma unroll
            for (int ww = 0; ww < NW; ++ww) logit += PL[(ww * 32 + tl) * 65 + lane];
            const float score = 1.0f / (1.0f + __expf(-logit)), choice = score + rbias;
            float m1 = choice; m1 = fmaxf(m1, __shfl_xor(m1, 1)); m1 = fmaxf(m1, __shfl_xor(m1, 2)); m1 = fmaxf(m1, __shfl_xor(m1, 4));
            int i1 = (choice == m1) ? lane : 64; i1 = min(i1, __shfl_xor(i1, 1)); i1 = min(i1, __shfl_xor(i1, 2)); i1 = min(i1, __shfl_xor(i1, 4));
            float m2 = (lane == i1) ? -INFINITY : choice; m2 = fmaxf(m2, __shfl_xor(m2, 1)); m2 = fmaxf(m2, __shfl_xor(m2, 2)); m2 = fmaxf(m2, __shfl_xor(m2, 4));
            const float gs = m1 + m2; const int myg = lane >> 3; int grank = 0;
#pragma unroll
            for (int gg = 0; gg < 8; ++gg) { const float gv = __int_as_float(__builtin_amdgcn_readlane(__float_as_int(gs), 8 * gg)); grank += (gv > gs || (gv == gs && gg < myg)) ? 1 : 0; }
            const float mc = (grank < 4) ? choice : -INFINITY; int er = 0;
#pragma unroll
            for (int e2 = 0; e2 < 64; ++e2) { const float v = __int_as_float(__builtin_amdgcn_readlane(__float_as_int(mc), e2)); er += (v > mc || (v == mc && e2 < lane)) ? 1 : 0; }
            const bool sel = er < TOPK; const float wsum = wave_sum(sel ? score : 0.f);
            const unsigned long long mask = __ballot(sel);
            selv[tt] = sel; wnv[tt] = score / (wsum + 1e-20f) * 2.5f; kv[tt] = __popcll(mask & ((1ull << lane) - 1ull)); locv[tt] = 0u;
            if (sel) locv[tt] = __hip_atomic_fetch_add(&HIST[lane], 1u, __ATOMIC_RELAXED, __HIP_MEMORY_SCOPE_WORKGROUP); }
        dsync<NW>(ctr, nb, lane); PROBE_SUB(F, 11);
        if (tid < 64) { const unsigned n = HIST[tid]; HIST[64 + tid] = n ? __hip_atomic_fetch_add(CNT + tid * CNT_STRIDE, n, __ATOMIC_RELAXED, __HIP_MEMORY_SCOPE_AGENT) : 0u; }
        dsync<NW>(ctr, nb, lane);
#pragma unroll
        for (int tt = 0; tt < TPW; ++tt) if (selv[tt]) { const int tok = tok0 + TPW * w + tt; const unsigned pos = HIST[64 + lane] + locv[tt];
            LIST[lane * NTOK + pos] = tok; AEP[tok * 8 + kv[tt]] = (int)((unsigned)lane << 16 | pos); AW[tok * 8 + kv[tt]] = wnv[tt]; }
        dsync<NW>(ctr, nb, lane); PROBE_SUB(F, 12);
    }
}

__device__ __forceinline__ void build_etab(Frame& F, int l) {
    LAS int* ET = (LAS int*)(F.lds + LDS_ETAB);
    unsigned* CNT = (unsigned*)(F.ws + WS_CTL) + CW_CNT + (size_t)l * 64 * CNT_STRIDE;
    if (F.tid < NE1) ET[F.tid] = F.tid < NE ? (int)__hip_atomic_load(CNT + F.tid * CNT_STRIDE, __ATOMIC_RELAXED, __HIP_MEMORY_SCOPE_AGENT) : NTOK;
    __syncthreads();
    if (F.tid == 0) { int ts = 0;
#pragma unroll 1
        for (int e = 0; e < NE1; ++e) { ET[68 + e] = ts; ET[136 + e] = ts * 256; ts += (ET[e] + 255) >> 8; } ET[68 + NE1] = ts; }
    __syncthreads();
}
struct ExpertSched {
    LAS const int* UD;
    LAS const unsigned* RT;
    const char* Abase; const char* Bbase; size_t bstride_e, bstride_pn; int arow_bytes, ncol; bool gather;
    __device__ __forceinline__ bool next(int i, pg8::Unit& u) const {
        if (i >= 16) return false; const int e = __builtin_amdgcn_readfirstlane(UD[4 * i]); if (e < 0) return false;
        const int row0 = __builtin_amdgcn_readfirstlane(UD[4 * i + 1]), pn = __builtin_amdgcn_readfirstlane(UD[4 * i + 2]);
        u.A = gather ? Abase : Abase + (size_t)row0 * arow_bytes; u.B = Bbase + (size_t)e * bstride_e + (size_t)pn * bstride_pn; u.row0 = row0; u.col0 = pn * ncol; u.nvalid = __builtin_amdgcn_readfirstlane(UD[4 * i + 3]); u.aux = e; return true;
    }
    __device__ __forceinline__ unsigned rowoff(int i, int r) const { return RT[i * 256 + r]; }
};
__device__ __forceinline__ int phase_role(const Frame& F, int NU, int& Gp) {
    NU = __builtin_amdgcn_readfirstlane(NU);
    if (F.G != 256 || NU <= 0) { Gp = F.G; return F.vcu; }
    const int R = (NU + 255) / 256; int g = (NU + R - 1) / R; g = (g + 7) & ~7; if (g > 256) g = 256; Gp = g;
    const int per = g >> 3, x = F.vcu >> 5, r = F.vcu & 31;
    return r < per ? x * per + r : -1 - (x * (32 - per) + (r - per));
}
__device__ __forceinline__ void build_units(Frame& F, int npn, bool gather, int cp, int Gp) {
    LAS int* ET = (LAS int*)(F.lds + LDS_ETAB); LAS int* UD = (LAS int*)(F.lds + LDS_UDESC); LAS unsigned* RT = (LAS unsigned*)(F.lds + LDS_ROWTAB);
    const int NU = ET[68 + NE1] * npn;
    if (F.tid < 16) { const int U = cp + F.tid * Gp; int e = -1, row0 = 0, pn = 0, nv = 0;
        if (U < NU) { const int tile = U / npn; pn = U % npn; e = 0;
#pragma unroll 1
            while (e < NE && ET[68 + e + 1] <= tile) ++e; const int mt = tile - ET[68 + e]; row0 = ET[136 + e] + 256 * mt; nv = ET[e] - 256 * mt; nv = nv > 256 ? 256 : nv; }
        UD[4 * F.tid] = e; UD[4 * F.tid + 1] = row0; UD[4 * F.tid + 2] = pn; UD[4 * F.tid + 3] = nv; }
    __syncthreads();
    if (gather) { const int* LIST = (const int*)(F.ws + WS_LIST);
        for (int i = F.tid; i < 4 * 256; i += 512) { const int ui = i >> 8, r = i & 255; const int e = UD[4 * ui]; unsigned off = 0u;
            if (e >= 0) { const int row0 = UD[4 * ui + 1], nv = UD[4 * ui + 3]; const int lr = row0 - ET[136 + e] + r; int tok = 0;
                tok = NTOK;
                if (r < nv) tok = (e < NE) ? LIST[e * NTOK + lr] : lr;
                off = (unsigned)tok * (unsigned)(D * 2); }
            RT[i] = off; }
        __syncthreads(); }
}

__device__ __forceinline__ void phase_g(Frame& F, int l) {
    const Args& A = *F.a; unsigned char* ws = F.ws; const int lane = F.lane;
    if (l + 1 < NL) { convert_cleanup(F, l * L_ITEMS + LI_X, (l + 1) * L_ITEMS); __syncthreads(); }
    build_etab(F, l);
    LAS const int* SB = (LAS const int*)(F.lds + LDS_ETAB) + 136;
    const bf16_t* X1B = (const bf16_t*)(ws + WS_X1B); const unsigned char* OB = (const unsigned char*)(ws + WS_OB); const int* AEP = (const int*)(ws + WS_ASG_EP); const float* AW = (const float*)(ws + WS_ASG_W);
    float* XO = (l == NL - 1) ? A.out : (float*)nullptr; bf16_t* XB = (bf16_t*)(ws + WS_XB);
    const bf16_t* OSH = (const bf16_t*)(ws + WS_OSH);
    LAS float* YS = (LAS float*)(F.lds + F.wave * 8192);
    int ep_n = 0; float w_n = 0.f;
    { const int tok0 = F.vcu * 8 + F.wave; if (tok0 < NTOK && lane < 8) { ep_n = AEP[tok0 * 8 + lane]; w_n = AW[tok0 * 8 + lane]; } }
    for (int tok = F.vcu * 8 + F.wave; tok < NTOK; tok += F.G * 8) {
        int slot = 0; const float wv = w_n;
        if (lane < 8) slot = SB[ep_n >> 16] + (ep_n & 0xffff);
        { const int tn = tok + F.G * 8; if (tn < NTOK && lane < 8) { ep_n = AEP[tn * 8 + lane]; w_n = AW[tn * 8 + lane]; } }
        float s = 0.f;
        u32x2 ovA[8], ovB[8]; u32x4 xrA, xrB, osA, osB;
#define G_LOADS(ov, xr, os, j) do { xr = *(const u32x4*)(X1B + (size_t)tok * D + 512 * (j) + 8 * lane); os = *(const u32x4*)(OSH + (size_t)tok * D + 512 * (j) + 8 * lane); \
            _Pragma("unroll") for (int k = 0; k < 8; ++k) { const int sl = __builtin_amdgcn_readlane(slot, k); ov[k] = *(const u32x2*)(OB + (size_t)sl * D + 512 * (j) + 8 * lane); } } while (0)
#define G_COMBINE(ov, xr, os, j) do { \
            float y[8] = {ALPHA * bf_lo(xr.x) + bf_lo(os.x), ALPHA * bf_hi(xr.x) + bf_hi(os.x), ALPHA * bf_lo(xr.y) + bf_lo(os.y), ALPHA * bf_hi(xr.y) + bf_hi(os.y), \
                          ALPHA * bf_lo(xr.z) + bf_lo(os.z), ALPHA * bf_hi(xr.z) + bf_hi(os.z), ALPHA * bf_lo(xr.w) + bf_lo(os.w), ALPHA * bf_hi(xr.w) + bf_hi(os.w)}; \
            _Pragma("unroll") for (int k = 0; k < 8; ++k) { const float wk = __int_as_float(__builtin_amdgcn_readlane(__float_as_int(wv), k)) * (1.0f / pg8::O8_SCALE); \
                const f32x2 a = __builtin_amdgcn_cvt_pk_f32_fp8((int)ov[k].x, false), b = __builtin_amdgcn_cvt_pk_f32_fp8((int)ov[k].x, true), \
                            c2 = __builtin_amdgcn_cvt_pk_f32_fp8((int)ov[k].y, false), d2 = __builtin_amdgcn_cvt_pk_f32_fp8((int)ov[k].y, true); \
                y[0] += wk * a.x; y[1] += wk * a.y; y[2] += wk * b.x; y[3] += wk * b.y; y[4] += wk * c2.x; y[5] += wk * c2.y; y[6] += wk * d2.x; y[7] += wk * d2.y; } \
            s += ((y[0] + y[1]) + (y[2] + y[3])) + ((y[4] + y[5]) + (y[6] + y[7])); \
            *(LAS f32x4*)(YS + 512 * (j) + 8 * lane) = (f32x4){y[0], y[1], y[2], y[3]}; *(LAS f32x4*)(YS + 512 * (j) + 8 * lane + 4) = (f32x4){y[4], y[5], y[6], y[7]}; } while (0)
        G_LOADS(ovA, xrA, osA, 0); G_LOADS(ovB, xrB, osB, 1);
        G_COMBINE(ovA, xrA, osA, 0); G_LOADS(ovA, xrA, osA, 2);
        G_COMBINE(ovB, xrB, osB, 1); G_LOADS(ovB, xrB, osB, 3);
        G_COMBINE(ovA, xrA, osA, 2);
        G_COMBINE(ovB, xrB, osB, 3);
#undef G_LOADS
#undef G_COMBINE
        const float mean = wave_sum(s) * (1.f / D); float s2 = 0.f;
#pragma unroll 1
        for (int j = 0; j < 4; ++j) { const f32x4 a = *(const LAS f32x4*)(YS + 512 * j + 8 * lane) - mean, b = *(const LAS f32x4*)(YS + 512 * j + 8 * lane + 4) - mean;
            s2 += ((a[0] * a[0] + a[1] * a[1]) + (a[2] * a[2] + a[3] * a[3])) + ((b[0] * b[0] + b[1] * b[1]) + (b[2] * b[2] + b[3] * b[3])); }
        const float rstd = 1.f / sqrtf(wave_sum(s2) * (1.f / D) + LN_EPS);
#pragma unroll 1
        for (int j = 0; j < 4; ++j) { const f32x4* gp = (const f32x4*)(A.in[I_LN2_G] + l * D + 512 * j + 8 * lane); const f32x4* bp = (const f32x4*)(A.in[I_LN2_B] + l * D + 512 * j + 8 * lane);
            const f32x4 a = *(const LAS f32x4*)(YS + 512 * j + 8 * lane) - mean, b = *(const LAS f32x4*)(YS + 512 * j + 8 * lane + 4) - mean;
            const f32x4 o0 = a * rstd * gp[0] + bp[0], o1 = b * rstd * gp[1] + bp[1];
            if (XO) { f32x4* op = (f32x4*)(XO + (size_t)tok * D + 512 * j + 8 * lane); op[0] = o0; op[1] = o1; }
            if (!XO) *(u32x4*)(XB + (size_t)tok * D + 512 * j + 8 * lane) = (u32x4){cvt_pk_bf16(o0[0], o0[1]), cvt_pk_bf16(o0[2], o0[3]), cvt_pk_bf16(o1[0], o1[1]), cvt_pk_bf16(o1[2], o1[3])}; }
    }
}

constexpr int NPHASE = 2 + 7 * NL;
__global__ void __launch_bounds__(512, 2) mk_fwd(Args args) {
    extern __shared__ __attribute__((aligned(16))) unsigned char lds[];
#define PHASE_FRAME() Frame F; { int tz_ = threadIdx.x; asm volatile("" : "+v"(tz_)); int bz_ = blockIdx.x; asm volatile("" : "+s"(bz_)); unsigned char* wz_ = args.ws; asm volatile("" : "+s"(wz_)); \
        F.lds = (LAS unsigned char*)lds; F.tid = tz_; F.lane = tz_ & 63; F.wave = __builtin_amdgcn_readfirstlane(tz_ >> 6); F.G = gridDim.x; F.vcu = (F.G % 8 == 0) ? (bz_ % 8) * (F.G / 8) + bz_ / 8 : bz_; F.a = &args; F.ws = wz_; } \
        unsigned char* ws = F.ws; const int c = F.vcu; (void)ws; (void)c
    volatile LAS unsigned* MISC = (volatile LAS unsigned*)((LAS unsigned char*)lds + LDS_MISC);
    if (threadIdx.x < 128) MISC[threadIdx.x] = 0u;
    __syncthreads();
    unsigned* ctl = (unsigned*)(args.ws + WS_CTL);
    XcdBarrier bar; bar.bar = ctl + CW_BAR; bar.x = 0; bar.st = nullptr;
    const int lo = args.ph_lo, hi = args.ph_hi;
    if (hi - lo > 1) bar = xcd_barrier_post(ctl + CW_BAR, MISC + 8);
#define IN(k) (lo <= (k) && (k) < hi)
#if PROBE_CLASS >= 0
#define PROBE_MARK(cls) do { if (blockIdx.x == 0 && threadIdx.x == 0) { const unsigned n_ = (unsigned)wall_clock64(); if ((cls) == PROBE_CLASS) MISC[65] += n_ - MISC[64]; MISC[64] = n_; } } while (0)
    if (blockIdx.x == 0 && threadIdx.x == 0) MISC[64] = (unsigned)wall_clock64();
#else
#define PROBE_MARK(cls) do { } while (0)
#endif
#define SEAM(k) do { if (IN(k) && IN((k) + 1)) xcd_barrier(bar); } while (0)

    if (IN(0)) { REP_LOOP(REP_P0) { PHASE_FRAME(); p0_prologue(F); } if (IN(2)) xcd_barrier(bar); PROBE_MARK(7); }
#pragma unroll 1
    for (int l_ = 0; l_ < NL; ++l_) {
        const int pb = 2 + 7 * l_;
        if (IN(pb + 0)) {
            REP_LOOP(REP_A) {
            PHASE_FRAME(); int l = l_; asm volatile("" : "+s"(l));
            int Gp; const int role = phase_role(F, (NTOK / 256) * (INW / 256), Gp); unsigned* PD = (unsigned*)(ws + WS_CTL) + CW_PD + (pb + 0) * 64;
            if (role >= 0) {
                pg8::DenseSched S; S.init((const bf16_t*)(ws + WS_XB), (const bf16_t*)(ws + WS_WT_IN) + (size_t)l * INW * D, NTOK, INW, D, Gp, role);
                pg8::EpiStoreBf16 E{(bf16_t*)(ws + WS_HB), INW};
                pg8::gemm_phase<pg8::EpiStoreBf16, pg8::DenseSched, false>(F.lds, D, S, E);
                if (Gp == F.G && role + F.G >= (NTOK / 256) * (INW / 256)) { __syncthreads(); convert_fill(F, l * L_ITEMS, 1); }
                if (F.tid == 0) xb_add(PD, 1u);
            } else {
                const int k = -1 - role;
                if (l == 0) {
                    { pg8::DenseSched S2; S2.init((const bf16_t*)(ws + WS_MEMN), (const bf16_t*)(ws + WS_WT_K), NMEMTOK, NL * 512, D, F.G, k);
                      pg8::EpiStoreBf16 E2{(bf16_t*)(ws + WS_KBUF), NL * 512};
                      pg8::gemm_phase<pg8::EpiStoreBf16, pg8::DenseSched, false>(F.lds, D, S2, E2); }
                    { pg8::DenseSched S2; S2.init((const bf16_t*)(ws + WS_WT_V), (const bf16_t*)(ws + WS_MEMN), NL * 512, NMEMTOK, D, F.G, k - 32);
                      pg8::EpiStoreBf16 E2{(bf16_t*)(ws + WS_VT), NMEMTOK};
                      pg8::gemm_phase<pg8::EpiStoreBf16, pg8::DenseSched, false>(F.lds, D, S2, E2); }
                    __syncthreads();
                }
#if PACE > 0
                convert_paced(F, l * L_ITEMS, PD, (unsigned)Gp / STOP_DIV + 1u);
#else
                convert_fill(F, l * L_ITEMS, (l == 0 && k < 64) ? FILL_A0 : FILL_A);
#endif
            } }
            SEAM(pb + 0); PROBE_MARK(0);
        }
        if (IN(pb + 1)) {
            REP_LOOP(REP_B) { PHASE_FRAME(); int l = l_; asm volatile("" : "+s"(l));
            for (int it = c; it < 256; it += F.G) mixer_sgu(F, l, it >> 2, it & 3);
            for (int it = c; it < 256; it += F.G) mixer_pool(F, l, it >> 2, it & 3);
            for (int it = c; it < 256; it += F.G) mixer_conv(F, l, it >> 2, it & 3);
            for (int it = c; it < 256; it += F.G) mixer_attn(F, l, it >> 2, it & 3); }
            SEAM(pb + 1); PROBE_MARK(1);
        }
        if (IN(pb + 2)) {
            REP_LOOP(REP_C) {
            PHASE_FRAME(); int l = l_; asm volatile("" : "+s"(l));
            pg8::DenseSched S; S.init((const bf16_t*)(ws + WS_MIX), (const bf16_t*)(ws + WS_WT_OUT) + (size_t)l * D * D, NTOK, D, D, F.G, c);
            pg8::EpiResidBf16 E{(bf16_t*)(ws + WS_Y1), l == 0 ? args.in[I_X] : (const float*)nullptr, (const bf16_t*)(ws + WS_XB), D, ALPHA};
            pg8::gemm_phase<pg8::EpiResidBf16, pg8::DenseSched, false>(F.lds, D, S, E); __syncthreads(); }
            SEAM(pb + 2); PROBE_MARK(2);
        }
        if (IN(pb + 3)) { PHASE_FRAME(); int l = l_; asm volatile("" : "+s"(l));
            if (F.G * 32 == NTOK) {
                if (F.tid == 0) ((LAS unsigned*)(F.lds + LDS_MISC))[16] = 0u;
                __syncthreads();
                if (F.wave < 4) phase_d<4>(F, l); else convert_beside_d(F, l * L_ITEMS, l * L_ITEMS + LI_X);
            } else { convert_cleanup(F, l * L_ITEMS, l * L_ITEMS + LI_X); __syncthreads(); phase_d<8>(F, l); }
            SEAM(pb + 3); PROBE_MARK(3); }
        if (IN(pb + 4)) {
            REP_LOOP(REP_E) {
            PHASE_FRAME(); int l = l_; asm volatile("" : "+s"(l));
            if (c == 0 && F.tid == 0) __hip_atomic_fetch_max((unsigned*)(ws + WS_CTL) + CW_Q, (unsigned)(l * L_ITEMS + LI_X), __ATOMIC_RELAXED, __HIP_MEMORY_SCOPE_AGENT);
            build_etab(F, l);
            int Gp; const int role = phase_role(F, ((LAS const int*)(F.lds + LDS_ETAB))[68 + NE1] * 2, Gp); unsigned* PD = (unsigned*)(ws + WS_CTL) + CW_PD + (pb + 4) * 64;
            if (role >= 0) {
                build_units(F, 2, true, role, Gp);
                ExpertSched S; S.UD = (LAS const int*)(F.lds + LDS_UDESC); S.RT = (LAS const unsigned*)(F.lds + LDS_ROWTAB);
                S.Abase = (const char*)(ws + WS_X1B); S.Bbase = (const char*)(ws + WS_WT_GU) + (size_t)l * NE1 * 512 * D * 2; S.bstride_e = (size_t)512 * D * 2; S.bstride_pn = (size_t)256 * D * 2; S.arow_bytes = D * 2; S.ncol = 128; S.gather = true;
                pg8::EpiSwiglu E{(bf16_t*)(ws + WS_HE)};
                pg8::gemm_phase<pg8::EpiSwiglu, ExpertSched, true>(F.lds, D, S, E);
                if (F.tid == 0) xb_add(PD, 1u);
            } else {
#if PACE > 0
                convert_paced(F, l * L_ITEMS + LI_X, PD, (unsigned)Gp / STOP_DIV + 1u);
#else
                convert_fill(F, l * L_ITEMS + LI_X, FILL_E);
#endif
            }
            __syncthreads(); }
            SEAM(pb + 4); PROBE_MARK(4);
        }
        if (IN(pb + 5)) {
            REP_LOOP(REP_F) {
            PHASE_FRAME(); int l = l_; asm volatile("" : "+s"(l));
            build_etab(F, l);
            int Gp; const int role = phase_role(F, ((LAS const int*)(F.lds + LDS_ETAB))[68 + NE1] * 8, Gp); unsigned* PD = (unsigned*)(ws + WS_CTL) + CW_PD + (pb + 5) * 64;
            if (role >= 0) {
                build_units(F, 8, false, role, Gp);
                ExpertSched S; S.UD = (LAS const int*)(F.lds + LDS_UDESC); S.RT = (LAS const unsigned*)(F.lds + LDS_ROWTAB);
                S.Abase = (const char*)(ws + WS_HE); S.Bbase = (const char*)(ws + WS_WT_D) + (size_t)l * NE1 * D * DE * 2; S.bstride_e = (size_t)D * DE * 2; S.bstride_pn = (size_t)256 * DE * 2; S.arow_bytes = DE * 2; S.ncol = 256; S.gather = false;
                pg8::EpiStoreFp8 E{(unsigned char*)(ws + WS_OB), D, (bf16_t*)(ws + WS_OSH), NE, __builtin_amdgcn_readfirstlane(((LAS const int*)(F.lds + LDS_ETAB))[136 + NE])};
                pg8::gemm_phase<pg8::EpiStoreFp8, ExpertSched, false>(F.lds, DE, S, E);
                if (F.tid == 0) xb_add(PD, 1u);
            } else {
#if PACE > 0
                convert_paced(F, l * L_ITEMS + LI_X, PD, (unsigned)Gp / STOP_DIV + 1u);
#else
                convert_fill(F, l * L_ITEMS + LI_X, FILL_F);
#endif
            }
            __syncthreads(); }
            SEAM(pb + 5); PROBE_MARK(5);
        }
        if (IN(pb + 6)) { REP_LOOP(REP_G) { PHASE_FRAME(); int l = l_; asm volatile("" : "+s"(l)); phase_g(F, l); __syncthreads(); } SEAM(pb + 6); PROBE_MARK(6); }
    }
#if PROBE_CLASS >= 0
    if (blockIdx.x == 0 && threadIdx.x == 0) { const long long t_end = (long long)wall_clock64() + (long long)PROBE_SCALE * MISC[65]; while ((long long)wall_clock64() < t_end) __builtin_amdgcn_s_sleep(64); }
#endif
#undef IN
#undef SEAM
}

extern "C" void kernel_launch(void* const* d_in, const int* in_sizes, int n_in, void* d_out, int out_size, void* d_ws, size_t ws_size, hipStream_t stream) {
    static int grid = 0;
    if (grid == 0) {
        if (n_in != 29 || out_size != NTOK * D || ws_size < WS_END) { fprintf(stderr, "kernel_launch: unexpected shapes (n_in %d out %d ws %zu need %zu)\n", n_in, out_size, ws_size, (size_t)WS_END); grid = -1; return; }
        int dev = 0, cus = 0, per_cu = 0;
        if (hipGetDevice(&dev) != hipSuccess || hipDeviceGetAttribute(&cus, hipDeviceAttributeMultiprocessorCount, dev) != hipSuccess) { grid = -1; return; }
        if (hipFuncSetAttribute((const void*)mk_fwd, hipFuncAttributeMaxDynamicSharedMemorySize, LDS_BYTES) != hipSuccess) { fprintf(stderr, "kernel_launch: hipFuncSetAttribute failed\n"); grid = -1; return; }
        if (hipOccupancyMaxActiveBlocksPerMultiprocessor(&per_cu, (const void*)mk_fwd, 512, LDS_BYTES) != hipSuccess || per_cu < 1) fprintf(stderr, "kernel_launch: occupancy query reports %d\n", per_cu);
        (void)hipGetLastError();
        grid = cus;
    }
    if (grid < 0) return;
    (void)hipMemsetAsync((char*)d_ws + WS_CTL, 0, CTL_ZERO_BYTES, stream);
    Args a{};
    for (int i = 0; i < 29; ++i) a.in[i] = (const float*)d_in[i];
    a.out = (float*)d_out; a.ws = (unsigned char*)d_ws;
#if MK_ONE_LAUNCH
    a.ph_lo = 0; a.ph_hi = NPHASE;
    hipLaunchKernelGGL(mk_fwd, dim3(grid), dim3(512), LDS_BYTES, stream, a);
#else
    for (int p = 0; p < NPHASE; ++p) { a.ph_lo = p; a.ph_hi = p + 1; hipLaunchKernelGGL(mk_fwd, dim3(grid), dim3(512), LDS_BYTES, stream, a); }
#endif
}
```

```cpp
#include <hip/hip_runtime.h>
#include <cstdio>
#include <cstdint>

#define LAS __attribute__((address_space(3)))
#define GAS __attribute__((address_space(1)))
typedef unsigned short bf16_t;
typedef short bf16x8 __attribute__((ext_vector_type(8)));
typedef float f32x4 __attribute__((ext_vector_type(4)));
typedef float f32x2 __attribute__((ext_vector_type(2)));
typedef unsigned u32x4 __attribute__((ext_vector_type(4)));
typedef unsigned u32x2 __attribute__((ext_vector_type(2)));

#ifndef REP_P0
#define REP_P0 1
#endif
#ifndef REP_B
#define REP_B 1
#endif
#ifndef REP_E
#define REP_E 1
#endif
#ifndef REP_F
#define REP_F 1
#endif
#ifndef REP_A
#define REP_A 1
#endif
#ifndef REP_C
#define REP_C 1
#endif
#ifndef REP_D1
#define REP_D1 1
#endif
#ifndef REP_D2
#define REP_D2 1
#endif
#ifndef REP_D3
#define REP_D3 1
#endif
#ifndef REP_G
#define REP_G 1
#endif
#define REP_LOOP(n) _Pragma("unroll 1") for (int rep_ = 0; rep_ < (n); ++rep_)
#ifndef FILL_P1
#define FILL_P1 2
#endif
#ifndef FILL_A
#define FILL_A 4
#endif
#ifndef FILL_A0
#define FILL_A0 2
#endif
#ifndef FILL_F
#define FILL_F 5
#endif
#ifndef FILL_CAP
#define FILL_CAP 64
#endif
#ifndef PROBE_CLASS
#define PROBE_CLASS -1
#endif
#ifndef PROBE_SCALE
#define PROBE_SCALE 40
#endif
#ifndef PACE
#define PACE 0
#endif
#ifndef Q_CP
#define Q_CP 4
#endif
#ifndef STOP_DIV
#define STOP_DIV 16
#endif
#ifndef FILL_E
#define FILL_E 6
#endif
#ifndef MK_ONE_LAUNCH
#define MK_ONE_LAUNCH 1
#endif

constexpr int D = 2048, NTOK = 8192, SEQ = 2048, NL = 4, INW = 3072, GW = 512, HD = 128, NMEMTOK = 1024, NE = 64, NE1 = 65, DE = 256, TOPK = 8;
constexpr float LN_EPS = 1e-5f;
constexpr float ALPHA = 1.6817928305074290861f;
constexpr int SLOT_CAP = 90112;

constexpr size_t MiB = 1u << 20;
constexpr size_t WS_CTL = 0, CTL_ZERO_BYTES = 2 * MiB;
constexpr size_t WS_WT_IN  = 2 * MiB;
constexpr size_t WS_WT_OUT = WS_WT_IN + 48 * MiB;
constexpr size_t WS_WT_K   = WS_WT_OUT + 32 * MiB;
constexpr size_t WS_WT_V   = WS_WT_K + 8 * MiB;
constexpr size_t WS_WT_GU  = WS_WT_V + 8 * MiB;
constexpr size_t WS_WT_D   = WS_WT_GU + 520 * MiB;
constexpr size_t WS_WPT    = WS_WT_D + 260 * MiB;
constexpr size_t WS_SGUW   = WS_WPT + 1 * MiB;
constexpr size_t WS_WR_HI  = WS_SGUW + 1 * MiB;
constexpr size_t WS_WR_LO  = WS_WR_HI + 1 * MiB;
constexpr size_t WS_MEMN   = WS_WR_LO + 1 * MiB;
constexpr size_t WS_KBUF   = WS_MEMN + 4 * MiB;
constexpr size_t WS_VT     = WS_KBUF + 4 * MiB;
constexpr size_t WS_XF     = WS_VT + 4 * MiB;
constexpr size_t WS_OSH    = WS_XF;
constexpr size_t WS_XB     = WS_XF + 64 * MiB;
constexpr size_t WS_HB     = WS_XB + 32 * MiB;
constexpr size_t WS_MIX    = WS_HB + 48 * MiB;
constexpr size_t WS_Y1     = WS_MIX + 32 * MiB;
constexpr size_t WS_X1F    = WS_Y1 + 64 * MiB;
constexpr size_t WS_X1B    = WS_X1F + 64 * MiB;
constexpr size_t WS_HE     = WS_X1B + 33 * MiB;
constexpr size_t WS_OB     = WS_HE + 44 * MiB;
constexpr size_t WS_LIST   = WS_OB + 352 * MiB;
constexpr size_t WS_ASG_EP = WS_LIST + 2 * MiB;
constexpr size_t WS_ASG_W  = WS_ASG_EP + 1 * MiB;
constexpr size_t WS_END    = WS_ASG_W + 1 * MiB;
constexpr int CW_BAR = 4096;
constexpr int CW_CNT = 16384, CNT_STRIDE = 1024;
static_assert((CW_CNT + 256 * CNT_STRIDE) * 4 <= (int)CTL_ZERO_BYTES, "ctl");

constexpr int RING_BYTES = 131072;
constexpr int LDS_MISC = RING_BYTES;
constexpr int LDS_ETAB = LDS_MISC + 512;
constexpr int LDS_UDESC = LDS_ETAB + 1024;
constexpr int LDS_ROWTAB = LDS_UDESC + 512;
constexpr int LDS_BYTES = 147456;
static_assert(LDS_ROWTAB + 4096 <= LDS_BYTES, "lds");

#define LDS_WAIT() asm volatile("s_waitcnt lgkmcnt(0)" ::: "memory")
#define VM_WAIT() asm volatile("s_waitcnt vmcnt(0)" ::: "memory")

__device__ __forceinline__ unsigned cvt_pk_bf16(float lo, float hi) { unsigned r; asm volatile("v_cvt_pk_bf16_f32 %0, %1, %2" : "=v"(r) : "v"(lo), "v"(hi)); return r; }
__device__ __forceinline__ float bf_lo(unsigned w) { return __uint_as_float(w << 16); }
__device__ __forceinline__ float bf_hi(unsigned w) { return __uint_as_float(w & 0xffff0000u); }
__device__ __forceinline__ float fast_sigmoid(float x) { return __builtin_amdgcn_rcpf(1.0f + __builtin_amdgcn_exp2f(-1.4426950408889634f * x)); }
__device__ __forceinline__ float silu_f(float x) { return x * fast_sigmoid(x); }
__device__ __forceinline__ float gelu_tanh_f(float x) { const float t = x + 0.044715f * x * x * x; return x * fast_sigmoid(1.5957691216057308f * t); }
__device__ __forceinline__ float wave_sum(float v) {
#pragma unroll
    for (int o = 1; o < 64; o <<= 1) v += __shfl_xor(v, o);
    return v;
}
__device__ __forceinline__ float g16_sum(float v) { v += __shfl_xor(v, 1); v += __shfl_xor(v, 2); v += __shfl_xor(v, 4); v += __shfl_xor(v, 8); return v; }

namespace pg8 {
constexpr int BM = 256, BK = 64, HALF = 128, HTB = HALF * BK * 2, STAGE_BYTES = 8 * HTB, NXCD = 8, WGM = 8;
__host__ __device__ __forceinline__ int lds_byte(int r, int c) { const int st = (r >> 4) * 2 + (c >> 5), rr = r & 15, cc = c & 31, ob = rr * 64 + cc * 2; return st * 1024 + (ob ^ (((ob >> 9) & 1) << 5)); }
__host__ __device__ __forceinline__ void stage_rc(int b, int& R, int& C) { const int st = b / 1024, sb = b % 1024, swz = sb ^ (((sb >> 9) & 1) << 5); R = (st >> 1) * 16 + swz / 64; C = (st & 1) * 32 + (swz % 64) / 2; }
__host__ __device__ __forceinline__ int perm32(int rho) { const int n = rho >> 4, i = rho & 15; return 8 * (i >> 2) + 4 * n + (i & 3); }

struct Unit { const char* A; const char* B; int row0, col0, nvalid, aux; };

struct StaticOrder {
    int nM, nN, nwg, G, c;
    __device__ void init(int M, int N, int G_, int c_) { nM = M / BM; nN = N / BM; nwg = nM * nN; G = G_; c = c_; }
    __device__ bool next(int i, int& pm, int& pn) const {
        const long L = (long)i * G + c; if (L >= nwg || c < 0) return false;
        int wgid = (int)L; { const int q = nwg / NXCD, r = nwg % NXCD, xcd = wgid % NXCD, off = wgid / NXCD; wgid = (xcd < r ? xcd * (q + 1) : r * (q + 1) + (xcd - r) * q) + off; }
        const int nig = WGM * nN, gid = wgid / nig, fm = gid * WGM, gsz = (nM - fm) < WGM ? (nM - fm) : WGM;
        pm = fm + ((wgid % nig) % gsz); pn = (wgid % nig) / gsz; return true;
    }
};
struct DenseSched {
    StaticOrder so; const char* A; const char* B; size_t tstep;
    __device__ void init(const bf16_t* A_, const bf16_t* B_, int M, int N, int K, int G, int c) { so.init(M, N, G, c); A = (const char*)A_; B = (const char*)B_; tstep = (size_t)BM * K * 2; }
    __device__ __forceinline__ bool next(int i, Unit& u) const { int pm, pn; if (!so.next(i, pm, pn)) return false; u.A = A + (size_t)pm * tstep; u.B = B + (size_t)pn * tstep; u.row0 = pm * BM; u.col0 = pn * BM; u.nvalid = BM; u.aux = 0; return true; }
    __device__ __forceinline__ unsigned rowoff(int, int) const { return 0u; }
};

struct EpiStoreBf16 {
    static constexpr bool PERM = true;
    bf16_t* O; int ldc;
    __device__ __forceinline__ void operator()(const f32x4 (&acc)[2][2][4][2], const Unit& u, int wr, int wc, int fr, int fq) const {
#pragma unroll
        for (int ai = 0; ai < 2; ++ai)
#pragma unroll
            for (int m = 0; m < 4; ++m) { const int lr = ai * HALF + wr * 64 + m * 16 + fr;
                if (lr < u.nvalid) { bf16_t* rowp = O + (size_t)(u.row0 + lr) * ldc + u.col0 + wc * 32 + 8 * fq;
#pragma unroll
                    for (int bj = 0; bj < 2; ++bj) { const f32x4 v0 = acc[ai][bj][m][0], v1 = acc[ai][bj][m][1];
                        u32x4 w; w.x = cvt_pk_bf16(v0[0], v0[1]); w.y = cvt_pk_bf16(v0[2], v0[3]); w.z = cvt_pk_bf16(v1[0], v1[1]); w.w = cvt_pk_bf16(v1[2], v1[3]);
                        *(u32x4*)(rowp + bj * HALF) = w; } } }
    }
};
constexpr float O8_SCALE = 16.0f;
struct EpiStoreFp8 {
    static constexpr bool PERM = true;
    unsigned char* O; int ldc; bf16_t* OS; int sh_e, sh_base;
    __device__ __forceinline__ void operator()(const f32x4 (&acc)[2][2][4][2], const Unit& u, int wr, int wc, int fr, int fq) const {
        if (u.aux == sh_e) {
#pragma unroll
            for (int ai = 0; ai < 2; ++ai)
#pragma unroll
                for (int m = 0; m < 4; ++m) { const int lr = ai * HALF + wr * 64 + m * 16 + fr; bf16_t* rowp = OS + (size_t)(u.row0 - sh_base + lr) * ldc + u.col0 + wc * 32 + 8 * fq;
#pragma unroll
                    for (int bj = 0; bj < 2; ++bj) { const f32x4 v0 = acc[ai][bj][m][0], v1 = acc[ai][bj][m][1];
                        *(u32x4*)(rowp + bj * HALF) = (u32x4){cvt_pk_bf16(v0[0], v0[1]), cvt_pk_bf16(v0[2], v0[3]), cvt_pk_bf16(v1[0], v1[1]), cvt_pk_bf16(v1[2], v1[3])}; } }
            return; }
#pragma unroll
        for (int ai = 0; ai < 2; ++ai)
#pragma unroll
            for (int m = 0; m < 4; ++m) { const int lr = ai * HALF + wr * 64 + m * 16 + fr;
                unsigned pk[2][2];
#pragma unroll
                for (int bj = 0; bj < 2; ++bj) { const f32x4 v0 = acc[ai][bj][m][0] * O8_SCALE, v1 = acc[ai][bj][m][1] * O8_SCALE;
                    int p = __builtin_amdgcn_cvt_pk_fp8_f32(v0[0], v0[1], 0, false); p = __builtin_amdgcn_cvt_pk_fp8_f32(v0[2], v0[3], p, true);
                    int q = __builtin_amdgcn_cvt_pk_fp8_f32(v1[0], v1[1], 0, false); q = __builtin_amdgcn_cvt_pk_fp8_f32(v1[2], v1[3], q, true);
                    pk[bj][0] = (unsigned)p; pk[bj][1] = (unsigned)q; }
                const auto s0 = __builtin_amdgcn_permlane16_swap(pk[0][0], pk[1][0], false, false), s1 = __builtin_amdgcn_permlane16_swap(pk[0][1], pk[1][1], false, false);
                if (lr < u.nvalid) *(u32x4*)(O + (size_t)(u.row0 + lr) * ldc + u.col0 + wc * 32 + (fq & 1) * HALF + (fq >> 1) * 16) = (u32x4){s0[0], s1[0], s0[1], s1[1]}; }
    }
};
struct EpiResidBf16 {
    static constexpr bool PERM = true;
    bf16_t* Y; const float* X; const bf16_t* XBp; int ldc; float alpha;
    __device__ __forceinline__ void operator()(const f32x4 (&acc)[2][2][4][2], const Unit& u, int wr, int wc, int fr, int fq) const {
#pragma unroll
        for (int ai = 0; ai < 2; ++ai)
#pragma unroll
            for (int m = 0; m < 4; ++m) { const size_t off = (size_t)(u.row0 + ai * HALF + wr * 64 + m * 16 + fr) * ldc + u.col0 + wc * 32 + 8 * fq;
#pragma unroll
                for (int bj = 0; bj < 2; ++bj) { f32x4 x0, x1;
                    if (X) { x0 = *(const f32x4*)(X + off + bj * HALF); x1 = *(const f32x4*)(X + off + bj * HALF + 4); }
                    else { const u32x4 r = *(const u32x4*)(XBp + off + bj * HALF); x0 = (f32x4){bf_lo(r.x), bf_hi(r.x), bf_lo(r.y), bf_hi(r.y)}; x1 = (f32x4){bf_lo(r.z), bf_hi(r.z), bf_lo(r.w), bf_hi(r.w)}; }
                    const f32x4 v0 = acc[ai][bj][m][0] + alpha * x0, v1 = acc[ai][bj][m][1] + alpha * x1;
                    *(u32x4*)(Y + off + bj * HALF) = (u32x4){cvt_pk_bf16(v0[0], v0[1]), cvt_pk_bf16(v0[2], v0[3]), cvt_pk_bf16(v1[0], v1[1]), cvt_pk_bf16(v1[2], v1[3])}; } }
    }
};
struct EpiSwiglu {
    static constexpr bool PERM = true;
    bf16_t* H;
    __device__ __forceinline__ void operator()(const f32x4 (&acc)[2][2][4][2], const Unit& u, int wr, int wc, int fr, int fq) const {
#pragma unroll
        for (int ai = 0; ai < 2; ++ai)
#pragma unroll
            for (int m = 0; m < 4; ++m) { const int lr = ai * HALF + wr * 64 + m * 16 + fr;
                if (lr < u.nvalid) { const f32x4 g0 = acc[ai][0][m][0], g1 = acc[ai][0][m][1], u0 = acc[ai][1][m][0], u1 = acc[ai][1][m][1];
                    u32x4 w; w.x = cvt_pk_bf16(silu_f(g0[0]) * u0[0], silu_f(g0[1]) * u0[1]); w.y = cvt_pk_bf16(silu_f(g0[2]) * u0[2], silu_f(g0[3]) * u0[3]);
                    w.z = cvt_pk_bf16(silu_f(g1[0]) * u1[0], silu_f(g1[1]) * u1[1]); w.w = cvt_pk_bf16(silu_f(g1[2]) * u1[2], silu_f(g1[3]) * u1[3]);
                    *(u32x4*)(H + (size_t)(u.row0 + lr) * DE + u.col0 + wc * 32 + 8 * fq) = w; } }
    }
};

template <class Epi, class Sched, bool GATHER>
__device__ __forceinline__ void gemm_phase(LAS unsigned char* lds, const int K, const Sched& S, const Epi& E) {
    int tid = threadIdx.x; asm volatile("" : "+v"(tid));
    const int wid = __builtin_amdgcn_readfirstlane(tid >> 6), lane = tid & 63, wr = wid >> 2, wc = wid & 3;
    const int nt = K / BK;
    unsigned voffB[2], oc[2][2];
#pragma unroll
    for (int i = 0; i < 2; ++i) { int R, C; stage_rc(tid * 16 + i * 8192, R, C); const int Rb = Epi::PERM ? ((R & ~31) + perm32(R & 31)) : R;
        voffB[i] = (unsigned)(Rb * K + C) * 2u; oc[0][i] = (unsigned)(R * K + C) * 2u; oc[1][i] = oc[0][i]; }
    const size_t kstep = (size_t)(BK * 2);
    const size_t hstep = (size_t)HALF * K * 2;
    const size_t ahstep = GATHER ? (size_t)0 : hstep;
    const unsigned ldsw = (unsigned)wid * 1024u;
    const int aoff = lds_byte(wr * 64 + (lane & 15), (lane >> 4) * 8), boff = lds_byte(wc * 32 + (lane & 15), (lane >> 4) * 8);
#define PG8_SA(b, h) (((b) * 2 + (h)) * HTB)
#define PG8_SB(b, h) ((4 + (b) * 2 + (h)) * HTB)
#define PG8_STAGE(bufoff, gbase, voff) do { _Pragma("unroll") for (int _i = 0; _i < 2; ++_i) \
        __builtin_amdgcn_global_load_lds((const unsigned*)((const char*)(gbase) + (voff)[_i]), (LAS unsigned*)(lds + (bufoff) + ldsw + _i * 8192), 16, 0, 0); } while (0)
#define PG8_STAGE_A(bufoff, gbase, h) PG8_STAGE(bufoff, (gbase) + (h) * ahstep, oc[GATHER ? (h) : 0])
#define PG8_LDA(dst, b, h) do { _Pragma("unroll") for (int m = 0; m < 4; ++m) _Pragma("unroll") for (int k = 0; k < 2; ++k) dst[m][k] = *(const LAS bf16x8*)(lds + PG8_SA(b, h) + aoff + m * 2048 + k * 1024); } while (0)
#define PG8_LDB(dst, b, h) do { _Pragma("unroll") for (int n = 0; n < 2; ++n) _Pragma("unroll") for (int k = 0; k < 2; ++k) dst[n][k] = *(const LAS bf16x8*)(lds + PG8_SB(b, h) + boff + n * 2048 + k * 1024); } while (0)
#define PG8_MMA(ai, bj, At, Bt) do { __builtin_amdgcn_s_setprio(1); _Pragma("unroll") for (int m = 0; m < 4; ++m) _Pragma("unroll") for (int n = 0; n < 2; ++n) _Pragma("unroll") for (int k = 0; k < 2; ++k) \
        acc[ai][bj][m][n] = __builtin_amdgcn_mfma_f32_16x16x32_bf16(Bt[n][k], At[m][k], acc[ai][bj][m][n], 0, 0, 0); __builtin_amdgcn_s_setprio(0); } while (0)
#define PG8_WAIT_V(n) asm volatile("s_waitcnt vmcnt(" #n ")" ::: "memory")
#define PG8_WAIT_L(n) asm volatile("s_waitcnt lgkmcnt(" #n ")" ::: "memory")
#define PG8_BAR __builtin_amdgcn_s_barrier()
#define PG8_SCHED __builtin_amdgcn_sched_barrier(0)
#define PG8_LOAD_ROWOFFS(uidx) do { int tz_ = threadIdx.x; asm volatile("" : "+v"(tz_)); _Pragma("unroll") for (int _i = 0; _i < 2; ++_i) { int R_, C_; stage_rc(tz_ * 16 + _i * 8192, R_, C_); \
        oc[0][_i] = S.rowoff((uidx), R_) + (unsigned)C_ * 2u; oc[1][_i] = S.rowoff((uidx), HALF + R_) + (unsigned)C_ * 2u; } } while (0)
    Unit cur, nxt; int ui = 0;
    if (!S.next(0, cur)) return;
    if constexpr (GATHER) { PG8_LOAD_ROWOFFS(0); }
    f32x4 acc[2][2][4][2];
#pragma unroll
    for (int a = 0; a < 2; ++a)
#pragma unroll
        for (int b = 0; b < 2; ++b)
#pragma unroll
            for (int m = 0; m < 4; ++m)
#pragma unroll
                for (int n = 0; n < 2; ++n) acc[a][b][m][n] = (f32x4){0.f, 0.f, 0.f, 0.f};
    bf16x8 At[4][2], B0[2][2], B1[2][2];
    const char* cA = cur.A; const char* cB = cur.B;
    LDS_WAIT();
    PG8_STAGE(PG8_SB(0, 0), cB, voffB); PG8_STAGE(PG8_SB(0, 1), cB + hstep, voffB); PG8_STAGE_A(PG8_SA(0, 0), cA, 0); PG8_STAGE_A(PG8_SA(0, 1), cA, 1);
    if (wr == 1) PG8_BAR;
    PG8_WAIT_V(2); PG8_BAR;
    PG8_STAGE(PG8_SB(1, 0), cB + kstep, voffB); PG8_STAGE_A(PG8_SA(1, 0), cA + kstep, 0); PG8_STAGE(PG8_SB(1, 1), cB + hstep + kstep, voffB);
    PG8_WAIT_V(6); PG8_BAR;
    for (;;) {
        const bool has_next = S.next(ui + 1, nxt);
        const char* nA = has_next ? nxt.A : cA; const char* nB = has_next ? nxt.B : cB;
#pragma unroll 1
        for (int t = 0; t < nt; t += 2) {
            const bool last = (t == nt - 2);
            const char* a1 = cA + (size_t)(t + 1) * kstep;
            const char* a2 = last ? nA : cA + (size_t)(t + 2) * kstep; const char* b2 = last ? nB : cB + (size_t)(t + 2) * kstep;
            const char* a3 = a2 + kstep; const char* b3 = b2 + kstep;
            PG8_LDB(B0, 0, 0); PG8_LDB(B1, 0, 1); PG8_SCHED; PG8_LDA(At, 0, 0); PG8_STAGE_A(PG8_SA(1, 1), a1, 1);
            if constexpr (GATHER) { if (last && has_next) { PG8_LOAD_ROWOFFS(ui + 1); } }
            PG8_WAIT_V(8); PG8_WAIT_L(0); PG8_BAR; PG8_MMA(0, 0, At, B0); PG8_MMA(0, 1, At, B1); PG8_BAR; PG8_SCHED;
            PG8_LDA(At, 0, 1); PG8_STAGE(PG8_SB(0, 0), b2, voffB); PG8_STAGE(PG8_SB(0, 1), b2 + hstep, voffB); PG8_STAGE_A(PG8_SA(0, 0), a2, 0);
            PG8_WAIT_V(8); PG8_WAIT_L(0); PG8_BAR; PG8_MMA(1, 0, At, B0); PG8_MMA(1, 1, At, B1); PG8_BAR; PG8_SCHED;
            PG8_LDB(B0, 1, 0); PG8_LDB(B1, 1, 1); PG8_SCHED; PG8_LDA(At, 1, 0); PG8_STAGE_A(PG8_SA(0, 1), a2, 1);
            PG8_WAIT_V(8); PG8_WAIT_L(0); PG8_BAR; PG8_MMA(0, 0, At, B0); PG8_MMA(0, 1, At, B1); PG8_BAR; PG8_SCHED;
            PG8_LDA(At, 1, 1); PG8_STAGE(PG8_SB(1, 0), b3, voffB); PG8_STAGE(PG8_SB(1, 1), b3 + hstep, voffB); PG8_STAGE_A(PG8_SA(1, 0), a3, 0);
            PG8_WAIT_V(8); PG8_WAIT_L(0); PG8_BAR; PG8_MMA(1, 0, At, B0); PG8_MMA(1, 1, At, B1); PG8_BAR; PG8_SCHED;
        }
        if (wr == 0) PG8_BAR;
        { int tz = threadIdx.x; asm volatile("" : "+v"(tz)); E(acc, cur, wr, wc, tz & 15, (tz & 63) >> 4); }
        if (!has_next) break;
#pragma unroll
        for (int a = 0; a < 2; ++a)
#pragma unroll
            for (int b = 0; b < 2; ++b)
#pragma unroll
                for (int m = 0; m < 4; ++m)
#pragma unroll
                    for (int n = 0; n < 2; ++n) acc[a][b][m][n] = (f32x4){0.f, 0.f, 0.f, 0.f};
        cur = nxt; cA = nA; cB = nB; ++ui;
        if (wr == 1) PG8_BAR;
    }
    PG8_WAIT_V(0);
    PG8_BAR;
#undef PG8_SA
#undef PG8_SB
#undef PG8_STAGE
#undef PG8_STAGE_A
#undef PG8_LOAD_ROWOFFS
#undef PG8_LDA
#undef PG8_LDB
#undef PG8_MMA
#undef PG8_WAIT_V
#undef PG8_WAIT_L
#undef PG8_BAR
#undef PG8_SCHED
}
}

#define XB_TMO      128
#define XB_XCNT(j)  (256  + 64 * (j))
#define XB_XSUB(j)  (1280 + 64 * (j))
#define XB_XGEN(j)  (2304 + 64 * (j))
#define XB_TOP      3328
#define XB_TOPGEN   3392
#define XCD_BAR_WORDS 3456
#define XB_SPIN_CAP (1u << 18)
__device__ __forceinline__ unsigned xb_ld(unsigned* p)              { return __hip_atomic_load(p, __ATOMIC_RELAXED, __HIP_MEMORY_SCOPE_AGENT); }
__device__ __forceinline__ unsigned xb_add(unsigned* p, unsigned v) { return __hip_atomic_fetch_add(p, v, __ATOMIC_RELAXED, __HIP_MEMORY_SCOPE_AGENT); }
__device__ __forceinline__ unsigned xb_xcc_id() { return (unsigned)__builtin_amdgcn_s_getreg((3 << 11) | 20) & 0xFu; }
#define XB_SPIN(cond, bar) do { unsigned _sp = 0; while (cond) { __builtin_amdgcn_s_sleep(1); \
    if ((++_sp & 255u) == 0u) { if (xb_ld(&(bar)[XB_TMO])) break; if (_sp > XB_SPIN_CAP) { atomicAdd(&(bar)[XB_TMO], 1u); break; } } } } while (0)
struct XcdBarrier { unsigned* bar; unsigned x; volatile LAS unsigned* st; };
__device__ __forceinline__ XcdBarrier xcd_barrier_post(unsigned* bar, volatile LAS unsigned* st) {
    XcdBarrier b; b.bar = bar; b.x = xb_xcc_id(); b.st = st;
    if (threadIdx.x == 0) (void)xb_add(&bar[XB_XCNT(b.x)], 1u);
    return b;
}
__device__ __forceinline__ void xcd_barrier_complete(unsigned* bar, unsigned x, unsigned& nloc, unsigned& nx) {
    const unsigned G = gridDim.x * gridDim.y * gridDim.z;
    unsigned sum, cnt, mine, sp = 0u;
    for (;;) {
        sum = 0u; cnt = 0u; mine = 0u;
#pragma unroll 1
        for (unsigned j = 0; j < 16; ++j) { const unsigned c = xb_ld(&bar[XB_XCNT(j)]); sum += c; cnt += (c > 0u) ? 1u : 0u; mine = (j == x) ? c : mine; }
        if (sum == G) break;
        __builtin_amdgcn_s_sleep(1);
        if ((++sp & 255u) == 0u) { if (xb_ld(&bar[XB_TMO])) break; if (sp > XB_SPIN_CAP) { atomicAdd(&bar[XB_TMO], 1u); break; } }
    }
    nloc = mine > 0u ? mine : 1u; nx = cnt > 0u ? cnt : 1u;
}
__device__ __forceinline__ void xcd_barrier(const XcdBarrier& b) {
    asm volatile("s_waitcnt vmcnt(0)" ::: "memory");
    __syncthreads();
    if (threadIdx.x == 0) {
        unsigned* bar = b.bar;
        __builtin_amdgcn_s_waitcnt(0);
        unsigned nloc = b.st[0], nx = b.st[1];
        if (nloc == 0u) { xcd_barrier_complete(bar, b.x, nloc, nx); b.st[0] = nloc; b.st[1] = nx; }
        const unsigned old = xb_add(&bar[XB_XSUB(b.x)], 1u);
        const unsigned gen = old / nloc;
        if (old + 1u == (gen + 1u) * nloc) {
            __builtin_amdgcn_fence(__ATOMIC_RELEASE, "agent");
            asm volatile("s_waitcnt vmcnt(0)" ::: "memory");
            const unsigned og = xb_add(&bar[XB_TOP], 1u);
            const unsigned tg = og / nx;
            if (og + 1u == (tg + 1u) * nx) xb_add(&bar[XB_TOPGEN], 1u);
            else XB_SPIN(xb_ld(&bar[XB_TOPGEN]) == tg, bar);
            __builtin_amdgcn_fence(__ATOMIC_ACQUIRE, "agent");
            xb_add(&bar[XB_XGEN(b.x)], 1u);
            asm volatile("s_waitcnt vmcnt(0)" ::: "memory");
        } else {
            XB_SPIN(xb_ld(&bar[XB_XGEN(b.x)]) == gen, bar);
            __builtin_amdgcn_fence(__ATOMIC_ACQUIRE, "agent");
            asm volatile("s_waitcnt vmcnt(0)" ::: "memory");
        }
    }
    __syncthreads();
}

struct Args { const float* in[29]; float* out; unsigned char* ws; int ph_lo, ph_hi; };
enum { I_X = 0, I_MEM, I_MEM_G, I_MEM_B, I_W_IN, I_SGU_G, I_SGU_B, I_SGU_W, I_SGU_BS, I_POOL_W, I_POOL_S, I_CONV_W, I_CONV_B, I_CONV_G, I_CONV_LB, I_W_KV, I_W_OUT, I_LN1_G, I_LN1_B,
       I_W_R, I_R_BIAS, I_E_G, I_E_U, I_E_D, I_S_G, I_S_U, I_S_D, I_LN2_G, I_LN2_B };

struct Frame {
    LAS unsigned char* lds;
    int tid, lane, wave, vcu, G;
    const Args* a;
    unsigned char* ws;
};

struct ItemDesc { const float* W; bf16_t* WT; bf16_t* WL; int ldw, ldt, k0, n0, drow0; };
constexpr int LI_IN = 3072, LI_OUT = 2048, LI_EX = 64 * 256, LI_SH = 256, LI_PW = 4 * 8, LI_RT = 64;
constexpr int L_ITEMS = LI_IN + LI_OUT + 3 * LI_EX + 3 * LI_SH + LI_PW + LI_RT;
constexpr int KV_ITEMS = 4 * 1024;
constexpr int LI_X = 3 * LI_EX + 3 * LI_SH, LI_S = L_ITEMS - LI_X;
constexpr int Q_TOTAL = NL * L_ITEMS - LI_S;
constexpr int CW_Q = 8192;
constexpr int CW_PD = 10240;
constexpr int Q_CH = 8;
__device__ __forceinline__ ItemDesc item_desc(const Args& A, unsigned char* ws, int l, int r) {
    bf16_t* WT_IN = (bf16_t*)(ws + WS_WT_IN); bf16_t* WT_OUT = (bf16_t*)(ws + WS_WT_OUT);
    bf16_t* WT_GU = (bf16_t*)(ws + WS_WT_GU); bf16_t* WT_D = (bf16_t*)(ws + WS_WT_D); bf16_t* WPT = (bf16_t*)(ws + WS_WPT);
    ItemDesc d; d.WL = nullptr;
    if (r < LI_IN) { const int kb = r / 96, nb = r % 96; d.W = A.in[I_W_IN] + (size_t)l * D * INW; d.ldw = INW; d.WT = WT_IN + (size_t)l * INW * D; d.ldt = D; d.k0 = kb * 64; d.n0 = nb * 32; d.drow0 = nb * 32; return d; } r -= LI_IN;
    if (r < LI_OUT) { const int kb = r / 64, nb = r % 64; d.W = A.in[I_W_OUT] + (size_t)l * D * D; d.ldw = D; d.WT = WT_OUT + (size_t)l * D * D; d.ldt = D; d.k0 = kb * 64; d.n0 = nb * 32; d.drow0 = nb * 32; return d; } r -= LI_OUT;
    if (r < 2 * LI_EX) { const int up = r >= LI_EX; if (up) r -= LI_EX; const int e = r / 256, rem = r % 256, kb = rem / 8, nb = rem % 8, n0 = nb * 32;
        d.W = A.in[up ? I_E_U : I_E_G] + (size_t)(l * NE + e) * D * DE; d.ldw = DE; d.WT = WT_GU + (size_t)(l * NE1 + e) * 512 * D; d.ldt = D; d.k0 = kb * 64; d.n0 = n0; d.drow0 = (n0 >> 7) * 256 + up * 128 + (n0 & 127); return d; } r -= 2 * LI_EX;
    if (r < LI_EX) { const int e = r / 256, rem = r % 256, kb = rem / 64, nb = rem % 64;
        d.W = A.in[I_E_D] + (size_t)(l * NE + e) * DE * D; d.ldw = D; d.WT = WT_D + (size_t)(l * NE1 + e) * D * DE; d.ldt = DE; d.k0 = kb * 64; d.n0 = nb * 32; d.drow0 = nb * 32; return d; } r -= LI_EX;
    if (r < 2 * LI_SH) { const int up = r >= LI_SH; if (up) r -= LI_SH; const int kb = r / 8, nb = r % 8, n0 = nb * 32;
        d.W = A.in[up ? I_S_U : I_S_G] + (size_t)l * D * DE; d.ldw = DE; d.WT = WT_GU + (size_t)(l * NE1 + 64) * 512 * D; d.ldt = D; d.k0 = kb * 64; d.n0 = n0; d.drow0 = (n0 >> 7) * 256 + up * 128 + (n0 & 127); return d; } r -= 2 * LI_SH;
    if (r < LI_SH) { const int kb = r / 64, nb = r % 64; d.W = A.in[I_S_D] + (size_t)l * DE * D; d.ldw = D; d.WT = WT_D + (size_t)(l * NE1 + 64) * D * DE; d.ldt = DE; d.k0 = kb * 64; d.n0 = nb * 32; d.drow0 = nb * 32; return d; } r -= LI_SH;
    if (r < LI_PW) { const int g = r / 8, rem = r % 8, kb = rem / 4, nb = rem % 4; d.W = A.in[I_POOL_W] + (size_t)(l * 4 + g) * 128 * 128; d.ldw = 128; d.WT = WPT + (size_t)(l * 4 + g) * 128 * 128; d.ldt = 128; d.k0 = kb * 64; d.n0 = nb * 32; d.drow0 = nb * 32; return d; } r -= LI_PW;
    { const int kb = r / 2, nb = r % 2; d.W = A.in[I_W_R] + (size_t)l * D * NE; d.ldw = NE; d.WT = (bf16_t*)(ws + WS_WR_HI) + (size_t)l * NE * D; d.WL = (bf16_t*)(ws + WS_WR_LO) + (size_t)l * NE * D; d.ldt = D; d.k0 = kb * 64; d.n0 = nb * 32; d.drow0 = nb * 32; return d; }
}
__device__ __forceinline__ ItemDesc kv_desc(const Args& A, unsigned char* ws, int r) {
    const int mat = r / 1024, rem = r % 1024, kb = rem / 32, nb = rem % 32, n0 = nb * 32; ItemDesc d; d.WL = nullptr;
    d.W = A.in[I_W_KV] + (size_t)mat * D * 1024; d.ldw = 1024; d.WT = (bf16_t*)(ws + (n0 < 512 ? WS_WT_K : WS_WT_V)); d.ldt = D; d.k0 = kb * 64; d.n0 = n0; d.drow0 = mat * 512 + (n0 & 511); return d;
}
__device__ __forceinline__ void item_load(const ItemDesc& d, f32x4 (&v)[8], int lane) {
#pragma unroll
    for (int i = 0; i < 8; ++i) v[i] = __builtin_nontemporal_load((const GAS f32x4*)(d.W + (size_t)(d.k0 + 8 * i + (lane >> 3)) * d.ldw + d.n0 + 4 * (lane & 7)));
}
__device__ __forceinline__ void item_finish(const ItemDesc& d, const f32x4 (&v)[8], LAS float* scr, int lane) {
#pragma unroll
    for (int i = 0; i < 8; ++i) { LAS float* p = scr + (8 * i + (lane >> 3)) * 33 + 4 * (lane & 7); p[0] = v[i][0]; p[1] = v[i][1]; p[2] = v[i][2]; p[3] = v[i][3]; }
    LDS_WAIT(); asm volatile("" ::: "memory");
    const int c = lane & 7;
#pragma unroll
    for (int j = 0; j < 4; ++j) { const int n = (lane >> 3) + 8 * j; const LAS float* s = scr + (8 * c) * 33 + n;
        float x[8]; unsigned h[4];
#pragma unroll
        for (int q = 0; q < 8; ++q) x[q] = s[q * 33];
#pragma unroll
        for (int q = 0; q < 4; ++q) h[q] = cvt_pk_bf16(x[2 * q], x[2 * q + 1]);
        if (!d.WL) __builtin_nontemporal_store((u32x4){h[0], h[1], h[2], h[3]}, (GAS u32x4*)(d.WT + (size_t)(d.drow0 + n) * d.ldt + d.k0 + 8 * c));
        else { unsigned lo[4];
            const int nn = d.drow0 + n, kk = d.k0 + 8 * c; const size_t off = ((size_t)((nn >> 4) * (D / 32) + (kk >> 5)) * 64 + 16 * ((kk & 31) >> 3) + (nn & 15)) * 8;
#pragma unroll
            for (int q = 0; q < 4; ++q) lo[q] = cvt_pk_bf16(x[2 * q] - bf_lo(h[q]), x[2 * q + 1] - bf_hi(h[q]));
            *(GAS u32x4*)(d.WT + off) = (u32x4){h[0], h[1], h[2], h[3]}; *(GAS u32x4*)(d.WL + off) = (u32x4){lo[0], lo[1], lo[2], lo[3]}; } }
    LDS_WAIT(); asm volatile("" ::: "memory");
}
__device__ __forceinline__ int s_item(int s) { return s < LI_IN + LI_OUT ? s : s + LI_X; }
struct GenPrologue { __device__ __forceinline__ ItemDesc operator()(const Args& A, unsigned char* ws, int id) const { return id < LI_S ? item_desc(A, ws, 0, s_item(id)) : kv_desc(A, ws, id - LI_S); } };
struct GenQueue    { __device__ __forceinline__ ItemDesc operator()(const Args& A, unsigned char* ws, int id) const { const int l = id / L_ITEMS, j = id % L_ITEMS;
    return j < LI_X ? item_desc(A, ws, l, LI_IN + LI_OUT + j) : item_desc(A, ws, l + 1, s_item(j - LI_X)); } };
template <class Gen> __device__ __forceinline__ void convert_seq(const Args& A, unsigned char* ws, int first, int end, int stride, LAS float* scr, int lane) {
    if (first >= end) return;
    const Gen gen; ItemDesc d0 = gen(A, ws, first); f32x4 v0[8]; item_load(d0, v0, lane);
#pragma unroll 1
    for (int id = first + stride; id < end; id += stride) { const ItemDesc d1 = gen(A, ws, id); f32x4 v1[8]; item_load(d1, v1, lane); item_finish(d0, v0, scr, lane); d0 = d1;
#pragma unroll
        for (int i = 0; i < 8; ++i) v0[i] = v1[i]; }
    item_finish(d0, v0, scr, lane);
}
__device__ __forceinline__ void convert_fill(Frame& F, int floor, int budget, unsigned* stop = nullptr, unsigned stop_at = 0u) {
    const Args& A = *F.a; LAS float* scr = (LAS float*)(F.lds + F.wave * 16384);
    unsigned* qh = (unsigned*)(F.ws + WS_CTL) + CW_Q;
#pragma unroll 1
    for (int b = 0; b < budget; ++b) {
        if (stop && __builtin_amdgcn_readfirstlane(xb_ld(stop)) >= stop_at) break;
        unsigned st = 0u; if (F.lane == 0) st = __hip_atomic_fetch_add(qh, (unsigned)Q_CH, __ATOMIC_RELAXED, __HIP_MEMORY_SCOPE_AGENT);
        const int s0 = __builtin_amdgcn_readfirstlane((int)st);
        if (s0 >= Q_TOTAL) break;
        const int lo = s0 > floor ? s0 : floor, hi = (s0 + Q_CH) < Q_TOTAL ? (s0 + Q_CH) : Q_TOTAL;
        if (lo >= hi) { ++budget; if (budget > (1 << 20)) break; continue; }
        convert_seq<GenQueue>(A, F.ws, lo, hi, 1, scr, F.lane);
    }
}
__device__ __forceinline__ void convert_paced(Frame& F, int floor, unsigned* stop, unsigned stop_at) {
    const Args& A = *F.a; LAS float* scr = (LAS float*)(F.lds + F.wave * 16384); const int lane = F.lane;
    unsigned* qh = (unsigned*)(F.ws + WS_CTL) + CW_Q;
    long long tn = (long long)wall_clock64() + F.wave * (PACE / 8); bool stopped = false;
#define PACE_WAIT() do { tn += PACE; long long now_ = (long long)wall_clock64(); if (now_ - tn > 2 * PACE) tn = now_ - 2 * PACE; \
        while (!stopped && now_ < tn) { __builtin_amdgcn_s_sleep(32); stopped = __builtin_amdgcn_readfirstlane(xb_ld(stop)) >= stop_at; now_ = (long long)wall_clock64(); } } while (0)
#pragma unroll 1
    for (int b = 0; b < FILL_CAP; ++b) {
        if (stopped || __builtin_amdgcn_readfirstlane(xb_ld(stop)) >= stop_at) break;
        unsigned st = 0u; if (lane == 0) st = __hip_atomic_fetch_add(qh, (unsigned)Q_CP, __ATOMIC_RELAXED, __HIP_MEMORY_SCOPE_AGENT);
        const int s0 = __builtin_amdgcn_readfirstlane((int)st);
        if (s0 >= Q_TOTAL) break;
        const int lo = s0 > floor ? s0 : floor, hi = (s0 + Q_CP) < Q_TOTAL ? (s0 + Q_CP) : Q_TOTAL;
        if (lo >= hi) continue;
        const GenQueue gen; ItemDesc d0 = gen(A, F.ws, lo); f32x4 v0[8]; item_load(d0, v0, lane);
#pragma unroll 1
        for (int id = lo + 1; id < hi; ++id) { PACE_WAIT(); const ItemDesc d1 = gen(A, F.ws, id); f32x4 v1[8]; item_load(d1, v1, lane); item_finish(d0, v0, scr, lane); d0 = d1;
#pragma unroll
            for (int i = 0; i < 8; ++i) v0[i] = v1[i]; }
        PACE_WAIT(); item_finish(d0, v0, scr, lane);
    }
#undef PACE_WAIT
}
__device__ __forceinline__ void convert_cleanup(Frame& F, int from, int upto) {
    const Args& A = *F.a; LAS float* scr = (LAS float*)(F.lds + F.wave * 16384);
    unsigned* qh = (unsigned*)(F.ws + WS_CTL) + CW_Q;
    int head = __builtin_amdgcn_readfirstlane((int)__hip_atomic_load(qh, __ATOMIC_RELAXED, __HIP_MEMORY_SCOPE_AGENT)); head = head > from ? head : from;
    convert_seq<GenQueue>(A, F.ws, head + F.vcu * 8 + F.wave, upto, F.G * 8, scr, F.lane);
}

__device__ __forceinline__ void convert_beside_d(Frame& F, int from, int upto) {
    const Args& A = *F.a; LAS float* scr = (LAS float*)(F.lds + 81920 + (F.wave - 4) * 8704);
    unsigned* qh = (unsigned*)(F.ws + WS_CTL) + CW_Q;
    int head = __builtin_amdgcn_readfirstlane((int)__hip_atomic_load(qh, __ATOMIC_RELAXED, __HIP_MEMORY_SCOPE_AGENT)); head = head > from ? head : from;
    convert_seq<GenQueue>(A, F.ws, head + F.vcu * 4 + (F.wave - 4), upto, F.G * 4, scr, F.lane);
}
__device__ __forceinline__ void p0_prologue(Frame& F) {
    const Args& A = *F.a; unsigned char* ws = F.ws;
    LAS float* scr = (LAS float*)(F.lds + F.wave * 16384);
    const int gw = F.vcu * 8 + F.wave, NGW = F.G * 8, lane = F.lane;
    convert_seq<GenPrologue>(A, ws, gw, LI_S + KV_ITEMS, NGW, scr, lane);
    { const int gt = F.vcu * 512 + F.tid, NGT = F.G * 512; bf16_t* SW = (bf16_t*)(ws + WS_SGUW);
      for (int i = gt; i < NL * 4 * 128 * 128 / 8; i += NGT) { const int t = (i >> 4) & 127, s0 = (i & 15) * 8; const f32x4* p = (const f32x4*)(A.in[I_SGU_W] + (size_t)i * 8); const f32x4 a = p[0], b = p[1];
          float v[8] = {a[0], a[1], a[2], a[3], b[0], b[1], b[2], b[3]};
#pragma unroll
          for (int q = 0; q < 8; ++q) v[q] = (s0 + q <= t) ? v[q] : 0.f;
          *(u32x4*)(SW + (size_t)i * 8) = (u32x4){cvt_pk_bf16(v[0], v[1]), cvt_pk_bf16(v[2], v[3]), cvt_pk_bf16(v[4], v[5]), cvt_pk_bf16(v[6], v[7])}; }
      bf16_t* XB = (bf16_t*)(ws + WS_XB);
      for (int i = gt; i < NTOK * D / 8; i += NGT) { const f32x4* p = (const f32x4*)(A.in[I_X] + (size_t)i * 8); const f32x4 a = p[0], b = p[1];
          *(u32x4*)(XB + (size_t)i * 8) = (u32x4){cvt_pk_bf16(a[0], a[1]), cvt_pk_bf16(a[2], a[3]), cvt_pk_bf16(b[0], b[1]), cvt_pk_bf16(b[2], b[3])}; } }
    if (F.vcu == 0 && F.tid < 256) *(u32x4*)((bf16_t*)(ws + WS_X1B) + (size_t)NTOK * D + F.tid * 8) = (u32x4){0u, 0u, 0u, 0u};
    { bf16_t* MN = (bf16_t*)(ws + WS_MEMN);
      for (int m = gw; m < NMEMTOK; m += NGW) { const f32x4* xr = (const f32x4*)(A.in[I_MEM] + (size_t)m * D) + lane; f32x4 v[8]; float s = 0.f;
#pragma unroll
          for (int j = 0; j < 8; ++j) { v[j] = xr[64 * j]; s += (v[j][0] + v[j][1]) + (v[j][2] + v[j][3]); }
          const float mean = wave_sum(s) * (1.f / D); float s2 = 0.f;
#pragma unroll
          for (int j = 0; j < 8; ++j) { v[j] = v[j] - mean; s2 += (v[j][0] * v[j][0] + v[j][1] * v[j][1]) + (v[j][2] * v[j][2] + v[j][3] * v[j][3]); }
          const float rstd = 1.f / sqrtf(wave_sum(s2) * (1.f / D) + LN_EPS);
#pragma unroll
          for (int j = 0; j < 8; ++j) { const f32x4 g = ((const f32x4*)A.in[I_MEM_G])[lane + 64 * j], b = ((const f32x4*)A.in[I_MEM_B])[lane + 64 * j]; const f32x4 o = v[j] * rstd * g + b;
              *(u32x2*)(MN + (size_t)m * D + 4 * lane + 256 * j) = (u32x2){cvt_pk_bf16(o[0], o[1]), cvt_pk_bf16(o[2], o[3])}; } } }
}

typedef f32x4 acc8_t[8];
__device__ __forceinline__ void mixer_sgu(Frame& F, int l, int chunk, int h) {
    const Args& A = *F.a; const int lane = F.lane, w = F.wave, fr = lane & 15, g = lane >> 4, t0 = chunk * 128;
    const bf16_t* HB = (const bf16_t*)(F.ws + WS_HB); bf16_t* MIX = (bf16_t*)(F.ws + WS_MIX); const bf16_t* SW = (const bf16_t*)(F.ws + WS_SGUW) + (size_t)(l * 4 + h) * 128 * 128;
    LAS unsigned char* VT = F.lds;
    const int t = 16 * w + fr;
    bf16x8 af[4]; u32x2 uraw[8];
#pragma unroll
    for (int ks = 0; ks < 4; ++ks) af[ks] = *(const bf16x8*)(SW + (size_t)t * 128 + 32 * ks + 8 * g);
#pragma unroll
    for (int j = 0; j < 8; ++j) uraw[j] = *(const u32x2*)(HB + (size_t)(t0 + t) * INW + h * 128 + 16 * j + 4 * g);
    const float bs = A.in[I_SGU_BS][(size_t)(l * 128 + t) * 4 + h];
    { const float* gp = A.in[I_SGU_G] + l * GW + h * 128 + 8 * fr; const float* bp = A.in[I_SGU_B] + l * GW + h * 128 + 8 * fr;
      const f32x4 g0 = *(const f32x4*)gp, g1 = *(const f32x4*)(gp + 4), b0 = *(const f32x4*)bp, b1 = *(const f32x4*)(bp + 4);
      const float gg[8] = {g0[0], g0[1], g0[2], g0[3], g1[0], g1[1], g1[2], g1[3]}, bb[8] = {b0[0], b0[1], b0[2], b0[3], b1[0], b1[1], b1[2], b1[3]};
      u32x4 raw[4];
#pragma unroll
      for (int p = 0; p < 4; ++p) raw[p] = *(const u32x4*)(HB + (size_t)(t0 + 16 * w + 4 * p + g) * INW + 512 + h * 128 + 8 * fr);
#pragma unroll
      for (int p = 0; p < 4; ++p) { const int tok = 16 * w + 4 * p + g;
          float v[8] = {bf_lo(raw[p].x), bf_hi(raw[p].x), bf_lo(raw[p].y), bf_hi(raw[p].y), bf_lo(raw[p].z), bf_hi(raw[p].z), bf_lo(raw[p].w), bf_hi(raw[p].w)}; float s = 0.f;
#pragma unroll
          for (int q = 0; q < 8; ++q) { v[q] = gelu_tanh_f(v[q]); s += v[q]; }
          const float mean = g16_sum(s) * (1.f / 128.f); float s2 = 0.f;
#pragma unroll
          for (int q = 0; q < 8; ++q) { v[q] -= mean; s2 += v[q] * v[q]; }
          const float rstd = 1.f / sqrtf(g16_sum(s2) * (1.f / 128.f) + LN_EPS);
#pragma unroll
          for (int q = 0; q < 8; q += 2) { const unsigned pk = cvt_pk_bf16(v[q] * rstd * gg[q] + bb[q], v[q + 1] * rstd * gg[q + 1] + bb[q + 1]);
              const int d0 = 8 * fr + q, d1 = d0 + 1;
              *(LAS bf16_t*)(VT + d0 * 256 + ((((tok >> 3) ^ d0 ^ (d0 >> 3)) & 15) << 4) + (tok & 7) * 2) = (bf16_t)(pk & 0xffffu);
              *(LAS bf16_t*)(VT + d1 * 256 + ((((tok >> 3) ^ d1 ^ (d1 >> 3)) & 15) << 4) + (tok & 7) * 2) = (bf16_t)(pk >> 16); } } }
    __syncthreads();
    f32x4 acc[8];
#pragma unroll
    for (int j = 0; j < 8; ++j) acc[j] = (f32x4){0.f, 0.f, 0.f, 0.f};
    const int nks = (w >> 1) + 1;
#pragma unroll
    for (int ks = 0; ks < 4; ++ks) if (ks < nks) {
#pragma unroll
        for (int j = 0; j < 8; ++j) { const int d = 16 * j + fr; const bf16x8 bfr = *(const LAS bf16x8*)(VT + d * 256 + ((((4 * ks + g) ^ d ^ (d >> 3)) & 15) << 4));
            acc[j] = __builtin_amdgcn_mfma_f32_16x16x32_bf16(bfr, af[ks], acc[j], 0, 0, 0); }
    }
#pragma unroll
    for (int j = 0; j < 8; ++j) { const u32x2 raw = uraw[j];
        const float u0 = gelu_tanh_f(bf_lo(raw.x)), u1 = gelu_tanh_f(bf_hi(raw.x)), u2 = gelu_tanh_f(bf_lo(raw.y)), u3 = gelu_tanh_f(bf_hi(raw.y));
        *(u32x2*)(MIX + (size_t)(t0 + t) * D + h * 128 + 16 * j + 4 * g) = (u32x2){cvt_pk_bf16(u0 * (acc[j][0] + bs), u1 * (acc[j][1] + bs)), cvt_pk_bf16(u2 * (acc[j][2] + bs), u3 * (acc[j][3] + bs))}; }
    __syncthreads();
}
__device__ __forceinline__ void mixer_pool(Frame& F, int l, int chunk, int grp) {
    const Args& A = *F.a; const int lane = F.lane, w = F.wave, fr = lane & 15, g = lane >> 4, t0 = chunk * 128, tid = F.tid;
    const bf16_t* HB = (const bf16_t*)(F.ws + WS_HB); bf16_t* MIX = (bf16_t*)(F.ws + WS_MIX); const bf16_t* WP = (const bf16_t*)(F.ws + WS_WPT) + (size_t)(l * 4 + grp) * 128 * 128;
    constexpr int PST = 272;
    LAS unsigned char* PT = F.lds;
    LAS unsigned char* PA = F.lds + 144 * PST;
    const int win = 2 << grp, pos0 = t0 & (SEQ - 1);
    LAS unsigned char* WS = F.lds + 144 * PST + 128 * PST;
    { u32x4 wv4[4];
#pragma unroll
      for (int i = 0; i < 4; ++i) wv4[i] = *(const u32x4*)(WP + (size_t)(tid + 512 * i) * 8);
      for (int i = tid; i < 144 * 16; i += 512) { const int r = i >> 4, cc = i & 15; const int trow = t0 - 16 + r; u32x4 v = (u32x4){0u, 0u, 0u, 0u};
          if (pos0 - 16 + r >= 0) v = *(const u32x4*)(HB + (size_t)trow * INW + 1024 + grp * 128 + 8 * cc);
          *(LAS u32x4*)(PT + r * PST + cc * 16) = v; }
#pragma unroll
      for (int i = 0; i < 4; ++i) { const int id = tid + 512 * i, d = id >> 4, cc = id & 15; *(LAS u32x4*)(WS + d * 256 + ((cc ^ (d & 15)) << 4)) = wv4[i]; } }
    f32x4 scv[8];
#pragma unroll
    for (int j = 0; j < 8; ++j) scv[j] = *(const f32x4*)(A.in[I_POOL_S] + l * GW + grp * 128 + 16 * j + 4 * g);
    __syncthreads();
    for (int i = tid; i < 128 * 16; i += 512) { const int t = i >> 4, cc = i & 15; float s[8] = {0.f, 0.f, 0.f, 0.f, 0.f, 0.f, 0.f, 0.f}; u32x4 cur = (u32x4){0u, 0u, 0u, 0u};
        for (int j = 0; j < win; ++j) { cur = *(const LAS u32x4*)(PT + (t + 16 - win + 1 + j) * PST + cc * 16);
            s[0] += bf_lo(cur.x); s[1] += bf_hi(cur.x); s[2] += bf_lo(cur.y); s[3] += bf_hi(cur.y); s[4] += bf_lo(cur.z); s[5] += bf_hi(cur.z); s[6] += bf_lo(cur.w); s[7] += bf_hi(cur.w); }
        const int pos = pos0 + t; const float inv = 1.0f / (float)((pos + 1) < win ? (pos + 1) : win);
        const float x[8] = {bf_lo(cur.x), bf_hi(cur.x), bf_lo(cur.y), bf_hi(cur.y), bf_lo(cur.z), bf_hi(cur.z), bf_lo(cur.w), bf_hi(cur.w)};
        *(LAS u32x4*)(PA + t * PST + cc * 16) = (u32x4){cvt_pk_bf16(s[0] * inv - x[0], s[1] * inv - x[1]), cvt_pk_bf16(s[2] * inv - x[2], s[3] * inv - x[3]),
                                                        cvt_pk_bf16(s[4] * inv - x[4], s[5] * inv - x[5]), cvt_pk_bf16(s[6] * inv - x[6], s[7] * inv - x[7])}; }
    __syncthreads();
    f32x4 acc[8];
#pragma unroll
    for (int j = 0; j < 8; ++j) acc[j] = (f32x4){0.f, 0.f, 0.f, 0.f};
#pragma unroll
    for (int ks = 0; ks < 4; ++ks) { const bf16x8 af = *(const LAS bf16x8*)(PA + (16 * w + fr) * PST + (32 * ks + 8 * g) * 2);
#pragma unroll
        for (int j = 0; j < 8; ++j) { const bf16x8 bfr = *(const LAS bf16x8*)(WS + (16 * j + fr) * 256 + (((4 * ks + g) ^ fr) << 4));
            acc[j] = __builtin_amdgcn_mfma_f32_16x16x32_bf16(bfr, af, acc[j], 0, 0, 0); } }
    { const int t = 16 * w + fr;
#pragma unroll
      for (int j = 0; j < 8; ++j) { const f32x4 sc = scv[j];
          *(u32x2*)(MIX + (size_t)(t0 + t) * D + 512 + grp * 128 + 16 * j + 4 * g) = (u32x2){cvt_pk_bf16(acc[j][0] * sc[0], acc[j][1] * sc[1]), cvt_pk_bf16(acc[j][2] * sc[2], acc[j][3] * sc[3])}; } }
    __syncthreads();
}
__device__ __forceinline__ void mixer_conv(Frame& F, int l, int chunk, int grp) {
    const Args& A = *F.a; const int lane = F.lane, w = F.wave, fr = lane & 15, g = lane >> 4, t0 = chunk * 128, tid = F.tid;
    const bf16_t* HB = (const bf16_t*)(F.ws + WS_HB); bf16_t* MIX = (bf16_t*)(F.ws + WS_MIX);
    LAS float* GT = (LAS float*)F.lds;
    const int pos0 = t0 & (SEQ - 1);
    for (int i = tid; i < 158 * 16; i += 512) { const int r = i >> 4, cc = i & 15; float o[8] = {0.f, 0.f, 0.f, 0.f, 0.f, 0.f, 0.f, 0.f};
        if (pos0 - 30 + r >= 0) { const bf16_t* rowp = HB + (size_t)(t0 - 30 + r) * INW + grp * 128 + 8 * cc; const u32x4 v = *(const u32x4*)(rowp + 1536), gt = *(const u32x4*)(rowp + 2048);
            o[0] = bf_lo(v.x) * fast_sigmoid(bf_lo(gt.x)); o[1] = bf_hi(v.x) * fast_sigmoid(bf_hi(gt.x)); o[2] = bf_lo(v.y) * fast_sigmoid(bf_lo(gt.y)); o[3] = bf_hi(v.y) * fast_sigmoid(bf_hi(gt.y));
            o[4] = bf_lo(v.z) * fast_sigmoid(bf_lo(gt.z)); o[5] = bf_hi(v.z) * fast_sigmoid(bf_hi(gt.z)); o[6] = bf_lo(v.w) * fast_sigmoid(bf_lo(gt.w)); o[7] = bf_hi(v.w) * fast_sigmoid(bf_hi(gt.w)); }
        *(LAS f32x4*)(GT + r * 128 + 8 * cc) = (f32x4){o[0], o[1], o[2], o[3]}; *(LAS f32x4*)(GT + r * 128 + 8 * cc + 4) = (f32x4){o[4], o[5], o[6], o[7]}; }
    __syncthreads();
    float y[32];
    { const int ch = tid & 127, tg = tid >> 7; float wv[31];
#pragma unroll
      for (int j = 0; j < 31; ++j) wv[j] = A.in[I_CONV_W][(size_t)(l * 31 + j) * GW + grp * 128 + ch];
      const float bias = A.in[I_CONV_B][l * GW + grp * 128 + ch];
      float xin[62];
#pragma unroll
      for (int j = 0; j < 62; ++j) xin[j] = GT[(tg * 32 + j) * 128 + ch];
#pragma unroll
      for (int t = 0; t < 32; ++t) { float s = bias;
#pragma unroll
          for (int j = 0; j < 31; ++j) s += wv[j] * xin[t + j];
          y[t] = s; }
      __syncthreads();
#pragma unroll
      for (int t = 0; t < 32; ++t) GT[(tg * 32 + t) * 128 + ch] = y[t]; }
    __syncthreads();
    { const float* gp = A.in[I_CONV_G] + l * GW + grp * 128 + 8 * fr; const float* bp = A.in[I_CONV_LB] + l * GW + grp * 128 + 8 * fr;
      const f32x4 g0 = *(const f32x4*)gp, g1 = *(const f32x4*)(gp + 4), b0 = *(const f32x4*)bp, b1 = *(const f32x4*)(bp + 4);
      const float gg[8] = {g0[0], g0[1], g0[2], g0[3], g1[0], g1[1], g1[2], g1[3]}, bb[8] = {b0[0], b0[1], b0[2], b0[3], b1[0], b1[1], b1[2], b1[3]};
#pragma unroll
      for (int p = 0; p < 4; ++p) { const int tok = 16 * w + 4 * p + g; const f32x4 a = *(const LAS f32x4*)(GT + tok * 128 + 8 * fr), b = *(const LAS f32x4*)(GT + tok * 128 + 8 * fr + 4);
          float v[8] = {a[0], a[1], a[2], a[3], b[0], b[1], b[2], b[3]}; float s = 0.f;
#pragma unroll
          for (int q = 0; q < 8; ++q) s += v[q];
          const float mean = g16_sum(s) * (1.f / 128.f); float s2 = 0.f;
#pragma unroll
          for (int q = 0; q < 8; ++q) { v[q] -= mean; s2 += v[q] * v[q]; }
          const float rstd = 1.f / sqrtf(g16_sum(s2) * (1.f / 128.f) + LN_EPS);
#pragma unroll
          for (int q = 0; q < 8; ++q) v[q] = silu_f(v[q] * rstd * gg[q] + bb[q]);
          *(u32x4*)(MIX + (size_t)(t0 + tok) * D + 1024 + grp * 128 + 8 * fr) = (u32x4){cvt_pk_bf16(v[0], v[1]), cvt_pk_bf16(v[2], v[3]), cvt_pk_bf16(v[4], v[5]), cvt_pk_bf16(v[6], v[7])}; } }
    __syncthreads();
}
__device__ __forceinline__ void mixer_attn(Frame& F, int l, int chunk, int h) {
    const int lane = F.lane, w = F.wave, fr = lane & 15, g = lane >> 4, t0 = chunk * 128, b = t0 / SEQ, tid = F.tid;
    const bf16_t* HB = (const bf16_t*)(F.ws + WS_HB); bf16_t* MIX = (bf16_t*)(F.ws + WS_MIX);
    const bf16_t* KB = (const bf16_t*)(F.ws + WS_KBUF) + (size_t)(b * 256) * D + l * 512 + h * 128;
    const bf16_t* VTp = (const bf16_t*)(F.ws + WS_VT) + (size_t)(l * 512 + h * 128) * NMEMTOK + b * 256;
    LAS unsigned char* KS = F.lds;
    LAS unsigned char* VS = F.lds + 65536;
    { u32x4 kv[8], vv[8];
#pragma unroll
      for (int i = 0; i < 8; ++i) { const int id = tid + 512 * i; kv[i] = *(const u32x4*)(KB + (size_t)(id >> 4) * D + (id & 15) * 8); vv[i] = *(const u32x4*)(VTp + (size_t)(id >> 5) * NMEMTOK + (id & 31) * 8); }
#pragma unroll
      for (int i = 0; i < 8; ++i) { const int id = tid + 512 * i; const int m = id >> 4, c = id & 15, d = id >> 5, c2 = id & 31;
          *(LAS u32x4*)(KS + m * 256 + ((c ^ (m & 15)) << 4)) = kv[i]; *(LAS u32x4*)(VS + d * 512 + ((c2 ^ (d & 15)) << 4)) = vv[i]; } }
    __syncthreads();
    const int t = 16 * w + fr;
    f32x4 sa[16];
#pragma unroll
    for (int j = 0; j < 16; ++j) sa[j] = (f32x4){0.f, 0.f, 0.f, 0.f};
    bf16x8 qf[4];
#pragma unroll
    for (int ks = 0; ks < 4; ++ks) qf[ks] = *(const bf16x8*)(HB + (size_t)(t0 + t) * INW + 2560 + h * 128 + 32 * ks + 8 * g);
#pragma unroll
    for (int ks = 0; ks < 4; ++ks)
#pragma unroll
        for (int j = 0; j < 16; ++j) { const bf16x8 kf = *(const LAS bf16x8*)(KS + (16 * j + fr) * 256 + (((4 * ks + g) ^ fr) << 4));
            sa[j] = __builtin_amdgcn_mfma_f32_16x16x32_bf16(kf, qf[ks], sa[j], 0, 0, 0); }
    float mx = -3.0e38f;
#pragma unroll
    for (int j = 0; j < 16; ++j) mx = fmaxf(mx, fmaxf(fmaxf(sa[j][0], sa[j][1]), fmaxf(sa[j][2], sa[j][3])));
    mx = fmaxf(mx, __shfl_xor(mx, 16)); mx = fmaxf(mx, __shfl_xor(mx, 32));
    const float sc = 0.08838834764831845f * 1.4426950408889634f; float sum = 0.f;
#pragma unroll
    for (int j = 0; j < 16; ++j)
#pragma unroll
        for (int r = 0; r < 4; ++r) { const float p = __builtin_amdgcn_exp2f((sa[j][r] - mx) * sc); sa[j][r] = p; sum += p; }
    sum += __shfl_xor(sum, 16); sum += __shfl_xor(sum, 32);
    const float inv = 1.0f / sum;
    f32x4 oa[8];
#pragma unroll
    for (int j = 0; j < 8; ++j) oa[j] = (f32x4){0.f, 0.f, 0.f, 0.f};
#pragma unroll
    for (int q = 0; q < 8; ++q) {
        union { bf16x8 v; unsigned u[4]; } pf; pf.u[0] = cvt_pk_bf16(sa[2 * q][0], sa[2 * q][1]); pf.u[1] = cvt_pk_bf16(sa[2 * q][2], sa[2 * q][3]);
        pf.u[2] = cvt_pk_bf16(sa[2 * q + 1][0], sa[2 * q + 1][1]); pf.u[3] = cvt_pk_bf16(sa[2 * q + 1][2], sa[2 * q + 1][3]);
#pragma unroll
        for (int jd = 0; jd < 8; ++jd) {
            const LAS unsigned char* vrow = VS + (16 * jd + fr) * 512 + ((g & 1) << 3);
            union { bf16x8 v; u32x2 u[2]; } vf; vf.u[0] = *(const LAS u32x2*)(vrow + (((4 * q + (g >> 1)) ^ fr) << 4)); vf.u[1] = *(const LAS u32x2*)(vrow + (((4 * q + 2 + (g >> 1)) ^ fr) << 4));
            oa[jd] = __builtin_amdgcn_mfma_f32_16x16x32_bf16(vf.v, pf.v, oa[jd], 0, 0, 0); } }
#pragma unroll
    for (int jd = 0; jd < 8; ++jd)
        *(u32x2*)(MIX + (size_t)(t0 + t) * D + 1536 + h * 128 + 16 * jd + 4 * g) = (u32x2){cvt_pk_bf16(oa[jd][0] * inv, oa[jd][1] * inv), cvt_pk_bf16(oa[jd][2] * inv, oa[jd][3] * inv)};
    __syncthreads();
}

#if PROBE_CLASS >= 0
#define PROBE_SUB(F, cls) do { if (blockIdx.x == 0 && (F).tid == 0) { volatile LAS unsigned* M_ = (volatile LAS unsigned*)((F).lds + LDS_MISC); const unsigned n_ = (unsigned)wall_clock64(); if ((cls) == PROBE_CLASS || PROBE_CLASS == 99) M_[65] += n_ - M_[64]; M_[64] = n_; } } while (0)
#else
#define PROBE_SUB(F, cls) do { } while (0)
#endif
template <int NW> __device__ __forceinline__ void dsync(LAS unsigned* ctr, unsigned& nb, int lane) {
    if constexpr (NW == 8) { asm volatile("s_waitcnt vmcnt(0)" ::: "memory"); __syncthreads(); }
    else { asm volatile("s_waitcnt vmcnt(0) lgkmcnt(0)" ::: "memory"); ++nb;
        if (lane == 0) __hip_atomic_fetch_add(ctr, 1u, __ATOMIC_RELAXED, __HIP_MEMORY_SCOPE_WORKGROUP);
        while (__hip_atomic_load(ctr, __ATOMIC_RELAXED, __HIP_MEMORY_SCOPE_WORKGROUP) < (unsigned)NW * nb) __builtin_amdgcn_s_sleep(1);
        asm volatile("" ::: "memory"); }
}
template <int NW> __device__ __forceinline__ void phase_d(Frame& F, int l) {
    constexpr int TPW = 32 / NW, KW = D / NW;
    const Args& A = *F.a; unsigned char* ws = F.ws; const int lane = F.lane, w = F.wave, tid = F.tid, fr = lane & 15, g = lane >> 4;
    const bf16_t* Y1 = (const bf16_t*)(ws + WS_Y1); bf16_t* X1L = (bf16_t*)(ws + WS_X1F); bf16_t* X1B = (bf16_t*)(ws + WS_X1B);
    const bf16_t* WRH = (const bf16_t*)(ws + WS_WR_HI) + (size_t)l * NE * D; const bf16_t* WRL = (const bf16_t*)(ws + WS_WR_LO) + (size_t)l * NE * D;
    int* LIST = (int*)(ws + WS_LIST); int* AEP = (int*)(ws + WS_ASG_EP); float* AW = (float*)(ws + WS_ASG_W);
    unsigned* CNT = (unsigned*)(ws + WS_CTL) + CW_CNT + (size_t)l * 64 * CNT_STRIDE;
    LAS float* PL = (LAS float*)F.lds;
    LAS unsigned* HIST = (LAS unsigned*)(F.lds + NW * 32 * 65 * 4);
    LAS unsigned* ctr = (LAS unsigned*)(F.lds + LDS_MISC) + 16; unsigned nb = 0u;
    for (int blk = F.vcu; blk < NTOK / 32; blk += F.G) {
        const int tok0 = blk * 32;
        if (tid < 128) HIST[tid] = 0u;
        PROBE_SUB(F, 8);
        { constexpr int PF = 2;
          const GAS u32x2* yb = (const GAS u32x2*)(Y1 + (size_t)(tok0 + TPW * w) * D) + lane;
          GAS u32x2* xh = (GAS u32x2*)(X1B + (size_t)(tok0 + TPW * w) * D) + lane; GAS u32x2* xl = (GAS u32x2*)(X1L + (size_t)(tok0 + TPW * w) * D) + lane;
          u32x2 raw[PF][8]; f32x4 gg[8], bb[8];
#pragma unroll
          for (int q = 0; q < PF; ++q)
#pragma unroll
              for (int j = 0; j < 8; ++j) raw[q][j] = yb[q * (D / 4) + 64 * j];
#pragma unroll
          for (int j = 0; j < 8; ++j) { gg[j] = ((const GAS f32x4*)(A.in[I_LN1_G] + l * D))[lane + 64 * j]; bb[j] = ((const GAS f32x4*)(A.in[I_LN1_B] + l * D))[lane + 64 * j]; }
#pragma unroll
          for (int tt = 0; tt < TPW; ++tt) { f32x4 v[8]; float s = 0.f;
#pragma unroll
              for (int j = 0; j < 8; ++j) { const u32x2 r = raw[tt % PF][j]; v[j] = (f32x4){bf_lo(r.x), bf_hi(r.x), bf_lo(r.y), bf_hi(r.y)}; s += (v[j][0] + v[j][1]) + (v[j][2] + v[j][3]); }
              if (tt + PF < TPW) {
#pragma unroll
                  for (int j = 0; j < 8; ++j) raw[tt % PF][j] = yb[(tt + PF) * (D / 4) + 64 * j]; }
              const float mean = wave_sum(s) * (1.f / D); float s2 = 0.f;
#pragma unroll
              for (int j = 0; j < 8; ++j) { v[j] = v[j] - mean; s2 += (v[j][0] * v[j][0] + v[j][1] * v[j][1]) + (v[j][2] * v[j][2] + v[j][3] * v[j][3]); }
              const float rstd = 1.f / sqrtf(wave_sum(s2) * (1.f / D) + LN_EPS);
#pragma unroll
              for (int j = 0; j < 8; ++j) { const f32x4 o = v[j] * rstd * gg[j] + bb[j];
                  const unsigned h0 = cvt_pk_bf16(o[0], o[1]), h1 = cvt_pk_bf16(o[2], o[3]);
                  xh[tt * (D / 4) + 64 * j] = (u32x2){h0, h1};
                  xl[tt * (D / 4) + 64 * j] = (u32x2){cvt_pk_bf16(o[0] - bf_lo(h0), o[1] - bf_hi(h0)), cvt_pk_bf16(o[2] - bf_lo(h1), o[3] - bf_hi(h1))}; } } }
        dsync<NW>(ctr, nb, lane); PROBE_SUB(F, 9);
        { f32x4 acc[2][4];
#pragma unroll
          for (int rb = 0; rb < 2; ++rb)
#pragma unroll
              for (int cb = 0; cb < 4; ++cb) acc[rb][cb] = (f32x4){0.f, 0.f, 0.f, 0.f};
          constexpr int NS = 2, NB = KW / 32;
          const GAS bf16x8* pah = (const GAS bf16x8*)(X1B + (size_t)(tok0 + fr) * D + KW * w + 8 * g); const GAS bf16x8* pal = (const GAS bf16x8*)(X1L + (size_t)(tok0 + fr) * D + KW * w + 8 * g);
          const GAS bf16x8* pbh = (const GAS bf16x8*)WRH + (KW / 32 * w) * 64 + lane;                   const GAS bf16x8* pbl = (const GAS bf16x8*)WRL + (KW / 32 * w) * 64 + lane;
          bf16x8 ah[NS][2], al[NS][2], bh[NS][4], bl[NS][4];
#define RT_LOAD(buf, b) do { const int ko = 4 * (b); \
              _Pragma("unroll") for (int rb = 0; rb < 2; ++rb) { ah[buf][rb] = pah[rb * 2 * D + ko]; al[buf][rb] = pal[rb * 2 * D + ko]; } \
              _Pragma("unroll") for (int cb = 0; cb < 4; ++cb) { bh[buf][cb] = pbh[cb * (D / 32) * 64 + 64 * (b)]; bl[buf][cb] = pbl[cb * (D / 32) * 64 + 64 * (b)]; } } while (0)
#pragma unroll
          for (int b = 0; b < NS - 1; ++b) RT_LOAD(b, b);
#pragma unroll 1
          for (int b0 = 0; b0 < NB; b0 += NS) {
#pragma unroll
              for (int s_ = 0; s_ < NS; ++s_) { const int b = b0 + s_;
                  if (b < NB) {
                      if (b + NS - 1 < NB) RT_LOAD((s_ + NS - 1) % NS, b + NS - 1);
                      __builtin_amdgcn_sched_barrier(0);
#pragma unroll
                      for (int cb = 0; cb < 4; ++cb)
#pragma unroll
                          for (int rb = 0; rb < 2; ++rb) { acc[rb][cb] = __builtin_amdgcn_mfma_f32_16x16x32_bf16(ah[s_][rb], bh[s_][cb], acc[rb][cb], 0, 0, 0);
                              acc[rb][cb] = __builtin_amdgcn_mfma_f32_16x16x32_bf16(ah[s_][rb], bl[s_][cb], acc[rb][cb], 0, 0, 0); acc[rb][cb] = __builtin_amdgcn_mfma_f32_16x16x32_bf16(al[s_][rb], bh[s_][cb], acc[rb][cb], 0, 0, 0); }
                      __builtin_amdgcn_sched_barrier(0); } } }
#undef RT_LOAD
#pragma unroll
          for (int rb = 0; rb < 2; ++rb)
#pragma unroll
              for (int cb = 0; cb < 4; ++cb)
#pragma unroll
                  for (int r = 0; r < 4; ++r) PL[(w * 32 + 16 * rb + 4 * g + r) * 65 + 16 * cb + fr] = acc[rb][cb][r]; }
        dsync<NW>(ctr, nb, lane); PROBE_SUB(F, 10);
        bool selv[TPW]; unsigned locv[TPW]; float wnv[TPW]; int kv[TPW];
        const float rbias = A.in[I_R_BIAS][l * NE + lane];
#pragma unroll
        for (int tt = 0; tt < TPW; ++tt) { const int tl = TPW * w + tt; float logit = 0.f;
#pragma unroll
            for (int ww = 0; ww < NW; ++ww) logit += PL[(ww * 32 + tl) * 65 + lane];
            const float score = 1.0f / (1.0f + __expf(-logit)), choice = score + rbias;
            float m1 = choice; m1 = fmaxf(m1, __shfl_xor(m1, 1)); m1 = fmaxf(m1, __shfl_xor(m1, 2)); m1 = fmaxf(m1, __shfl_xor(m1, 4));
            int i1 = (choice == m1) ? lane : 64; i1 = min(i1, __shfl_xor(i1, 1)); i1 = min(i1, __shfl_xor(i1, 2)); i1 = min(i1, __shfl_xor(i1, 4));
            float m2 = (lane == i1) ? -INFINITY : choice; m2 = fmaxf(m2, __shfl_xor(m2, 1)); m2 = fmaxf(m2, __shfl_xor(m2, 2)); m2 = fmaxf(m2, __shfl_xor(m2, 4));
            const float gs = m1 + m2; const int myg = lane >> 3; int grank = 0;
#pragma unroll
            for (int gg = 0; gg < 8; ++gg) { const float gv = __int_as_float(__builtin_amdgcn_readlane(__float_as_int(gs), 8 * gg)); grank += (gv > gs || (gv == gs && gg < myg)) ? 1 : 0; }
            const float mc = (grank < 4) ? choice : -INFINITY; int er = 0;
#pragma unroll
            for (int e2 = 0; e2 < 64; ++e2) { const float v = __int_as_float(__builtin_amdgcn_readlane(__float_as_int(mc), e2)); er += (v > mc || (v == mc && e2 < lane)) ? 1 : 0; }
            const bool sel = er < TOPK; const float wsum = wave_sum(sel ? score : 0.f);
            const unsigned long long mask = __ballot(sel);
            selv[tt] = sel; wnv[tt] = score / (wsum + 1e-20f) * 2.5f; kv[tt] = __popcll(mask & ((1ull << lane) - 1ull)); locv[tt] = 0u;
            if (sel) locv[tt] = __hip_atomic_fetch_add(&HIST[lane], 1u, __ATOMIC_RELAXED, __HIP_MEMORY_SCOPE_WORKGROUP); }
        dsync<NW>(ctr, nb, lane); PROBE_SUB(F, 11);
        if (tid < 64) { const unsigned n = HIST[tid]; HIST[64 + tid] = n ? __hip_atomic_fetch_add(CNT + tid * CNT_STRIDE, n, __ATOMIC_RELAXED, __HIP_MEMORY_SCOPE_AGENT) : 0u; }
        dsync<NW>(ctr, nb, lane);
#pragma unroll
        for (int tt = 0; tt < TPW; ++tt) if (selv[tt]) { const int tok = tok0 + TPW * w + tt; const unsigned pos = HIST[64 + lane] + locv[tt];
            LIST[lane * NTOK + pos] = tok; AEP[tok * 8 + kv[tt]] = (int)((unsigned)lane << 16 | pos); AW[tok * 8 + kv[tt]] = wnv[tt]; }
        dsync<NW>(ctr, nb, lane); PROBE_SUB(F, 12);
    }
}

__device__ __forceinline__ void build_etab(Frame& F, int l) {
    LAS int* ET = (LAS int*)(F.lds + LDS_ETAB);
    unsigned* CNT = (unsigned*)(F.ws + WS_CTL) + CW_CNT + (size_t)l * 64 * CNT_STRIDE;
    if (F.tid < NE1) ET[F.tid] = F.tid < NE ? (int)__hip_atomic_load(CNT + F.tid * CNT_STRIDE, __ATOMIC_RELAXED, __HIP_MEMORY_SCOPE_AGENT) : NTOK;
    __syncthreads();
    if (F.tid == 0) { int ts = 0;
#pragma unroll 1
        for (int e = 0; e < NE1; ++e) { ET[68 + e] = ts; ET[136 + e] = ts * 256; ts += (ET[e] + 255) >> 8; } ET[68 + NE1] = ts; }
    __syncthreads();
}
struct ExpertSched {
    LAS const int* UD;
    LAS const unsigned* RT;
    const char* Abase; const char* Bbase; size_t bstride_e, bstride_pn; int arow_bytes, ncol; bool gather;
    __device__ __forceinline__ bool next(int i, pg8::Unit& u) const {
        if (i >= 16) return false; const int e = __builtin_amdgcn_readfirstlane(UD[4 * i]); if (e < 0) return false;
        const int row0 = __builtin_amdgcn_readfirstlane(UD[4 * i + 1]), pn = __builtin_amdgcn_readfirstlane(UD[4 * i + 2]);
        u.A = gather ? Abase : Abase + (size_t)row0 * arow_bytes; u.B = Bbase + (size_t)e * bstride_e + (size_t)pn * bstride_pn; u.row0 = row0; u.col0 = pn * ncol; u.nvalid = __builtin_amdgcn_readfirstlane(UD[4 * i + 3]); u.aux = e; return true;
    }
    __device__ __forceinline__ unsigned rowoff(int i, int r) const { return RT[i * 256 + r]; }
};
__device__ __forceinline__ int phase_role(const Frame& F, int NU, int& Gp) {
    NU = __builtin_amdgcn_readfirstlane(NU);
    if (F.G != 256 || NU <= 0) { Gp = F.G; return F.vcu; }
    const int R = (NU + 255) / 256; int g = (NU + R - 1) / R; g = (g + 7) & ~7; if (g > 256) g = 256; Gp = g;
    const int per = g >> 3, x = F.vcu >> 5, r = F.vcu & 31;
    return r < per ? x * per + r : -1 - (x * (32 - per) + (r - per));
}
__device__ __forceinline__ void build_units(Frame& F, int npn, bool gather, int cp, int Gp) {
    LAS int* ET = (LAS int*)(F.lds + LDS_ETAB); LAS int* UD = (LAS int*)(F.lds + LDS_UDESC); LAS unsigned* RT = (LAS unsigned*)(F.lds + LDS_ROWTAB);
    const int NU = ET[68 + NE1] * npn;
    if (F.tid < 16) { const int U = cp + F.tid * Gp; int e = -1, row0 = 0, pn = 0, nv = 0;
        if (U < NU) { const int tile = U / npn; pn = U % npn; e = 0;
#pragma unroll 1
            while (e < NE && ET[68 + e + 1] <= tile) ++e; const int mt = tile - ET[68 + e]; row0 = ET[136 + e] + 256 * mt; nv = ET[e] - 256 * mt; nv = nv > 256 ? 256 : nv; }
        UD[4 * F.tid] = e; UD[4 * F.tid + 1] = row0; UD[4 * F.tid + 2] = pn; UD[4 * F.tid + 3] = nv; }
    __syncthreads();
    if (gather) { const int* LIST = (const int*)(F.ws + WS_LIST);
        for (int i = F.tid; i < 4 * 256; i += 512) { const int ui = i >> 8, r = i & 255; const int e = UD[4 * ui]; unsigned off = 0u;
            if (e >= 0) { const int row0 = UD[4 * ui + 1], nv = UD[4 * ui + 3]; const int lr = row0 - ET[136 + e] + r; int tok = 0;
                tok = NTOK;
                if (r < nv) tok = (e < NE) ? LIST[e * NTOK + lr] : lr;
                off = (unsigned)tok * (unsigned)(D * 2); }
            RT[i] = off; }
        __syncthreads(); }
}

__device__ __forceinline__ void phase_g(Frame& F, int l) {
    const Args& A = *F.a; unsigned char* ws = F.ws; const int lane = F.lane;
    if (l + 1 < NL) { convert_cleanup(F, l * L_ITEMS + LI_X, (l + 1) * L_ITEMS); __syncthreads(); }
    build_etab(F, l);
    LAS const int* SB = (LAS const int*)(F.lds + LDS_ETAB) + 136;
    const bf16_t* X1B = (const bf16_t*)(ws + WS_X1B); const unsigned char* OB = (const unsigned char*)(ws + WS_OB); const int* AEP = (const int*)(ws + WS_ASG_EP); const float* AW = (const float*)(ws + WS_ASG_W);
    float* XO = (l == NL - 1) ? A.out : (float*)nullptr; bf16_t* XB = (bf16_t*)(ws + WS_XB);
    const bf16_t* OSH = (const bf16_t*)(ws + WS_OSH);
    LAS float* YS = (LAS float*)(F.lds + F.wave * 8192);
    int ep_n = 0; float w_n = 0.f;
    { const int tok0 = F.vcu * 8 + F.wave; if (tok0 < NTOK && lane < 8) { ep_n = AEP[tok0 * 8 + lane]; w_n = AW[tok0 * 8 + lane]; } }
    for (int tok = F.vcu * 8 + F.wave; tok < NTOK; tok += F.G * 8) {
        int slot = 0; const float wv = w_n;
        if (lane < 8) slot = SB[ep_n >> 16] + (ep_n & 0xffff);
        { const int tn = tok + F.G * 8; if (tn < NTOK && lane < 8) { ep_n = AEP[tn * 8 + lane]; w_n = AW[tn * 8 + lane]; } }
        float s = 0.f;
        u32x2 ovA[8], ovB[8]; u32x4 xrA, xrB, osA, osB;
#define G_LOADS(ov, xr, os, j) do { xr = *(const u32x4*)(X1B + (size_t)tok * D + 512 * (j) + 8 * lane); os = *(const u32x4*)(OSH + (size_t)tok * D + 512 * (j) + 8 * lane); \
            _Pragma("unroll") for (int k = 0; k < 8; ++k) { const int sl = __builtin_amdgcn_readlane(slot, k); ov[k] = *(const u32x2*)(OB + (size_t)sl * D + 512 * (j) + 8 * lane); } } while (0)
#define G_COMBINE(ov, xr, os, j) do { \
            float y[8] = {ALPHA * bf_lo(xr.x) + bf_lo(os.x), ALPHA * bf_hi(xr.x) + bf_hi(os.x), ALPHA * bf_lo(xr.y) + bf_lo(os.y), ALPHA * bf_hi(xr.y) + bf_hi(os.y), \
                          ALPHA * bf_lo(xr.z) + bf_lo(os.z), ALPHA * bf_hi(xr.z) + bf_hi(os.z), ALPHA * bf_lo(xr.w) + bf_lo(os.w), ALPHA * bf_hi(xr.w) + bf_hi(os.w)}; \
            _Pragma("unroll") for (int k = 0; k < 8; ++k) { const float wk = __int_as_float(__builtin_amdgcn_readlane(__float_as_int(wv), k)) * (1.0f / pg8::O8_SCALE); \
                const f32x2 a = __builtin_amdgcn_cvt_pk_f32_fp8((int)ov[k].x, false), b = __builtin_amdgcn_cvt_pk_f32_fp8((int)ov[k].x, true), \
                            c2 = __builtin_amdgcn_cvt_pk_f32_fp8((int)ov[k].y, false), d2 = __builtin_amdgcn_cvt_pk_f32_fp8((int)ov[k].y, true); \
                y[0] += wk * a.x; y[1] += wk * a.y; y[2] += wk * b.x; y[3] += wk * b.y; y[4] += wk * c2.x; y[5] += wk * c2.y; y[6] += wk * d2.x; y[7] += wk * d2.y; } \
            s += ((y[0] + y[1]) + (y[2] + y[3])) + ((y[4] + y[5]) + (y[6] + y[7])); \
            *(LAS f32x4*)(YS + 512 * (j) + 8 * lane) = (f32x4){y[0], y[1], y[2], y[3]}; *(LAS f32x4*)(YS + 512 * (j) + 8 * lane + 4) = (f32x4){y[4], y[5], y[6], y[7]}; } while (0)
        G_LOADS(ovA, xrA, osA, 0); G_LOADS(ovB, xrB, osB, 1);
        G_COMBINE(ovA, xrA, osA, 0); G_LOADS(ovA, xrA, osA, 2);
        G_COMBINE(ovB, xrB, osB, 1); G_LOADS(ovB, xrB, osB, 3);
        G_COMBINE(ovA, xrA, osA, 2);
        G_COMBINE(ovB, xrB, osB, 3);
#undef G_LOADS
#undef G_COMBINE
        const float mean = wave_sum(s) * (1.f / D); float s2 = 0.f;
#pragma unroll 1
        for (int j = 0; j < 4; ++j) { const f32x4 a = *(const LAS f32x4*)(YS + 512 * j + 8 * lane) - mean, b = *(const LAS f32x4*)(YS + 512 * j + 8 * lane + 4) - mean;
            s2 += ((a[0] * a[0] + a[1] * a[1]) + (a[2] * a[2] + a[3] * a[3])) + ((b[0] * b[0] + b[1] * b[1]) + (b[2] * b[2] + b[3] * b[3])); }
        const float rstd = 1.f / sqrtf(wave_sum(s2) * (1.f / D) + LN_EPS);
#pragma unroll 1
        for (int j = 0; j < 4; ++j) { const f32x4* gp = (const f32x4*)(A.in[I_LN2_G] + l * D + 512 * j + 8 * lane); const f32x4* bp = (const f32x4*)(A.in[I_LN2_B] + l * D + 512 * j + 8 * lane);
            const f32x4 a = *(const LAS f32x4*)(YS + 512 * j + 8 * lane) - mean, b = *(const LAS f32x4*)(YS + 512 * j + 8 * lane + 4) - mean;
            const f32x4 o0 = a * rstd * gp[0] + bp[0], o1 = b * rstd * gp[1] + bp[1];
            if (XO) { f32x4* op = (f32x4*)(XO + (size_t)tok * D + 512 * j + 8 * lane); op[0] = o0; op[1] = o1; }
            if (!XO) *(u32x4*)(XB + (size_t)tok * D + 512 * j + 8 * lane) = (u32x4){cvt_pk_bf16(o0[0], o0[1]), cvt_pk_bf16(o0[2], o0[3]), cvt_pk_bf16(o1[0], o1[1]), cvt_pk_bf16(o1[2], o1[3])}; }
    }
}

constexpr int NPHASE = 2 + 7 * NL;
__global__ void __launch_bounds__(512, 2) mk_fwd(Args args) {
    extern __shared__ __attribute__((aligned(16))) unsigned char lds[];
#define PHASE_FRAME() Frame F; { int tz_ = threadIdx.x; asm volatile("" : "+v"(tz_)); int bz_ = blockIdx.x; asm volatile("" : "+s"(bz_)); unsigned char* wz_ = args.ws; asm volatile("" : "+s"(wz_)); \
        F.lds = (LAS unsigned char*)lds; F.tid = tz_; F.lane = tz_ & 63; F.wave = __builtin_amdgcn_readfirstlane(tz_ >> 6); F.G = gridDim.x; F.vcu = (F.G % 8 == 0) ? (bz_ % 8) * (F.G / 8) + bz_ / 8 : bz_; F.a = &args; F.ws = wz_; } \
        unsigned char* ws = F.ws; const int c = F.vcu; (void)ws; (void)c
    volatile LAS unsigned* MISC = (volatile LAS unsigned*)((LAS unsigned char*)lds + LDS_MISC);
    if (threadIdx.x < 128) MISC[threadIdx.x] = 0u;
    __syncthreads();
    unsigned* ctl = (unsigned*)(args.ws + WS_CTL);
    XcdBarrier bar; bar.bar = ctl + CW_BAR; bar.x = 0; bar.st = nullptr;
    const int lo = args.ph_lo, hi = args.ph_hi;
    if (hi - lo > 1) bar = xcd_barrier_post(ctl + CW_BAR, MISC + 8);
#define IN(k) (lo <= (k) && (k) < hi)
#if PROBE_CLASS >= 0
#define PROBE_MARK(cls) do { if (blockIdx.x == 0 && threadIdx.x == 0) { const unsigned n_ = (unsigned)wall_clock64(); if ((cls) == PROBE_CLASS || PROBE_CLASS == 99) MISC[65] += n_ - MISC[64]; MISC[64] = n_; } } while (0)
    if (blockIdx.x == 0 && threadIdx.x == 0) MISC[64] = (unsigned)wall_clock64();
#else
#define PROBE_MARK(cls) do { } while (0)
#endif
#define SEAM(k) do { if (IN(k) && IN((k) + 1)) xcd_barrier(bar); } while (0)

    if (IN(0)) { REP_LOOP(REP_P0) { PHASE_FRAME(); p0_prologue(F); } if (IN(2)) xcd_barrier(bar); PROBE_MARK(7); }
#pragma unroll 1
    for (int l_ = 0; l_ < NL; ++l_) {
        const int pb = 2 + 7 * l_;
        if (IN(pb + 0)) {
            REP_LOOP(REP_A) {
            PHASE_FRAME(); int l = l_; asm volatile("" : "+s"(l));
            int Gp; const int role = phase_role(F, (NTOK / 256) * (INW / 256), Gp); unsigned* PD = (unsigned*)(ws + WS_CTL) + CW_PD + (pb + 0) * 64;
            if (role >= 0) {
                pg8::DenseSched S; S.init((const bf16_t*)(ws + WS_XB), (const bf16_t*)(ws + WS_WT_IN) + (size_t)l * INW * D, NTOK, INW, D, Gp, role);
                pg8::EpiStoreBf16 E{(bf16_t*)(ws + WS_HB), INW};
                pg8::gemm_phase<pg8::EpiStoreBf16, pg8::DenseSched, false>(F.lds, D, S, E);
                if (Gp == F.G && role + F.G >= (NTOK / 256) * (INW / 256)) { __syncthreads(); convert_fill(F, l * L_ITEMS, 1); }
                if (F.tid == 0) xb_add(PD, 1u);
            } else {
                const int k = -1 - role;
                if (l == 0) {
                    { pg8::DenseSched S2; S2.init((const bf16_t*)(ws + WS_MEMN), (const bf16_t*)(ws + WS_WT_K), NMEMTOK, NL * 512, D, F.G, k);
                      pg8::EpiStoreBf16 E2{(bf16_t*)(ws + WS_KBUF), NL * 512};
                      pg8::gemm_phase<pg8::EpiStoreBf16, pg8::DenseSched, false>(F.lds, D, S2, E2); }
                    { pg8::DenseSched S2; S2.init((const bf16_t*)(ws + WS_WT_V), (const bf16_t*)(ws + WS_MEMN), NL * 512, NMEMTOK, D, F.G, k - 32);
                      pg8::EpiStoreBf16 E2{(bf16_t*)(ws + WS_VT), NMEMTOK};
                      pg8::gemm_phase<pg8::EpiStoreBf16, pg8::DenseSched, false>(F.lds, D, S2, E2); }
                    __syncthreads();
                }
#if PACE > 0
                convert_paced(F, l * L_ITEMS, PD, (unsigned)Gp / STOP_DIV + 1u);
#else
                convert_fill(F, l * L_ITEMS, (l == 0 && k < 64) ? FILL_A0 : FILL_A);
#endif
            } }
            SEAM(pb + 0); PROBE_MARK(0);
        }
        if (IN(pb + 1)) {
            REP_LOOP(REP_B) { PHASE_FRAME(); int l = l_; asm volatile("" : "+s"(l));
            for (int it = c; it < 256; it += F.G) mixer_sgu(F, l, it >> 2, it & 3);
            for (int it = c; it < 256; it += F.G) mixer_pool(F, l, it >> 2, it & 3);
            for (int it = c; it < 256; it += F.G) mixer_conv(F, l, it >> 2, it & 3);
            for (int it = c; it < 256; it += F.G) mixer_attn(F, l, it >> 2, it & 3); }
            SEAM(pb + 1); PROBE_MARK(1);
        }
        if (IN(pb + 2)) {
            REP_LOOP(REP_C) {
            PHASE_FRAME(); int l = l_; asm volatile("" : "+s"(l));
            pg8::DenseSched S; S.init((const bf16_t*)(ws + WS_MIX), (const bf16_t*)(ws + WS_WT_OUT) + (size_t)l * D * D, NTOK, D, D, F.G, c);
            pg8::EpiResidBf16 E{(bf16_t*)(ws + WS_Y1), l == 0 ? args.in[I_X] : (const float*)nullptr, (const bf16_t*)(ws + WS_XB), D, ALPHA};
            pg8::gemm_phase<pg8::EpiResidBf16, pg8::DenseSched, false>(F.lds, D, S, E); __syncthreads(); }
            SEAM(pb + 2); PROBE_MARK(2);
        }
        if (IN(pb + 3)) { PHASE_FRAME(); int l = l_; asm volatile("" : "+s"(l));
            if (F.G * 32 == NTOK) {
                if (F.tid == 0) ((LAS unsigned*)(F.lds + LDS_MISC))[16] = 0u;
                __syncthreads();
                if (F.wave < 4) phase_d<4>(F, l); else convert_beside_d(F, l * L_ITEMS, l * L_ITEMS + LI_X);
            } else { convert_cleanup(F, l * L_ITEMS, l * L_ITEMS + LI_X); __syncthreads(); phase_d<8>(F, l); }
            SEAM(pb + 3); PROBE_MARK(3); }
        if (IN(pb + 4)) {
            REP_LOOP(REP_E) {
            PHASE_FRAME(); int l = l_; asm volatile("" : "+s"(l));
            if (c == 0 && F.tid == 0) __hip_atomic_fetch_max((unsigned*)(ws + WS_CTL) + CW_Q, (unsigned)(l * L_ITEMS + LI_X), __ATOMIC_RELAXED, __HIP_MEMORY_SCOPE_AGENT);
            build_etab(F, l);
            int Gp; const int role = phase_role(F, ((LAS const int*)(F.lds + LDS_ETAB))[68 + NE1] * 2, Gp); unsigned* PD = (unsigned*)(ws + WS_CTL) + CW_PD + (pb + 4) * 64;
            if (role >= 0) {
                build_units(F, 2, true, role, Gp);
                ExpertSched S; S.UD = (LAS const int*)(F.lds + LDS_UDESC); S.RT = (LAS const unsigned*)(F.lds + LDS_ROWTAB);
                S.Abase = (const char*)(ws + WS_X1B); S.Bbase = (const char*)(ws + WS_WT_GU) + (size_t)l * NE1 * 512 * D * 2; S.bstride_e = (size_t)512 * D * 2; S.bstride_pn = (size_t)256 * D * 2; S.arow_bytes = D * 2; S.ncol = 128; S.gather = true;
                pg8::EpiSwiglu E{(bf16_t*)(ws + WS_HE)};
                pg8::gemm_phase<pg8::EpiSwiglu, ExpertSched, true>(F.lds, D, S, E);
                if (F.tid == 0) xb_add(PD, 1u);
            } else {
#if PACE > 0
                convert_paced(F, l * L_ITEMS + LI_X, PD, (unsigned)Gp / STOP_DIV + 1u);
#else
                convert_fill(F, l * L_ITEMS + LI_X, FILL_E);
#endif
            }
            __syncthreads(); }
            SEAM(pb + 4); PROBE_MARK(4);
        }
        if (IN(pb + 5)) {
            REP_LOOP(REP_F) {
            PHASE_FRAME(); int l = l_; asm volatile("" : "+s"(l));
            build_etab(F, l);
            int Gp; const int role = phase_role(F, ((LAS const int*)(F.lds + LDS_ETAB))[68 + NE1] * 8, Gp); unsigned* PD = (unsigned*)(ws + WS_CTL) + CW_PD + (pb + 5) * 64;
            if (role >= 0) {
                build_units(F, 8, false, role, Gp);
                ExpertSched S; S.UD = (LAS const int*)(F.lds + LDS_UDESC); S.RT = (LAS const unsigned*)(F.lds + LDS_ROWTAB);
                S.Abase = (const char*)(ws + WS_HE); S.Bbase = (const char*)(ws + WS_WT_D) + (size_t)l * NE1 * D * DE * 2; S.bstride_e = (size_t)D * DE * 2; S.bstride_pn = (size_t)256 * DE * 2; S.arow_bytes = DE * 2; S.ncol = 256; S.gather = false;
                pg8::EpiStoreFp8 E{(unsigned char*)(ws + WS_OB), D, (bf16_t*)(ws + WS_OSH), NE, __builtin_amdgcn_readfirstlane(((LAS const int*)(F.lds + LDS_ETAB))[136 + NE])};
                pg8::gemm_phase<pg8::EpiStoreFp8, ExpertSched, false>(F.lds, DE, S, E);
                if (F.tid == 0) xb_add(PD, 1u);
            } else {
#if PACE > 0
                convert_paced(F, l * L_ITEMS + LI_X, PD, (unsigned)Gp / STOP_DIV + 1u);
#else
                convert_fill(F, l * L_ITEMS + LI_X, FILL_F);
#endif
            }
            __syncthreads(); }
            SEAM(pb + 5); PROBE_MARK(5);
        }
        if (IN(pb + 6)) { REP_LOOP(REP_G) { PHASE_FRAME(); int l = l_; asm volatile("" : "+s"(l)); phase_g(F, l); __syncthreads(); } SEAM(pb + 6); PROBE_MARK(6); }
    }
#if PROBE_CLASS >= 0
    if (blockIdx.x == 0 && threadIdx.x == 0) { const long long t_end = (long long)wall_clock64() + (long long)PROBE_SCALE * MISC[65]; while ((long long)wall_clock64() < t_end) __builtin_amdgcn_s_sleep(64); }
#endif
#undef IN
#undef SEAM
}

extern "C" void kernel_launch(void* const* d_in, const int* in_sizes, int n_in, void* d_out, int out_size, void* d_ws, size_t ws_size, hipStream_t stream) {
    static int grid = 0;
    if (grid == 0) {
        if (n_in != 29 || out_size != NTOK * D || ws_size < WS_END) { fprintf(stderr, "kernel_launch: unexpected shapes (n_in %d out %d ws %zu need %zu)\n", n_in, out_size, ws_size, (size_t)WS_END); grid = -1; return; }
        int dev = 0, cus = 0, per_cu = 0;
        if (hipGetDevice(&dev) != hipSuccess || hipDeviceGetAttribute(&cus, hipDeviceAttributeMultiprocessorCount, dev) != hipSuccess) { grid = -1; return; }
        if (hipFuncSetAttribute((const void*)mk_fwd, hipFuncAttributeMaxDynamicSharedMemorySize, LDS_BYTES) != hipSuccess) { fprintf(stderr, "kernel_launch: hipFuncSetAttribute failed\n"); grid = -1; return; }
        if (hipOccupancyMaxActiveBlocksPerMultiprocessor(&per_cu, (const void*)mk_fwd, 512, LDS_BYTES) != hipSuccess || per_cu < 1) fprintf(stderr, "kernel_launch: occupancy query reports %d\n", per_cu);
        (void)hipGetLastError();
        grid = cus;
    }
    if (grid < 0) return;
    (void)hipMemsetAsync((char*)d_ws + WS_CTL, 0, CTL_ZERO_BYTES, stream);
    Args a{};
    for (int i = 0; i < 29; ++i) a.in[i] = (const float*)d_in[i];
    a.out = (float*)d_out; a.ws = (unsigned char*)d_ws;
#if MK_ONE_LAUNCH
    a.ph_lo = 0; a.ph_hi = NPHASE;
    hipLaunchKernelGGL(mk_fwd, dim3(grid), dim3(512), LDS_BYTES, stream, a);
#else
    for (int p = 0; p < NPHASE; ++p) { a.ph_lo = p; a.ph_hi = p + 1; hipLaunchKernelGGL(mk_fwd, dim3(grid), dim3(512), LDS_BYTES, stream, a); }
#endif
}
```

```cpp
#include <hip/hip_runtime.h>
#include <cstdio>
#include <cstdint>

#define LAS __attribute__((address_space(3)))
#define GAS __attribute__((address_space(1)))
typedef unsigned short bf16_t;
typedef short bf16x8 __attribute__((ext_vector_type(8)));
typedef float f32x4 __attribute__((ext_vector_type(4)));
typedef float f32x2 __attribute__((ext_vector_type(2)));
typedef unsigned u32x4 __attribute__((ext_vector_type(4)));
typedef unsigned u32x2 __attribute__((ext_vector_type(2)));

#ifndef REP_P0
#define REP_P0 1
#endif
#ifndef REP_B
#define REP_B 1
#endif
#ifndef REP_E
#define REP_E 1
#endif
#ifndef REP_F
#define REP_F 1
#endif
#ifndef REP_A
#define REP_A 1
#endif
#ifndef REP_C
#define REP_C 1
#endif
#ifndef REP_D1
#define REP_D1 1
#endif
#ifndef REP_D2
#define REP_D2 1
#endif
#ifndef REP_D3
#define REP_D3 1
#endif
#ifndef REP_G
#define REP_G 1
#endif
#define REP_LOOP(n) _Pragma("unroll 1") for (int rep_ = 0; rep_ < (n); ++rep_)
#ifndef FILL_P1
#define FILL_P1 2
#endif
#ifndef FILL_A
#define FILL_A 4
#endif
#ifndef FILL_A0
#define FILL_A0 2
#endif
#ifndef FILL_F
#define FILL_F 5
#endif
#ifndef FILL_CAP
#define FILL_CAP 64
#endif
#ifndef PROBE_CLASS
#define PROBE_CLASS -1
#endif
#ifndef PROBE_SCALE
#define PROBE_SCALE 40
#endif
#ifndef PACE
#define PACE 0
#endif
#ifndef Q_CP
#define Q_CP 4
#endif
#ifndef STOP_DIV
#define STOP_DIV 16
#endif
#ifndef FILL_E
#define FILL_E 6
#endif
#ifndef MK_ONE_LAUNCH
#define MK_ONE_LAUNCH 1
#endif

constexpr int D = 2048, NTOK = 8192, SEQ = 2048, NL = 4, INW = 3072, GW = 512, HD = 128, NMEMTOK = 1024, NE = 64, NE1 = 65, DE = 256, TOPK = 8;
constexpr float LN_EPS = 1e-5f;
constexpr float ALPHA = 1.6817928305074290861f;
constexpr int SLOT_CAP = 90112;

constexpr size_t MiB = 1u << 20;
constexpr size_t WS_CTL = 0, CTL_ZERO_BYTES = 2 * MiB;
constexpr size_t WS_WT_IN  = 2 * MiB;
constexpr size_t WS_WT_OUT = WS_WT_IN + 48 * MiB;
constexpr size_t WS_WT_K   = WS_WT_OUT + 32 * MiB;
constexpr size_t WS_WT_V   = WS_WT_K + 8 * MiB;
constexpr size_t WS_WT_GU  = WS_WT_V + 8 * MiB;
constexpr size_t WS_WT_D   = WS_WT_GU + 520 * MiB;
constexpr size_t WS_WPT    = WS_WT_D + 260 * MiB;
constexpr size_t WS_SGUW   = WS_WPT + 1 * MiB;
constexpr size_t WS_WR_HI  = WS_SGUW + 1 * MiB;
constexpr size_t WS_WR_LO  = WS_WR_HI + 1 * MiB;
constexpr size_t WS_MEMN   = WS_WR_LO + 1 * MiB;
constexpr size_t WS_KBUF   = WS_MEMN + 4 * MiB;
constexpr size_t WS_VT     = WS_KBUF + 4 * MiB;
constexpr size_t WS_XF     = WS_VT + 4 * MiB;
constexpr size_t WS_OSH    = WS_XF;
constexpr size_t WS_XB     = WS_XF + 64 * MiB;
constexpr size_t WS_HB     = WS_XB + 32 * MiB;
constexpr size_t WS_MIX    = WS_HB + 48 * MiB;
constexpr size_t WS_Y1     = WS_MIX + 32 * MiB;
constexpr size_t WS_X1F    = WS_Y1 + 64 * MiB;
constexpr size_t WS_X1B    = WS_X1F + 64 * MiB;
constexpr size_t WS_HE     = WS_X1B + 33 * MiB;
constexpr size_t WS_OB     = WS_HE + 44 * MiB;
constexpr size_t WS_LIST   = WS_OB + 352 * MiB;
constexpr size_t WS_ASG_EP = WS_LIST + 2 * MiB;
constexpr size_t WS_ASG_W  = WS_ASG_EP + 1 * MiB;
constexpr size_t WS_END    = WS_ASG_W + 1 * MiB;
constexpr int CW_BAR = 4096;
constexpr int CW_CNT = 16384, CNT_STRIDE = 1024;
static_assert((CW_CNT + 256 * CNT_STRIDE) * 4 <= (int)CTL_ZERO_BYTES, "ctl");

constexpr int RING_BYTES = 131072;
constexpr int LDS_MISC = RING_BYTES;
constexpr int LDS_ETAB = LDS_MISC + 512;
constexpr int LDS_UDESC = LDS_ETAB + 1024;
constexpr int LDS_ROWTAB = LDS_UDESC + 512;
constexpr int LDS_BYTES = 147456;
static_assert(LDS_ROWTAB + 4096 <= LDS_BYTES, "lds");

#define LDS_WAIT() asm volatile("s_waitcnt lgkmcnt(0)" ::: "memory")
#define VM_WAIT() asm volatile("s_waitcnt vmcnt(0)" ::: "memory")

__device__ __forceinline__ unsigned cvt_pk_bf16(float lo, float hi) { unsigned r; asm volatile("v_cvt_pk_bf16_f32 %0, %1, %2" : "=v"(r) : "v"(lo), "v"(hi)); return r; }
__device__ __forceinline__ float bf_lo(unsigned w) { return __uint_as_float(w << 16); }
__device__ __forceinline__ float bf_hi(unsigned w) { return __uint_as_float(w & 0xffff0000u); }
__device__ __forceinline__ float fast_sigmoid(float x) { return __builtin_amdgcn_rcpf(1.0f + __builtin_amdgcn_exp2f(-1.4426950408889634f * x)); }
__device__ __forceinline__ float silu_f(float x) { return x * fast_sigmoid(x); }
__device__ __forceinline__ float gelu_tanh_f(float x) { const float t = x + 0.044715f * x * x * x; return x * fast_sigmoid(1.5957691216057308f * t); }
__device__ __forceinline__ float wave_sum(float v) {
#pragma unroll
    for (int o = 1; o < 64; o <<= 1) v += __shfl_xor(v, o);
    return v;
}
__device__ __forceinline__ float g16_sum(float v) { v += __shfl_xor(v, 1); v += __shfl_xor(v, 2); v += __shfl_xor(v, 4); v += __shfl_xor(v, 8); return v; }

namespace pg8 {
constexpr int BM = 256, BK = 64, HALF = 128, HTB = HALF * BK * 2, STAGE_BYTES = 8 * HTB, NXCD = 8, WGM = 8;
__host__ __device__ __forceinline__ int lds_byte(int r, int c) { const int st = (r >> 4) * 2 + (c >> 5), rr = r & 15, cc = c & 31, ob = rr * 64 + cc * 2; return st * 1024 + (ob ^ (((ob >> 9) & 1) << 5)); }
__host__ __device__ __forceinline__ void stage_rc(int b, int& R, int& C) { const int st = b / 1024, sb = b % 1024, swz = sb ^ (((sb >> 9) & 1) << 5); R = (st >> 1) * 16 + swz / 64; C = (st & 1) * 32 + (swz % 64) / 2; }
__host__ __device__ __forceinline__ int perm32(int rho) { const int n = rho >> 4, i = rho & 15; return 8 * (i >> 2) + 4 * n + (i & 3); }

struct Unit { const char* A; const char* B; int row0, col0, nvalid, aux; };

struct StaticOrder {
    int nM, nN, nwg, G, c;
    __device__ void init(int M, int N, int G_, int c_) { nM = M / BM; nN = N / BM; nwg = nM * nN; G = G_; c = c_; }
    __device__ bool next(int i, int& pm, int& pn) const {
        const long L = (long)i * G + c; if (L >= nwg || c < 0) return false;
        int wgid = (int)L; { const int q = nwg / NXCD, r = nwg % NXCD, xcd = wgid % NXCD, off = wgid / NXCD; wgid = (xcd < r ? xcd * (q + 1) : r * (q + 1) + (xcd - r) * q) + off; }
        const int nig = WGM * nN, gid = wgid / nig, fm = gid * WGM, gsz = (nM - fm) < WGM ? (nM - fm) : WGM;
        pm = fm + ((wgid % nig) % gsz); pn = (wgid % nig) / gsz; return true;
    }
};
struct DenseSched {
    StaticOrder so; const char* A; const char* B; size_t tstep;
    __device__ void init(const bf16_t* A_, const bf16_t* B_, int M, int N, int K, int G, int c) { so.init(M, N, G, c); A = (const char*)A_; B = (const char*)B_; tstep = (size_t)BM * K * 2; }
    __device__ __forceinline__ bool next(int i, Unit& u) const { int pm, pn; if (!so.next(i, pm, pn)) return false; u.A = A + (size_t)pm * tstep; u.B = B + (size_t)pn * tstep; u.row0 = pm * BM; u.col0 = pn * BM; u.nvalid = BM; u.aux = 0; return true; }
    __device__ __forceinline__ unsigned rowoff(int, int) const { return 0u; }
};

struct EpiStoreBf16 {
    static constexpr bool PERM = true;
    bf16_t* O; int ldc;
    __device__ __forceinline__ void operator()(const f32x4 (&acc)[2][2][4][2], const Unit& u, int wr, int wc, int fr, int fq) const {
#pragma unroll
        for (int ai = 0; ai < 2; ++ai)
#pragma unroll
            for (int m = 0; m < 4; ++m) { const int lr = ai * HALF + wr * 64 + m * 16 + fr;
                if (lr < u.nvalid) { bf16_t* rowp = O + (size_t)(u.row0 + lr) * ldc + u.col0 + wc * 32 + 8 * fq;
#pragma unroll
                    for (int bj = 0; bj < 2; ++bj) { const f32x4 v0 = acc[ai][bj][m][0], v1 = acc[ai][bj][m][1];
                        u32x4 w; w.x = cvt_pk_bf16(v0[0], v0[1]); w.y = cvt_pk_bf16(v0[2], v0[3]); w.z = cvt_pk_bf16(v1[0], v1[1]); w.w = cvt_pk_bf16(v1[2], v1[3]);
                        *(u32x4*)(rowp + bj * HALF) = w; } } }
    }
};
constexpr float O8_SCALE = 16.0f;
struct EpiStoreFp8 {
    static constexpr bool PERM = true;
    unsigned char* O; int ldc; bf16_t* OS; int sh_e, sh_base;
    __device__ __forceinline__ void operator()(const f32x4 (&acc)[2][2][4][2], const Unit& u, int wr, int wc, int fr, int fq) const {
        if (u.aux == sh_e) {
#pragma unroll
            for (int ai = 0; ai < 2; ++ai)
#pragma unroll
                for (int m = 0; m < 4; ++m) { const int lr = ai * HALF + wr * 64 + m * 16 + fr; bf16_t* rowp = OS + (size_t)(u.row0 - sh_base + lr) * ldc + u.col0 + wc * 32 + 8 * fq;
#pragma unroll
                    for (int bj = 0; bj < 2; ++bj) { const f32x4 v0 = acc[ai][bj][m][0], v1 = acc[ai][bj][m][1];
                        *(u32x4*)(rowp + bj * HALF) = (u32x4){cvt_pk_bf16(v0[0], v0[1]), cvt_pk_bf16(v0[2], v0[3]), cvt_pk_bf16(v1[0], v1[1]), cvt_pk_bf16(v1[2], v1[3])}; } }
            return; }
#pragma unroll
        for (int ai = 0; ai < 2; ++ai)
#pragma unroll
            for (int m = 0; m < 4; ++m) { const int lr = ai * HALF + wr * 64 + m * 16 + fr;
                unsigned pk[2][2];
#pragma unroll
                for (int bj = 0; bj < 2; ++bj) { const f32x4 v0 = acc[ai][bj][m][0] * O8_SCALE, v1 = acc[ai][bj][m][1] * O8_SCALE;
                    int p = __builtin_amdgcn_cvt_pk_fp8_f32(v0[0], v0[1], 0, false); p = __builtin_amdgcn_cvt_pk_fp8_f32(v0[2], v0[3], p, true);
                    int q = __builtin_amdgcn_cvt_pk_fp8_f32(v1[0], v1[1], 0, false); q = __builtin_amdgcn_cvt_pk_fp8_f32(v1[2], v1[3], q, true);
                    pk[bj][0] = (unsigned)p; pk[bj][1] = (unsigned)q; }
                const auto s0 = __builtin_amdgcn_permlane16_swap(pk[0][0], pk[1][0], false, false), s1 = __builtin_amdgcn_permlane16_swap(pk[0][1], pk[1][1], false, false);
                if (lr < u.nvalid) *(u32x4*)(O + (size_t)(u.row0 + lr) * ldc + u.col0 + wc * 32 + (fq & 1) * HALF + (fq >> 1) * 16) = (u32x4){s0[0], s1[0], s0[1], s1[1]}; }
    }
};
struct EpiResidBf16 {
    static constexpr bool PERM = true;
    bf16_t* Y; const float* X; const bf16_t* XBp; int ldc; float alpha;
    __device__ __forceinline__ void operator()(const f32x4 (&acc)[2][2][4][2], const Unit& u, int wr, int wc, int fr, int fq) const {
#pragma unroll
        for (int ai = 0; ai < 2; ++ai)
#pragma unroll
            for (int m = 0; m < 4; ++m) { const size_t off = (size_t)(u.row0 + ai * HALF + wr * 64 + m * 16 + fr) * ldc + u.col0 + wc * 32 + 8 * fq;
#pragma unroll
                for (int bj = 0; bj < 2; ++bj) { f32x4 x0, x1;
                    if (X) { x0 = *(const f32x4*)(X + off + bj * HALF); x1 = *(const f32x4*)(X + off + bj * HALF + 4); }
                    else { const u32x4 r = *(const u32x4*)(XBp + off + bj * HALF); x0 = (f32x4){bf_lo(r.x), bf_hi(r.x), bf_lo(r.y), bf_hi(r.y)}; x1 = (f32x4){bf_lo(r.z), bf_hi(r.z), bf_lo(r.w), bf_hi(r.w)}; }
                    const f32x4 v0 = acc[ai][bj][m][0] + alpha * x0, v1 = acc[ai][bj][m][1] + alpha * x1;
                    *(u32x4*)(Y + off + bj * HALF) = (u32x4){cvt_pk_bf16(v0[0], v0[1]), cvt_pk_bf16(v0[2], v0[3]), cvt_pk_bf16(v1[0], v1[1]), cvt_pk_bf16(v1[2], v1[3])}; } }
    }
};
struct EpiSwiglu {
    static constexpr bool PERM = true;
    bf16_t* H;
    __device__ __forceinline__ void operator()(const f32x4 (&acc)[2][2][4][2], const Unit& u, int wr, int wc, int fr, int fq) const {
#pragma unroll
        for (int ai = 0; ai < 2; ++ai)
#pragma unroll
            for (int m = 0; m < 4; ++m) { const int lr = ai * HALF + wr * 64 + m * 16 + fr;
                if (lr < u.nvalid) { const f32x4 g0 = acc[ai][0][m][0], g1 = acc[ai][0][m][1], u0 = acc[ai][1][m][0], u1 = acc[ai][1][m][1];
                    u32x4 w; w.x = cvt_pk_bf16(silu_f(g0[0]) * u0[0], silu_f(g0[1]) * u0[1]); w.y = cvt_pk_bf16(silu_f(g0[2]) * u0[2], silu_f(g0[3]) * u0[3]);
                    w.z = cvt_pk_bf16(silu_f(g1[0]) * u1[0], silu_f(g1[1]) * u1[1]); w.w = cvt_pk_bf16(silu_f(g1[2]) * u1[2], silu_f(g1[3]) * u1[3]);
                    *(u32x4*)(H + (size_t)(u.row0 + lr) * DE + u.col0 + wc * 32 + 8 * fq) = w; } }
    }
};

template <class Epi, class Sched, bool GATHER>
__device__ __forceinline__ void gemm_phase(LAS unsigned char* lds, const int K, const Sched& S, const Epi& E) {
    int tid = threadIdx.x; asm volatile("" : "+v"(tid));
    const int wid = __builtin_amdgcn_readfirstlane(tid >> 6), lane = tid & 63, wr = wid >> 2, wc = wid & 3;
    const int nt = K / BK;
    unsigned voffB[2], oc[2][2];
#pragma unroll
    for (int i = 0; i < 2; ++i) { int R, C; stage_rc(tid * 16 + i * 8192, R, C); const int Rb = Epi::PERM ? ((R & ~31) + perm32(R & 31)) : R;
        voffB[i] = (unsigned)(Rb * K + C) * 2u; oc[0][i] = (unsigned)(R * K + C) * 2u; oc[1][i] = oc[0][i]; }
    const size_t kstep = (size_t)(BK * 2);
    const size_t hstep = (size_t)HALF * K * 2;
    const size_t ahstep = GATHER ? (size_t)0 : hstep;
    const unsigned ldsw = (unsigned)wid * 1024u;
    const int aoff = lds_byte(wr * 64 + (lane & 15), (lane >> 4) * 8), boff = lds_byte(wc * 32 + (lane & 15), (lane >> 4) * 8);
#define PG8_SA(b, h) (((b) * 2 + (h)) * HTB)
#define PG8_SB(b, h) ((4 + (b) * 2 + (h)) * HTB)
#define PG8_STAGE(bufoff, gbase, voff) do { _Pragma("unroll") for (int _i = 0; _i < 2; ++_i) \
        __builtin_amdgcn_global_load_lds((const unsigned*)((const char*)(gbase) + (voff)[_i]), (LAS unsigned*)(lds + (bufoff) + ldsw + _i * 8192), 16, 0, 0); } while (0)
#define PG8_STAGE_A(bufoff, gbase, h) PG8_STAGE(bufoff, (gbase) + (h) * ahstep, oc[GATHER ? (h) : 0])
#define PG8_LDA(dst, b, h) do { _Pragma("unroll") for (int m = 0; m < 4; ++m) _Pragma("unroll") for (int k = 0; k < 2; ++k) dst[m][k] = *(const LAS bf16x8*)(lds + PG8_SA(b, h) + aoff + m * 2048 + k * 1024); } while (0)
#define PG8_LDB(dst, b, h) do { _Pragma("unroll") for (int n = 0; n < 2; ++n) _Pragma("unroll") for (int k = 0; k < 2; ++k) dst[n][k] = *(const LAS bf16x8*)(lds + PG8_SB(b, h) + boff + n * 2048 + k * 1024); } while (0)
#define PG8_MMA(ai, bj, At, Bt) do { __builtin_amdgcn_s_setprio(1); _Pragma("unroll") for (int m = 0; m < 4; ++m) _Pragma("unroll") for (int n = 0; n < 2; ++n) _Pragma("unroll") for (int k = 0; k < 2; ++k) \
        acc[ai][bj][m][n] = __builtin_amdgcn_mfma_f32_16x16x32_bf16(Bt[n][k], At[m][k], acc[ai][bj][m][n], 0, 0, 0); __builtin_amdgcn_s_setprio(0); } while (0)
#define PG8_WAIT_V(n) asm volatile("s_waitcnt vmcnt(" #n ")" ::: "memory")
#define PG8_WAIT_L(n) asm volatile("s_waitcnt lgkmcnt(" #n ")" ::: "memory")
#define PG8_BAR __builtin_amdgcn_s_barrier()
#define PG8_SCHED __builtin_amdgcn_sched_barrier(0)
#define PG8_LOAD_ROWOFFS(uidx) do { int tz_ = threadIdx.x; asm volatile("" : "+v"(tz_)); _Pragma("unroll") for (int _i = 0; _i < 2; ++_i) { int R_, C_; stage_rc(tz_ * 16 + _i * 8192, R_, C_); \
        oc[0][_i] = S.rowoff((uidx), R_) + (unsigned)C_ * 2u; oc[1][_i] = S.rowoff((uidx), HALF + R_) + (unsigned)C_ * 2u; } } while (0)
    Unit cur, nxt; int ui = 0;
    if (!S.next(0, cur)) return;
    if constexpr (GATHER) { PG8_LOAD_ROWOFFS(0); }
    f32x4 acc[2][2][4][2];
#pragma unroll
    for (int a = 0; a < 2; ++a)
#pragma unroll
        for (int b = 0; b < 2; ++b)
#pragma unroll
            for (int m = 0; m < 4; ++m)
#pragma unroll
                for (int n = 0; n < 2; ++n) acc[a][b][m][n] = (f32x4){0.f, 0.f, 0.f, 0.f};
    bf16x8 At[4][2], B0[2][2], B1[2][2];
    const char* cA = cur.A; const char* cB = cur.B;
    LDS_WAIT();
    PG8_STAGE(PG8_SB(0, 0), cB, voffB); PG8_STAGE(PG8_SB(0, 1), cB + hstep, voffB); PG8_STAGE_A(PG8_SA(0, 0), cA, 0); PG8_STAGE_A(PG8_SA(0, 1), cA, 1);
    if (wr == 1) PG8_BAR;
    PG8_WAIT_V(2); PG8_BAR;
    PG8_STAGE(PG8_SB(1, 0), cB + kstep, voffB); PG8_STAGE_A(PG8_SA(1, 0), cA + kstep, 0); PG8_STAGE(PG8_SB(1, 1), cB + hstep + kstep, voffB);
    PG8_WAIT_V(6); PG8_BAR;
    for (;;) {
        const bool has_next = S.next(ui + 1, nxt);
        const char* nA = has_next ? nxt.A : cA; const char* nB = has_next ? nxt.B : cB;
#pragma unroll 1
        for (int t = 0; t < nt; t += 2) {
            const bool last = (t == nt - 2);
            const char* a1 = cA + (size_t)(t + 1) * kstep;
            const char* a2 = last ? nA : cA + (size_t)(t + 2) * kstep; const char* b2 = last ? nB : cB + (size_t)(t + 2) * kstep;
            const char* a3 = a2 + kstep; const char* b3 = b2 + kstep;
            PG8_LDB(B0, 0, 0); PG8_LDB(B1, 0, 1); PG8_SCHED; PG8_LDA(At, 0, 0); PG8_STAGE_A(PG8_SA(1, 1), a1, 1);
            if constexpr (GATHER) { if (last && has_next) { PG8_LOAD_ROWOFFS(ui + 1); } }
            PG8_WAIT_V(8); PG8_WAIT_L(0); PG8_BAR; PG8_MMA(0, 0, At, B0); PG8_MMA(0, 1, At, B1); PG8_BAR; PG8_SCHED;
            PG8_LDA(At, 0, 1); PG8_STAGE(PG8_SB(0, 0), b2, voffB); PG8_STAGE(PG8_SB(0, 1), b2 + hstep, voffB); PG8_STAGE_A(PG8_SA(0, 0), a2, 0);
            PG8_WAIT_V(8); PG8_WAIT_L(0); PG8_BAR; PG8_MMA(1, 0, At, B0); PG8_MMA(1, 1, At, B1); PG8_BAR; PG8_SCHED;
            PG8_LDB(B0, 1, 0); PG8_LDB(B1, 1, 1); PG8_SCHED; PG8_LDA(At, 1, 0); PG8_STAGE_A(PG8_SA(0, 1), a2, 1);
            PG8_WAIT_V(8); PG8_WAIT_L(0); PG8_BAR; PG8_MMA(0, 0, At, B0); PG8_MMA(0, 1, At, B1); PG8_BAR; PG8_SCHED;
            PG8_LDA(At, 1, 1); PG8_STAGE(PG8_SB(1, 0), b3, voffB); PG8_STAGE(PG8_SB(1, 1), b3 + hstep, voffB); PG8_STAGE_A(PG8_SA(1, 0), a3, 0);
            PG8_WAIT_V(8); PG8_WAIT_L(0); PG8_BAR; PG8_MMA(1, 0, At, B0); PG8_MMA(1, 1, At, B1); PG8_BAR; PG8_SCHED;
        }
        if (wr == 0) PG8_BAR;
        { int tz = threadIdx.x; asm volatile("" : "+v"(tz)); E(acc, cur, wr, wc, tz & 15, (tz & 63) >> 4); }
        if (!has_next) break;
#pragma unroll
        for (int a = 0; a < 2; ++a)
#pragma unroll
            for (int b = 0; b < 2; ++b)
#pragma unroll
                for (int m = 0; m < 4; ++m)
#pragma unroll
                    for (int n = 0; n < 2; ++n) acc[a][b][m][n] = (f32x4){0.f, 0.f, 0.f, 0.f};
        cur = nxt; cA = nA; cB = nB; ++ui;
        if (wr == 1) PG8_BAR;
    }
    PG8_WAIT_V(0);
    PG8_BAR;
#undef PG8_SA
#undef PG8_SB
#undef PG8_STAGE
#undef PG8_STAGE_A
#undef PG8_LOAD_ROWOFFS
#undef PG8_LDA
#undef PG8_LDB
#undef PG8_MMA
#undef PG8_WAIT_V
#undef PG8_WAIT_L
#undef PG8_BAR
#undef PG8_SCHED
}
}

#define XB_TMO      128
#define XB_XCNT(j)  (256  + 64 * (j))
#define XB_XSUB(j)  (1280 + 64 * (j))
#define XB_XGEN(j)  (2304 + 64 * (j))
#define XB_TOP      3328
#define XB_TOPGEN   3392
#define XCD_BAR_WORDS 3456
#define XB_SPIN_CAP (1u << 18)
__device__ __forceinline__ unsigned xb_ld(unsigned* p)              { return __hip_atomic_load(p, __ATOMIC_RELAXED, __HIP_MEMORY_SCOPE_AGENT); }
__device__ __forceinline__ unsigned xb_add(unsigned* p, unsigned v) { return __hip_atomic_fetch_add(p, v, __ATOMIC_RELAXED, __HIP_MEMORY_SCOPE_AGENT); }
__device__ __forceinline__ unsigned xb_xcc_id() { return (unsigned)__builtin_amdgcn_s_getreg((3 << 11) | 20) & 0xFu; }
#define XB_SPIN(cond, bar) do { unsigned _sp = 0; while (cond) { __builtin_amdgcn_s_sleep(1); \
    if ((++_sp & 255u) == 0u) { if (xb_ld(&(bar)[XB_TMO])) break; if (_sp > XB_SPIN_CAP) { atomicAdd(&(bar)[XB_TMO], 1u); break; } } } } while (0)
struct XcdBarrier { unsigned* bar; unsigned x; volatile LAS unsigned* st; };
__device__ __forceinline__ XcdBarrier xcd_barrier_post(unsigned* bar, volatile LAS unsigned* st) {
    XcdBarrier b; b.bar = bar; b.x = xb_xcc_id(); b.st = st;
    if (threadIdx.x == 0) (void)xb_add(&bar[XB_XCNT(b.x)], 1u);
    return b;
}
__device__ __forceinline__ void xcd_barrier_complete(unsigned* bar, unsigned x, unsigned& nloc, unsigned& nx) {
    const unsigned G = gridDim.x * gridDim.y * gridDim.z;
    unsigned sum, cnt, mine, sp = 0u;
    for (;;) {
        sum = 0u; cnt = 0u; mine = 0u;
#pragma unroll 1
        for (unsigned j = 0; j < 16; ++j) { const unsigned c = xb_ld(&bar[XB_XCNT(j)]); sum += c; cnt += (c > 0u) ? 1u : 0u; mine = (j == x) ? c : mine; }
        if (sum == G) break;
        __builtin_amdgcn_s_sleep(1);
        if ((++sp & 255u) == 0u) { if (xb_ld(&bar[XB_TMO])) break; if (sp > XB_SPIN_CAP) { atomicAdd(&bar[XB_TMO], 1u); break; } }
    }
    nloc = mine > 0u ? mine : 1u; nx = cnt > 0u ? cnt : 1u;
}
__device__ __forceinline__ void xcd_barrier(const XcdBarrier& b) {
    asm volatile("s_waitcnt vmcnt(0)" ::: "memory");
    __syncthreads();
    if (threadIdx.x == 0) {
        unsigned* bar = b.bar;
        __builtin_amdgcn_s_waitcnt(0);
        unsigned nloc = b.st[0], nx = b.st[1];
        if (nloc == 0u) { xcd_barrier_complete(bar, b.x, nloc, nx); b.st[0] = nloc; b.st[1] = nx; }
        const unsigned old = xb_add(&bar[XB_XSUB(b.x)], 1u);
        const unsigned gen = old / nloc;
        if (old + 1u == (gen + 1u) * nloc) {
            __builtin_amdgcn_fence(__ATOMIC_RELEASE, "agent");
            asm volatile("s_waitcnt vmcnt(0)" ::: "memory");
            const unsigned og = xb_add(&bar[XB_TOP], 1u);
            const unsigned tg = og / nx;
            if (og + 1u == (tg + 1u) * nx) xb_add(&bar[XB_TOPGEN], 1u);
            else XB_SPIN(xb_ld(&bar[XB_TOPGEN]) == tg, bar);
            __builtin_amdgcn_fence(__ATOMIC_ACQUIRE, "agent");
            xb_add(&bar[XB_XGEN(b.x)], 1u);
            asm volatile("s_waitcnt vmcnt(0)" ::: "memory");
        } else {
            XB_SPIN(xb_ld(&bar[XB_XGEN(b.x)]) == gen, bar);
            __builtin_amdgcn_fence(__ATOMIC_ACQUIRE, "agent");
            asm volatile("s_waitcnt vmcnt(0)" ::: "memory");
        }
    }
    __syncthreads();
}

struct Args { const float* in[29]; float* out; unsigned char* ws; int ph_lo, ph_hi; };
enum { I_X = 0, I_MEM, I_MEM_G, I_MEM_B, I_W_IN, I_SGU_G, I_SGU_B, I_SGU_W, I_SGU_BS, I_POOL_W, I_POOL_S, I_CONV_W, I_CONV_B, I_CONV_G, I_CONV_LB, I_W_KV, I_W_OUT, I_LN1_G, I_LN1_B,
       I_W_R, I_R_BIAS, I_E_G, I_E_U, I_E_D, I_S_G, I_S_U, I_S_D, I_LN2_G, I_LN2_B };

struct Frame {
    LAS unsigned char* lds;
    int tid, lane, wave, vcu, G;
    const Args* a;
    unsigned char* ws;
};

struct ItemDesc { const float* W; bf16_t* WT; bf16_t* WL; int ldw, ldt, k0, n0, drow0; };
constexpr int LI_IN = 3072, LI_OUT = 2048, LI_EX = 64 * 256, LI_SH = 256, LI_PW = 4 * 8, LI_RT = 64;
constexpr int L_ITEMS = LI_IN + LI_OUT + 3 * LI_EX + 3 * LI_SH + LI_PW + LI_RT;
constexpr int KV_ITEMS = 4 * 1024;
constexpr int LI_X = 3 * LI_EX + 3 * LI_SH, LI_S = L_ITEMS - LI_X;
constexpr int Q_TOTAL = NL * L_ITEMS - LI_S;
constexpr int CW_Q = 8192;
constexpr int CW_PD = 10240;
constexpr int Q_CH = 8;
__device__ __forceinline__ ItemDesc item_desc(const Args& A, unsigned char* ws, int l, int r) {
    bf16_t* WT_IN = (bf16_t*)(ws + WS_WT_IN); bf16_t* WT_OUT = (bf16_t*)(ws + WS_WT_OUT);
    bf16_t* WT_GU = (bf16_t*)(ws + WS_WT_GU); bf16_t* WT_D = (bf16_t*)(ws + WS_WT_D); bf16_t* WPT = (bf16_t*)(ws + WS_WPT);
    ItemDesc d; d.WL = nullptr;
    if (r < LI_IN) { const int kb = r / 96, nb = r % 96; d.W = A.in[I_W_IN] + (size_t)l * D * INW; d.ldw = INW; d.WT = WT_IN + (size_t)l * INW * D; d.ldt = D; d.k0 = kb * 64; d.n0 = nb * 32; d.drow0 = nb * 32; return d; } r -= LI_IN;
    if (r < LI_OUT) { const int kb = r / 64, nb = r % 64; d.W = A.in[I_W_OUT] + (size_t)l * D * D; d.ldw = D; d.WT = WT_OUT + (size_t)l * D * D; d.ldt = D; d.k0 = kb * 64; d.n0 = nb * 32; d.drow0 = nb * 32; return d; } r -= LI_OUT;
    if (r < 2 * LI_EX) { const int up = r >= LI_EX; if (up) r -= LI_EX; const int e = r / 256, rem = r % 256, kb = rem / 8, nb = rem % 8, n0 = nb * 32;
        d.W = A.in[up ? I_E_U : I_E_G] + (size_t)(l * NE + e) * D * DE; d.ldw = DE; d.WT = WT_GU + (size_t)(l * NE1 + e) * 512 * D; d.ldt = D; d.k0 = kb * 64; d.n0 = n0; d.drow0 = (n0 >> 7) * 256 + up * 128 + (n0 & 127); return d; } r -= 2 * LI_EX;
    if (r < LI_EX) { const int e = r / 256, rem = r % 256, kb = rem / 64, nb = rem % 64;
        d.W = A.in[I_E_D] + (size_t)(l * NE + e) * DE * D; d.ldw = D; d.WT = WT_D + (size_t)(l * NE1 + e) * D * DE; d.ldt = DE; d.k0 = kb * 64; d.n0 = nb * 32; d.drow0 = nb * 32; return d; } r -= LI_EX;
    if (r < 2 * LI_SH) { const int up = r >= LI_SH; if (up) r -= LI_SH; const int kb = r / 8, nb = r % 8, n0 = nb * 32;
        d.W = A.in[up ? I_S_U : I_S_G] + (size_t)l * D * DE; d.ldw = DE; d.WT = WT_GU + (size_t)(l * NE1 + 64) * 512 * D; d.ldt = D; d.k0 = kb * 64; d.n0 = n0; d.drow0 = (n0 >> 7) * 256 + up * 128 + (n0 & 127); return d; } r -= 2 * LI_SH;
    if (r < LI_SH) { const int kb = r / 64, nb = r % 64; d.W = A.in[I_S_D] + (size_t)l * DE * D; d.ldw = D; d.WT = WT_D + (size_t)(l * NE1 + 64) * D * DE; d.ldt = DE; d.k0 = kb * 64; d.n0 = nb * 32; d.drow0 = nb * 32; return d; } r -= LI_SH;
    if (r < LI_PW) { const int g = r / 8, rem = r % 8, kb = rem / 4, nb = rem % 4; d.W = A.in[I_POOL_W] + (size_t)(l * 4 + g) * 128 * 128; d.ldw = 128; d.WT = WPT + (size_t)(l * 4 + g) * 128 * 128; d.ldt = 128; d.k0 = kb * 64; d.n0 = nb * 32; d.drow0 = nb * 32; return d; } r -= LI_PW;
    { const int kb = r / 2, nb = r % 2; d.W = A.in[I_W_R] + (size_t)l * D * NE; d.ldw = NE; d.WT = (bf16_t*)(ws + WS_WR_HI) + (size_t)l * NE * D; d.WL = (bf16_t*)(ws + WS_WR_LO) + (size_t)l * NE * D; d.ldt = D; d.k0 = kb * 64; d.n0 = nb * 32; d.drow0 = nb * 32; return d; }
}
__device__ __forceinline__ ItemDesc kv_desc(const Args& A, unsigned char* ws, int r) {
    const int mat = r / 1024, rem = r % 1024, kb = rem / 32, nb = rem % 32, n0 = nb * 32; ItemDesc d; d.WL = nullptr;
    d.W = A.in[I_W_KV] + (size_t)mat * D * 1024; d.ldw = 1024; d.WT = (bf16_t*)(ws + (n0 < 512 ? WS_WT_K : WS_WT_V)); d.ldt = D; d.k0 = kb * 64; d.n0 = n0; d.drow0 = mat * 512 + (n0 & 511); return d;
}
__device__ __forceinline__ void item_load(const ItemDesc& d, f32x4 (&v)[8], int lane) {
#pragma unroll
    for (int i = 0; i < 8; ++i) v[i] = __builtin_nontemporal_load((const GAS f32x4*)(d.W + (size_t)(d.k0 + 8 * i + (lane >> 3)) * d.ldw + d.n0 + 4 * (lane & 7)));
}
__device__ __forceinline__ void item_finish(const ItemDesc& d, const f32x4 (&v)[8], LAS float* scr, int lane) {
#pragma unroll
    for (int i = 0; i < 8; ++i) { LAS float* p = scr + (8 * i + (lane >> 3)) * 33 + 4 * (lane & 7); p[0] = v[i][0]; p[1] = v[i][1]; p[2] = v[i][2]; p[3] = v[i][3]; }
    LDS_WAIT(); asm volatile("" ::: "memory");
    const int c = lane & 7;
#pragma unroll
    for (int j = 0; j < 4; ++j) { const int n = (lane >> 3) + 8 * j; const LAS float* s = scr + (8 * c) * 33 + n;
        float x[8]; unsigned h[4];
#pragma unroll
        for (int q = 0; q < 8; ++q) x[q] = s[q * 33];
#pragma unroll
        for (int q = 0; q < 4; ++q) h[q] = cvt_pk_bf16(x[2 * q], x[2 * q + 1]);
        if (!d.WL) __builtin_nontemporal_store((u32x4){h[0], h[1], h[2], h[3]}, (GAS u32x4*)(d.WT + (size_t)(d.drow0 + n) * d.ldt + d.k0 + 8 * c));
        else { unsigned lo[4];
            const int nn = d.drow0 + n, kk = d.k0 + 8 * c; const size_t off = ((size_t)((nn >> 4) * (D / 32) + (kk >> 5)) * 64 + 16 * ((kk & 31) >> 3) + (nn & 15)) * 8;
#pragma unroll
            for (int q = 0; q < 4; ++q) lo[q] = cvt_pk_bf16(x[2 * q] - bf_lo(h[q]), x[2 * q + 1] - bf_hi(h[q]));
            *(GAS u32x4*)(d.WT + off) = (u32x4){h[0], h[1], h[2], h[3]}; *(GAS u32x4*)(d.WL + off) = (u32x4){lo[0], lo[1], lo[2], lo[3]}; } }
    LDS_WAIT(); asm volatile("" ::: "memory");
}
__device__ __forceinline__ int s_item(int s) { return s < LI_IN + LI_OUT ? s : s + LI_X; }
struct GenPrologue { __device__ __forceinline__ ItemDesc operator()(const Args& A, unsigned char* ws, int id) const { return id < LI_S ? item_desc(A, ws, 0, s_item(id)) : kv_desc(A, ws, id - LI_S); } };
struct GenQueue    { __device__ __forceinline__ ItemDesc operator()(const Args& A, unsigned char* ws, int id) const { const int l = id / L_ITEMS, j = id % L_ITEMS;
    return j < LI_X ? item_desc(A, ws, l, LI_IN + LI_OUT + j) : item_desc(A, ws, l + 1, s_item(j - LI_X)); } };
template <class Gen> __device__ __forceinline__ void convert_seq(const Args& A, unsigned char* ws, int first, int end, int stride, LAS float* scr, int lane) {
    if (first >= end) return;
    const Gen gen; ItemDesc d0 = gen(A, ws, first); f32x4 v0[8]; item_load(d0, v0, lane);
#pragma unroll 1
    for (int id = first + stride; id < end; id += stride) { const ItemDesc d1 = gen(A, ws, id); f32x4 v1[8]; item_load(d1, v1, lane); item_finish(d0, v0, scr, lane); d0 = d1;
#pragma unroll
        for (int i = 0; i < 8; ++i) v0[i] = v1[i]; }
    item_finish(d0, v0, scr, lane);
}
__device__ __forceinline__ void convert_fill(Frame& F, int floor, int budget, unsigned* stop = nullptr, unsigned stop_at = 0u) {
    const Args& A = *F.a; LAS float* scr = (LAS float*)(F.lds + F.wave * 16384);
    unsigned* qh = (unsigned*)(F.ws + WS_CTL) + CW_Q;
#pragma unroll 1
    for (int b = 0; b < budget; ++b) {
        if (stop && __builtin_amdgcn_readfirstlane(xb_ld(stop)) >= stop_at) break;
        unsigned st = 0u; if (F.lane == 0) st = __hip_atomic_fetch_add(qh, (unsigned)Q_CH, __ATOMIC_RELAXED, __HIP_MEMORY_SCOPE_AGENT);
        const int s0 = __builtin_amdgcn_readfirstlane((int)st);
        if (s0 >= Q_TOTAL) break;
        const int lo = s0 > floor ? s0 : floor, hi = (s0 + Q_CH) < Q_TOTAL ? (s0 + Q_CH) : Q_TOTAL;
        if (lo >= hi) { ++budget; if (budget > (1 << 20)) break; continue; }
        convert_seq<GenQueue>(A, F.ws, lo, hi, 1, scr, F.lane);
    }
}
__device__ __forceinline__ void convert_paced(Frame& F, int floor, unsigned* stop, unsigned stop_at) {
    const Args& A = *F.a; LAS float* scr = (LAS float*)(F.lds + F.wave * 16384); const int lane = F.lane;
    unsigned* qh = (unsigned*)(F.ws + WS_CTL) + CW_Q;
    long long tn = (long long)wall_clock64() + F.wave * (PACE / 8); bool stopped = false;
#define PACE_WAIT() do { tn += PACE; long long now_ = (long long)wall_clock64(); if (now_ - tn > 2 * PACE) tn = now_ - 2 * PACE; \
        while (!stopped && now_ < tn) { __builtin_amdgcn_s_sleep(32); stopped = __builtin_amdgcn_readfirstlane(xb_ld(stop)) >= stop_at; now_ = (long long)wall_clock64(); } } while (0)
#pragma unroll 1
    for (int b = 0; b < FILL_CAP; ++b) {
        if (stopped || __builtin_amdgcn_readfirstlane(xb_ld(stop)) >= stop_at) break;
        unsigned st = 0u; if (lane == 0) st = __hip_atomic_fetch_add(qh, (unsigned)Q_CP, __ATOMIC_RELAXED, __HIP_MEMORY_SCOPE_AGENT);
        const int s0 = __builtin_amdgcn_readfirstlane((int)st);
        if (s0 >= Q_TOTAL) break;
        const int lo = s0 > floor ? s0 : floor, hi = (s0 + Q_CP) < Q_TOTAL ? (s0 + Q_CP) : Q_TOTAL;
        if (lo >= hi) continue;
        const GenQueue gen; ItemDesc d0 = gen(A, F.ws, lo); f32x4 v0[8]; item_load(d0, v0, lane);
#pragma unroll 1
        for (int id = lo + 1; id < hi; ++id) { PACE_WAIT(); const ItemDesc d1 = gen(A, F.ws, id); f32x4 v1[8]; item_load(d1, v1, lane); item_finish(d0, v0, scr, lane); d0 = d1;
#pragma unroll
            for (int i = 0; i < 8; ++i) v0[i] = v1[i]; }
        PACE_WAIT(); item_finish(d0, v0, scr, lane);
    }
#undef PACE_WAIT
}
__device__ __forceinline__ void convert_cleanup(Frame& F, int from, int upto) {
    const Args& A = *F.a; LAS float* scr = (LAS float*)(F.lds + F.wave * 16384);
    unsigned* qh = (unsigned*)(F.ws + WS_CTL) + CW_Q;
    int head = __builtin_amdgcn_readfirstlane((int)__hip_atomic_load(qh, __ATOMIC_RELAXED, __HIP_MEMORY_SCOPE_AGENT)); head = head > from ? head : from;
    convert_seq<GenQueue>(A, F.ws, head + F.vcu * 8 + F.wave, upto, F.G * 8, scr, F.lane);
}

__device__ __forceinline__ void convert_beside_d(Frame& F, int from, int upto) {
    const Args& A = *F.a; LAS float* scr = (LAS float*)(F.lds + 81920 + (F.wave - 4) * 8704);
    unsigned* qh = (unsigned*)(F.ws + WS_CTL) + CW_Q;
    int head = __builtin_amdgcn_readfirstlane((int)__hip_atomic_load(qh, __ATOMIC_RELAXED, __HIP_MEMORY_SCOPE_AGENT)); head = head > from ? head : from;
    convert_seq<GenQueue>(A, F.ws, head + F.vcu * 4 + (F.wave - 4), upto, F.G * 4, scr, F.lane);
}
__device__ __forceinline__ void p0_prologue(Frame& F) {
    const Args& A = *F.a; unsigned char* ws = F.ws;
    LAS float* scr = (LAS float*)(F.lds + F.wave * 16384);
    const int gw = F.vcu * 8 + F.wave, NGW = F.G * 8, lane = F.lane;
    convert_seq<GenPrologue>(A, ws, gw, LI_S + KV_ITEMS, NGW, scr, lane);
    { const int gt = F.vcu * 512 + F.tid, NGT = F.G * 512; bf16_t* SW = (bf16_t*)(ws + WS_SGUW);
      for (int i = gt; i < NL * 4 * 128 * 128 / 8; i += NGT) { const int t = (i >> 4) & 127, s0 = (i & 15) * 8; const f32x4* p = (const f32x4*)(A.in[I_SGU_W] + (size_t)i * 8); const f32x4 a = p[0], b = p[1];
          float v[8] = {a[0], a[1], a[2], a[3], b[0], b[1], b[2], b[3]};
#pragma unroll
          for (int q = 0; q < 8; ++q) v[q] = (s0 + q <= t) ? v[q] : 0.f;
          *(u32x4*)(SW + (size_t)i * 8) = (u32x4){cvt_pk_bf16(v[0], v[1]), cvt_pk_bf16(v[2], v[3]), cvt_pk_bf16(v[4], v[5]), cvt_pk_bf16(v[6], v[7])}; }
      bf16_t* XB = (bf16_t*)(ws + WS_XB);
      for (int i = gt; i < NTOK * D / 8; i += NGT) { const f32x4* p = (const f32x4*)(A.in[I_X] + (size_t)i * 8); const f32x4 a = p[0], b = p[1];
          *(u32x4*)(XB + (size_t)i * 8) = (u32x4){cvt_pk_bf16(a[0], a[1]), cvt_pk_bf16(a[2], a[3]), cvt_pk_bf16(b[0], b[1]), cvt_pk_bf16(b[2], b[3])}; } }
    if (F.vcu == 0 && F.tid < 256) *(u32x4*)((bf16_t*)(ws + WS_X1B) + (size_t)NTOK * D + F.tid * 8) = (u32x4){0u, 0u, 0u, 0u};
    { bf16_t* MN = (bf16_t*)(ws + WS_MEMN);
      for (int m = gw; m < NMEMTOK; m += NGW) { const f32x4* xr = (const f32x4*)(A.in[I_MEM] + (size_t)m * D) + lane; f32x4 v[8]; float s = 0.f;
#pragma unroll
          for (int j = 0; j < 8; ++j) { v[j] = xr[64 * j]; s += (v[j][0] + v[j][1]) + (v[j][2] + v[j][3]); }
          const float mean = wave_sum(s) * (1.f / D); float s2 = 0.f;
#pragma unroll
          for (int j = 0; j < 8; ++j) { v[j] = v[j] - mean; s2 += (v[j][0] * v[j][0] + v[j][1] * v[j][1]) + (v[j][2] * v[j][2] + v[j][3] * v[j][3]); }
          const float rstd = 1.f / sqrtf(wave_sum(s2) * (1.f / D) + LN_EPS);
#pragma unroll
          for (int j = 0; j < 8; ++j) { const f32x4 g = ((const f32x4*)A.in[I_MEM_G])[lane + 64 * j], b = ((const f32x4*)A.in[I_MEM_B])[lane + 64 * j]; const f32x4 o = v[j] * rstd * g + b;
              *(u32x2*)(MN + (size_t)m * D + 4 * lane + 256 * j) = (u32x2){cvt_pk_bf16(o[0], o[1]), cvt_pk_bf16(o[2], o[3])}; } } }
}

typedef f32x4 acc8_t[8];
__device__ __forceinline__ void mixer_sgu(Frame& F, int l, int chunk, int h) {
    const Args& A = *F.a; const int lane = F.lane, w = F.wave, fr = lane & 15, g = lane >> 4, t0 = chunk * 128;
    const bf16_t* HB = (const bf16_t*)(F.ws + WS_HB); bf16_t* MIX = (bf16_t*)(F.ws + WS_MIX); const bf16_t* SW = (const bf16_t*)(F.ws + WS_SGUW) + (size_t)(l * 4 + h) * 128 * 128;
    LAS unsigned char* VT = F.lds;
    const int t = 16 * w + fr;
    bf16x8 af[4]; u32x2 uraw[8];
#pragma unroll
    for (int ks = 0; ks < 4; ++ks) af[ks] = *(const GAS bf16x8*)(SW + (size_t)t * 128 + 32 * ks + 8 * g);
#pragma unroll
    for (int j = 0; j < 8; ++j) uraw[j] = *(const GAS u32x2*)(HB + (size_t)(t0 + t) * INW + h * 128 + 16 * j + 4 * g);
    const float bs = A.in[I_SGU_BS][(size_t)(l * 128 + t) * 4 + h];
    { const float* gp = A.in[I_SGU_G] + l * GW + h * 128 + 8 * fr; const float* bp = A.in[I_SGU_B] + l * GW + h * 128 + 8 * fr;
      const f32x4 g0 = *(const f32x4*)gp, g1 = *(const GAS f32x4*)(gp + 4), b0 = *(const f32x4*)bp, b1 = *(const GAS f32x4*)(bp + 4);
      const float gg[8] = {g0[0], g0[1], g0[2], g0[3], g1[0], g1[1], g1[2], g1[3]}, bb[8] = {b0[0], b0[1], b0[2], b0[3], b1[0], b1[1], b1[2], b1[3]};
      u32x4 raw[4];
#pragma unroll
      for (int p = 0; p < 4; ++p) raw[p] = *(const GAS u32x4*)(HB + (size_t)(t0 + 16 * w + 4 * p + g) * INW + 512 + h * 128 + 8 * fr);
#pragma unroll
      for (int p = 0; p < 4; ++p) { const int tok = 16 * w + 4 * p + g;
          float v[8] = {bf_lo(raw[p].x), bf_hi(raw[p].x), bf_lo(raw[p].y), bf_hi(raw[p].y), bf_lo(raw[p].z), bf_hi(raw[p].z), bf_lo(raw[p].w), bf_hi(raw[p].w)}; float s = 0.f;
#pragma unroll
          for (int q = 0; q < 8; ++q) { v[q] = gelu_tanh_f(v[q]); s += v[q]; }
          const float mean = g16_sum(s) * (1.f / 128.f); float s2 = 0.f;
#pragma unroll
          for (int q = 0; q < 8; ++q) { v[q] -= mean; s2 += v[q] * v[q]; }
          const float rstd = 1.f / sqrtf(g16_sum(s2) * (1.f / 128.f) + LN_EPS);
#pragma unroll
          for (int q = 0; q < 8; q += 2) { const unsigned pk = cvt_pk_bf16(v[q] * rstd * gg[q] + bb[q], v[q + 1] * rstd * gg[q + 1] + bb[q + 1]);
              const int d0 = 8 * fr + q, d1 = d0 + 1;
              *(LAS bf16_t*)(VT + d0 * 256 + ((((tok >> 3) ^ d0 ^ (d0 >> 3)) & 15) << 4) + (tok & 7) * 2) = (bf16_t)(pk & 0xffffu);
              *(LAS bf16_t*)(VT + d1 * 256 + ((((tok >> 3) ^ d1 ^ (d1 >> 3)) & 15) << 4) + (tok & 7) * 2) = (bf16_t)(pk >> 16); } } }
    __syncthreads();
    f32x4 acc[8];
#pragma unroll
    for (int j = 0; j < 8; ++j) acc[j] = (f32x4){0.f, 0.f, 0.f, 0.f};
    const int nks = (w >> 1) + 1;
#pragma unroll
    for (int ks = 0; ks < 4; ++ks) if (ks < nks) {
#pragma unroll
        for (int j = 0; j < 8; ++j) { const int d = 16 * j + fr; const bf16x8 bfr = *(const LAS bf16x8*)(VT + d * 256 + ((((4 * ks + g) ^ d ^ (d >> 3)) & 15) << 4));
            acc[j] = __builtin_amdgcn_mfma_f32_16x16x32_bf16(bfr, af[ks], acc[j], 0, 0, 0); }
    }
#pragma unroll
    for (int j = 0; j < 8; ++j) { const u32x2 raw = uraw[j];
        const float u0 = gelu_tanh_f(bf_lo(raw.x)), u1 = gelu_tanh_f(bf_hi(raw.x)), u2 = gelu_tanh_f(bf_lo(raw.y)), u3 = gelu_tanh_f(bf_hi(raw.y));
        *(GAS u32x2*)(MIX + (size_t)(t0 + t) * D + h * 128 + 16 * j + 4 * g) = (u32x2){cvt_pk_bf16(u0 * (acc[j][0] + bs), u1 * (acc[j][1] + bs)), cvt_pk_bf16(u2 * (acc[j][2] + bs), u3 * (acc[j][3] + bs))}; }
    __syncthreads();
}
__device__ __forceinline__ void mixer_pool(Frame& F, int l, int chunk, int grp) {
    const Args& A = *F.a; const int lane = F.lane, w = F.wave, fr = lane & 15, g = lane >> 4, t0 = chunk * 128, tid = F.tid;
    const bf16_t* HB = (const bf16_t*)(F.ws + WS_HB); bf16_t* MIX = (bf16_t*)(F.ws + WS_MIX); const bf16_t* WP = (const bf16_t*)(F.ws + WS_WPT) + (size_t)(l * 4 + grp) * 128 * 128;
    constexpr int PST = 272;
    LAS unsigned char* PT = F.lds;
    LAS unsigned char* PA = F.lds + 144 * PST;
    const int win = 2 << grp, pos0 = t0 & (SEQ - 1);
    LAS unsigned char* WS = F.lds + 144 * PST + 128 * PST;
    { u32x4 wv4[4];
#pragma unroll
      for (int i = 0; i < 4; ++i) wv4[i] = *(const GAS u32x4*)(WP + (size_t)(tid + 512 * i) * 8);
      for (int i = tid; i < 144 * 16; i += 512) { const int r = i >> 4, cc = i & 15; const int trow = t0 - 16 + r; u32x4 v = (u32x4){0u, 0u, 0u, 0u};
          if (pos0 - 16 + r >= 0) v = *(const GAS u32x4*)(HB + (size_t)trow * INW + 1024 + grp * 128 + 8 * cc);
          *(LAS u32x4*)(PT + r * PST + cc * 16) = v; }
#pragma unroll
      for (int i = 0; i < 4; ++i) { const int id = tid + 512 * i, d = id >> 4, cc = id & 15; *(LAS u32x4*)(WS + d * 256 + ((cc ^ (d & 15)) << 4)) = wv4[i]; } }
    f32x4 scv[8];
#pragma unroll
    for (int j = 0; j < 8; ++j) scv[j] = *(const GAS f32x4*)(A.in[I_POOL_S] + l * GW + grp * 128 + 16 * j + 4 * g);
    __syncthreads();
    for (int i = tid; i < 128 * 16; i += 512) { const int t = i >> 4, cc = i & 15; float s[8] = {0.f, 0.f, 0.f, 0.f, 0.f, 0.f, 0.f, 0.f}; u32x4 cur = (u32x4){0u, 0u, 0u, 0u};
        for (int j = 0; j < win; ++j) { cur = *(const LAS u32x4*)(PT + (t + 16 - win + 1 + j) * PST + cc * 16);
            s[0] += bf_lo(cur.x); s[1] += bf_hi(cur.x); s[2] += bf_lo(cur.y); s[3] += bf_hi(cur.y); s[4] += bf_lo(cur.z); s[5] += bf_hi(cur.z); s[6] += bf_lo(cur.w); s[7] += bf_hi(cur.w); }
        const int pos = pos0 + t; const float inv = 1.0f / (float)((pos + 1) < win ? (pos + 1) : win);
        const float x[8] = {bf_lo(cur.x), bf_hi(cur.x), bf_lo(cur.y), bf_hi(cur.y), bf_lo(cur.z), bf_hi(cur.z), bf_lo(cur.w), bf_hi(cur.w)};
        *(LAS u32x4*)(PA + t * PST + cc * 16) = (u32x4){cvt_pk_bf16(s[0] * inv - x[0], s[1] * inv - x[1]), cvt_pk_bf16(s[2] * inv - x[2], s[3] * inv - x[3]),
                                                        cvt_pk_bf16(s[4] * inv - x[4], s[5] * inv - x[5]), cvt_pk_bf16(s[6] * inv - x[6], s[7] * inv - x[7])}; }
    __syncthreads();
    f32x4 acc[8];
#pragma unroll
    for (int j = 0; j < 8; ++j) acc[j] = (f32x4){0.f, 0.f, 0.f, 0.f};
#pragma unroll
    for (int ks = 0; ks < 4; ++ks) { const bf16x8 af = *(const LAS bf16x8*)(PA + (16 * w + fr) * PST + (32 * ks + 8 * g) * 2);
#pragma unroll
        for (int j = 0; j < 8; ++j) { const bf16x8 bfr = *(const LAS bf16x8*)(WS + (16 * j + fr) * 256 + (((4 * ks + g) ^ fr) << 4));
            acc[j] = __builtin_amdgcn_mfma_f32_16x16x32_bf16(bfr, af, acc[j], 0, 0, 0); } }
    { const int t = 16 * w + fr;
#pragma unroll
      for (int j = 0; j < 8; ++j) { const f32x4 sc = scv[j];
          *(GAS u32x2*)(MIX + (size_t)(t0 + t) * D + 512 + grp * 128 + 16 * j + 4 * g) = (u32x2){cvt_pk_bf16(acc[j][0] * sc[0], acc[j][1] * sc[1]), cvt_pk_bf16(acc[j][2] * sc[2], acc[j][3] * sc[3])}; } }
    __syncthreads();
}
__device__ __forceinline__ void mixer_conv(Frame& F, int l, int chunk, int grp) {
    const Args& A = *F.a; const int lane = F.lane, w = F.wave, fr = lane & 15, g = lane >> 4, t0 = chunk * 128, tid = F.tid;
    const bf16_t* HB = (const bf16_t*)(F.ws + WS_HB); bf16_t* MIX = (bf16_t*)(F.ws + WS_MIX);
    LAS float* GT = (LAS float*)F.lds;
    const int pos0 = t0 & (SEQ - 1);
    for (int i = tid; i < 158 * 16; i += 512) { const int r = i >> 4, cc = i & 15; float o[8] = {0.f, 0.f, 0.f, 0.f, 0.f, 0.f, 0.f, 0.f};
        if (pos0 - 30 + r >= 0) { const bf16_t* rowp = HB + (size_t)(t0 - 30 + r) * INW + grp * 128 + 8 * cc; const u32x4 v = *(const GAS u32x4*)(rowp + 1536), gt = *(const GAS u32x4*)(rowp + 2048);
            o[0] = bf_lo(v.x) * fast_sigmoid(bf_lo(gt.x)); o[1] = bf_hi(v.x) * fast_sigmoid(bf_hi(gt.x)); o[2] = bf_lo(v.y) * fast_sigmoid(bf_lo(gt.y)); o[3] = bf_hi(v.y) * fast_sigmoid(bf_hi(gt.y));
            o[4] = bf_lo(v.z) * fast_sigmoid(bf_lo(gt.z)); o[5] = bf_hi(v.z) * fast_sigmoid(bf_hi(gt.z)); o[6] = bf_lo(v.w) * fast_sigmoid(bf_lo(gt.w)); o[7] = bf_hi(v.w) * fast_sigmoid(bf_hi(gt.w)); }
        *(LAS f32x4*)(GT + r * 128 + 8 * cc) = (f32x4){o[0], o[1], o[2], o[3]}; *(LAS f32x4*)(GT + r * 128 + 8 * cc + 4) = (f32x4){o[4], o[5], o[6], o[7]}; }
    __syncthreads();
    float y[32];
    { const int ch = tid & 127, tg = tid >> 7; float wv[31];
#pragma unroll
      for (int j = 0; j < 31; ++j) wv[j] = A.in[I_CONV_W][(size_t)(l * 31 + j) * GW + grp * 128 + ch];
      const float bias = A.in[I_CONV_B][l * GW + grp * 128 + ch];
      float xin[62];
#pragma unroll
      for (int j = 0; j < 62; ++j) xin[j] = GT[(tg * 32 + j) * 128 + ch];
#pragma unroll
      for (int t = 0; t < 32; ++t) { float s = bias;
#pragma unroll
          for (int j = 0; j < 31; ++j) s += wv[j] * xin[t + j];
          y[t] = s; }
      __syncthreads();
#pragma unroll
      for (int t = 0; t < 32; ++t) GT[(tg * 32 + t) * 128 + ch] = y[t]; }
    __syncthreads();
    { const float* gp = A.in[I_CONV_G] + l * GW + grp * 128 + 8 * fr; const float* bp = A.in[I_CONV_LB] + l * GW + grp * 128 + 8 * fr;
      const f32x4 g0 = *(const f32x4*)gp, g1 = *(const GAS f32x4*)(gp + 4), b0 = *(const f32x4*)bp, b1 = *(const GAS f32x4*)(bp + 4);
      const float gg[8] = {g0[0], g0[1], g0[2], g0[3], g1[0], g1[1], g1[2], g1[3]}, bb[8] = {b0[0], b0[1], b0[2], b0[3], b1[0], b1[1], b1[2], b1[3]};
#pragma unroll
      for (int p = 0; p < 4; ++p) { const int tok = 16 * w + 4 * p + g; const f32x4 a = *(const LAS f32x4*)(GT + tok * 128 + 8 * fr), b = *(const LAS f32x4*)(GT + tok * 128 + 8 * fr + 4);
          float v[8] = {a[0], a[1], a[2], a[3], b[0], b[1], b[2], b[3]}; float s = 0.f;
#pragma unroll
          for (int q = 0; q < 8; ++q) s += v[q];
          const float mean = g16_sum(s) * (1.f / 128.f); float s2 = 0.f;
#pragma unroll
          for (int q = 0; q < 8; ++q) { v[q] -= mean; s2 += v[q] * v[q]; }
          const float rstd = 1.f / sqrtf(g16_sum(s2) * (1.f / 128.f) + LN_EPS);
#pragma unroll
          for (int q = 0; q < 8; ++q) v[q] = silu_f(v[q] * rstd * gg[q] + bb[q]);
          *(GAS u32x4*)(MIX + (size_t)(t0 + tok) * D + 1024 + grp * 128 + 8 * fr) = (u32x4){cvt_pk_bf16(v[0], v[1]), cvt_pk_bf16(v[2], v[3]), cvt_pk_bf16(v[4], v[5]), cvt_pk_bf16(v[6], v[7])}; } }
    __syncthreads();
}
__device__ __forceinline__ void mixer_attn(Frame& F, int l, int chunk, int h) {
    const int lane = F.lane, w = F.wave, fr = lane & 15, g = lane >> 4, t0 = chunk * 128, b = t0 / SEQ, tid = F.tid;
    const bf16_t* HB = (const bf16_t*)(F.ws + WS_HB); bf16_t* MIX = (bf16_t*)(F.ws + WS_MIX);
    const bf16_t* KB = (const bf16_t*)(F.ws + WS_KBUF) + (size_t)(b * 256) * D + l * 512 + h * 128;
    const bf16_t* VTp = (const bf16_t*)(F.ws + WS_VT) + (size_t)(l * 512 + h * 128) * NMEMTOK + b * 256;
    LAS unsigned char* KS = F.lds;
    LAS unsigned char* VS = F.lds + 65536;
    { u32x4 kv[8], vv[8];
#pragma unroll
      for (int i = 0; i < 8; ++i) { const int id = tid + 512 * i; kv[i] = *(const GAS u32x4*)(KB + (size_t)(id >> 4) * D + (id & 15) * 8); vv[i] = *(const GAS u32x4*)(VTp + (size_t)(id >> 5) * NMEMTOK + (id & 31) * 8); }
#pragma unroll
      for (int i = 0; i < 8; ++i) { const int id = tid + 512 * i; const int m = id >> 4, c = id & 15, d = id >> 5, c2 = id & 31;
          *(LAS u32x4*)(KS + m * 256 + ((c ^ (m & 15)) << 4)) = kv[i]; *(LAS u32x4*)(VS + d * 512 + ((c2 ^ (d & 15)) << 4)) = vv[i]; } }
    __syncthreads();
    const int t = 16 * w + fr;
    f32x4 sa[16];
#pragma unroll
    for (int j = 0; j < 16; ++j) sa[j] = (f32x4){0.f, 0.f, 0.f, 0.f};
    bf16x8 qf[4];
#pragma unroll
    for (int ks = 0; ks < 4; ++ks) qf[ks] = *(const GAS bf16x8*)(HB + (size_t)(t0 + t) * INW + 2560 + h * 128 + 32 * ks + 8 * g);
#pragma unroll
    for (int ks = 0; ks < 4; ++ks)
#pragma unroll
        for (int j = 0; j < 16; ++j) { const bf16x8 kf = *(const LAS bf16x8*)(KS + (16 * j + fr) * 256 + (((4 * ks + g) ^ fr) << 4));
            sa[j] = __builtin_amdgcn_mfma_f32_16x16x32_bf16(kf, qf[ks], sa[j], 0, 0, 0); }
    float mx = -3.0e38f;
#pragma unroll
    for (int j = 0; j < 16; ++j) mx = fmaxf(mx, fmaxf(fmaxf(sa[j][0], sa[j][1]), fmaxf(sa[j][2], sa[j][3])));
    mx = fmaxf(mx, __shfl_xor(mx, 16)); mx = fmaxf(mx, __shfl_xor(mx, 32));
    const float sc = 0.08838834764831845f * 1.4426950408889634f; float sum = 0.f;
#pragma unroll
    for (int j = 0; j < 16; ++j)
#pragma unroll
        for (int r = 0; r < 4; ++r) { const float p = __builtin_amdgcn_exp2f((sa[j][r] - mx) * sc); sa[j][r] = p; sum += p; }
    sum += __shfl_xor(sum, 16); sum += __shfl_xor(sum, 32);
    const float inv = 1.0f / sum;
    f32x4 oa[8];
#pragma unroll
    for (int j = 0; j < 8; ++j) oa[j] = (f32x4){0.f, 0.f, 0.f, 0.f};
#pragma unroll
    for (int q = 0; q < 8; ++q) {
        union { bf16x8 v; unsigned u[4]; } pf; pf.u[0] = cvt_pk_bf16(sa[2 * q][0], sa[2 * q][1]); pf.u[1] = cvt_pk_bf16(sa[2 * q][2], sa[2 * q][3]);
        pf.u[2] = cvt_pk_bf16(sa[2 * q + 1][0], sa[2 * q + 1][1]); pf.u[3] = cvt_pk_bf16(sa[2 * q + 1][2], sa[2 * q + 1][3]);
#pragma unroll
        for (int jd = 0; jd < 8; ++jd) {
            const LAS unsigned char* vrow = VS + (16 * jd + fr) * 512 + ((g & 1) << 3);
            union { bf16x8 v; u32x2 u[2]; } vf; vf.u[0] = *(const LAS u32x2*)(vrow + (((4 * q + (g >> 1)) ^ fr) << 4)); vf.u[1] = *(const LAS u32x2*)(vrow + (((4 * q + 2 + (g >> 1)) ^ fr) << 4));
            oa[jd] = __builtin_amdgcn_mfma_f32_16x16x32_bf16(vf.v, pf.v, oa[jd], 0, 0, 0); } }
#pragma unroll
    for (int jd = 0; jd < 8; ++jd)
        *(GAS u32x2*)(MIX + (size_t)(t0 + t) * D + 1536 + h * 128 + 16 * jd + 4 * g) = (u32x2){cvt_pk_bf16(oa[jd][0] * inv, oa[jd][1] * inv), cvt_pk_bf16(oa[jd][2] * inv, oa[jd][3] * inv)};
    __syncthreads();
}

#if PROBE_CLASS >= 0
#define PROBE_SUB(F, cls) do { if (blockIdx.x == 0 && (F).tid == 0) { volatile LAS unsigned* M_ = (volatile LAS unsigned*)((F).lds + LDS_MISC); const unsigned n_ = (unsigned)wall_clock64(); if ((cls) == PROBE_CLASS || PROBE_CLASS == 99) M_[65] += n_ - M_[64]; M_[64] = n_; } } while (0)
#else
#define PROBE_SUB(F, cls) do { } while (0)
#endif
template <int NW> __device__ __forceinline__ void dsync(LAS unsigned* ctr, unsigned& nb, int lane) {
    if constexpr (NW == 8) { asm volatile("s_waitcnt vmcnt(0)" ::: "memory"); __syncthreads(); }
    else { asm volatile("s_waitcnt vmcnt(0) lgkmcnt(0)" ::: "memory"); ++nb;
        if (lane == 0) __hip_atomic_fetch_add(ctr, 1u, __ATOMIC_RELAXED, __HIP_MEMORY_SCOPE_WORKGROUP);
        while (__hip_atomic_load(ctr, __ATOMIC_RELAXED, __HIP_MEMORY_SCOPE_WORKGROUP) < (unsigned)NW * nb) __builtin_amdgcn_s_sleep(1);
        asm volatile("" ::: "memory"); }
}
template <int NW> __device__ __forceinline__ void phase_d(Frame& F, int l) {
    constexpr int TPW = 32 / NW, KW = D / NW;
    const Args& A = *F.a; unsigned char* ws = F.ws; const int lane = F.lane, w = F.wave, tid = F.tid, fr = lane & 15, g = lane >> 4;
    const bf16_t* Y1 = (const bf16_t*)(ws + WS_Y1); bf16_t* X1L = (bf16_t*)(ws + WS_X1F); bf16_t* X1B = (bf16_t*)(ws + WS_X1B);
    const bf16_t* WRH = (const bf16_t*)(ws + WS_WR_HI) + (size_t)l * NE * D; const bf16_t* WRL = (const bf16_t*)(ws + WS_WR_LO) + (size_t)l * NE * D;
    int* LIST = (int*)(ws + WS_LIST); int* AEP = (int*)(ws + WS_ASG_EP); float* AW = (float*)(ws + WS_ASG_W);
    unsigned* CNT = (unsigned*)(ws + WS_CTL) + CW_CNT + (size_t)l * 64 * CNT_STRIDE;
    LAS float* PL = (LAS float*)F.lds;
    LAS unsigned* HIST = (LAS unsigned*)(F.lds + NW * 32 * 65 * 4);
    LAS unsigned* ctr = (LAS unsigned*)(F.lds + LDS_MISC) + 16; unsigned nb = 0u;
    for (int blk = F.vcu; blk < NTOK / 32; blk += F.G) {
        const int tok0 = blk * 32;
        if (tid < 128) HIST[tid] = 0u;
        PROBE_SUB(F, 8);
        { constexpr int PF = 2;
          const GAS u32x2* yb = (const GAS u32x2*)(Y1 + (size_t)(tok0 + TPW * w) * D) + lane;
          GAS u32x2* xh = (GAS u32x2*)(X1B + (size_t)(tok0 + TPW * w) * D) + lane; GAS u32x2* xl = (GAS u32x2*)(X1L + (size_t)(tok0 + TPW * w) * D) + lane;
          u32x2 raw[PF][8]; f32x4 gg[8], bb[8];
#pragma unroll
          for (int q = 0; q < PF; ++q)
#pragma unroll
              for (int j = 0; j < 8; ++j) raw[q][j] = yb[q * (D / 4) + 64 * j];
#pragma unroll
          for (int j = 0; j < 8; ++j) { gg[j] = ((const GAS f32x4*)(A.in[I_LN1_G] + l * D))[lane + 64 * j]; bb[j] = ((const GAS f32x4*)(A.in[I_LN1_B] + l * D))[lane + 64 * j]; }
#pragma unroll
          for (int tt = 0; tt < TPW; ++tt) { f32x4 v[8]; float s = 0.f;
#pragma unroll
              for (int j = 0; j < 8; ++j) { const u32x2 r = raw[tt % PF][j]; v[j] = (f32x4){bf_lo(r.x), bf_hi(r.x), bf_lo(r.y), bf_hi(r.y)}; s += (v[j][0] + v[j][1]) + (v[j][2] + v[j][3]); }
              if (tt + PF < TPW) {
#pragma unroll
                  for (int j = 0; j < 8; ++j) raw[tt % PF][j] = yb[(tt + PF) * (D / 4) + 64 * j]; }
              const float mean = wave_sum(s) * (1.f / D); float s2 = 0.f;
#pragma unroll
              for (int j = 0; j < 8; ++j) { v[j] = v[j] - mean; s2 += (v[j][0] * v[j][0] + v[j][1] * v[j][1]) + (v[j][2] * v[j][2] + v[j][3] * v[j][3]); }
              const float rstd = 1.f / sqrtf(wave_sum(s2) * (1.f / D) + LN_EPS);
#pragma unroll
              for (int j = 0; j < 8; ++j) { const f32x4 o = v[j] * rstd * gg[j] + bb[j];
                  const unsigned h0 = cvt_pk_bf16(o[0], o[1]), h1 = cvt_pk_bf16(o[2], o[3]);
                  xh[tt * (D / 4) + 64 * j] = (u32x2){h0, h1};
                  xl[tt * (D / 4) + 64 * j] = (u32x2){cvt_pk_bf16(o[0] - bf_lo(h0), o[1] - bf_hi(h0)), cvt_pk_bf16(o[2] - bf_lo(h1), o[3] - bf_hi(h1))}; } } }
        dsync<NW>(ctr, nb, lane); PROBE_SUB(F, 9);
        { f32x4 acc[2][4];
#pragma unroll
          for (int rb = 0; rb < 2; ++rb)
#pragma unroll
              for (int cb = 0; cb < 4; ++cb) acc[rb][cb] = (f32x4){0.f, 0.f, 0.f, 0.f};
          constexpr int NS = 2, NB = KW / 32;
          const GAS bf16x8* pah = (const GAS bf16x8*)(X1B + (size_t)(tok0 + fr) * D + KW * w + 8 * g); const GAS bf16x8* pal = (const GAS bf16x8*)(X1L + (size_t)(tok0 + fr) * D + KW * w + 8 * g);
          const GAS bf16x8* pbh = (const GAS bf16x8*)WRH + (KW / 32 * w) * 64 + lane;                   const GAS bf16x8* pbl = (const GAS bf16x8*)WRL + (KW / 32 * w) * 64 + lane;
          bf16x8 ah[NS][2], al[NS][2], bh[NS][4], bl[NS][4];
#define RT_LOAD(buf, b) do { const int ko = 4 * (b); \
              _Pragma("unroll") for (int rb = 0; rb < 2; ++rb) { ah[buf][rb] = pah[rb * 2 * D + ko]; al[buf][rb] = pal[rb * 2 * D + ko]; } \
              _Pragma("unroll") for (int cb = 0; cb < 4; ++cb) { bh[buf][cb] = pbh[cb * (D / 32) * 64 + 64 * (b)]; bl[buf][cb] = pbl[cb * (D / 32) * 64 + 64 * (b)]; } } while (0)
#pragma unroll
          for (int b = 0; b < NS - 1; ++b) RT_LOAD(b, b);
#pragma unroll 1
          for (int b0 = 0; b0 < NB; b0 += NS) {
#pragma unroll
              for (int s_ = 0; s_ < NS; ++s_) { const int b = b0 + s_;
                  if (b < NB) {
                      if (b + NS - 1 < NB) RT_LOAD((s_ + NS - 1) % NS, b + NS - 1);
                      __builtin_amdgcn_sched_barrier(0);
#pragma unroll
                      for (int cb = 0; cb < 4; ++cb)
#pragma unroll
                          for (int rb = 0; rb < 2; ++rb) { acc[rb][cb] = __builtin_amdgcn_mfma_f32_16x16x32_bf16(ah[s_][rb], bh[s_][cb], acc[rb][cb], 0, 0, 0);
                              acc[rb][cb] = __builtin_amdgcn_mfma_f32_16x16x32_bf16(ah[s_][rb], bl[s_][cb], acc[rb][cb], 0, 0, 0); acc[rb][cb] = __builtin_amdgcn_mfma_f32_16x16x32_bf16(al[s_][rb], bh[s_][cb], acc[rb][cb], 0, 0, 0); }
                      __builtin_amdgcn_sched_barrier(0); } } }
#undef RT_LOAD
#pragma unroll
          for (int rb = 0; rb < 2; ++rb)
#pragma unroll
              for (int cb = 0; cb < 4; ++cb)
#pragma unroll
                  for (int r = 0; r < 4; ++r) PL[(w * 32 + 16 * rb + 4 * g + r) * 65 + 16 * cb + fr] = acc[rb][cb][r]; }
        dsync<NW>(ctr, nb, lane); PROBE_SUB(F, 10);
        bool selv[TPW]; unsigned locv[TPW]; float wnv[TPW]; int kv[TPW];
        const float rbias = A.in[I_R_BIAS][l * NE + lane];
#pragma unroll
        for (int tt = 0; tt < TPW; ++tt) { const int tl = TPW * w + tt; float logit = 0.f;
#pragma unroll
            for (int ww = 0; ww < NW; ++ww) logit += PL[(ww * 32 + tl) * 65 + lane];
            const float score = 1.0f / (1.0f + __expf(-logit)), choice = score + rbias;
            float m1 = choice; m1 = fmaxf(m1, __shfl_xor(m1, 1)); m1 = fmaxf(m1, __shfl_xor(m1, 2)); m1 = fmaxf(m1, __shfl_xor(m1, 4));
            int i1 = (choice == m1) ? lane : 64; i1 = min(i1, __shfl_xor(i1, 1)); i1 = min(i1, __shfl_xor(i1, 2)); i1 = min(i1, __shfl_xor(i1, 4));
            float m2 = (lane == i1) ? -INFINITY : choice; m2 = fmaxf(m2, __shfl_xor(m2, 1)); m2 = fmaxf(m2, __shfl_xor(m2, 2)); m2 = fmaxf(m2, __shfl_xor(m2, 4));
            const float gs = m1 + m2; const int myg = lane >> 3; int grank = 0;
#pragma unroll
            for (int gg = 0; gg < 8; ++gg) { const float gv = __int_as_float(__builtin_amdgcn_readlane(__float_as_int(gs), 8 * gg)); grank += (gv > gs || (gv == gs && gg < myg)) ? 1 : 0; }
            const float mc = (grank < 4) ? choice : -INFINITY; int er = 0;
#pragma unroll
            for (int e2 = 0; e2 < 64; ++e2) { const float v = __int_as_float(__builtin_amdgcn_readlane(__float_as_int(mc), e2)); er += (v > mc || (v == mc && e2 < lane)) ? 1 : 0; }
            const bool sel = er < TOPK; const float wsum = wave_sum(sel ? score : 0.f);
            const unsigned long long mask = __ballot(sel);
            selv[tt] = sel; wnv[tt] = score / (wsum + 1e-20f) * 2.5f; kv[tt] = __popcll(mask & ((1ull << lane) - 1ull)); locv[tt] = 0u;
            if (sel) locv[tt] = __hip_atomic_fetch_add(&HIST[lane], 1u, __ATOMIC_RELAXED, __HIP_MEMORY_SCOPE_WORKGROUP); }
        dsync<NW>(ctr, nb, lane); PROBE_SUB(F, 11);
        if (tid < 64) { const unsigned n = HIST[tid]; HIST[64 + tid] = n ? __hip_atomic_fetch_add(CNT + tid * CNT_STRIDE, n, __ATOMIC_RELAXED, __HIP_MEMORY_SCOPE_AGENT) : 0u; }
        dsync<NW>(ctr, nb, lane);
#pragma unroll
        for (int tt = 0; tt < TPW; ++tt) if (selv[tt]) { const int tok = tok0 + TPW * w + tt; const unsigned pos = HIST[64 + lane] + locv[tt];
            LIST[lane * NTOK + pos] = tok; AEP[tok * 8 + kv[tt]] = (int)((unsigned)lane << 16 | pos); AW[tok * 8 + kv[tt]] = wnv[tt]; }
        dsync<NW>(ctr, nb, lane); PROBE_SUB(F, 12);
    }
}

__device__ __forceinline__ void build_etab(Frame& F, int l) {
    LAS int* ET = (LAS int*)(F.lds + LDS_ETAB);
    unsigned* CNT = (unsigned*)(F.ws + WS_CTL) + CW_CNT + (size_t)l * 64 * CNT_STRIDE;
    if (F.tid < NE1) ET[F.tid] = F.tid < NE ? (int)__hip_atomic_load(CNT + F.tid * CNT_STRIDE, __ATOMIC_RELAXED, __HIP_MEMORY_SCOPE_AGENT) : NTOK;
    __syncthreads();
    if (F.tid == 0) { int ts = 0;
#pragma unroll 1
        for (int e = 0; e < NE1; ++e) { ET[68 + e] = ts; ET[136 + e] = ts * 256; ts += (ET[e] + 255) >> 8; } ET[68 + NE1] = ts; }
    __syncthreads();
}
struct ExpertSched {
    LAS const int* UD;
    LAS const unsigned* RT;
    const char* Abase; const char* Bbase; size_t bstride_e, bstride_pn; int arow_bytes, ncol; bool gather;
    __device__ __forceinline__ bool next(int i, pg8::Unit& u) const {
        if (i >= 16) return false; const int e = __builtin_amdgcn_readfirstlane(UD[4 * i]); if (e < 0) return false;
        const int row0 = __builtin_amdgcn_readfirstlane(UD[4 * i + 1]), pn = __builtin_amdgcn_readfirstlane(UD[4 * i + 2]);
        u.A = gather ? Abase : Abase + (size_t)row0 * arow_bytes; u.B = Bbase + (size_t)e * bstride_e + (size_t)pn * bstride_pn; u.row0 = row0; u.col0 = pn * ncol; u.nvalid = __builtin_amdgcn_readfirstlane(UD[4 * i + 3]); u.aux = e; return true;
    }
    __device__ __forceinline__ unsigned rowoff(int i, int r) const { return RT[i * 256 + r]; }
};
__device__ __forceinline__ int phase_role(const Frame& F, int NU, int& Gp) {
    NU = __builtin_amdgcn_readfirstlane(NU);
    if (F.G != 256 || NU <= 0) { Gp = F.G; return F.vcu; }
    const int R = (NU + 255) / 256; int g = (NU + R - 1) / R; g = (g + 7) & ~7; if (g > 256) g = 256; Gp = g;
    const int per = g >> 3, x = F.vcu >> 5, r = F.vcu & 31;
    return r < per ? x * per + r : -1 - (x * (32 - per) + (r - per));
}
__device__ __forceinline__ void build_units(Frame& F, int npn, bool gather, int cp, int Gp) {
    LAS int* ET = (LAS int*)(F.lds + LDS_ETAB); LAS int* UD = (LAS int*)(F.lds + LDS_UDESC); LAS unsigned* RT = (LAS unsigned*)(F.lds + LDS_ROWTAB);
    const int NU = ET[68 + NE1] * npn;
    if (F.tid < 16) { const int U = cp + F.tid * Gp; int e = -1, row0 = 0, pn = 0, nv = 0;
        if (U < NU) { const int tile = U / npn; pn = U % npn; e = 0;
#pragma unroll 1
            while (e < NE && ET[68 + e + 1] <= tile) ++e; const int mt = tile - ET[68 + e]; row0 = ET[136 + e] + 256 * mt; nv = ET[e] - 256 * mt; nv = nv > 256 ? 256 : nv; }
        UD[4 * F.tid] = e; UD[4 * F.tid + 1] = row0; UD[4 * F.tid + 2] = pn; UD[4 * F.tid + 3] = nv; }
    __syncthreads();
    if (gather) { const int* LIST = (const int*)(F.ws + WS_LIST);
        for (int i = F.tid; i < 4 * 256; i += 512) { const int ui = i >> 8, r = i & 255; const int e = UD[4 * ui]; unsigned off = 0u;
            if (e >= 0) { const int row0 = UD[4 * ui + 1], nv = UD[4 * ui + 3]; const int lr = row0 - ET[136 + e] + r; int tok = 0;
                tok = NTOK;
                if (r < nv) tok = (e < NE) ? LIST[e * NTOK + lr] : lr;
                off = (unsigned)tok * (unsigned)(D * 2); }
            RT[i] = off; }
        __syncthreads(); }
}

__device__ __forceinline__ void phase_g(Frame& F, int l) {
    const Args& A = *F.a; unsigned char* ws = F.ws; const int lane = F.lane;
    if (l + 1 < NL) { convert_cleanup(F, l * L_ITEMS + LI_X, (l + 1) * L_ITEMS); __syncthreads(); }
    build_etab(F, l);
    LAS const int* SB = (LAS const int*)(F.lds + LDS_ETAB) + 136;
    const bf16_t* X1B = (const bf16_t*)(ws + WS_X1B); const unsigned char* OB = (const unsigned char*)(ws + WS_OB); const int* AEP = (const int*)(ws + WS_ASG_EP); const float* AW = (const float*)(ws + WS_ASG_W);
    float* XO = (l == NL - 1) ? A.out : (float*)nullptr; bf16_t* XB = (bf16_t*)(ws + WS_XB);
    const bf16_t* OSH = (const bf16_t*)(ws + WS_OSH);
    LAS float* YS = (LAS float*)(F.lds + F.wave * 8192);
    int ep_n = 0; float w_n = 0.f;
    { const int tok0 = F.vcu * 8 + F.wave; if (tok0 < NTOK && lane < 8) { ep_n = AEP[tok0 * 8 + lane]; w_n = AW[tok0 * 8 + lane]; } }
    for (int tok = F.vcu * 8 + F.wave; tok < NTOK; tok += F.G * 8) {
        int slot = 0; const float wv = w_n;
        if (lane < 8) slot = SB[ep_n >> 16] + (ep_n & 0xffff);
        { const int tn = tok + F.G * 8; if (tn < NTOK && lane < 8) { ep_n = AEP[tn * 8 + lane]; w_n = AW[tn * 8 + lane]; } }
        float s = 0.f;
        u32x2 ovA[8], ovB[8]; u32x4 xrA, xrB, osA, osB;
#define G_LOADS(ov, xr, os, j) do { xr = *(const u32x4*)(X1B + (size_t)tok * D + 512 * (j) + 8 * lane); os = *(const u32x4*)(OSH + (size_t)tok * D + 512 * (j) + 8 * lane); \
            _Pragma("unroll") for (int k = 0; k < 8; ++k) { const int sl = __builtin_amdgcn_readlane(slot, k); ov[k] = *(const u32x2*)(OB + (size_t)sl * D + 512 * (j) + 8 * lane); } } while (0)
#define G_COMBINE(ov, xr, os, j) do { \
            float y[8] = {ALPHA * bf_lo(xr.x) + bf_lo(os.x), ALPHA * bf_hi(xr.x) + bf_hi(os.x), ALPHA * bf_lo(xr.y) + bf_lo(os.y), ALPHA * bf_hi(xr.y) + bf_hi(os.y), \
                          ALPHA * bf_lo(xr.z) + bf_lo(os.z), ALPHA * bf_hi(xr.z) + bf_hi(os.z), ALPHA * bf_lo(xr.w) + bf_lo(os.w), ALPHA * bf_hi(xr.w) + bf_hi(os.w)}; \
            _Pragma("unroll") for (int k = 0; k < 8; ++k) { const float wk = __int_as_float(__builtin_amdgcn_readlane(__float_as_int(wv), k)) * (1.0f / pg8::O8_SCALE); \
                const f32x2 a = __builtin_amdgcn_cvt_pk_f32_fp8((int)ov[k].x, false), b = __builtin_amdgcn_cvt_pk_f32_fp8((int)ov[k].x, true), \
                            c2 = __builtin_amdgcn_cvt_pk_f32_fp8((int)ov[k].y, false), d2 = __builtin_amdgcn_cvt_pk_f32_fp8((int)ov[k].y, true); \
                y[0] += wk * a.x; y[1] += wk * a.y; y[2] += wk * b.x; y[3] += wk * b.y; y[4] += wk * c2.x; y[5] += wk * c2.y; y[6] += wk * d2.x; y[7] += wk * d2.y; } \
            s += ((y[0] + y[1]) + (y[2] + y[3])) + ((y[4] + y[5]) + (y[6] + y[7])); \
            *(LAS f32x4*)(YS + 512 * (j) + 8 * lane) = (f32x4){y[0], y[1], y[2], y[3]}; *(LAS f32x4*)(YS + 512 * (j) + 8 * lane + 4) = (f32x4){y[4], y[5], y[6], y[7]}; } while (0)
        G_LOADS(ovA, xrA, osA, 0); G_LOADS(ovB, xrB, osB, 1);
        G_COMBINE(ovA, xrA, osA, 0); G_LOADS(ovA, xrA, osA, 2);
        G_COMBINE(ovB, xrB, osB, 1); G_LOADS(ovB, xrB, osB, 3);
        G_COMBINE(ovA, xrA, osA, 2);
        G_COMBINE(ovB, xrB, osB, 3);
#undef G_LOADS
#undef G_COMBINE
        const float mean = wave_sum(s) * (1.f / D); float s2 = 0.f;
#pragma unroll 1
        for (int j = 0; j < 4; ++j) { const f32x4 a = *(const LAS f32x4*)(YS + 512 * j + 8 * lane) - mean, b = *(const LAS f32x4*)(YS + 512 * j + 8 * lane + 4) - mean;
            s2 += ((a[0] * a[0] + a[1] * a[1]) + (a[2] * a[2] + a[3] * a[3])) + ((b[0] * b[0] + b[1] * b[1]) + (b[2] * b[2] + b[3] * b[3])); }
        const float rstd = 1.f / sqrtf(wave_sum(s2) * (1.f / D) + LN_EPS);
#pragma unroll 1
        for (int j = 0; j < 4; ++j) { const f32x4* gp = (const f32x4*)(A.in[I_LN2_G] + l * D + 512 * j + 8 * lane); const f32x4* bp = (const f32x4*)(A.in[I_LN2_B] + l * D + 512 * j + 8 * lane);
            const f32x4 a = *(const LAS f32x4*)(YS + 512 * j + 8 * lane) - mean, b = *(const LAS f32x4*)(YS + 512 * j + 8 * lane + 4) - mean;
            const f32x4 o0 = a * rstd * gp[0] + bp[0], o1 = b * rstd * gp[1] + bp[1];
            if (XO) { f32x4* op = (f32x4*)(XO + (size_t)tok * D + 512 * j + 8 * lane); op[0] = o0; op[1] = o1; }
            if (!XO) *(u32x4*)(XB + (size_t)tok * D + 512 * j + 8 * lane) = (u32x4){cvt_pk_bf16(o0[0], o0[1]), cvt_pk_bf16(o0[2], o0[3]), cvt_pk_bf16(o1[0], o1[1]), cvt_pk_bf16(o1[2], o1[3])}; }
    }
}

constexpr int NPHASE = 2 + 7 * NL;
__global__ void __launch_bounds__(512, 2) mk_fwd(Args args) {
    extern __shared__ __attribute__((aligned(16))) unsigned char lds[];
#define PHASE_FRAME() Frame F; { int tz_ = threadIdx.x; asm volatile("" : "+v"(tz_)); int bz_ = blockIdx.x; asm volatile("" : "+s"(bz_)); unsigned char* wz_ = args.ws; asm volatile("" : "+s"(wz_)); \
        F.lds = (LAS unsigned char*)lds; F.tid = tz_; F.lane = tz_ & 63; F.wave = __builtin_amdgcn_readfirstlane(tz_ >> 6); F.G = gridDim.x; F.vcu = (F.G % 8 == 0) ? (bz_ % 8) * (F.G / 8) + bz_ / 8 : bz_; F.a = &args; F.ws = wz_; } \
        unsigned char* ws = F.ws; const int c = F.vcu; (void)ws; (void)c
    volatile LAS unsigned* MISC = (volatile LAS unsigned*)((LAS unsigned char*)lds + LDS_MISC);
    if (threadIdx.x < 128) MISC[threadIdx.x] = 0u;
    __syncthreads();
    unsigned* ctl = (unsigned*)(args.ws + WS_CTL);
    XcdBarrier bar; bar.bar = ctl + CW_BAR; bar.x = 0; bar.st = nullptr;
    const int lo = args.ph_lo, hi = args.ph_hi;
    if (hi - lo > 1) bar = xcd_barrier_post(ctl + CW_BAR, MISC + 8);
#define IN(k) (lo <= (k) && (k) < hi)
#if PROBE_CLASS >= 0
#define PROBE_MARK(cls) do { if (blockIdx.x == 0 && threadIdx.x == 0) { const unsigned n_ = (unsigned)wall_clock64(); if ((cls) == PROBE_CLASS || PROBE_CLASS == 99) MISC[65] += n_ - MISC[64]; MISC[64] = n_; } } while (0)
    if (blockIdx.x == 0 && threadIdx.x == 0) MISC[64] = (unsigned)wall_clock64();
#else
#define PROBE_MARK(cls) do { } while (0)
#endif
#define SEAM(k) do { if (IN(k) && IN((k) + 1)) xcd_barrier(bar); } while (0)

    if (IN(0)) { REP_LOOP(REP_P0) { PHASE_FRAME(); p0_prologue(F); } if (IN(2)) xcd_barrier(bar); PROBE_MARK(7); }
#pragma unroll 1
    for (int l_ = 0; l_ < NL; ++l_) {
        const int pb = 2 + 7 * l_;
        if (IN(pb + 0)) {
            REP_LOOP(REP_A) {
            PHASE_FRAME(); int l = l_; asm volatile("" : "+s"(l));
            int Gp; const int role = phase_role(F, (NTOK / 256) * (INW / 256), Gp); unsigned* PD = (unsigned*)(ws + WS_CTL) + CW_PD + (pb + 0) * 64;
            if (role >= 0) {
                pg8::DenseSched S; S.init((const bf16_t*)(ws + WS_XB), (const bf16_t*)(ws + WS_WT_IN) + (size_t)l * INW * D, NTOK, INW, D, Gp, role);
                pg8::EpiStoreBf16 E{(bf16_t*)(ws + WS_HB), INW};
                pg8::gemm_phase<pg8::EpiStoreBf16, pg8::DenseSched, false>(F.lds, D, S, E);
                if (Gp == F.G && role + F.G >= (NTOK / 256) * (INW / 256)) { __syncthreads(); convert_fill(F, l * L_ITEMS, 1); }
                if (F.tid == 0) xb_add(PD, 1u);
            } else {
                const int k = -1 - role;
                if (l == 0) {
                    { pg8::DenseSched S2; S2.init((const bf16_t*)(ws + WS_MEMN), (const bf16_t*)(ws + WS_WT_K), NMEMTOK, NL * 512, D, F.G, k);
                      pg8::EpiStoreBf16 E2{(bf16_t*)(ws + WS_KBUF), NL * 512};
                      pg8::gemm_phase<pg8::EpiStoreBf16, pg8::DenseSched, false>(F.lds, D, S2, E2); }
                    { pg8::DenseSched S2; S2.init((const bf16_t*)(ws + WS_WT_V), (const bf16_t*)(ws + WS_MEMN), NL * 512, NMEMTOK, D, F.G, k - 32);
                      pg8::EpiStoreBf16 E2{(bf16_t*)(ws + WS_VT), NMEMTOK};
                      pg8::gemm_phase<pg8::EpiStoreBf16, pg8::DenseSched, false>(F.lds, D, S2, E2); }
                    __syncthreads();
                }
#if PACE > 0
                convert_paced(F, l * L_ITEMS, PD, (unsigned)Gp / STOP_DIV + 1u);
#else
                convert_fill(F, l * L_ITEMS, (l == 0 && k < 64) ? FILL_A0 : FILL_A);
#endif
            } }
            SEAM(pb + 0); PROBE_MARK(0);
        }
        if (IN(pb + 1)) {
            REP_LOOP(REP_B) { PHASE_FRAME(); int l = l_; asm volatile("" : "+s"(l));
            for (int it = c; it < 256; it += F.G) mixer_sgu(F, l, it >> 2, it & 3);
            for (int it = c; it < 256; it += F.G) mixer_pool(F, l, it >> 2, it & 3);
            for (int it = c; it < 256; it += F.G) mixer_conv(F, l, it >> 2, it & 3);
            for (int it = c; it < 256; it += F.G) mixer_attn(F, l, it >> 2, it & 3); }
            SEAM(pb + 1); PROBE_MARK(1);
        }
        if (IN(pb + 2)) {
            REP_LOOP(REP_C) {
            PHASE_FRAME(); int l = l_; asm volatile("" : "+s"(l));
            pg8::DenseSched S; S.init((const bf16_t*)(ws + WS_MIX), (const bf16_t*)(ws + WS_WT_OUT) + (size_t)l * D * D, NTOK, D, D, F.G, c);
            pg8::EpiResidBf16 E{(bf16_t*)(ws + WS_Y1), l == 0 ? args.in[I_X] : (const float*)nullptr, (const bf16_t*)(ws + WS_XB), D, ALPHA};
            pg8::gemm_phase<pg8::EpiResidBf16, pg8::DenseSched, false>(F.lds, D, S, E); __syncthreads(); }
            SEAM(pb + 2); PROBE_MARK(2);
        }
        if (IN(pb + 3)) { PHASE_FRAME(); int l = l_; asm volatile("" : "+s"(l));
            if (F.G * 32 == NTOK) {
                if (F.tid == 0) ((LAS unsigned*)(F.lds + LDS_MISC))[16] = 0u;
                __syncthreads();
                if (F.wave < 4) phase_d<4>(F, l); else convert_beside_d(F, l * L_ITEMS, l * L_ITEMS + LI_X);
            } else { convert_cleanup(F, l * L_ITEMS, l * L_ITEMS + LI_X); __syncthreads(); phase_d<8>(F, l); }
            SEAM(pb + 3); PROBE_MARK(3); }
        if (IN(pb + 4)) {
            REP_LOOP(REP_E) {
            PHASE_FRAME(); int l = l_; asm volatile("" : "+s"(l));
            if (c == 0 && F.tid == 0) __hip_atomic_fetch_max((unsigned*)(ws + WS_CTL) + CW_Q, (unsigned)(l * L_ITEMS + LI_X), __ATOMIC_RELAXED, __HIP_MEMORY_SCOPE_AGENT);
            build_etab(F, l);
            int Gp; const int role = phase_role(F, ((LAS const int*)(F.lds + LDS_ETAB))[68 + NE1] * 2, Gp); unsigned* PD = (unsigned*)(ws + WS_CTL) + CW_PD + (pb + 4) * 64;
            if (role >= 0) {
                build_units(F, 2, true, role, Gp);
                ExpertSched S; S.UD = (LAS const int*)(F.lds + LDS_UDESC); S.RT = (LAS const unsigned*)(F.lds + LDS_ROWTAB);
                S.Abase = (const char*)(ws + WS_X1B); S.Bbase = (const char*)(ws + WS_WT_GU) + (size_t)l * NE1 * 512 * D * 2; S.bstride_e = (size_t)512 * D * 2; S.bstride_pn = (size_t)256 * D * 2; S.arow_bytes = D * 2; S.ncol = 128; S.gather = true;
                pg8::EpiSwiglu E{(bf16_t*)(ws + WS_HE)};
                pg8::gemm_phase<pg8::EpiSwiglu, ExpertSched, true>(F.lds, D, S, E);
                if (F.tid == 0) xb_add(PD, 1u);
            } else {
#if PACE > 0
                convert_paced(F, l * L_ITEMS + LI_X, PD, (unsigned)Gp / STOP_DIV + 1u);
#else
                convert_fill(F, l * L_ITEMS + LI_X, FILL_E);
#endif
            }
            __syncthreads(); }
            SEAM(pb + 4); PROBE_MARK(4);
        }
        if (IN(pb + 5)) {
            REP_LOOP(REP_F) {
            PHASE_FRAME(); int l = l_; asm volatile("" : "+s"(l));
            build_etab(F, l);
            int Gp; const int role = phase_role(F, ((LAS const int*)(F.lds + LDS_ETAB))[68 + NE1] * 8, Gp); unsigned* PD = (unsigned*)(ws + WS_CTL) + CW_PD + (pb + 5) * 64;
            if (role >= 0) {
                build_units(F, 8, false, role, Gp);
                ExpertSched S; S.UD = (LAS const int*)(F.lds + LDS_UDESC); S.RT = (LAS const unsigned*)(F.lds + LDS_ROWTAB);
                S.Abase = (const char*)(ws + WS_HE); S.Bbase = (const char*)(ws + WS_WT_D) + (size_t)l * NE1 * D * DE * 2; S.bstride_e = (size_t)D * DE * 2; S.bstride_pn = (size_t)256 * DE * 2; S.arow_bytes = DE * 2; S.ncol = 256; S.gather = false;
                pg8::EpiStoreFp8 E{(unsigned char*)(ws + WS_OB), D, (bf16_t*)(ws + WS_OSH), NE, __builtin_amdgcn_readfirstlane(((LAS const int*)(F.lds + LDS_ETAB))[136 + NE])};
                pg8::gemm_phase<pg8::EpiStoreFp8, ExpertSched, false>(F.lds, DE, S, E);
                if (F.tid == 0) xb_add(PD, 1u);
            } else {
#if PACE > 0
                convert_paced(F, l * L_ITEMS + LI_X, PD, (unsigned)Gp / STOP_DIV + 1u);
#else
                convert_fill(F, l * L_ITEMS + LI_X, FILL_F);
#endif
            }
            __syncthreads(); }
            SEAM(pb + 5); PROBE_MARK(5);
        }
        if (IN(pb + 6)) { REP_LOOP(REP_G) { PHASE_FRAME(); int l = l_; asm volatile("" : "+s"(l)); phase_g(F, l); __syncthreads(); } SEAM(pb + 6); PROBE_MARK(6); }
    }
#if PROBE_CLASS >= 0
    if (blockIdx.x == 0 && threadIdx.x == 0) { const long long t_end = (long long)wall_clock64() + (long long)PROBE_SCALE * MISC[65]; while ((long long)wall_clock64() < t_end) __builtin_amdgcn_s_sleep(64); }
#endif
#undef IN
#undef SEAM
}

extern "C" void kernel_launch(void* const* d_in, const int* in_sizes, int n_in, void* d_out, int out_size, void* d_ws, size_t ws_size, hipStream_t stream) {
    static int grid = 0;
    if (grid == 0) {
        if (n_in != 29 || out_size != NTOK * D || ws_size < WS_END) { fprintf(stderr, "kernel_launch: unexpected shapes (n_in %d out %d ws %zu need %zu)\n", n_in, out_size, ws_size, (size_t)WS_END); grid = -1; return; }
        int dev = 0, cus = 0, per_cu = 0;
        if (hipGetDevice(&dev) != hipSuccess || hipDeviceGetAttribute(&cus, hipDeviceAttributeMultiprocessorCount, dev) != hipSuccess) { grid = -1; return; }
        if (hipFuncSetAttribute((const void*)mk_fwd, hipFuncAttributeMaxDynamicSharedMemorySize, LDS_BYTES) != hipSuccess) { fprintf(stderr, "kernel_launch: hipFuncSetAttribute failed\n"); grid = -1; return; }
        if (hipOccupancyMaxActiveBlocksPerMultiprocessor(&per_cu, (const void*)mk_fwd, 512, LDS_BYTES) != hipSuccess || per_cu < 1) fprintf(stderr, "kernel_launch: occupancy query reports %d\n", per_cu);
        (void)hipGetLastError();
        grid = cus;
    }
    if (grid < 0) return;
    (void)hipMemsetAsync((char*)d_ws + WS_CTL, 0, CTL_ZERO_BYTES, stream);
    Args a{};
    for (int i = 0; i < 29; ++i) a.in[i] = (const float*)d_in[i];
    a.out = (float*)d_out; a.ws = (unsigned char*)d_ws;
#if MK_ONE_LAUNCH
    a.ph_lo = 0; a.ph_hi = NPHASE;
    hipLaunchKernelGGL(mk_fwd, dim3(grid), dim3(512), LDS_BYTES, stream, a);
#else
    for (int p = 0; p < NPHASE; ++p) { a.ph_lo = p; a.ph_hi = p + 1; hipLaunchKernelGGL(mk_fwd, dim3(grid), dim3(512), LDS_BYTES, stream, a); }
#endif
}
```

```cpp
#include <hip/hip_runtime.h>
#include <cstdio>
#include <cstdint>

#define LAS __attribute__((address_space(3)))
#define GAS __attribute__((address_space(1)))
typedef unsigned short bf16_t;
typedef short bf16x8 __attribute__((ext_vector_type(8)));
typedef float f32x4 __attribute__((ext_vector_type(4)));
typedef float f32x2 __attribute__((ext_vector_type(2)));
typedef unsigned u32x4 __attribute__((ext_vector_type(4)));
typedef unsigned u32x2 __attribute__((ext_vector_type(2)));

#ifndef REP_P0
#define REP_P0 1
#endif
#ifndef REP_B
#define REP_B 1
#endif
#ifndef REP_E
#define REP_E 1
#endif
#ifndef REP_F
#define REP_F 1
#endif
#ifndef REP_A
#define REP_A 1
#endif
#ifndef REP_C
#define REP_C 1
#endif
#ifndef REP_D1
#define REP_D1 1
#endif
#ifndef REP_D2
#define REP_D2 1
#endif
#ifndef REP_D3
#define REP_D3 1
#endif
#ifndef REP_G
#define REP_G 1
#endif
#define REP_LOOP(n) _Pragma("unroll 1") for (int rep_ = 0; rep_ < (n); ++rep_)
#ifndef FILL_P1
#define FILL_P1 2
#endif
#ifndef FILL_A
#define FILL_A 4
#endif
#ifndef FILL_A0
#define FILL_A0 2
#endif
#ifndef FILL_F
#define FILL_F 5
#endif
#ifndef FILL_CAP
#define FILL_CAP 64
#endif
#ifndef PROBE_CLASS
#define PROBE_CLASS -1
#endif
#ifndef PROBE_SCALE
#define PROBE_SCALE 40
#endif
#ifndef PACE
#define PACE 0
#endif
#ifndef Q_CP
#define Q_CP 4
#endif
#ifndef STOP_DIV
#define STOP_DIV 16
#endif
#ifndef FILL_E
#define FILL_E 6
#endif
#ifndef MK_ONE_LAUNCH
#define MK_ONE_LAUNCH 1
#endif

constexpr int D = 2048, NTOK = 8192, SEQ = 2048, NL = 4, INW = 3072, GW = 512, HD = 128, NMEMTOK = 1024, NE = 64, NE1 = 65, DE = 256, TOPK = 8;
constexpr float LN_EPS = 1e-5f;
constexpr float ALPHA = 1.6817928305074290861f;
constexpr int SLOT_CAP = 90112;

constexpr size_t MiB = 1u << 20;
constexpr size_t WS_CTL = 0, CTL_ZERO_BYTES = 2 * MiB;
constexpr size_t WS_WT_IN  = 2 * MiB;
constexpr size_t WS_WT_OUT = WS_WT_IN + 48 * MiB;
constexpr size_t WS_WT_K   = WS_WT_OUT + 32 * MiB;
constexpr size_t WS_WT_V   = WS_WT_K + 8 * MiB;
constexpr size_t WS_WT_GU  = WS_WT_V + 8 * MiB;
constexpr size_t WS_WT_D   = WS_WT_GU + 520 * MiB;
constexpr size_t WS_WPT    = WS_WT_D + 260 * MiB;
constexpr size_t WS_SGUW   = WS_WPT + 1 * MiB;
constexpr size_t WS_WR_HI  = WS_SGUW + 1 * MiB;
constexpr size_t WS_WR_LO  = WS_WR_HI + 1 * MiB;
constexpr size_t WS_MEMN   = WS_WR_LO + 1 * MiB;
constexpr size_t WS_KBUF   = WS_MEMN + 4 * MiB;
constexpr size_t WS_VT     = WS_KBUF + 4 * MiB;
constexpr size_t WS_XF     = WS_VT + 4 * MiB;
constexpr size_t WS_OSH    = WS_XF;
constexpr size_t WS_XB     = WS_XF + 64 * MiB;
constexpr size_t WS_HB     = WS_XB + 32 * MiB;
constexpr size_t WS_MIX    = WS_HB + 48 * MiB;
constexpr size_t WS_Y1     = WS_MIX + 32 * MiB;
constexpr size_t WS_X1F    = WS_Y1 + 64 * MiB;
constexpr size_t WS_X1B    = WS_X1F + 64 * MiB;
constexpr size_t WS_HE     = WS_X1B + 33 * MiB;
constexpr size_t WS_OB     = WS_HE + 44 * MiB;
constexpr size_t WS_LIST   = WS_OB + 352 * MiB;
constexpr size_t WS_ASG_EP = WS_LIST + 2 * MiB;
constexpr size_t WS_ASG_W  = WS_ASG_EP + 1 * MiB;
constexpr size_t WS_END    = WS_ASG_W + 1 * MiB;
constexpr int CW_BAR = 4096;
constexpr int CW_CNT = 16384, CNT_STRIDE = 1024;
static_assert((CW_CNT + 256 * CNT_STRIDE) * 4 <= (int)CTL_ZERO_BYTES, "ctl");

constexpr int RING_BYTES = 131072;
constexpr int LDS_MISC = RING_BYTES;
constexpr int LDS_ETAB = LDS_MISC + 512;
constexpr int LDS_UDESC = LDS_ETAB + 1024;
constexpr int LDS_ROWTAB = LDS_UDESC + 512;
constexpr int LDS_BYTES = 147456;
static_assert(LDS_ROWTAB + 4096 <= LDS_BYTES, "lds");

#define LDS_WAIT() asm volatile("s_waitcnt lgkmcnt(0)" ::: "memory")
#define VM_WAIT() asm volatile("s_waitcnt vmcnt(0)" ::: "memory")

__device__ __forceinline__ unsigned cvt_pk_bf16(float lo, float hi) { unsigned r; asm volatile("v_cvt_pk_bf16_f32 %0, %1, %2" : "=v"(r) : "v"(lo), "v"(hi)); return r; }
__device__ __forceinline__ float bf_lo(unsigned w) { return __uint_as_float(w << 16); }
__device__ __forceinline__ float bf_hi(unsigned w) { return __uint_as_float(w & 0xffff0000u); }
__device__ __forceinline__ float fast_sigmoid(float x) { return __builtin_amdgcn_rcpf(1.0f + __builtin_amdgcn_exp2f(-1.4426950408889634f * x)); }
__device__ __forceinline__ float silu_f(float x) { return x * fast_sigmoid(x); }
__device__ __forceinline__ float gelu_tanh_f(float x) { const float t = x + 0.044715f * x * x * x; return x * fast_sigmoid(1.5957691216057308f * t); }
__device__ __forceinline__ float wave_sum(float v) {
#pragma unroll
    for (int o = 1; o < 64; o <<= 1) v += __shfl_xor(v, o);
    return v;
}
__device__ __forceinline__ float g16_sum(float v) { v += __shfl_xor(v, 1); v += __shfl_xor(v, 2); v += __shfl_xor(v, 4); v += __shfl_xor(v, 8); return v; }

namespace pg8 {
constexpr int BM = 256, BK = 64, HALF = 128, HTB = HALF * BK * 2, STAGE_BYTES = 8 * HTB, NXCD = 8, WGM = 8;
__host__ __device__ __forceinline__ int lds_byte(int r, int c) { const int st = (r >> 4) * 2 + (c >> 5), rr = r & 15, cc = c & 31, ob = rr * 64 + cc * 2; return st * 1024 + (ob ^ (((ob >> 9) & 1) << 5)); }
__host__ __device__ __forceinline__ void stage_rc(int b, int& R, int& C) { const int st = b / 1024, sb = b % 1024, swz = sb ^ (((sb >> 9) & 1) << 5); R = (st >> 1) * 16 + swz / 64; C = (st & 1) * 32 + (swz % 64) / 2; }
__host__ __device__ __forceinline__ int perm32(int rho) { const int n = rho >> 4, i = rho & 15; return 8 * (i >> 2) + 4 * n + (i & 3); }

struct Unit { const char* A; const char* B; int row0, col0, nvalid, aux; };

struct StaticOrder {
    int nM, nN, nwg, G, c;
    __device__ void init(int M, int N, int G_, int c_) { nM = M / BM; nN = N / BM; nwg = nM * nN; G = G_; c = c_; }
    __device__ bool next(int i, int& pm, int& pn) const {
        const long L = (long)i * G + c; if (L >= nwg || c < 0) return false;
        int wgid = (int)L; { const int q = nwg / NXCD, r = nwg % NXCD, xcd = wgid % NXCD, off = wgid / NXCD; wgid = (xcd < r ? xcd * (q + 1) : r * (q + 1) + (xcd - r) * q) + off; }
        const int nig = WGM * nN, gid = wgid / nig, fm = gid * WGM, gsz = (nM - fm) < WGM ? (nM - fm) : WGM;
        pm = fm + ((wgid % nig) % gsz); pn = (wgid % nig) / gsz; return true;
    }
};
struct DenseSched {
    StaticOrder so; const char* A; const char* B; size_t tstep;
    __device__ void init(const bf16_t* A_, const bf16_t* B_, int M, int N, int K, int G, int c) { so.init(M, N, G, c); A = (const char*)A_; B = (const char*)B_; tstep = (size_t)BM * K * 2; }
    __device__ __forceinline__ bool next(int i, Unit& u) const { int pm, pn; if (!so.next(i, pm, pn)) return false; u.A = A + (size_t)pm * tstep; u.B = B + (size_t)pn * tstep; u.row0 = pm * BM; u.col0 = pn * BM; u.nvalid = BM; u.aux = 0; return true; }
    __device__ __forceinline__ unsigned rowoff(int, int) const { return 0u; }
};

struct EpiStoreBf16 {
    static constexpr bool PERM = true;
    bf16_t* O; int ldc;
    __device__ __forceinline__ void operator()(const f32x4 (&acc)[2][2][4][2], const Unit& u, int wr, int wc, int fr, int fq) const {
#pragma unroll
        for (int ai = 0; ai < 2; ++ai)
#pragma unroll
            for (int m = 0; m < 4; ++m) { const int lr = ai * HALF + wr * 64 + m * 16 + fr;
                if (lr < u.nvalid) { bf16_t* rowp = O + (size_t)(u.row0 + lr) * ldc + u.col0 + wc * 32 + 8 * fq;
#pragma unroll
                    for (int bj = 0; bj < 2; ++bj) { const f32x4 v0 = acc[ai][bj][m][0], v1 = acc[ai][bj][m][1];
                        u32x4 w; w.x = cvt_pk_bf16(v0[0], v0[1]); w.y = cvt_pk_bf16(v0[2], v0[3]); w.z = cvt_pk_bf16(v1[0], v1[1]); w.w = cvt_pk_bf16(v1[2], v1[3]);
                        *(u32x4*)(rowp + bj * HALF) = w; } } }
    }
};
constexpr float O8_SCALE = 16.0f;
struct EpiStoreFp8 {
    static constexpr bool PERM = true;
    unsigned char* O; int ldc; bf16_t* OS; int sh_e, sh_base;
    __device__ __forceinline__ void operator()(const f32x4 (&acc)[2][2][4][2], const Unit& u, int wr, int wc, int fr, int fq) const {
        if (u.aux == sh_e) {
#pragma unroll
            for (int ai = 0; ai < 2; ++ai)
#pragma unroll
                for (int m = 0; m < 4; ++m) { const int lr = ai * HALF + wr * 64 + m * 16 + fr; bf16_t* rowp = OS + (size_t)(u.row0 - sh_base + lr) * ldc + u.col0 + wc * 32 + 8 * fq;
#pragma unroll
                    for (int bj = 0; bj < 2; ++bj) { const f32x4 v0 = acc[ai][bj][m][0], v1 = acc[ai][bj][m][1];
                        *(u32x4*)(rowp + bj * HALF) = (u32x4){cvt_pk_bf16(v0[0], v0[1]), cvt_pk_bf16(v0[2], v0[3]), cvt_pk_bf16(v1[0], v1[1]), cvt_pk_bf16(v1[2], v1[3])}; } }
            return; }
#pragma unroll
        for (int ai = 0; ai < 2; ++ai)
#pragma unroll
            for (int m = 0; m < 4; ++m) { const int lr = ai * HALF + wr * 64 + m * 16 + fr;
                unsigned pk[2][2];
#pragma unroll
                for (int bj = 0; bj < 2; ++bj) { const f32x4 v0 = acc[ai][bj][m][0] * O8_SCALE, v1 = acc[ai][bj][m][1] * O8_SCALE;
                    int p = __builtin_amdgcn_cvt_pk_fp8_f32(v0[0], v0[1], 0, false); p = __builtin_amdgcn_cvt_pk_fp8_f32(v0[2], v0[3], p, true);
                    int q = __builtin_amdgcn_cvt_pk_fp8_f32(v1[0], v1[1], 0, false); q = __builtin_amdgcn_cvt_pk_fp8_f32(v1[2], v1[3], q, true);
                    pk[bj][0] = (unsigned)p; pk[bj][1] = (unsigned)q; }
                const auto s0 = __builtin_amdgcn_permlane16_swap(pk[0][0], pk[1][0], false, false), s1 = __builtin_amdgcn_permlane16_swap(pk[0][1], pk[1][1], false, false);
                if (lr < u.nvalid) *(u32x4*)(O + (size_t)(u.row0 + lr) * ldc + u.col0 + wc * 32 + (fq & 1) * HALF + (fq >> 1) * 16) = (u32x4){s0[0], s1[0], s0[1], s1[1]}; }
    }
};
struct EpiResidBf16 {
    static constexpr bool PERM = true;
    bf16_t* Y; const float* X; const bf16_t* XBp; int ldc; float alpha;
    __device__ __forceinline__ void operator()(const f32x4 (&acc)[2][2][4][2], const Unit& u, int wr, int wc, int fr, int fq) const {
#pragma unroll
        for (int ai = 0; ai < 2; ++ai)
#pragma unroll
            for (int m = 0; m < 4; ++m) { const size_t off = (size_t)(u.row0 + ai * HALF + wr * 64 + m * 16 + fr) * ldc + u.col0 + wc * 32 + 8 * fq;
#pragma unroll
                for (int bj = 0; bj < 2; ++bj) { f32x4 x0, x1;
                    if (X) { x0 = *(const f32x4*)(X + off + bj * HALF); x1 = *(const f32x4*)(X + off + bj * HALF + 4); }
                    else { const u32x4 r = *(const u32x4*)(XBp + off + bj * HALF); x0 = (f32x4){bf_lo(r.x), bf_hi(r.x), bf_lo(r.y), bf_hi(r.y)}; x1 = (f32x4){bf_lo(r.z), bf_hi(r.z), bf_lo(r.w), bf_hi(r.w)}; }
                    const f32x4 v0 = acc[ai][bj][m][0] + alpha * x0, v1 = acc[ai][bj][m][1] + alpha * x1;
                    *(u32x4*)(Y + off + bj * HALF) = (u32x4){cvt_pk_bf16(v0[0], v0[1]), cvt_pk_bf16(v0[2], v0[3]), cvt_pk_bf16(v1[0], v1[1]), cvt_pk_bf16(v1[2], v1[3])}; } }
    }
};
struct EpiSwiglu {
    static constexpr bool PERM = true;
    bf16_t* H;
    __device__ __forceinline__ void operator()(const f32x4 (&acc)[2][2][4][2], const Unit& u, int wr, int wc, int fr, int fq) const {
#pragma unroll
        for (int ai = 0; ai < 2; ++ai)
#pragma unroll
            for (int m = 0; m < 4; ++m) { const int lr = ai * HALF + wr * 64 + m * 16 + fr;
                if (lr < u.nvalid) { const f32x4 g0 = acc[ai][0][m][0], g1 = acc[ai][0][m][1], u0 = acc[ai][1][m][0], u1 = acc[ai][1][m][1];
                    u32x4 w; w.x = cvt_pk_bf16(silu_f(g0[0]) * u0[0], silu_f(g0[1]) * u0[1]); w.y = cvt_pk_bf16(silu_f(g0[2]) * u0[2], silu_f(g0[3]) * u0[3]);
                    w.z = cvt_pk_bf16(silu_f(g1[0]) * u1[0], silu_f(g1[1]) * u1[1]); w.w = cvt_pk_bf16(silu_f(g1[2]) * u1[2], silu_f(g1[3]) * u1[3]);
                    *(u32x4*)(H + (size_t)(u.row0 + lr) * DE + u.col0 + wc * 32 + 8 * fq) = w; } }
    }
};

template <class Epi, class Sched, bool GATHER>
__device__ __forceinline__ void gemm_phase(LAS unsigned char* lds, const int K, const Sched& S, const Epi& E) {
    int tid = threadIdx.x; asm volatile("" : "+v"(tid));
    const int wid = __builtin_amdgcn_readfirstlane(tid >> 6), lane = tid & 63, wr = wid >> 2, wc = wid & 3;
    const int nt = K / BK;
    unsigned voffB[2], oc[2][2];
#pragma unroll
    for (int i = 0; i < 2; ++i) { int R, C; stage_rc(tid * 16 + i * 8192, R, C); const int Rb = Epi::PERM ? ((R & ~31) + perm32(R & 31)) : R;
        voffB[i] = (unsigned)(Rb * K + C) * 2u; oc[0][i] = (unsigned)(R * K + C) * 2u; oc[1][i] = oc[0][i]; }
    const size_t kstep = (size_t)(BK * 2);
    const size_t hstep = (size_t)HALF * K * 2;
    const size_t ahstep = GATHER ? (size_t)0 : hstep;
    const unsigned ldsw = (unsigned)wid * 1024u;
    const int aoff = lds_byte(wr * 64 + (lane & 15), (lane >> 4) * 8), boff = lds_byte(wc * 32 + (lane & 15), (lane >> 4) * 8);
#define PG8_SA(b, h) (((b) * 2 + (h)) * HTB)
#define PG8_SB(b, h) ((4 + (b) * 2 + (h)) * HTB)
#define PG8_STAGE(bufoff, gbase, voff) do { _Pragma("unroll") for (int _i = 0; _i < 2; ++_i) \
        __builtin_amdgcn_global_load_lds((const unsigned*)((const char*)(gbase) + (voff)[_i]), (LAS unsigned*)(lds + (bufoff) + ldsw + _i * 8192), 16, 0, 0); } while (0)
#define PG8_STAGE_A(bufoff, gbase, h) PG8_STAGE(bufoff, (gbase) + (h) * ahstep, oc[GATHER ? (h) : 0])
#define PG8_LDA(dst, b, h) do { _Pragma("unroll") for (int m = 0; m < 4; ++m) _Pragma("unroll") for (int k = 0; k < 2; ++k) dst[m][k] = *(const LAS bf16x8*)(lds + PG8_SA(b, h) + aoff + m * 2048 + k * 1024); } while (0)
#define PG8_LDB(dst, b, h) do { _Pragma("unroll") for (int n = 0; n < 2; ++n) _Pragma("unroll") for (int k = 0; k < 2; ++k) dst[n][k] = *(const LAS bf16x8*)(lds + PG8_SB(b, h) + boff + n * 2048 + k * 1024); } while (0)
#define PG8_MMA(ai, bj, At, Bt) do { __builtin_amdgcn_s_setprio(1); _Pragma("unroll") for (int m = 0; m < 4; ++m) _Pragma("unroll") for (int n = 0; n < 2; ++n) _Pragma("unroll") for (int k = 0; k < 2; ++k) \
        acc[ai][bj][m][n] = __builtin_amdgcn_mfma_f32_16x16x32_bf16(Bt[n][k], At[m][k], acc[ai][bj][m][n], 0, 0, 0); __builtin_amdgcn_s_setprio(0); } while (0)
#define PG8_WAIT_V(n) asm volatile("s_waitcnt vmcnt(" #n ")" ::: "memory")
#define PG8_WAIT_L(n) asm volatile("s_waitcnt lgkmcnt(" #n ")" ::: "memory")
#define PG8_BAR __builtin_amdgcn_s_barrier()
#define PG8_SCHED __builtin_amdgcn_sched_barrier(0)
#define PG8_LOAD_ROWOFFS(uidx) do { int tz_ = threadIdx.x; asm volatile("" : "+v"(tz_)); _Pragma("unroll") for (int _i = 0; _i < 2; ++_i) { int R_, C_; stage_rc(tz_ * 16 + _i * 8192, R_, C_); \
        oc[0][_i] = S.rowoff((uidx), R_) + (unsigned)C_ * 2u; oc[1][_i] = S.rowoff((uidx), HALF + R_) + (unsigned)C_ * 2u; } } while (0)
    Unit cur, nxt; int ui = 0;
    if (!S.next(0, cur)) return;
    if constexpr (GATHER) { PG8_LOAD_ROWOFFS(0); }
    f32x4 acc[2][2][4][2];
#pragma unroll
    for (int a = 0; a < 2; ++a)
#pragma unroll
        for (int b = 0; b < 2; ++b)
#pragma unroll
            for (int m = 0; m < 4; ++m)
#pragma unroll
                for (int n = 0; n < 2; ++n) acc[a][b][m][n] = (f32x4){0.f, 0.f, 0.f, 0.f};
    bf16x8 At[4][2], B0[2][2], B1[2][2];
    const char* cA = cur.A; const char* cB = cur.B;
    LDS_WAIT();
    PG8_STAGE(PG8_SB(0, 0), cB, voffB); PG8_STAGE(PG8_SB(0, 1), cB + hstep, voffB); PG8_STAGE_A(PG8_SA(0, 0), cA, 0); PG8_STAGE_A(PG8_SA(0, 1), cA, 1);
    if (wr == 1) PG8_BAR;
    PG8_WAIT_V(2); PG8_BAR;
    PG8_STAGE(PG8_SB(1, 0), cB + kstep, voffB); PG8_STAGE_A(PG8_SA(1, 0), cA + kstep, 0); PG8_STAGE(PG8_SB(1, 1), cB + hstep + kstep, voffB);
    PG8_WAIT_V(6); PG8_BAR;
    for (;;) {
        const bool has_next = S.next(ui + 1, nxt);
        const char* nA = has_next ? nxt.A : cA; const char* nB = has_next ? nxt.B : cB;
#pragma unroll 1
        for (int t = 0; t < nt; t += 2) {
            const bool last = (t == nt - 2);
            const char* a1 = cA + (size_t)(t + 1) * kstep;
            const char* a2 = last ? nA : cA + (size_t)(t + 2) * kstep; const char* b2 = last ? nB : cB + (size_t)(t + 2) * kstep;
            const char* a3 = a2 + kstep; const char* b3 = b2 + kstep;
            PG8_LDB(B0, 0, 0); PG8_LDB(B1, 0, 1); PG8_SCHED; PG8_LDA(At, 0, 0); PG8_STAGE_A(PG8_SA(1, 1), a1, 1);
            if constexpr (GATHER) { if (last && has_next) { PG8_LOAD_ROWOFFS(ui + 1); } }
            PG8_WAIT_V(8); PG8_WAIT_L(0); PG8_BAR; PG8_MMA(0, 0, At, B0); PG8_MMA(0, 1, At, B1); PG8_BAR; PG8_SCHED;
            PG8_LDA(At, 0, 1); PG8_STAGE(PG8_SB(0, 0), b2, voffB); PG8_STAGE(PG8_SB(0, 1), b2 + hstep, voffB); PG8_STAGE_A(PG8_SA(0, 0), a2, 0);
            PG8_WAIT_V(8); PG8_WAIT_L(0); PG8_BAR; PG8_MMA(1, 0, At, B0); PG8_MMA(1, 1, At, B1); PG8_BAR; PG8_SCHED;
            PG8_LDB(B0, 1, 0); PG8_LDB(B1, 1, 1); PG8_SCHED; PG8_LDA(At, 1, 0); PG8_STAGE_A(PG8_SA(0, 1), a2, 1);
            PG8_WAIT_V(8); PG8_WAIT_L(0); PG8_BAR; PG8_MMA(0, 0, At, B0); PG8_MMA(0, 1, At, B1); PG8_BAR; PG8_SCHED;
            PG8_LDA(At, 1, 1); PG8_STAGE(PG8_SB(1, 0), b3, voffB); PG8_STAGE(PG8_SB(1, 1), b3 + hstep, voffB); PG8_STAGE_A(PG8_SA(1, 0), a3, 0);
            PG8_WAIT_V(8); PG8_WAIT_L(0); PG8_BAR; PG8_MMA(1, 0, At, B0); PG8_MMA(1, 1, At, B1); PG8_BAR; PG8_SCHED;
        }
        if (wr == 0) PG8_BAR;
        { int tz = threadIdx.x; asm volatile("" : "+v"(tz)); E(acc, cur, wr, wc, tz & 15, (tz & 63) >> 4); }
        if (!has_next) break;
#pragma unroll
        for (int a = 0; a < 2; ++a)
#pragma unroll
            for (int b = 0; b < 2; ++b)
#pragma unroll
                for (int m = 0; m < 4; ++m)
#pragma unroll
                    for (int n = 0; n < 2; ++n) acc[a][b][m][n] = (f32x4){0.f, 0.f, 0.f, 0.f};
        cur = nxt; cA = nA; cB = nB; ++ui;
        if (wr == 1) PG8_BAR;
    }
    PG8_WAIT_V(0);
    PG8_BAR;
#undef PG8_SA
#undef PG8_SB
#undef PG8_STAGE
#undef PG8_STAGE_A
#undef PG8_LOAD_ROWOFFS
#undef PG8_LDA
#undef PG8_LDB
#undef PG8_MMA
#undef PG8_WAIT_V
#undef PG8_WAIT_L
#undef PG8_BAR
#undef PG8_SCHED
}
}

#define XB_TMO      128
#define XB_XCNT(j)  (256  + 64 * (j))
#define XB_XSUB(j)  (1280 + 64 * (j))
#define XB_XGEN(j)  (2304 + 64 * (j))
#define XB_TOP      3328
#define XB_TOPGEN   3392
#define XCD_BAR_WORDS 3456
#define XB_SPIN_CAP (1u << 18)
__device__ __forceinline__ unsigned xb_ld(unsigned* p)              { return __hip_atomic_load(p, __ATOMIC_RELAXED, __HIP_MEMORY_SCOPE_AGENT); }
__device__ __forceinline__ unsigned xb_add(unsigned* p, unsigned v) { return __hip_atomic_fetch_add(p, v, __ATOMIC_RELAXED, __HIP_MEMORY_SCOPE_AGENT); }
__device__ __forceinline__ unsigned xb_xcc_id() { return (unsigned)__builtin_amdgcn_s_getreg((3 << 11) | 20) & 0xFu; }
#define XB_SPIN(cond, bar) do { unsigned _sp = 0; while (cond) { __builtin_amdgcn_s_sleep(1); \
    if ((++_sp & 255u) == 0u) { if (xb_ld(&(bar)[XB_TMO])) break; if (_sp > XB_SPIN_CAP) { atomicAdd(&(bar)[XB_TMO], 1u); break; } } } } while (0)
struct XcdBarrier { unsigned* bar; unsigned x; volatile LAS unsigned* st; };
__device__ __forceinline__ XcdBarrier xcd_barrier_post(unsigned* bar, volatile LAS unsigned* st) {
    XcdBarrier b; b.bar = bar; b.x = xb_xcc_id(); b.st = st;
    if (threadIdx.x == 0) (void)xb_add(&bar[XB_XCNT(b.x)], 1u);
    return b;
}
__device__ __forceinline__ void xcd_barrier_complete(unsigned* bar, unsigned x, unsigned& nloc, unsigned& nx) {
    const unsigned G = gridDim.x * gridDim.y * gridDim.z;
    unsigned sum, cnt, mine, sp = 0u;
    for (;;) {
        sum = 0u; cnt = 0u; mine = 0u;
#pragma unroll 1
        for (unsigned j = 0; j < 16; ++j) { const unsigned c = xb_ld(&bar[XB_XCNT(j)]); sum += c; cnt += (c > 0u) ? 1u : 0u; mine = (j == x) ? c : mine; }
        if (sum == G) break;
        __builtin_amdgcn_s_sleep(1);
        if ((++sp & 255u) == 0u) { if (xb_ld(&bar[XB_TMO])) break; if (sp > XB_SPIN_CAP) { atomicAdd(&bar[XB_TMO], 1u); break; } }
    }
    nloc = mine > 0u ? mine : 1u; nx = cnt > 0u ? cnt : 1u;
}
__device__ __forceinline__ void xcd_barrier(const XcdBarrier& b) {
    asm volatile("s_waitcnt vmcnt(0)" ::: "memory");
    __syncthreads();
    if (threadIdx.x == 0) {
        unsigned* bar = b.bar;
        __builtin_amdgcn_s_waitcnt(0);
        unsigned nloc = b.st[0], nx = b.st[1];
        if (nloc == 0u) { xcd_barrier_complete(bar, b.x, nloc, nx); b.st[0] = nloc; b.st[1] = nx; }
        const unsigned old = xb_add(&bar[XB_XSUB(b.x)], 1u);
        const unsigned gen = old / nloc;
        if (old + 1u == (gen + 1u) * nloc) {
            __builtin_amdgcn_fence(__ATOMIC_RELEASE, "agent");
            asm volatile("s_waitcnt vmcnt(0)" ::: "memory");
            const unsigned og = xb_add(&bar[XB_TOP], 1u);
            const unsigned tg = og / nx;
            if (og + 1u == (tg + 1u) * nx) xb_add(&bar[XB_TOPGEN], 1u);
            else XB_SPIN(xb_ld(&bar[XB_TOPGEN]) == tg, bar);
            __builtin_amdgcn_fence(__ATOMIC_ACQUIRE, "agent");
            xb_add(&bar[XB_XGEN(b.x)], 1u);
            asm volatile("s_waitcnt vmcnt(0)" ::: "memory");
        } else {
            XB_SPIN(xb_ld(&bar[XB_XGEN(b.x)]) == gen, bar);
            __builtin_amdgcn_fence(__ATOMIC_ACQUIRE, "agent");
            asm volatile("s_waitcnt vmcnt(0)" ::: "memory");
        }
    }
    __syncthreads();
}

struct Args { const float* in[29]; float* out; unsigned char* ws; int ph_lo, ph_hi; };
enum { I_X = 0, I_MEM, I_MEM_G, I_MEM_B, I_W_IN, I_SGU_G, I_SGU_B, I_SGU_W, I_SGU_BS, I_POOL_W, I_POOL_S, I_CONV_W, I_CONV_B, I_CONV_G, I_CONV_LB, I_W_KV, I_W_OUT, I_LN1_G, I_LN1_B,
       I_W_R, I_R_BIAS, I_E_G, I_E_U, I_E_D, I_S_G, I_S_U, I_S_D, I_LN2_G, I_LN2_B };

struct Frame {
    LAS unsigned char* lds;
    int tid, lane, wave, vcu, G;
    const Args* a;
    unsigned char* ws;
};

struct ItemDesc { const float* W; bf16_t* WT; bf16_t* WL; int ldw, ldt, k0, n0, drow0; };
constexpr int LI_IN = 3072, LI_OUT = 2048, LI_EX = 64 * 256, LI_SH = 256, LI_PW = 4 * 8, LI_RT = 64;
constexpr int L_ITEMS = LI_IN + LI_OUT + 3 * LI_EX + 3 * LI_SH + LI_PW + LI_RT;
constexpr int KV_ITEMS = 4 * 1024;
constexpr int LI_X = 3 * LI_EX + 3 * LI_SH, LI_S = L_ITEMS - LI_X;
constexpr int Q_TOTAL = NL * L_ITEMS - LI_S;
constexpr int CW_Q = 8192;
constexpr int CW_PD = 10240;
constexpr int Q_CH = 8;
__device__ __forceinline__ ItemDesc item_desc(const Args& A, unsigned char* ws, int l, int r) {
    bf16_t* WT_IN = (bf16_t*)(ws + WS_WT_IN); bf16_t* WT_OUT = (bf16_t*)(ws + WS_WT_OUT);
    bf16_t* WT_GU = (bf16_t*)(ws + WS_WT_GU); bf16_t* WT_D = (bf16_t*)(ws + WS_WT_D); bf16_t* WPT = (bf16_t*)(ws + WS_WPT);
    ItemDesc d; d.WL = nullptr;
    if (r < LI_IN) { const int kb = r / 96, nb = r % 96; d.W = A.in[I_W_IN] + (size_t)l * D * INW; d.ldw = INW; d.WT = WT_IN + (size_t)l * INW * D; d.ldt = D; d.k0 = kb * 64; d.n0 = nb * 32; d.drow0 = nb * 32; return d; } r -= LI_IN;
    if (r < LI_OUT) { const int kb = r / 64, nb = r % 64; d.W = A.in[I_W_OUT] + (size_t)l * D * D; d.ldw = D; d.WT = WT_OUT + (size_t)l * D * D; d.ldt = D; d.k0 = kb * 64; d.n0 = nb * 32; d.drow0 = nb * 32; return d; } r -= LI_OUT;
    if (r < 2 * LI_EX) { const int up = r >= LI_EX; if (up) r -= LI_EX; const int e = r / 256, rem = r % 256, kb = rem / 8, nb = rem % 8, n0 = nb * 32;
        d.W = A.in[up ? I_E_U : I_E_G] + (size_t)(l * NE + e) * D * DE; d.ldw = DE; d.WT = WT_GU + (size_t)(l * NE1 + e) * 512 * D; d.ldt = D; d.k0 = kb * 64; d.n0 = n0; d.drow0 = (n0 >> 7) * 256 + up * 128 + (n0 & 127); return d; } r -= 2 * LI_EX;
    if (r < LI_EX) { const int e = r / 256, rem = r % 256, kb = rem / 64, nb = rem % 64;
        d.W = A.in[I_E_D] + (size_t)(l * NE + e) * DE * D; d.ldw = D; d.WT = WT_D + (size_t)(l * NE1 + e) * D * DE; d.ldt = DE; d.k0 = kb * 64; d.n0 = nb * 32; d.drow0 = nb * 32; return d; } r -= LI_EX;
    if (r < 2 * LI_SH) { const int up = r >= LI_SH; if (up) r -= LI_SH; const int kb = r / 8, nb = r % 8, n0 = nb * 32;
        d.W = A.in[up ? I_S_U : I_S_G] + (size_t)l * D * DE; d.ldw = DE; d.WT = WT_GU + (size_t)(l * NE1 + 64) * 512 * D; d.ldt = D; d.k0 = kb * 64; d.n0 = n0; d.drow0 = (n0 >> 7) * 256 + up * 128 + (n0 & 127); return d; } r -= 2 * LI_SH;
    if (r < LI_SH) { const int kb = r / 64, nb = r % 64; d.W = A.in[I_S_D] + (size_t)l * DE * D; d.ldw = D; d.WT = WT_D + (size_t)(l * NE1 + 64) * D * DE; d.ldt = DE; d.k0 = kb * 64; d.n0 = nb * 32; d.drow0 = nb * 32; return d; } r -= LI_SH;
    if (r < LI_PW) { const int g = r / 8, rem = r % 8, kb = rem / 4, nb = rem % 4; d.W = A.in[I_POOL_W] + (size_t)(l * 4 + g) * 128 * 128; d.ldw = 128; d.WT = WPT + (size_t)(l * 4 + g) * 128 * 128; d.ldt = 128; d.k0 = kb * 64; d.n0 = nb * 32; d.drow0 = nb * 32; return d; } r -= LI_PW;
    { const int kb = r / 2, nb = r % 2; d.W = A.in[I_W_R] + (size_t)l * D * NE; d.ldw = NE; d.WT = (bf16_t*)(ws + WS_WR_HI) + (size_t)l * NE * D; d.WL = (bf16_t*)(ws + WS_WR_LO) + (size_t)l * NE * D; d.ldt = D; d.k0 = kb * 64; d.n0 = nb * 32; d.drow0 = nb * 32; return d; }
}
__device__ __forceinline__ ItemDesc kv_desc(const Args& A, unsigned char* ws, int r) {
    const int mat = r / 1024, rem = r % 1024, kb = rem / 32, nb = rem % 32, n0 = nb * 32; ItemDesc d; d.WL = nullptr;
    d.W = A.in[I_W_KV] + (size_t)mat * D * 1024; d.ldw = 1024; d.WT = (bf16_t*)(ws + (n0 < 512 ? WS_WT_K : WS_WT_V)); d.ldt = D; d.k0 = kb * 64; d.n0 = n0; d.drow0 = mat * 512 + (n0 & 511); return d;
}
__device__ __forceinline__ void item_load(const ItemDesc& d, f32x4 (&v)[8], int lane) {
#pragma unroll
    for (int i = 0; i < 8; ++i) v[i] = __builtin_nontemporal_load((const GAS f32x4*)(d.W + (size_t)(d.k0 + 8 * i + (lane >> 3)) * d.ldw + d.n0 + 4 * (lane & 7)));
}
__device__ __forceinline__ void item_finish(const ItemDesc& d, const f32x4 (&v)[8], LAS float* scr, int lane) {
#pragma unroll
    for (int i = 0; i < 8; ++i) { LAS float* p = scr + (8 * i + (lane >> 3)) * 33 + 4 * (lane & 7); p[0] = v[i][0]; p[1] = v[i][1]; p[2] = v[i][2]; p[3] = v[i][3]; }
    LDS_WAIT(); asm volatile("" ::: "memory");
    const int c = lane & 7;
#pragma unroll
    for (int j = 0; j < 4; ++j) { const int n = (lane >> 3) + 8 * j; const LAS float* s = scr + (8 * c) * 33 + n;
        float x[8]; unsigned h[4];
#pragma unroll
        for (int q = 0; q < 8; ++q) x[q] = s[q * 33];
#pragma unroll
        for (int q = 0; q < 4; ++q) h[q] = cvt_pk_bf16(x[2 * q], x[2 * q + 1]);
        if (!d.WL) __builtin_nontemporal_store((u32x4){h[0], h[1], h[2], h[3]}, (GAS u32x4*)(d.WT + (size_t)(d.drow0 + n) * d.ldt + d.k0 + 8 * c));
        else { unsigned lo[4];
            const int nn = d.drow0 + n, kk = d.k0 + 8 * c; const size_t off = ((size_t)((nn >> 4) * (D / 32) + (kk >> 5)) * 64 + 16 * ((kk & 31) >> 3) + (nn & 15)) * 8;
#pragma unroll
            for (int q = 0; q < 4; ++q) lo[q] = cvt_pk_bf16(x[2 * q] - bf_lo(h[q]), x[2 * q + 1] - bf_hi(h[q]));
            *(GAS u32x4*)(d.WT + off) = (u32x4){h[0], h[1], h[2], h[3]}; *(GAS u32x4*)(d.WL + off) = (u32x4){lo[0], lo[1], lo[2], lo[3]}; } }
    LDS_WAIT(); asm volatile("" ::: "memory");
}
__device__ __forceinline__ int s_item(int s) { return s < LI_IN + LI_OUT ? s : s + LI_X; }
struct GenPrologue { __device__ __forceinline__ ItemDesc operator()(const Args& A, unsigned char* ws, int id) const { return id < LI_S ? item_desc(A, ws, 0, s_item(id)) : kv_desc(A, ws, id - LI_S); } };
struct GenQueue    { __device__ __forceinline__ ItemDesc operator()(const Args& A, unsigned char* ws, int id) const { const int l = id / L_ITEMS, j = id % L_ITEMS;
    return j < LI_X ? item_desc(A, ws, l, LI_IN + LI_OUT + j) : item_desc(A, ws, l + 1, s_item(j - LI_X)); } };
template <class Gen> __device__ __forceinline__ void convert_seq(const Args& A, unsigned char* ws, int first, int end, int stride, LAS float* scr, int lane) {
    if (first >= end) return;
    const Gen gen; ItemDesc d0 = gen(A, ws, first); f32x4 v0[8]; item_load(d0, v0, lane);
#pragma unroll 1
    for (int id = first + stride; id < end; id += stride) { const ItemDesc d1 = gen(A, ws, id); f32x4 v1[8]; item_load(d1, v1, lane); item_finish(d0, v0, scr, lane); d0 = d1;
#pragma unroll
        for (int i = 0; i < 8; ++i) v0[i] = v1[i]; }
    item_finish(d0, v0, scr, lane);
}
__device__ __forceinline__ void convert_fill(Frame& F, int floor, int budget, unsigned* stop = nullptr, unsigned stop_at = 0u) {
    const Args& A = *F.a; LAS float* scr = (LAS float*)(F.lds + F.wave * 16384);
    unsigned* qh = (unsigned*)(F.ws + WS_CTL) + CW_Q;
#pragma unroll 1
    for (int b = 0; b < budget; ++b) {
        if (stop && __builtin_amdgcn_readfirstlane(xb_ld(stop)) >= stop_at) break;
        unsigned st = 0u; if (F.lane == 0) st = __hip_atomic_fetch_add(qh, (unsigned)Q_CH, __ATOMIC_RELAXED, __HIP_MEMORY_SCOPE_AGENT);
        const int s0 = __builtin_amdgcn_readfirstlane((int)st);
        if (s0 >= Q_TOTAL) break;
        const int lo = s0 > floor ? s0 : floor, hi = (s0 + Q_CH) < Q_TOTAL ? (s0 + Q_CH) : Q_TOTAL;
        if (lo >= hi) { ++budget; if (budget > (1 << 20)) break; continue; }
        convert_seq<GenQueue>(A, F.ws, lo, hi, 1, scr, F.lane);
    }
}
__device__ __forceinline__ void convert_paced(Frame& F, int floor, unsigned* stop, unsigned stop_at) {
    const Args& A = *F.a; LAS float* scr = (LAS float*)(F.lds + F.wave * 16384); const int lane = F.lane;
    unsigned* qh = (unsigned*)(F.ws + WS_CTL) + CW_Q;
    long long tn = (long long)wall_clock64() + F.wave * (PACE / 8); bool stopped = false;
#define PACE_WAIT() do { tn += PACE; long long now_ = (long long)wall_clock64(); if (now_ - tn > 2 * PACE) tn = now_ - 2 * PACE; \
        while (!stopped && now_ < tn) { __builtin_amdgcn_s_sleep(32); stopped = __builtin_amdgcn_readfirstlane(xb_ld(stop)) >= stop_at; now_ = (long long)wall_clock64(); } } while (0)
#pragma unroll 1
    for (int b = 0; b < FILL_CAP; ++b) {
        if (stopped || __builtin_amdgcn_readfirstlane(xb_ld(stop)) >= stop_at) break;
        unsigned st = 0u; if (lane == 0) st = __hip_atomic_fetch_add(qh, (unsigned)Q_CP, __ATOMIC_RELAXED, __HIP_MEMORY_SCOPE_AGENT);
        const int s0 = __builtin_amdgcn_readfirstlane((int)st);
        if (s0 >= Q_TOTAL) break;
        const int lo = s0 > floor ? s0 : floor, hi = (s0 + Q_CP) < Q_TOTAL ? (s0 + Q_CP) : Q_TOTAL;
        if (lo >= hi) continue;
        const GenQueue gen; ItemDesc d0 = gen(A, F.ws, lo); f32x4 v0[8]; item_load(d0, v0, lane);
#pragma unroll 1
        for (int id = lo + 1; id < hi; ++id) { PACE_WAIT(); const ItemDesc d1 = gen(A, F.ws, id); f32x4 v1[8]; item_load(d1, v1, lane); item_finish(d0, v0, scr, lane); d0 = d1;
#pragma unroll
            for (int i = 0; i < 8; ++i) v0[i] = v1[i]; }
        PACE_WAIT(); item_finish(d0, v0, scr, lane);
    }
#undef PACE_WAIT
}
__device__ __forceinline__ void convert_cleanup(Frame& F, int from, int upto) {
    const Args& A = *F.a; LAS float* scr = (LAS float*)(F.lds + F.wave * 16384);
    unsigned* qh = (unsigned*)(F.ws + WS_CTL) + CW_Q;
    int head = __builtin_amdgcn_readfirstlane((int)__hip_atomic_load(qh, __ATOMIC_RELAXED, __HIP_MEMORY_SCOPE_AGENT)); head = head > from ? head : from;
    convert_seq<GenQueue>(A, F.ws, head + F.vcu * 8 + F.wave, upto, F.G * 8, scr, F.lane);
}

__device__ __forceinline__ void convert_beside_d(Frame& F, int from, int upto) {
    const Args& A = *F.a; LAS float* scr = (LAS float*)(F.lds + 81920 + (F.wave - 4) * 8704);
    unsigned* qh = (unsigned*)(F.ws + WS_CTL) + CW_Q;
    int head = __builtin_amdgcn_readfirstlane((int)__hip_atomic_load(qh, __ATOMIC_RELAXED, __HIP_MEMORY_SCOPE_AGENT)); head = head > from ? head : from;
    convert_seq<GenQueue>(A, F.ws, head + F.vcu * 4 + (F.wave - 4), upto, F.G * 4, scr, F.lane);
}
__device__ __forceinline__ void p0_prologue(Frame& F) {
    const Args& A = *F.a; unsigned char* ws = F.ws;
    LAS float* scr = (LAS float*)(F.lds + F.wave * 16384);
    const int gw = F.vcu * 8 + F.wave, NGW = F.G * 8, lane = F.lane;
    convert_seq<GenPrologue>(A, ws, gw, LI_S + KV_ITEMS, NGW, scr, lane);
    { const int gt = F.vcu * 512 + F.tid, NGT = F.G * 512; bf16_t* SW = (bf16_t*)(ws + WS_SGUW);
      for (int i = gt; i < NL * 4 * 128 * 128 / 8; i += NGT) { const int t = (i >> 4) & 127, s0 = (i & 15) * 8; const f32x4* p = (const f32x4*)(A.in[I_SGU_W] + (size_t)i * 8); const f32x4 a = p[0], b = p[1];
          float v[8] = {a[0], a[1], a[2], a[3], b[0], b[1], b[2], b[3]};
#pragma unroll
          for (int q = 0; q < 8; ++q) v[q] = (s0 + q <= t) ? v[q] : 0.f;
          *(u32x4*)(SW + (size_t)i * 8) = (u32x4){cvt_pk_bf16(v[0], v[1]), cvt_pk_bf16(v[2], v[3]), cvt_pk_bf16(v[4], v[5]), cvt_pk_bf16(v[6], v[7])}; }
      bf16_t* XB = (bf16_t*)(ws + WS_XB);
      for (int i = gt; i < NTOK * D / 8; i += NGT) { const f32x4* p = (const f32x4*)(A.in[I_X] + (size_t)i * 8); const f32x4 a = p[0], b = p[1];
          *(u32x4*)(XB + (size_t)i * 8) = (u32x4){cvt_pk_bf16(a[0], a[1]), cvt_pk_bf16(a[2], a[3]), cvt_pk_bf16(b[0], b[1]), cvt_pk_bf16(b[2], b[3])}; } }
    if (F.vcu == 0 && F.tid < 256) *(u32x4*)((bf16_t*)(ws + WS_X1B) + (size_t)NTOK * D + F.tid * 8) = (u32x4){0u, 0u, 0u, 0u};
    { bf16_t* MN = (bf16_t*)(ws + WS_MEMN);
      for (int m = gw; m < NMEMTOK; m += NGW) { const f32x4* xr = (const f32x4*)(A.in[I_MEM] + (size_t)m * D) + lane; f32x4 v[8]; float s = 0.f;
#pragma unroll
          for (int j = 0; j < 8; ++j) { v[j] = xr[64 * j]; s += (v[j][0] + v[j][1]) + (v[j][2] + v[j][3]); }
          const float mean = wave_sum(s) * (1.f / D); float s2 = 0.f;
#pragma unroll
          for (int j = 0; j < 8; ++j) { v[j] = v[j] - mean; s2 += (v[j][0] * v[j][0] + v[j][1] * v[j][1]) + (v[j][2] * v[j][2] + v[j][3] * v[j][3]); }
          const float rstd = 1.f / sqrtf(wave_sum(s2) * (1.f / D) + LN_EPS);
#pragma unroll
          for (int j = 0; j < 8; ++j) { const f32x4 g = ((const f32x4*)A.in[I_MEM_G])[lane + 64 * j], b = ((const f32x4*)A.in[I_MEM_B])[lane + 64 * j]; const f32x4 o = v[j] * rstd * g + b;
              *(u32x2*)(MN + (size_t)m * D + 4 * lane + 256 * j) = (u32x2){cvt_pk_bf16(o[0], o[1]), cvt_pk_bf16(o[2], o[3])}; } } }
}

typedef f32x4 acc8_t[8];
__device__ __forceinline__ void mixer_sgu(Frame& F, int l, int chunk, int h) {
    const Args& A = *F.a; const int lane = F.lane, w = F.wave, fr = lane & 15, g = lane >> 4, t0 = chunk * 128;
    const bf16_t* HB = (const bf16_t*)(F.ws + WS_HB); bf16_t* MIX = (bf16_t*)(F.ws + WS_MIX); const bf16_t* SW = (const bf16_t*)(F.ws + WS_SGUW) + (size_t)(l * 4 + h) * 128 * 128;
    LAS unsigned char* VT = F.lds;
    const int t = 16 * w + fr;
    bf16x8 af[4]; u32x2 uraw[8];
#pragma unroll
    for (int ks = 0; ks < 4; ++ks) af[ks] = *(const GAS bf16x8*)(SW + (size_t)t * 128 + 32 * ks + 8 * g);
#pragma unroll
    for (int j = 0; j < 8; ++j) uraw[j] = *(const GAS u32x2*)(HB + (size_t)(t0 + t) * INW + h * 128 + 16 * j + 4 * g);
    const float bs = A.in[I_SGU_BS][(size_t)(l * 128 + t) * 4 + h];
    { const float* gp = A.in[I_SGU_G] + l * GW + h * 128 + 8 * fr; const float* bp = A.in[I_SGU_B] + l * GW + h * 128 + 8 * fr;
      const f32x4 g0 = *(const f32x4*)gp, g1 = *(const GAS f32x4*)(gp + 4), b0 = *(const f32x4*)bp, b1 = *(const GAS f32x4*)(bp + 4);
      const float gg[8] = {g0[0], g0[1], g0[2], g0[3], g1[0], g1[1], g1[2], g1[3]}, bb[8] = {b0[0], b0[1], b0[2], b0[3], b1[0], b1[1], b1[2], b1[3]};
      u32x4 raw[4];
#pragma unroll
      for (int p = 0; p < 4; ++p) raw[p] = *(const GAS u32x4*)(HB + (size_t)(t0 + 16 * w + 4 * p + g) * INW + 512 + h * 128 + 8 * fr);
#pragma unroll
      for (int p = 0; p < 4; ++p) { const int tok = 16 * w + 4 * p + g;
          float v[8] = {bf_lo(raw[p].x), bf_hi(raw[p].x), bf_lo(raw[p].y), bf_hi(raw[p].y), bf_lo(raw[p].z), bf_hi(raw[p].z), bf_lo(raw[p].w), bf_hi(raw[p].w)}; float s = 0.f;
#pragma unroll
          for (int q = 0; q < 8; ++q) { v[q] = gelu_tanh_f(v[q]); s += v[q]; }
          const float mean = g16_sum(s) * (1.f / 128.f); float s2 = 0.f;
#pragma unroll
          for (int q = 0; q < 8; ++q) { v[q] -= mean; s2 += v[q] * v[q]; }
          const float rstd = 1.f / sqrtf(g16_sum(s2) * (1.f / 128.f) + LN_EPS);
#pragma unroll
          for (int q = 0; q < 8; q += 2) { const unsigned pk = cvt_pk_bf16(v[q] * rstd * gg[q] + bb[q], v[q + 1] * rstd * gg[q + 1] + bb[q + 1]);
              const int d0 = 8 * fr + q, d1 = d0 + 1;
              *(LAS bf16_t*)(VT + d0 * 256 + ((((tok >> 3) ^ d0 ^ (d0 >> 3)) & 15) << 4) + (tok & 7) * 2) = (bf16_t)(pk & 0xffffu);
              *(LAS bf16_t*)(VT + d1 * 256 + ((((tok >> 3) ^ d1 ^ (d1 >> 3)) & 15) << 4) + (tok & 7) * 2) = (bf16_t)(pk >> 16); } } }
    __syncthreads();
    f32x4 acc[8];
#pragma unroll
    for (int j = 0; j < 8; ++j) acc[j] = (f32x4){0.f, 0.f, 0.f, 0.f};
    const int nks = (w >> 1) + 1;
#pragma unroll
    for (int ks = 0; ks < 4; ++ks) if (ks < nks) {
#pragma unroll
        for (int j = 0; j < 8; ++j) { const int d = 16 * j + fr; const bf16x8 bfr = *(const LAS bf16x8*)(VT + d * 256 + ((((4 * ks + g) ^ d ^ (d >> 3)) & 15) << 4));
            acc[j] = __builtin_amdgcn_mfma_f32_16x16x32_bf16(bfr, af[ks], acc[j], 0, 0, 0); }
    }
#pragma unroll
    for (int j = 0; j < 8; ++j) { const u32x2 raw = uraw[j];
        const float u0 = gelu_tanh_f(bf_lo(raw.x)), u1 = gelu_tanh_f(bf_hi(raw.x)), u2 = gelu_tanh_f(bf_lo(raw.y)), u3 = gelu_tanh_f(bf_hi(raw.y));
        *(GAS u32x2*)(MIX + (size_t)(t0 + t) * D + h * 128 + 16 * j + 4 * g) = (u32x2){cvt_pk_bf16(u0 * (acc[j][0] + bs), u1 * (acc[j][1] + bs)), cvt_pk_bf16(u2 * (acc[j][2] + bs), u3 * (acc[j][3] + bs))}; }
    __syncthreads();
}
__device__ __forceinline__ void mixer_pool(Frame& F, int l, int chunk, int grp) {
    const Args& A = *F.a; const int lane = F.lane, w = F.wave, fr = lane & 15, g = lane >> 4, t0 = chunk * 128, tid = F.tid;
    const bf16_t* HB = (const bf16_t*)(F.ws + WS_HB); bf16_t* MIX = (bf16_t*)(F.ws + WS_MIX); const bf16_t* WP = (const bf16_t*)(F.ws + WS_WPT) + (size_t)(l * 4 + grp) * 128 * 128;
    constexpr int PST = 272;
    LAS unsigned char* PT = F.lds;
    LAS unsigned char* PA = F.lds + 144 * PST;
    const int win = 2 << grp, pos0 = t0 & (SEQ - 1);
    LAS unsigned char* WS = F.lds + 144 * PST + 128 * PST;
    { u32x4 wv4[4];
#pragma unroll
      for (int i = 0; i < 4; ++i) wv4[i] = *(const GAS u32x4*)(WP + (size_t)(tid + 512 * i) * 8);
      for (int i = tid; i < 144 * 16; i += 512) { const int r = i >> 4, cc = i & 15; const int trow = t0 - 16 + r; u32x4 v = (u32x4){0u, 0u, 0u, 0u};
          if (pos0 - 16 + r >= 0) v = *(const GAS u32x4*)(HB + (size_t)trow * INW + 1024 + grp * 128 + 8 * cc);
          *(LAS u32x4*)(PT + r * PST + cc * 16) = v; }
#pragma unroll
      for (int i = 0; i < 4; ++i) { const int id = tid + 512 * i, d = id >> 4, cc = id & 15; *(LAS u32x4*)(WS + d * 256 + ((cc ^ (d & 15)) << 4)) = wv4[i]; } }
    f32x4 scv[8];
#pragma unroll
    for (int j = 0; j < 8; ++j) scv[j] = *(const GAS f32x4*)(A.in[I_POOL_S] + l * GW + grp * 128 + 16 * j + 4 * g);
    __syncthreads();
    for (int i = tid; i < 128 * 16; i += 512) { const int t = i >> 4, cc = i & 15; float s[8] = {0.f, 0.f, 0.f, 0.f, 0.f, 0.f, 0.f, 0.f}; u32x4 cur = (u32x4){0u, 0u, 0u, 0u};
        for (int j = 0; j < win; ++j) { cur = *(const LAS u32x4*)(PT + (t + 16 - win + 1 + j) * PST + cc * 16);
            s[0] += bf_lo(cur.x); s[1] += bf_hi(cur.x); s[2] += bf_lo(cur.y); s[3] += bf_hi(cur.y); s[4] += bf_lo(cur.z); s[5] += bf_hi(cur.z); s[6] += bf_lo(cur.w); s[7] += bf_hi(cur.w); }
        const int pos = pos0 + t; const float inv = 1.0f / (float)((pos + 1) < win ? (pos + 1) : win);
        const float x[8] = {bf_lo(cur.x), bf_hi(cur.x), bf_lo(cur.y), bf_hi(cur.y), bf_lo(cur.z), bf_hi(cur.z), bf_lo(cur.w), bf_hi(cur.w)};
        *(LAS u32x4*)(PA + t * PST + cc * 16) = (u32x4){cvt_pk_bf16(s[0] * inv - x[0], s[1] * inv - x[1]), cvt_pk_bf16(s[2] * inv - x[2], s[3] * inv - x[3]),
                                                        cvt_pk_bf16(s[4] * inv - x[4], s[5] * inv - x[5]), cvt_pk_bf16(s[6] * inv - x[6], s[7] * inv - x[7])}; }
    __syncthreads();
    f32x4 acc[8];
#pragma unroll
    for (int j = 0; j < 8; ++j) acc[j] = (f32x4){0.f, 0.f, 0.f, 0.f};
#pragma unroll
    for (int ks = 0; ks < 4; ++ks) { const bf16x8 af = *(const LAS bf16x8*)(PA + (16 * w + fr) * PST + (32 * ks + 8 * g) * 2);
#pragma unroll
        for (int j = 0; j < 8; ++j) { const bf16x8 bfr = *(const LAS bf16x8*)(WS + (16 * j + fr) * 256 + (((4 * ks + g) ^ fr) << 4));
            acc[j] = __builtin_amdgcn_mfma_f32_16x16x32_bf16(bfr, af, acc[j], 0, 0, 0); } }
    { const int t = 16 * w + fr;
#pragma unroll
      for (int j = 0; j < 8; ++j) { const f32x4 sc = scv[j];
          *(GAS u32x2*)(MIX + (size_t)(t0 + t) * D + 512 + grp * 128 + 16 * j + 4 * g) = (u32x2){cvt_pk_bf16(acc[j][0] * sc[0], acc[j][1] * sc[1]), cvt_pk_bf16(acc[j][2] * sc[2], acc[j][3] * sc[3])}; } }
    __syncthreads();
}
__device__ __forceinline__ void mixer_conv(Frame& F, int l, int chunk, int grp) {
    const Args& A = *F.a; const int lane = F.lane, w = F.wave, fr = lane & 15, g = lane >> 4, t0 = chunk * 128, tid = F.tid;
    const bf16_t* HB = (const bf16_t*)(F.ws + WS_HB); bf16_t* MIX = (bf16_t*)(F.ws + WS_MIX);
    LAS float* GT = (LAS float*)F.lds;
    const int pos0 = t0 & (SEQ - 1);
    for (int i = tid; i < 158 * 16; i += 512) { const int r = i >> 4, cc = i & 15; float o[8] = {0.f, 0.f, 0.f, 0.f, 0.f, 0.f, 0.f, 0.f};
        if (pos0 - 30 + r >= 0) { const bf16_t* rowp = HB + (size_t)(t0 - 30 + r) * INW + grp * 128 + 8 * cc; const u32x4 v = *(const GAS u32x4*)(rowp + 1536), gt = *(const GAS u32x4*)(rowp + 2048);
            o[0] = bf_lo(v.x) * fast_sigmoid(bf_lo(gt.x)); o[1] = bf_hi(v.x) * fast_sigmoid(bf_hi(gt.x)); o[2] = bf_lo(v.y) * fast_sigmoid(bf_lo(gt.y)); o[3] = bf_hi(v.y) * fast_sigmoid(bf_hi(gt.y));
            o[4] = bf_lo(v.z) * fast_sigmoid(bf_lo(gt.z)); o[5] = bf_hi(v.z) * fast_sigmoid(bf_hi(gt.z)); o[6] = bf_lo(v.w) * fast_sigmoid(bf_lo(gt.w)); o[7] = bf_hi(v.w) * fast_sigmoid(bf_hi(gt.w)); }
        *(LAS f32x4*)(GT + r * 128 + 8 * cc) = (f32x4){o[0], o[1], o[2], o[3]}; *(LAS f32x4*)(GT + r * 128 + 8 * cc + 4) = (f32x4){o[4], o[5], o[6], o[7]}; }
    __syncthreads();
    float y[32];
    { const int ch = tid & 127, tg = tid >> 7; float wv[31];
#pragma unroll
      for (int j = 0; j < 31; ++j) wv[j] = A.in[I_CONV_W][(size_t)(l * 31 + j) * GW + grp * 128 + ch];
      const float bias = A.in[I_CONV_B][l * GW + grp * 128 + ch];
      float xin[62];
#pragma unroll
      for (int j = 0; j < 62; ++j) xin[j] = GT[(tg * 32 + j) * 128 + ch];
#pragma unroll
      for (int t = 0; t < 32; ++t) { float s = bias;
#pragma unroll
          for (int j = 0; j < 31; ++j) s += wv[j] * xin[t + j];
          y[t] = s; }
      __syncthreads();
#pragma unroll
      for (int t = 0; t < 32; ++t) GT[(tg * 32 + t) * 128 + ch] = y[t]; }
    __syncthreads();
    { const float* gp = A.in[I_CONV_G] + l * GW + grp * 128 + 8 * fr; const float* bp = A.in[I_CONV_LB] + l * GW + grp * 128 + 8 * fr;
      const f32x4 g0 = *(const f32x4*)gp, g1 = *(const GAS f32x4*)(gp + 4), b0 = *(const f32x4*)bp, b1 = *(const GAS f32x4*)(bp + 4);
      const float gg[8] = {g0[0], g0[1], g0[2], g0[3], g1[0], g1[1], g1[2], g1[3]}, bb[8] = {b0[0], b0[1], b0[2], b0[3], b1[0], b1[1], b1[2], b1[3]};
#pragma unroll
      for (int p = 0; p < 4; ++p) { const int tok = 16 * w + 4 * p + g; const f32x4 a = *(const LAS f32x4*)(GT + tok * 128 + 8 * fr), b = *(const LAS f32x4*)(GT + tok * 128 + 8 * fr + 4);
          float v[8] = {a[0], a[1], a[2], a[3], b[0], b[1], b[2], b[3]}; float s = 0.f;
#pragma unroll
          for (int q = 0; q < 8; ++q) s += v[q];
          const float mean = g16_sum(s) * (1.f / 128.f); float s2 = 0.f;
#pragma unroll
          for (int q = 0; q < 8; ++q) { v[q] -= mean; s2 += v[q] * v[q]; }
          const float rstd = 1.f / sqrtf(g16_sum(s2) * (1.f / 128.f) + LN_EPS);
#pragma unroll
          for (int q = 0; q < 8; ++q) v[q] = silu_f(v[q] * rstd * gg[q] + bb[q]);
          *(GAS u32x4*)(MIX + (size_t)(t0 + tok) * D + 1024 + grp * 128 + 8 * fr) = (u32x4){cvt_pk_bf16(v[0], v[1]), cvt_pk_bf16(v[2], v[3]), cvt_pk_bf16(v[4], v[5]), cvt_pk_bf16(v[6], v[7])}; } }
    __syncthreads();
}
__device__ __forceinline__ void mixer_attn(Frame& F, int l, int chunk, int h) {
    const int lane = F.lane, w = F.wave, fr = lane & 15, g = lane >> 4, t0 = chunk * 128, b = t0 / SEQ, tid = F.tid;
    const bf16_t* HB = (const bf16_t*)(F.ws + WS_HB); bf16_t* MIX = (bf16_t*)(F.ws + WS_MIX);
    const bf16_t* KB = (const bf16_t*)(F.ws + WS_KBUF) + (size_t)(b * 256) * D + l * 512 + h * 128;
    const bf16_t* VTp = (const bf16_t*)(F.ws + WS_VT) + (size_t)(l * 512 + h * 128) * NMEMTOK + b * 256;
    LAS unsigned char* KS = F.lds;
    LAS unsigned char* VS = F.lds + 65536;
    { u32x4 kv[8], vv[8];
#pragma unroll
      for (int i = 0; i < 8; ++i) { const int id = tid + 512 * i; kv[i] = *(const GAS u32x4*)(KB + (size_t)(id >> 4) * D + (id & 15) * 8); vv[i] = *(const GAS u32x4*)(VTp + (size_t)(id >> 5) * NMEMTOK + (id & 31) * 8); }
#pragma unroll
      for (int i = 0; i < 8; ++i) { const int id = tid + 512 * i; const int m = id >> 4, c = id & 15, d = id >> 5, c2 = id & 31;
          *(LAS u32x4*)(KS + m * 256 + ((c ^ (m & 15)) << 4)) = kv[i]; *(LAS u32x4*)(VS + d * 512 + ((c2 ^ (d & 15)) << 4)) = vv[i]; } }
    __syncthreads();
    const int t = 16 * w + fr;
    f32x4 sa[16];
#pragma unroll
    for (int j = 0; j < 16; ++j) sa[j] = (f32x4){0.f, 0.f, 0.f, 0.f};
    bf16x8 qf[4];
#pragma unroll
    for (int ks = 0; ks < 4; ++ks) qf[ks] = *(const GAS bf16x8*)(HB + (size_t)(t0 + t) * INW + 2560 + h * 128 + 32 * ks + 8 * g);
#pragma unroll
    for (int ks = 0; ks < 4; ++ks)
#pragma unroll
        for (int j = 0; j < 16; ++j) { const bf16x8 kf = *(const LAS bf16x8*)(KS + (16 * j + fr) * 256 + (((4 * ks + g) ^ fr) << 4));
            sa[j] = __builtin_amdgcn_mfma_f32_16x16x32_bf16(kf, qf[ks], sa[j], 0, 0, 0); }
    float mx = -3.0e38f;
#pragma unroll
    for (int j = 0; j < 16; ++j) mx = fmaxf(mx, fmaxf(fmaxf(sa[j][0], sa[j][1]), fmaxf(sa[j][2], sa[j][3])));
    mx = fmaxf(mx, __shfl_xor(mx, 16)); mx = fmaxf(mx, __shfl_xor(mx, 32));
    const float sc = 0.08838834764831845f * 1.4426950408889634f; float sum = 0.f;
#pragma unroll
    for (int j = 0; j < 16; ++j)
#pragma unroll
        for (int r = 0; r < 4; ++r) { const float p = __builtin_amdgcn_exp2f((sa[j][r] - mx) * sc); sa[j][r] = p; sum += p; }
    sum += __shfl_xor(sum, 16); sum += __shfl_xor(sum, 32);
    const float inv = 1.0f / sum;
    f32x4 oa[8];
#pragma unroll
    for (int j = 0; j < 8; ++j) oa[j] = (f32x4){0.f, 0.f, 0.f, 0.f};
#pragma unroll
    for (int q = 0; q < 8; ++q) {
        union { bf16x8 v; unsigned u[4]; } pf; pf.u[0] = cvt_pk_bf16(sa[2 * q][0], sa[2 * q][1]); pf.u[1] = cvt_pk_bf16(sa[2 * q][2], sa[2 * q][3]);
        pf.u[2] = cvt_pk_bf16(sa[2 * q + 1][0], sa[2 * q + 1][1]); pf.u[3] = cvt_pk_bf16(sa[2 * q + 1][2], sa[2 * q + 1][3]);
#pragma unroll
        for (int jd = 0; jd < 8; ++jd) {
            const LAS unsigned char* vrow = VS + (16 * jd + fr) * 512 + ((g & 1) << 3);
            union { bf16x8 v; u32x2 u[2]; } vf; vf.u[0] = *(const LAS u32x2*)(vrow + (((4 * q + (g >> 1)) ^ fr) << 4)); vf.u[1] = *(const LAS u32x2*)(vrow + (((4 * q + 2 + (g >> 1)) ^ fr) << 4));
            oa[jd] = __builtin_amdgcn_mfma_f32_16x16x32_bf16(vf.v, pf.v, oa[jd], 0, 0, 0); } }
#pragma unroll
    for (int jd = 0; jd < 8; ++jd)
        *(GAS u32x2*)(MIX + (size_t)(t0 + t) * D + 1536 + h * 128 + 16 * jd + 4 * g) = (u32x2){cvt_pk_bf16(oa[jd][0] * inv, oa[jd][1] * inv), cvt_pk_bf16(oa[jd][2] * inv, oa[jd][3] * inv)};
    __syncthreads();
}

#if PROBE_CLASS >= 0
#define PROBE_SUB(F, cls) do { if (blockIdx.x == 0 && (F).tid == 0) { volatile LAS unsigned* M_ = (volatile LAS unsigned*)((F).lds + LDS_MISC); const unsigned n_ = (unsigned)wall_clock64(); if ((cls) == PROBE_CLASS || PROBE_CLASS == 99) M_[65] += n_ - M_[64]; M_[64] = n_; } } while (0)
#else
#define PROBE_SUB(F, cls) do { } while (0)
#endif
template <int NW> __device__ __forceinline__ void dsync(LAS unsigned* ctr, unsigned& nb, int lane) {
    if constexpr (NW == 8) { asm volatile("s_waitcnt vmcnt(0)" ::: "memory"); __syncthreads(); }
    else { asm volatile("s_waitcnt vmcnt(0) lgkmcnt(0)" ::: "memory"); ++nb;
        if (lane == 0) __hip_atomic_fetch_add(ctr, 1u, __ATOMIC_RELAXED, __HIP_MEMORY_SCOPE_WORKGROUP);
        while (__hip_atomic_load(ctr, __ATOMIC_RELAXED, __HIP_MEMORY_SCOPE_WORKGROUP) < (unsigned)NW * nb) __builtin_amdgcn_s_sleep(1);
        asm volatile("" ::: "memory"); }
}
template <int NW> __device__ __forceinline__ void phase_d(Frame& F, int l) {
    constexpr int TPW = 32 / NW, KW = D / NW;
    const Args& A = *F.a; unsigned char* ws = F.ws; const int lane = F.lane, w = F.wave, tid = F.tid, fr = lane & 15, g = lane >> 4;
    const bf16_t* Y1 = (const bf16_t*)(ws + WS_Y1); bf16_t* X1L = (bf16_t*)(ws + WS_X1F); bf16_t* X1B = (bf16_t*)(ws + WS_X1B);
    const bf16_t* WRH = (const bf16_t*)(ws + WS_WR_HI) + (size_t)l * NE * D; const bf16_t* WRL = (const bf16_t*)(ws + WS_WR_LO) + (size_t)l * NE * D;
    int* LIST = (int*)(ws + WS_LIST); int* AEP = (int*)(ws + WS_ASG_EP); float* AW = (float*)(ws + WS_ASG_W);
    unsigned* CNT = (unsigned*)(ws + WS_CTL) + CW_CNT + (size_t)l * 64 * CNT_STRIDE;
    LAS float* PL = (LAS float*)F.lds;
    LAS unsigned* HIST = (LAS unsigned*)(F.lds + NW * 32 * 65 * 4);
    LAS unsigned* ctr = (LAS unsigned*)(F.lds + LDS_MISC) + 16; unsigned nb = 0u;
    for (int blk = F.vcu; blk < NTOK / 32; blk += F.G) {
        const int tok0 = blk * 32;
        if (tid < 128) HIST[tid] = 0u;
        PROBE_SUB(F, 8);
        { constexpr int PF = 2;
          const GAS u32x2* yb = (const GAS u32x2*)(Y1 + (size_t)(tok0 + TPW * w) * D) + lane;
          GAS u32x2* xh = (GAS u32x2*)(X1B + (size_t)(tok0 + TPW * w) * D) + lane; GAS u32x2* xl = (GAS u32x2*)(X1L + (size_t)(tok0 + TPW * w) * D) + lane;
          u32x2 raw[PF][8]; f32x4 gg[8], bb[8];
#pragma unroll
          for (int q = 0; q < PF; ++q)
#pragma unroll
              for (int j = 0; j < 8; ++j) raw[q][j] = yb[q * (D / 4) + 64 * j];
#pragma unroll
          for (int j = 0; j < 8; ++j) { gg[j] = ((const GAS f32x4*)(A.in[I_LN1_G] + l * D))[lane + 64 * j]; bb[j] = ((const GAS f32x4*)(A.in[I_LN1_B] + l * D))[lane + 64 * j]; }
#pragma unroll
          for (int tt = 0; tt < TPW; ++tt) { f32x4 v[8]; float s = 0.f;
#pragma unroll
              for (int j = 0; j < 8; ++j) { const u32x2 r = raw[tt % PF][j]; v[j] = (f32x4){bf_lo(r.x), bf_hi(r.x), bf_lo(r.y), bf_hi(r.y)}; s += (v[j][0] + v[j][1]) + (v[j][2] + v[j][3]); }
              if (tt + PF < TPW) {
#pragma unroll
                  for (int j = 0; j < 8; ++j) raw[tt % PF][j] = yb[(tt + PF) * (D / 4) + 64 * j]; }
              const float mean = wave_sum(s) * (1.f / D); float s2 = 0.f;
#pragma unroll
              for (int j = 0; j < 8; ++j) { v[j] = v[j] - mean; s2 += (v[j][0] * v[j][0] + v[j][1] * v[j][1]) + (v[j][2] * v[j][2] + v[j][3] * v[j][3]); }
              const float rstd = 1.f / sqrtf(wave_sum(s2) * (1.f / D) + LN_EPS);
#pragma unroll
              for (int j = 0; j < 8; ++j) { const f32x4 o = v[j] * rstd * gg[j] + bb[j];
                  const unsigned h0 = cvt_pk_bf16(o[0], o[1]), h1 = cvt_pk_bf16(o[2], o[3]);
                  xh[tt * (D / 4) + 64 * j] = (u32x2){h0, h1};
                  xl[tt * (D / 4) + 64 * j] = (u32x2){cvt_pk_bf16(o[0] - bf_lo(h0), o[1] - bf_hi(h0)), cvt_pk_bf16(o[2] - bf_lo(h1), o[3] - bf_hi(h1))}; } } }
        dsync<NW>(ctr, nb, lane); PROBE_SUB(F, 9);
        { f32x4 acc[2][4];
#pragma unroll
          for (int rb = 0; rb < 2; ++rb)
#pragma unroll
              for (int cb = 0; cb < 4; ++cb) acc[rb][cb] = (f32x4){0.f, 0.f, 0.f, 0.f};
          constexpr int NS = 2, NB = KW / 32;
          const GAS bf16x8* pah = (const GAS bf16x8*)(X1B + (size_t)(tok0 + fr) * D + KW * w + 8 * g); const GAS bf16x8* pal = (const GAS bf16x8*)(X1L + (size_t)(tok0 + fr) * D + KW * w + 8 * g);
          const GAS bf16x8* pbh = (const GAS bf16x8*)WRH + (KW / 32 * w) * 64 + lane;                   const GAS bf16x8* pbl = (const GAS bf16x8*)WRL + (KW / 32 * w) * 64 + lane;
          bf16x8 ah[NS][2], al[NS][2], bh[NS][4], bl[NS][4];
#define RT_LOAD(buf, b) do { const int ko = 4 * (b); \
              _Pragma("unroll") for (int rb = 0; rb < 2; ++rb) { ah[buf][rb] = pah[rb * 2 * D + ko]; al[buf][rb] = pal[rb * 2 * D + ko]; } \
              _Pragma("unroll") for (int cb = 0; cb < 4; ++cb) { bh[buf][cb] = pbh[cb * (D / 32) * 64 + 64 * (b)]; bl[buf][cb] = pbl[cb * (D / 32) * 64 + 64 * (b)]; } } while (0)
#pragma unroll
          for (int b = 0; b < NS - 1; ++b) RT_LOAD(b, b);
#pragma unroll 1
          for (int b0 = 0; b0 < NB; b0 += NS) {
#pragma unroll
              for (int s_ = 0; s_ < NS; ++s_) { const int b = b0 + s_;
                  if (b < NB) {
                      if (b + NS - 1 < NB) RT_LOAD((s_ + NS - 1) % NS, b + NS - 1);
                      __builtin_amdgcn_sched_barrier(0);
#pragma unroll
                      for (int cb = 0; cb < 4; ++cb)
#pragma unroll
                          for (int rb = 0; rb < 2; ++rb) { acc[rb][cb] = __builtin_amdgcn_mfma_f32_16x16x32_bf16(ah[s_][rb], bh[s_][cb], acc[rb][cb], 0, 0, 0);
                              acc[rb][cb] = __builtin_amdgcn_mfma_f32_16x16x32_bf16(ah[s_][rb], bl[s_][cb], acc[rb][cb], 0, 0, 0); acc[rb][cb] = __builtin_amdgcn_mfma_f32_16x16x32_bf16(al[s_][rb], bh[s_][cb], acc[rb][cb], 0, 0, 0); }
                      __builtin_amdgcn_sched_barrier(0); } } }
#undef RT_LOAD
#pragma unroll
          for (int rb = 0; rb < 2; ++rb)
#pragma unroll
              for (int cb = 0; cb < 4; ++cb)
#pragma unroll
                  for (int r = 0; r < 4; ++r) PL[(w * 32 + 16 * rb + 4 * g + r) * 65 + 16 * cb + fr] = acc[rb][cb][r]; }
        dsync<NW>(ctr, nb, lane); PROBE_SUB(F, 10);
        const int tq = lane >> 3, gi = lane & 7; const bool act = tq < TPW; const int tl = TPW * w + (act ? tq : 0), tokq = tok0 + tl;
        float sc8[8], mc[8]; unsigned selm = 0u; unsigned loc8[8]; float rsum; int kbase;
        { float lg[8];
#pragma unroll
          for (int i = 0; i < 8; ++i) lg[i] = 0.f;
#pragma unroll
          for (int ww = 0; ww < NW; ++ww)
#pragma unroll
              for (int i = 0; i < 8; ++i) lg[i] += PL[(ww * 32 + tl) * 65 + 8 * gi + i];
          const f32x4 rb0 = *(const GAS f32x4*)(A.in[I_R_BIAS] + l * NE + 8 * gi), rb1 = *(const GAS f32x4*)(A.in[I_R_BIAS] + l * NE + 8 * gi + 4);
          const float rb[8] = {rb0[0], rb0[1], rb0[2], rb0[3], rb1[0], rb1[1], rb1[2], rb1[3]};
          float m1 = -INFINITY, m2 = -INFINITY;
#pragma unroll
          for (int i = 0; i < 8; ++i) { sc8[i] = 1.0f / (1.0f + __expf(-lg[i])); mc[i] = sc8[i] + rb[i]; m2 = fmaxf(m2, fminf(m1, mc[i])); m1 = fmaxf(m1, mc[i]); }
          const float gs = m1 + m2; int grank = 0;
#pragma unroll
          for (int j = 1; j < 8; ++j) { const float gv = __shfl_xor(gs, j); grank += (gv > gs || (gv == gs && (gi ^ j) < gi)) ? 1 : 0; }
          if (grank >= 4) {
#pragma unroll
              for (int i = 0; i < 8; ++i) mc[i] = -INFINITY; } }
#pragma unroll 1
        for (int r = 0; r < TOPK; ++r) {
            float bv = mc[0]; int bi = 0;
#pragma unroll
            for (int i = 1; i < 8; ++i) { const bool t_ = mc[i] > bv; bv = t_ ? mc[i] : bv; bi = t_ ? i : bi; }
            float v = bv; int own = gi;
#pragma unroll
            for (int m = 1; m < 8; m <<= 1) { const float ov = __shfl_xor(v, m); const int oo = __shfl_xor(own, m); const bool t_ = (ov > v) || (ov == v && oo < own); v = t_ ? ov : v; own = t_ ? oo : own; }
            const bool mine = own == gi;
#pragma unroll
            for (int i = 0; i < 8; ++i) { const bool h_ = mine && bi == i; mc[i] = h_ ? -INFINITY : mc[i]; selm |= h_ ? (1u << i) : 0u; } }
        { float ps = 0.f;
#pragma unroll
          for (int i = 0; i < 8; ++i) ps += ((selm >> i) & 1u) ? sc8[i] : 0.f;
          ps += __shfl_xor(ps, 1); ps += __shfl_xor(ps, 2); ps += __shfl_xor(ps, 4); rsum = 2.5f / (ps + 1e-20f);
          const int cnt = __popc(selm); int inc = cnt;
#pragma unroll
          for (int m = 1; m < 8; m <<= 1) { const int o = __shfl_up(inc, m); inc += (gi >= m) ? o : 0; }
          kbase = inc - cnt; }
#pragma unroll
        for (int i = 0; i < 8; ++i) { loc8[i] = 0u; if (act && ((selm >> i) & 1u)) loc8[i] = __hip_atomic_fetch_add(&HIST[8 * gi + i], 1u, __ATOMIC_RELAXED, __HIP_MEMORY_SCOPE_WORKGROUP); }
        dsync<NW>(ctr, nb, lane); PROBE_SUB(F, 11);
        if (tid < 64) { const unsigned n = HIST[tid]; HIST[64 + tid] = n ? __hip_atomic_fetch_add(CNT + tid * CNT_STRIDE, n, __ATOMIC_RELAXED, __HIP_MEMORY_SCOPE_AGENT) : 0u; }
        dsync<NW>(ctr, nb, lane);
        int gi2 = gi; asm volatile("" : "+v"(gi2));
#pragma unroll
        for (int i = 0; i < 8; ++i) if (act && ((selm >> i) & 1u)) { const int e = 8 * gi2 + i, k = kbase + __popc(selm & ((1u << i) - 1u)); const unsigned pos = HIST[64 + e] + loc8[i];
            LIST[e * NTOK + pos] = tokq; AEP[tokq * 8 + k] = (int)((unsigned)e << 16 | pos); AW[tokq * 8 + k] = sc8[i] * rsum; }
        dsync<NW>(ctr, nb, lane); PROBE_SUB(F, 12);
    }
}

__device__ __forceinline__ void build_etab(Frame& F, int l) {
    LAS int* ET = (LAS int*)(F.lds + LDS_ETAB);
    unsigned* CNT = (unsigned*)(F.ws + WS_CTL) + CW_CNT + (size_t)l * 64 * CNT_STRIDE;
    if (F.tid < NE1) ET[F.tid] = F.tid < NE ? (int)__hip_atomic_load(CNT + F.tid * CNT_STRIDE, __ATOMIC_RELAXED, __HIP_MEMORY_SCOPE_AGENT) : NTOK;
    __syncthreads();
    if (F.tid == 0) { int ts = 0;
#pragma unroll 1
        for (int e = 0; e < NE1; ++e) { ET[68 + e] = ts; ET[136 + e] = ts * 256; ts += (ET[e] + 255) >> 8; } ET[68 + NE1] = ts; }
    __syncthreads();
}
struct ExpertSched {
    LAS const int* UD;
    LAS const unsigned* RT;
    const char* Abase; const char* Bbase; size_t bstride_e, bstride_pn; int arow_bytes, ncol; bool gather;
    __device__ __forceinline__ bool next(int i, pg8::Unit& u) const {
        if (i >= 16) return false; const int e = __builtin_amdgcn_readfirstlane(UD[4 * i]); if (e < 0) return false;
        const int row0 = __builtin_amdgcn_readfirstlane(UD[4 * i + 1]), pn = __builtin_amdgcn_readfirstlane(UD[4 * i + 2]);
        u.A = gather ? Abase : Abase + (size_t)row0 * arow_bytes; u.B = Bbase + (size_t)e * bstride_e + (size_t)pn * bstride_pn; u.row0 = row0; u.col0 = pn * ncol; u.nvalid = __builtin_amdgcn_readfirstlane(UD[4 * i + 3]); u.aux = e; return true;
    }
    __device__ __forceinline__ unsigned rowoff(int i, int r) const { return RT[i * 256 + r]; }
};
__device__ __forceinline__ int phase_role(const Frame& F, int NU, int& Gp) {
    NU = __builtin_amdgcn_readfirstlane(NU);
    if (F.G != 256 || NU <= 0) { Gp = F.G; return F.vcu; }
    const int R = (NU + 255) / 256; int g = (NU + R - 1) / R; g = (g + 7) & ~7; if (g > 256) g = 256; Gp = g;
    const int per = g >> 3, x = F.vcu >> 5, r = F.vcu & 31;
    return r < per ? x * per + r : -1 - (x * (32 - per) + (r - per));
}
__device__ __forceinline__ void build_units(Frame& F, int npn, bool gather, int cp, int Gp) {
    LAS int* ET = (LAS int*)(F.lds + LDS_ETAB); LAS int* UD = (LAS int*)(F.lds + LDS_UDESC); LAS unsigned* RT = (LAS unsigned*)(F.lds + LDS_ROWTAB);
    const int NU = ET[68 + NE1] * npn;
    if (F.tid < 16) { const int U = cp + F.tid * Gp; int e = -1, row0 = 0, pn = 0, nv = 0;
        if (U < NU) { const int tile = U / npn; pn = U % npn; e = 0;
#pragma unroll 1
            while (e < NE && ET[68 + e + 1] <= tile) ++e; const int mt = tile - ET[68 + e]; row0 = ET[136 + e] + 256 * mt; nv = ET[e] - 256 * mt; nv = nv > 256 ? 256 : nv; }
        UD[4 * F.tid] = e; UD[4 * F.tid + 1] = row0; UD[4 * F.tid + 2] = pn; UD[4 * F.tid + 3] = nv; }
    __syncthreads();
    if (gather) { const int* LIST = (const int*)(F.ws + WS_LIST);
        for (int i = F.tid; i < 4 * 256; i += 512) { const int ui = i >> 8, r = i & 255; const int e = UD[4 * ui]; unsigned off = 0u;
            if (e >= 0) { const int row0 = UD[4 * ui + 1], nv = UD[4 * ui + 3]; const int lr = row0 - ET[136 + e] + r; int tok = 0;
                tok = NTOK;
                if (r < nv) tok = (e < NE) ? LIST[e * NTOK + lr] : lr;
                off = (unsigned)tok * (unsigned)(D * 2); }
            RT[i] = off; }
        __syncthreads(); }
}

__device__ __forceinline__ void phase_g(Frame& F, int l) {
    const Args& A = *F.a; unsigned char* ws = F.ws; const int lane = F.lane;
    if (l + 1 < NL) { convert_cleanup(F, l * L_ITEMS + LI_X, (l + 1) * L_ITEMS); __syncthreads(); }
    build_etab(F, l);
    LAS const int* SB = (LAS const int*)(F.lds + LDS_ETAB) + 136;
    const bf16_t* X1B = (const bf16_t*)(ws + WS_X1B); const unsigned char* OB = (const unsigned char*)(ws + WS_OB); const int* AEP = (const int*)(ws + WS_ASG_EP); const float* AW = (const float*)(ws + WS_ASG_W);
    float* XO = (l == NL - 1) ? A.out : (float*)nullptr; bf16_t* XB = (bf16_t*)(ws + WS_XB);
    const bf16_t* OSH = (const bf16_t*)(ws + WS_OSH);
    LAS float* YS = (LAS float*)(F.lds + F.wave * 8192);
    int ep_n = 0; float w_n = 0.f;
    { const int tok0 = F.vcu * 8 + F.wave; if (tok0 < NTOK && lane < 8) { ep_n = AEP[tok0 * 8 + lane]; w_n = AW[tok0 * 8 + lane]; } }
    for (int tok = F.vcu * 8 + F.wave; tok < NTOK; tok += F.G * 8) {
        int slot = 0; const float wv = w_n;
        if (lane < 8) slot = SB[ep_n >> 16] + (ep_n & 0xffff);
        { const int tn = tok + F.G * 8; if (tn < NTOK && lane < 8) { ep_n = AEP[tn * 8 + lane]; w_n = AW[tn * 8 + lane]; } }
        float s = 0.f;
        u32x2 ovA[8], ovB[8]; u32x4 xrA, xrB, osA, osB;
#define G_LOADS(ov, xr, os, j) do { xr = *(const u32x4*)(X1B + (size_t)tok * D + 512 * (j) + 8 * lane); os = *(const u32x4*)(OSH + (size_t)tok * D + 512 * (j) + 8 * lane); \
            _Pragma("unroll") for (int k = 0; k < 8; ++k) { const int sl = __builtin_amdgcn_readlane(slot, k); ov[k] = *(const u32x2*)(OB + (size_t)sl * D + 512 * (j) + 8 * lane); } } while (0)
#define G_COMBINE(ov, xr, os, j) do { \
            float y[8] = {ALPHA * bf_lo(xr.x) + bf_lo(os.x), ALPHA * bf_hi(xr.x) + bf_hi(os.x), ALPHA * bf_lo(xr.y) + bf_lo(os.y), ALPHA * bf_hi(xr.y) + bf_hi(os.y), \
                          ALPHA * bf_lo(xr.z) + bf_lo(os.z), ALPHA * bf_hi(xr.z) + bf_hi(os.z), ALPHA * bf_lo(xr.w) + bf_lo(os.w), ALPHA * bf_hi(xr.w) + bf_hi(os.w)}; \
            _Pragma("unroll") for (int k = 0; k < 8; ++k) { const float wk = __int_as_float(__builtin_amdgcn_readlane(__float_as_int(wv), k)) * (1.0f / pg8::O8_SCALE); \
                const f32x2 a = __builtin_amdgcn_cvt_pk_f32_fp8((int)ov[k].x, false), b = __builtin_amdgcn_cvt_pk_f32_fp8((int)ov[k].x, true), \
                            c2 = __builtin_amdgcn_cvt_pk_f32_fp8((int)ov[k].y, false), d2 = __builtin_amdgcn_cvt_pk_f32_fp8((int)ov[k].y, true); \
                y[0] += wk * a.x; y[1] += wk * a.y; y[2] += wk * b.x; y[3] += wk * b.y; y[4] += wk * c2.x; y[5] += wk * c2.y; y[6] += wk * d2.x; y[7] += wk * d2.y; } \
            s += ((y[0] + y[1]) + (y[2] + y[3])) + ((y[4] + y[5]) + (y[6] + y[7])); \
            *(LAS f32x4*)(YS + 512 * (j) + 8 * lane) = (f32x4){y[0], y[1], y[2], y[3]}; *(LAS f32x4*)(YS + 512 * (j) + 8 * lane + 4) = (f32x4){y[4], y[5], y[6], y[7]}; } while (0)
        G_LOADS(ovA, xrA, osA, 0); G_LOADS(ovB, xrB, osB, 1);
        G_COMBINE(ovA, xrA, osA, 0); G_LOADS(ovA, xrA, osA, 2);
        G_COMBINE(ovB, xrB, osB, 1); G_LOADS(ovB, xrB, osB, 3);
        G_COMBINE(ovA, xrA, osA, 2);
        G_COMBINE(ovB, xrB, osB, 3);
#undef G_LOADS
#undef G_COMBINE
        const float mean = wave_sum(s) * (1.f / D); float s2 = 0.f;
#pragma unroll 1
        for (int j = 0; j < 4; ++j) { const f32x4 a = *(const LAS f32x4*)(YS + 512 * j + 8 * lane) - mean, b = *(const LAS f32x4*)(YS + 512 * j + 8 * lane + 4) - mean;
            s2 += ((a[0] * a[0] + a[1] * a[1]) + (a[2] * a[2] + a[3] * a[3])) + ((b[0] * b[0] + b[1] * b[1]) + (b[2] * b[2] + b[3] * b[3])); }
        const float rstd = 1.f / sqrtf(wave_sum(s2) * (1.f / D) + LN_EPS);
#pragma unroll 1
        for (int j = 0; j < 4; ++j) { const f32x4* gp = (const f32x4*)(A.in[I_LN2_G] + l * D + 512 * j + 8 * lane); const f32x4* bp = (const f32x4*)(A.in[I_LN2_B] + l * D + 512 * j + 8 * lane);
            const f32x4 a = *(const LAS f32x4*)(YS + 512 * j + 8 * lane) - mean, b = *(const LAS f32x4*)(YS + 512 * j + 8 * lane + 4) - mean;
            const f32x4 o0 = a * rstd * gp[0] + bp[0], o1 = b * rstd * gp[1] + bp[1];
            if (XO) { f32x4* op = (f32x4*)(XO + (size_t)tok * D + 512 * j + 8 * lane); op[0] = o0; op[1] = o1; }
            if (!XO) *(u32x4*)(XB + (size_t)tok * D + 512 * j + 8 * lane) = (u32x4){cvt_pk_bf16(o0[0], o0[1]), cvt_pk_bf16(o0[2], o0[3]), cvt_pk_bf16(o1[0], o1[1]), cvt_pk_bf16(o1[2], o1[3])}; }
    }
}

constexpr int NPHASE = 2 + 7 * NL;
__global__ void __launch_bounds__(512, 2) mk_fwd(Args args) {
    extern __shared__ __attribute__((aligned(16))) unsigned char lds[];
#define PHASE_FRAME() Frame F; { int tz_ = threadIdx.x; asm volatile("" : "+v"(tz_)); int bz_ = blockIdx.x; asm volatile("" : "+s"(bz_)); unsigned char* wz_ = args.ws; asm volatile("" : "+s"(wz_)); \
        F.lds = (LAS unsigned char*)lds; F.tid = tz_; F.lane = tz_ & 63; F.wave = __builtin_amdgcn_readfirstlane(tz_ >> 6); F.G = gridDim.x; F.vcu = (F.G % 8 == 0) ? (bz_ % 8) * (F.G / 8) + bz_ / 8 : bz_; F.a = &args; F.ws = wz_; } \
        unsigned char* ws = F.ws; const int c = F.vcu; (void)ws; (void)c
    volatile LAS unsigned* MISC = (volatile LAS unsigned*)((LAS unsigned char*)lds + LDS_MISC);
    if (threadIdx.x < 128) MISC[threadIdx.x] = 0u;
    __syncthreads();
    unsigned* ctl = (unsigned*)(args.ws + WS_CTL);
    XcdBarrier bar; bar.bar = ctl + CW_BAR; bar.x = 0; bar.st = nullptr;
    const int lo = args.ph_lo, hi = args.ph_hi;
    if (hi - lo > 1) bar = xcd_barrier_post(ctl + CW_BAR, MISC + 8);
#define IN(k) (lo <= (k) && (k) < hi)
#if PROBE_CLASS >= 0
#define PROBE_MARK(cls) do { if (blockIdx.x == 0 && threadIdx.x == 0) { const unsigned n_ = (unsigned)wall_clock64(); if ((cls) == PROBE_CLASS || PROBE_CLASS == 99) MISC[65] += n_ - MISC[64]; MISC[64] = n_; } } while (0)
    if (blockIdx.x == 0 && threadIdx.x == 0) MISC[64] = (unsigned)wall_clock64();
#else
#define PROBE_MARK(cls) do { } while (0)
#endif
#define SEAM(k) do { if (IN(k) && IN((k) + 1)) xcd_barrier(bar); } while (0)

    if (IN(0)) { REP_LOOP(REP_P0) { PHASE_FRAME(); p0_prologue(F); } if (IN(2)) xcd_barrier(bar); PROBE_MARK(7); }
#pragma unroll 1
    for (int l_ = 0; l_ < NL; ++l_) {
        const int pb = 2 + 7 * l_;
        if (IN(pb + 0)) {
            REP_LOOP(REP_A) {
            PHASE_FRAME(); int l = l_; asm volatile("" : "+s"(l));
            int Gp; const int role = phase_role(F, (NTOK / 256) * (INW / 256), Gp); unsigned* PD = (unsigned*)(ws + WS_CTL) + CW_PD + (pb + 0) * 64;
            if (role >= 0) {
                pg8::DenseSched S; S.init((const bf16_t*)(ws + WS_XB), (const bf16_t*)(ws + WS_WT_IN) + (size_t)l * INW * D, NTOK, INW, D, Gp, role);
                pg8::EpiStoreBf16 E{(bf16_t*)(ws + WS_HB), INW};
                pg8::gemm_phase<pg8::EpiStoreBf16, pg8::DenseSched, false>(F.lds, D, S, E);
                if (Gp == F.G && role + F.G >= (NTOK / 256) * (INW / 256)) { __syncthreads(); convert_fill(F, l * L_ITEMS, 1); }
                if (F.tid == 0) xb_add(PD, 1u);
            } else {
                const int k = -1 - role;
                if (l == 0) {
                    { pg8::DenseSched S2; S2.init((const bf16_t*)(ws + WS_MEMN), (const bf16_t*)(ws + WS_WT_K), NMEMTOK, NL * 512, D, F.G, k);
                      pg8::EpiStoreBf16 E2{(bf16_t*)(ws + WS_KBUF), NL * 512};
                      pg8::gemm_phase<pg8::EpiStoreBf16, pg8::DenseSched, false>(F.lds, D, S2, E2); }
                    { pg8::DenseSched S2; S2.init((const bf16_t*)(ws + WS_WT_V), (const bf16_t*)(ws + WS_MEMN), NL * 512, NMEMTOK, D, F.G, k - 32);
                      pg8::EpiStoreBf16 E2{(bf16_t*)(ws + WS_VT), NMEMTOK};
                      pg8::gemm_phase<pg8::EpiStoreBf16, pg8::DenseSched, false>(F.lds, D, S2, E2); }
                    __syncthreads();
                }
#if PACE > 0
                convert_paced(F, l * L_ITEMS, PD, (unsigned)Gp / STOP_DIV + 1u);
#else
                convert_fill(F, l * L_ITEMS, (l == 0 && k < 64) ? FILL_A0 : FILL_A);
#endif
            } }
            SEAM(pb + 0); PROBE_MARK(0);
        }
        if (IN(pb + 1)) {
            REP_LOOP(REP_B) { PHASE_FRAME(); int l = l_; asm volatile("" : "+s"(l));
            for (int it = c; it < 256; it += F.G) mixer_sgu(F, l, it >> 2, it & 3);
            for (int it = c; it < 256; it += F.G) mixer_pool(F, l, it >> 2, it & 3);
            for (int it = c; it < 256; it += F.G) mixer_conv(F, l, it >> 2, it & 3);
            for (int it = c; it < 256; it += F.G) mixer_attn(F, l, it >> 2, it & 3); }
            SEAM(pb + 1); PROBE_MARK(1);
        }
        if (IN(pb + 2)) {
            REP_LOOP(REP_C) {
            PHASE_FRAME(); int l = l_; asm volatile("" : "+s"(l));
            pg8::DenseSched S; S.init((const bf16_t*)(ws + WS_MIX), (const bf16_t*)(ws + WS_WT_OUT) + (size_t)l * D * D, NTOK, D, D, F.G, c);
            pg8::EpiResidBf16 E{(bf16_t*)(ws + WS_Y1), l == 0 ? args.in[I_X] : (const float*)nullptr, (const bf16_t*)(ws + WS_XB), D, ALPHA};
            pg8::gemm_phase<pg8::EpiResidBf16, pg8::DenseSched, false>(F.lds, D, S, E); __syncthreads(); }
            SEAM(pb + 2); PROBE_MARK(2);
        }
        if (IN(pb + 3)) { PHASE_FRAME(); int l = l_; asm volatile("" : "+s"(l));
            if (F.G * 32 == NTOK) {
                if (F.tid == 0) ((LAS unsigned*)(F.lds + LDS_MISC))[16] = 0u;
                __syncthreads();
                if (F.wave < 4) phase_d<4>(F, l);
                else {
#if PROBE_CLASS == 13
                    const unsigned t0_ = (unsigned)wall_clock64();
#endif
                    convert_beside_d(F, l * L_ITEMS, l * L_ITEMS + LI_X);
#if PROBE_CLASS == 13
                    if (blockIdx.x == 0 && F.tid == 256) { volatile LAS unsigned* M_ = (volatile LAS unsigned*)(F.lds + LDS_MISC); M_[65] += (unsigned)wall_clock64() - t0_; }
#endif
                }
            } else { convert_cleanup(F, l * L_ITEMS, l * L_ITEMS + LI_X); __syncthreads(); phase_d<8>(F, l); }
            SEAM(pb + 3); PROBE_MARK(3); }
        if (IN(pb + 4)) {
            REP_LOOP(REP_E) {
            PHASE_FRAME(); int l = l_; asm volatile("" : "+s"(l));
            if (c == 0 && F.tid == 0) __hip_atomic_fetch_max((unsigned*)(ws + WS_CTL) + CW_Q, (unsigned)(l * L_ITEMS + LI_X), __ATOMIC_RELAXED, __HIP_MEMORY_SCOPE_AGENT);
            build_etab(F, l);
            int Gp; const int role = phase_role(F, ((LAS const int*)(F.lds + LDS_ETAB))[68 + NE1] * 2, Gp); unsigned* PD = (unsigned*)(ws + WS_CTL) + CW_PD + (pb + 4) * 64;
            if (role >= 0) {
                build_units(F, 2, true, role, Gp);
                ExpertSched S; S.UD = (LAS const int*)(F.lds + LDS_UDESC); S.RT = (LAS const unsigned*)(F.lds + LDS_ROWTAB);
                S.Abase = (const char*)(ws + WS_X1B); S.Bbase = (const char*)(ws + WS_WT_GU) + (size_t)l * NE1 * 512 * D * 2; S.bstride_e = (size_t)512 * D * 2; S.bstride_pn = (size_t)256 * D * 2; S.arow_bytes = D * 2; S.ncol = 128; S.gather = true;
                pg8::EpiSwiglu E{(bf16_t*)(ws + WS_HE)};
                pg8::gemm_phase<pg8::EpiSwiglu, ExpertSched, true>(F.lds, D, S, E);
                if (F.tid == 0) xb_add(PD, 1u);
            } else {
#if PACE > 0
                convert_paced(F, l * L_ITEMS + LI_X, PD, (unsigned)Gp / STOP_DIV + 1u);
#else
                convert_fill(F, l * L_ITEMS + LI_X, FILL_E);
#endif
            }
            __syncthreads(); }
            SEAM(pb + 4); PROBE_MARK(4);
        }
        if (IN(pb + 5)) {
            REP_LOOP(REP_F) {
            PHASE_FRAME(); int l = l_; asm volatile("" : "+s"(l));
            build_etab(F, l);
            int Gp; const int role = phase_role(F, ((LAS const int*)(F.lds + LDS_ETAB))[68 + NE1] * 8, Gp); unsigned* PD = (unsigned*)(ws + WS_CTL) + CW_PD + (pb + 5) * 64;
            if (role >= 0) {
                build_units(F, 8, false, role, Gp);
                ExpertSched S; S.UD = (LAS const int*)(F.lds + LDS_UDESC); S.RT = (LAS const unsigned*)(F.lds + LDS_ROWTAB);
                S.Abase = (const char*)(ws + WS_HE); S.Bbase = (const char*)(ws + WS_WT_D) + (size_t)l * NE1 * D * DE * 2; S.bstride_e = (size_t)D * DE * 2; S.bstride_pn = (size_t)256 * DE * 2; S.arow_bytes = DE * 2; S.ncol = 256; S.gather = false;
                pg8::EpiStoreFp8 E{(unsigned char*)(ws + WS_OB), D, (bf16_t*)(ws + WS_OSH), NE, __builtin_amdgcn_readfirstlane(((LAS const int*)(F.lds + LDS_ETAB))[136 + NE])};
                pg8::gemm_phase<pg8::EpiStoreFp8, ExpertSched, false>(F.lds, DE, S, E);
                if (F.tid == 0) xb_add(PD, 1u);
            } else {
#if PACE > 0
                convert_paced(F, l * L_ITEMS + LI_X, PD, (unsigned)Gp / STOP_DIV + 1u);
#else
                convert_fill(F, l * L_ITEMS + LI_X, FILL_F);
#endif
            }
            __syncthreads(); }
            SEAM(pb + 5); PROBE_MARK(5);
        }
        if (IN(pb + 6)) { REP_LOOP(REP_G) { PHASE_FRAME(); int l = l_; asm volatile("" : "+s"(l)); phase_g(F, l); __syncthreads(); } SEAM(pb + 6); PROBE_MARK(6); }
    }
#if PROBE_CLASS >= 0
    if (blockIdx.x == 0 && threadIdx.x == 0) { const long long t_end = (long long)wall_clock64() + (long long)PROBE_SCALE * MISC[65]; while ((long long)wall_clock64() < t_end) __builtin_amdgcn_s_sleep(64); }
#endif
#undef IN
#undef SEAM
}

extern "C" void kernel_launch(void* const* d_in, const int* in_sizes, int n_in, void* d_out, int out_size, void* d_ws, size_t ws_size, hipStream_t stream) {
    static int grid = 0;
    if (grid == 0) {
        if (n_in != 29 || out_size != NTOK * D || ws_size < WS_END) { fprintf(stderr, "kernel_launch: unexpected shapes (n_in %d out %d ws %zu need %zu)\n", n_in, out_size, ws_size, (size_t)WS_END); grid = -1; return; }
        int dev = 0, cus = 0, per_cu = 0;
        if (hipGetDevice(&dev) != hipSuccess || hipDeviceGetAttribute(&cus, hipDeviceAttributeMultiprocessorCount, dev) != hipSuccess) { grid = -1; return; }
        if (hipFuncSetAttribute((const void*)mk_fwd, hipFuncAttributeMaxDynamicSharedMemorySize, LDS_BYTES) != hipSuccess) { fprintf(stderr, "kernel_launch: hipFuncSetAttribute failed\n"); grid = -1; return; }
        if (hipOccupancyMaxActiveBlocksPerMultiprocessor(&per_cu, (const void*)mk_fwd, 512, LDS_BYTES) != hipSuccess || per_cu < 1) fprintf(stderr, "kernel_launch: occupancy query reports %d\n", per_cu);
        (void)hipGetLastError();
        grid = cus;
    }
    if (grid < 0) return;
    (void)hipMemsetAsync((char*)d_ws + WS_CTL, 0, CTL_ZERO_BYTES, stream);
    Args a{};
    for (int i = 0; i < 29; ++i) a.in[i] = (const float*)d_in[i];
    a.out = (float*)d_out; a.ws = (unsigned char*)d_ws;
#if MK_ONE_LAUNCH
    a.ph_lo = 0; a.ph_hi = NPHASE;
    hipLaunchKernelGGL(mk_fwd, dim3(grid), dim3(512), LDS_BYTES, stream, a);
#else
    for (int p = 0; p < NPHASE; ++p) { a.ph_lo = p; a.ph_hi = p + 1; hipLaunchKernelGGL(mk_fwd, dim3(grid), dim3(512), LDS_BYTES, stream, a); }
#endif
}
```

```cpp
#include <hip/hip_runtime.h>
#include <cstdio>
#include <cstdint>

#define LAS __attribute__((address_space(3)))
#define GAS __attribute__((address_space(1)))
typedef unsigned short bf16_t;
typedef short bf16x8 __attribute__((ext_vector_type(8)));
typedef float f32x4 __attribute__((ext_vector_type(4)));
typedef float f32x2 __attribute__((ext_vector_type(2)));
typedef unsigned u32x4 __attribute__((ext_vector_type(4)));
typedef unsigned u32x2 __attribute__((ext_vector_type(2)));

#ifndef REP_P0
#define REP_P0 1
#endif
#ifndef REP_B
#define REP_B 1
#endif
#ifndef REP_E
#define REP_E 1
#endif
#ifndef REP_F
#define REP_F 1
#endif
#ifndef REP_A
#define REP_A 1
#endif
#ifndef REP_C
#define REP_C 1
#endif
#ifndef REP_D1
#define REP_D1 1
#endif
#ifndef REP_D2
#define REP_D2 1
#endif
#ifndef REP_D3
#define REP_D3 1
#endif
#ifndef REP_G
#define REP_G 1
#endif
#define REP_LOOP(n) _Pragma("unroll 1") for (int rep_ = 0; rep_ < (n); ++rep_)
#ifndef FILL_P1
#define FILL_P1 2
#endif
#ifndef FILL_A
#define FILL_A 5
#endif
#ifndef FILL_A0
#define FILL_A0 2
#endif
#ifndef FILL_F
#define FILL_F 3
#endif
#ifndef FILL_CAP
#define FILL_CAP 64
#endif
#ifndef RT_NS
#define RT_NS 3
#endif
#ifndef CONV_DEEP
#define CONV_DEEP 1
#endif
#if CONV_DEEP
#define CONVERT_WG convert_fill4
#else
#define CONVERT_WG convert_fill
#endif
#ifndef PROBE_CLASS
#define PROBE_CLASS -1
#endif
#ifndef PROBE_SCALE
#define PROBE_SCALE 40
#endif
#ifndef PACE
#define PACE 0
#endif
#ifndef Q_CP
#define Q_CP 4
#endif
#ifndef STOP_DIV
#define STOP_DIV 16
#endif
#ifndef FILL_E
#define FILL_E 8
#endif
#ifndef MK_ONE_LAUNCH
#define MK_ONE_LAUNCH 1
#endif

constexpr int D = 2048, NTOK = 8192, SEQ = 2048, NL = 4, INW = 3072, GW = 512, HD = 128, NMEMTOK = 1024, NE = 64, NE1 = 65, DE = 256, TOPK = 8;
constexpr float LN_EPS = 1e-5f;
constexpr float ALPHA = 1.6817928305074290861f;
constexpr int SLOT_CAP = 90112;

constexpr size_t MiB = 1u << 20;
constexpr size_t WS_CTL = 0, CTL_ZERO_BYTES = 2 * MiB;
constexpr size_t WS_WT_IN  = 2 * MiB;
constexpr size_t WS_WT_OUT = WS_WT_IN + 48 * MiB;
constexpr size_t WS_WT_K   = WS_WT_OUT + 32 * MiB;
constexpr size_t WS_WT_V   = WS_WT_K + 8 * MiB;
constexpr size_t WS_WT_GU  = WS_WT_V + 8 * MiB;
constexpr size_t WS_WT_D   = WS_WT_GU + 520 * MiB;
constexpr size_t WS_WPT    = WS_WT_D + 260 * MiB;
constexpr size_t WS_SGUW   = WS_WPT + 1 * MiB;
constexpr size_t WS_WR_HI  = WS_SGUW + 1 * MiB;
constexpr size_t WS_WR_LO  = WS_WR_HI + 1 * MiB;
constexpr size_t WS_MEMN   = WS_WR_LO + 1 * MiB;
constexpr size_t WS_KBUF   = WS_MEMN + 4 * MiB;
constexpr size_t WS_VT     = WS_KBUF + 4 * MiB;
constexpr size_t WS_XF     = WS_VT + 4 * MiB;
constexpr size_t WS_OSH    = WS_XF;
constexpr size_t WS_XB     = WS_XF + 64 * MiB;
constexpr size_t WS_HB     = WS_XB + 32 * MiB;
constexpr size_t WS_MIX    = WS_HB + 48 * MiB;
constexpr size_t WS_Y1     = WS_MIX + 32 * MiB;
constexpr size_t WS_X1F    = WS_Y1 + 64 * MiB;
constexpr size_t WS_RC     = WS_X1F;
constexpr size_t WS_RCP    = WS_X1F + 4096;
constexpr size_t WS_X1B    = WS_X1F + 64 * MiB;
constexpr size_t WS_HE     = WS_X1B + 33 * MiB;
constexpr size_t WS_OB     = WS_HE + 44 * MiB;
constexpr size_t WS_LIST   = WS_OB + 352 * MiB;
constexpr size_t WS_ASG_EP = WS_LIST + 2 * MiB;
constexpr size_t WS_ASG_W  = WS_ASG_EP + 1 * MiB;
constexpr size_t WS_END    = WS_ASG_W + 1 * MiB;
constexpr int CW_BAR = 4096;
constexpr int CW_CNT = 16384, CNT_STRIDE = 1024;
static_assert((CW_CNT + 256 * CNT_STRIDE) * 4 <= (int)CTL_ZERO_BYTES, "ctl");

constexpr int RING_BYTES = 131072;
constexpr int LDS_MISC = RING_BYTES;
constexpr int LDS_ETAB = LDS_MISC + 512;
constexpr int LDS_UDESC = LDS_ETAB + 1024;
constexpr int LDS_ROWTAB = LDS_UDESC + 512;
constexpr int LDS_BYTES = 147456;
static_assert(LDS_ROWTAB + 4096 <= LDS_BYTES, "lds");

#define LDS_WAIT() asm volatile("s_waitcnt lgkmcnt(0)" ::: "memory")
#define VM_WAIT() asm volatile("s_waitcnt vmcnt(0)" ::: "memory")

__device__ __forceinline__ unsigned cvt_pk_bf16(float lo, float hi) { unsigned r; asm volatile("v_cvt_pk_bf16_f32 %0, %1, %2" : "=v"(r) : "v"(lo), "v"(hi)); return r; }
__device__ __forceinline__ float bf_lo(unsigned w) { return __uint_as_float(w << 16); }
__device__ __forceinline__ float bf_hi(unsigned w) { return __uint_as_float(w & 0xffff0000u); }
__device__ __forceinline__ float fast_sigmoid(float x) { return __builtin_amdgcn_rcpf(1.0f + __builtin_amdgcn_exp2f(-1.4426950408889634f * x)); }
__device__ __forceinline__ float silu_f(float x) { return x * fast_sigmoid(x); }
__device__ __forceinline__ float gelu_tanh_f(float x) { const float t = x + 0.044715f * x * x * x; return x * fast_sigmoid(1.5957691216057308f * t); }
__device__ __forceinline__ float wave_sum(float v) {
#pragma unroll
    for (int o = 1; o < 64; o <<= 1) v += __shfl_xor(v, o);
    return v;
}
__device__ __forceinline__ float g16_sum(float v) { v += __shfl_xor(v, 1); v += __shfl_xor(v, 2); v += __shfl_xor(v, 4); v += __shfl_xor(v, 8); return v; }

namespace pg8 {
constexpr int BM = 256, BK = 64, HALF = 128, HTB = HALF * BK * 2, STAGE_BYTES = 8 * HTB, NXCD = 8, WGM = 8;
__host__ __device__ __forceinline__ int lds_byte(int r, int c) { const int st = (r >> 4) * 2 + (c >> 5), rr = r & 15, cc = c & 31, ob = rr * 64 + cc * 2; return st * 1024 + (ob ^ (((ob >> 9) & 1) << 5)); }
__host__ __device__ __forceinline__ void stage_rc(int b, int& R, int& C) { const int st = b / 1024, sb = b % 1024, swz = sb ^ (((sb >> 9) & 1) << 5); R = (st >> 1) * 16 + swz / 64; C = (st & 1) * 32 + (swz % 64) / 2; }
__host__ __device__ __forceinline__ int perm32(int rho) { const int n = rho >> 4, i = rho & 15; return 8 * (i >> 2) + 4 * n + (i & 3); }

struct Unit { const char* A; const char* B; int row0, col0, nvalid, aux; };

struct StaticOrder {
    int nM, nN, nwg, G, c;
    __device__ void init(int M, int N, int G_, int c_) { nM = M / BM; nN = N / BM; nwg = nM * nN; G = G_; c = c_; }
    __device__ bool next(int i, int& pm, int& pn) const {
        const long L = (long)i * G + c; if (L >= nwg || c < 0) return false;
        int wgid = (int)L; { const int q = nwg / NXCD, r = nwg % NXCD, xcd = wgid % NXCD, off = wgid / NXCD; wgid = (xcd < r ? xcd * (q + 1) : r * (q + 1) + (xcd - r) * q) + off; }
        const int nig = WGM * nN, gid = wgid / nig, fm = gid * WGM, gsz = (nM - fm) < WGM ? (nM - fm) : WGM;
        pm = fm + ((wgid % nig) % gsz); pn = (wgid % nig) / gsz; return true;
    }
};
struct DenseSched {
    StaticOrder so; const char* A; const char* B; size_t tstep;
    __device__ void init(const bf16_t* A_, const bf16_t* B_, int M, int N, int K, int G, int c) { so.init(M, N, G, c); A = (const char*)A_; B = (const char*)B_; tstep = (size_t)BM * K * 2; }
    __device__ __forceinline__ bool next(int i, Unit& u) const { int pm, pn; if (!so.next(i, pm, pn)) return false; u.A = A + (size_t)pm * tstep; u.B = B + (size_t)pn * tstep; u.row0 = pm * BM; u.col0 = pn * BM; u.nvalid = BM; u.aux = 0; return true; }
    __device__ __forceinline__ unsigned rowoff(int, int) const { return 0u; }
};

struct EpiStoreBf16 {
    static constexpr bool PERM = true;
    bf16_t* O; int ldc;
    __device__ __forceinline__ void operator()(const f32x4 (&acc)[2][2][4][2], const Unit& u, int wr, int wc, int fr, int fq) const {
#pragma unroll
        for (int ai = 0; ai < 2; ++ai)
#pragma unroll
            for (int m = 0; m < 4; ++m) { const int lr = ai * HALF + wr * 64 + m * 16 + fr;
                if (lr < u.nvalid) { bf16_t* rowp = O + (size_t)(u.row0 + lr) * ldc + u.col0 + wc * 32 + 8 * fq;
#pragma unroll
                    for (int bj = 0; bj < 2; ++bj) { const f32x4 v0 = acc[ai][bj][m][0], v1 = acc[ai][bj][m][1];
                        u32x4 w; w.x = cvt_pk_bf16(v0[0], v0[1]); w.y = cvt_pk_bf16(v0[2], v0[3]); w.z = cvt_pk_bf16(v1[0], v1[1]); w.w = cvt_pk_bf16(v1[2], v1[3]);
                        *(u32x4*)(rowp + bj * HALF) = w; } } }
    }
};
constexpr float O8_SCALE = 16.0f;
struct EpiStoreFp8 {
    static constexpr bool PERM = true;
    unsigned char* O; int ldc; bf16_t* OS; int sh_e, sh_base;
    __device__ __forceinline__ void operator()(const f32x4 (&acc)[2][2][4][2], const Unit& u, int wr, int wc, int fr, int fq) const {
        if (u.aux == sh_e) {
#pragma unroll
            for (int ai = 0; ai < 2; ++ai)
#pragma unroll
                for (int m = 0; m < 4; ++m) { const int lr = ai * HALF + wr * 64 + m * 16 + fr; bf16_t* rowp = OS + (size_t)(u.row0 - sh_base + lr) * ldc + u.col0 + wc * 32 + 8 * fq;
#pragma unroll
                    for (int bj = 0; bj < 2; ++bj) { const f32x4 v0 = acc[ai][bj][m][0], v1 = acc[ai][bj][m][1];
                        *(u32x4*)(rowp + bj * HALF) = (u32x4){cvt_pk_bf16(v0[0], v0[1]), cvt_pk_bf16(v0[2], v0[3]), cvt_pk_bf16(v1[0], v1[1]), cvt_pk_bf16(v1[2], v1[3])}; } }
            return; }
#pragma unroll
        for (int ai = 0; ai < 2; ++ai)
#pragma unroll
            for (int m = 0; m < 4; ++m) { const int lr = ai * HALF + wr * 64 + m * 16 + fr;
                unsigned pk[2][2];
#pragma unroll
                for (int bj = 0; bj < 2; ++bj) { const f32x4 v0 = acc[ai][bj][m][0] * O8_SCALE, v1 = acc[ai][bj][m][1] * O8_SCALE;
                    int p = __builtin_amdgcn_cvt_pk_fp8_f32(v0[0], v0[1], 0, false); p = __builtin_amdgcn_cvt_pk_fp8_f32(v0[2], v0[3], p, true);
                    int q = __builtin_amdgcn_cvt_pk_fp8_f32(v1[0], v1[1], 0, false); q = __builtin_amdgcn_cvt_pk_fp8_f32(v1[2], v1[3], q, true);
                    pk[bj][0] = (unsigned)p; pk[bj][1] = (unsigned)q; }
                const auto s0 = __builtin_amdgcn_permlane16_swap(pk[0][0], pk[1][0], false, false), s1 = __builtin_amdgcn_permlane16_swap(pk[0][1], pk[1][1], false, false);
                if (lr < u.nvalid) *(u32x4*)(O + (size_t)(u.row0 + lr) * ldc + u.col0 + wc * 32 + (fq & 1) * HALF + (fq >> 1) * 16) = (u32x4){s0[0], s1[0], s0[1], s1[1]}; }
    }
};
struct EpiResidBf16 {
    static constexpr bool PERM = true;
    bf16_t* Y; const float* X; const bf16_t* XBp; int ldc; float alpha;
    __device__ __forceinline__ void operator()(const f32x4 (&acc)[2][2][4][2], const Unit& u, int wr, int wc, int fr, int fq) const {
#pragma unroll
        for (int ai = 0; ai < 2; ++ai)
#pragma unroll
            for (int m = 0; m < 4; ++m) { const size_t off = (size_t)(u.row0 + ai * HALF + wr * 64 + m * 16 + fr) * ldc + u.col0 + wc * 32 + 8 * fq;
#pragma unroll
                for (int bj = 0; bj < 2; ++bj) { f32x4 x0, x1;
                    if (X) { x0 = *(const f32x4*)(X + off + bj * HALF); x1 = *(const f32x4*)(X + off + bj * HALF + 4); }
                    else { const u32x4 r = *(const u32x4*)(XBp + off + bj * HALF); x0 = (f32x4){bf_lo(r.x), bf_hi(r.x), bf_lo(r.y), bf_hi(r.y)}; x1 = (f32x4){bf_lo(r.z), bf_hi(r.z), bf_lo(r.w), bf_hi(r.w)}; }
                    const f32x4 v0 = acc[ai][bj][m][0] + alpha * x0, v1 = acc[ai][bj][m][1] + alpha * x1;
                    *(u32x4*)(Y + off + bj * HALF) = (u32x4){cvt_pk_bf16(v0[0], v0[1]), cvt_pk_bf16(v0[2], v0[3]), cvt_pk_bf16(v1[0], v1[1]), cvt_pk_bf16(v1[2], v1[3])}; } }
    }
};
struct EpiSwiglu {
    static constexpr bool PERM = true;
    bf16_t* H;
    __device__ __forceinline__ void operator()(const f32x4 (&acc)[2][2][4][2], const Unit& u, int wr, int wc, int fr, int fq) const {
#pragma unroll
        for (int ai = 0; ai < 2; ++ai)
#pragma unroll
            for (int m = 0; m < 4; ++m) { const int lr = ai * HALF + wr * 64 + m * 16 + fr;
                if (lr < u.nvalid) { const f32x4 g0 = acc[ai][0][m][0], g1 = acc[ai][0][m][1], u0 = acc[ai][1][m][0], u1 = acc[ai][1][m][1];
                    u32x4 w; w.x = cvt_pk_bf16(silu_f(g0[0]) * u0[0], silu_f(g0[1]) * u0[1]); w.y = cvt_pk_bf16(silu_f(g0[2]) * u0[2], silu_f(g0[3]) * u0[3]);
                    w.z = cvt_pk_bf16(silu_f(g1[0]) * u1[0], silu_f(g1[1]) * u1[1]); w.w = cvt_pk_bf16(silu_f(g1[2]) * u1[2], silu_f(g1[3]) * u1[3]);
                    *(u32x4*)(H + (size_t)(u.row0 + lr) * DE + u.col0 + wc * 32 + 8 * fq) = w; } }
    }
};

template <class Epi, class Sched, bool GATHER>
__device__ __forceinline__ void gemm_phase(LAS unsigned char* lds, const int K, const Sched& S, const Epi& E) {
    int tid = threadIdx.x; asm volatile("" : "+v"(tid));
    const int wid = __builtin_amdgcn_readfirstlane(tid >> 6), lane = tid & 63, wr = wid >> 2, wc = wid & 3;
    const int nt = K / BK;
    unsigned voffB[2], oc[2][2];
#pragma unroll
    for (int i = 0; i < 2; ++i) { int R, C; stage_rc(tid * 16 + i * 8192, R, C); const int Rb = Epi::PERM ? ((R & ~31) + perm32(R & 31)) : R;
        voffB[i] = (unsigned)(Rb * K + C) * 2u; oc[0][i] = (unsigned)(R * K + C) * 2u; oc[1][i] = oc[0][i]; }
    const size_t kstep = (size_t)(BK * 2);
    const size_t hstep = (size_t)HALF * K * 2;
    const size_t ahstep = GATHER ? (size_t)0 : hstep;
    const unsigned ldsw = (unsigned)wid * 1024u;
    const int aoff = lds_byte(wr * 64 + (lane & 15), (lane >> 4) * 8), boff = lds_byte(wc * 32 + (lane & 15), (lane >> 4) * 8);
#define PG8_SA(b, h) (((b) * 2 + (h)) * HTB)
#define PG8_SB(b, h) ((4 + (b) * 2 + (h)) * HTB)
#define PG8_STAGE(bufoff, gbase, voff) do { _Pragma("unroll") for (int _i = 0; _i < 2; ++_i) \
        __builtin_amdgcn_global_load_lds((const unsigned*)((const char*)(gbase) + (voff)[_i]), (LAS unsigned*)(lds + (bufoff) + ldsw + _i * 8192), 16, 0, 0); } while (0)
#define PG8_STAGE_A(bufoff, gbase, h) PG8_STAGE(bufoff, (gbase) + (h) * ahstep, oc[GATHER ? (h) : 0])
#define PG8_LDA(dst, b, h) do { _Pragma("unroll") for (int m = 0; m < 4; ++m) _Pragma("unroll") for (int k = 0; k < 2; ++k) dst[m][k] = *(const LAS bf16x8*)(lds + PG8_SA(b, h) + aoff + m * 2048 + k * 1024); } while (0)
#define PG8_LDB(dst, b, h) do { _Pragma("unroll") for (int n = 0; n < 2; ++n) _Pragma("unroll") for (int k = 0; k < 2; ++k) dst[n][k] = *(const LAS bf16x8*)(lds + PG8_SB(b, h) + boff + n * 2048 + k * 1024); } while (0)
#define PG8_MMA(ai, bj, At, Bt) do { __builtin_amdgcn_s_setprio(1); _Pragma("unroll") for (int m = 0; m < 4; ++m) _Pragma("unroll") for (int n = 0; n < 2; ++n) _Pragma("unroll") for (int k = 0; k < 2; ++k) \
        acc[ai][bj][m][n] = __builtin_amdgcn_mfma_f32_16x16x32_bf16(Bt[n][k], At[m][k], acc[ai][bj][m][n], 0, 0, 0); __builtin_amdgcn_s_setprio(0); } while (0)
#define PG8_WAIT_V(n) asm volatile("s_waitcnt vmcnt(" #n ")" ::: "memory")
#define PG8_WAIT_L(n) asm volatile("s_waitcnt lgkmcnt(" #n ")" ::: "memory")
#define PG8_BAR __builtin_amdgcn_s_barrier()
#define PG8_SCHED __builtin_amdgcn_sched_barrier(0)
#define PG8_LOAD_ROWOFFS(uidx) do { int tz_ = threadIdx.x; asm volatile("" : "+v"(tz_)); _Pragma("unroll") for (int _i = 0; _i < 2; ++_i) { int R_, C_; stage_rc(tz_ * 16 + _i * 8192, R_, C_); \
        oc[0][_i] = S.rowoff((uidx), R_) + (unsigned)C_ * 2u; oc[1][_i] = S.rowoff((uidx), HALF + R_) + (unsigned)C_ * 2u; } } while (0)
    Unit cur, nxt; int ui = 0;
    if (!S.next(0, cur)) return;
    if constexpr (GATHER) { PG8_LOAD_ROWOFFS(0); }
    f32x4 acc[2][2][4][2];
#pragma unroll
    for (int a = 0; a < 2; ++a)
#pragma unroll
        for (int b = 0; b < 2; ++b)
#pragma unroll
            for (int m = 0; m < 4; ++m)
#pragma unroll
                for (int n = 0; n < 2; ++n) acc[a][b][m][n] = (f32x4){0.f, 0.f, 0.f, 0.f};
    bf16x8 At[4][2], B0[2][2], B1[2][2];
    const char* cA = cur.A; const char* cB = cur.B;
    LDS_WAIT();
    PG8_STAGE(PG8_SB(0, 0), cB, voffB); PG8_STAGE(PG8_SB(0, 1), cB + hstep, voffB); PG8_STAGE_A(PG8_SA(0, 0), cA, 0); PG8_STAGE_A(PG8_SA(0, 1), cA, 1);
    if (wr == 1) PG8_BAR;
    PG8_WAIT_V(2); PG8_BAR;
    PG8_STAGE(PG8_SB(1, 0), cB + kstep, voffB); PG8_STAGE_A(PG8_SA(1, 0), cA + kstep, 0); PG8_STAGE(PG8_SB(1, 1), cB + hstep + kstep, voffB);
    PG8_WAIT_V(6); PG8_BAR;
    for (;;) {
        const bool has_next = S.next(ui + 1, nxt);
        const char* nA = has_next ? nxt.A : cA; const char* nB = has_next ? nxt.B : cB;
#pragma unroll 1
        for (int t = 0; t < nt; t += 2) {
            const bool last = (t == nt - 2);
            const char* a1 = cA + (size_t)(t + 1) * kstep;
            const char* a2 = last ? nA : cA + (size_t)(t + 2) * kstep; const char* b2 = last ? nB : cB + (size_t)(t + 2) * kstep;
            const char* a3 = a2 + kstep; const char* b3 = b2 + kstep;
            PG8_LDB(B0, 0, 0); PG8_LDB(B1, 0, 1); PG8_SCHED; PG8_LDA(At, 0, 0); PG8_STAGE_A(PG8_SA(1, 1), a1, 1);
            if constexpr (GATHER) { if (last && has_next) { PG8_LOAD_ROWOFFS(ui + 1); } }
            PG8_WAIT_V(8); PG8_WAIT_L(0); PG8_BAR; PG8_MMA(0, 0, At, B0); PG8_MMA(0, 1, At, B1); PG8_BAR; PG8_SCHED;
            PG8_LDA(At, 0, 1); PG8_STAGE(PG8_SB(0, 0), b2, voffB); PG8_STAGE(PG8_SB(0, 1), b2 + hstep, voffB); PG8_STAGE_A(PG8_SA(0, 0), a2, 0);
            PG8_WAIT_V(8); PG8_WAIT_L(0); PG8_BAR; PG8_MMA(1, 0, At, B0); PG8_MMA(1, 1, At, B1); PG8_BAR; PG8_SCHED;
            PG8_LDB(B0, 1, 0); PG8_LDB(B1, 1, 1); PG8_SCHED; PG8_LDA(At, 1, 0); PG8_STAGE_A(PG8_SA(0, 1), a2, 1);
            PG8_WAIT_V(8); PG8_WAIT_L(0); PG8_BAR; PG8_MMA(0, 0, At, B0); PG8_MMA(0, 1, At, B1); PG8_BAR; PG8_SCHED;
            PG8_LDA(At, 1, 1); PG8_STAGE(PG8_SB(1, 0), b3, voffB); PG8_STAGE(PG8_SB(1, 1), b3 + hstep, voffB); PG8_STAGE_A(PG8_SA(1, 0), a3, 0);
            PG8_WAIT_V(8); PG8_WAIT_L(0); PG8_BAR; PG8_MMA(1, 0, At, B0); PG8_MMA(1, 1, At, B1); PG8_BAR; PG8_SCHED;
        }
        if (wr == 0) PG8_BAR;
        { int tz = threadIdx.x; asm volatile("" : "+v"(tz)); E(acc, cur, wr, wc, tz & 15, (tz & 63) >> 4); }
        if (!has_next) break;
#pragma unroll
        for (int a = 0; a < 2; ++a)
#pragma unroll
            for (int b = 0; b < 2; ++b)
#pragma unroll
                for (int m = 0; m < 4; ++m)
#pragma unroll
                    for (int n = 0; n < 2; ++n) acc[a][b][m][n] = (f32x4){0.f, 0.f, 0.f, 0.f};
        cur = nxt; cA = nA; cB = nB; ++ui;
        if (wr == 1) PG8_BAR;
    }
    PG8_WAIT_V(0);
    PG8_BAR;
#undef PG8_SA
#undef PG8_SB
#undef PG8_STAGE
#undef PG8_STAGE_A
#undef PG8_LOAD_ROWOFFS
#undef PG8_LDA
#undef PG8_LDB
#undef PG8_MMA
#undef PG8_WAIT_V
#undef PG8_WAIT_L
#undef PG8_BAR
#undef PG8_SCHED
}
}

#define XB_TMO      128
#define XB_XCNT(j)  (256  + 64 * (j))
#define XB_XSUB(j)  (1280 + 64 * (j))
#define XB_XGEN(j)  (2304 + 64 * (j))
#define XB_TOP      3328
#define XB_TOPGEN   3392
#define XCD_BAR_WORDS 3456
#define XB_SPIN_CAP (1u << 18)
__device__ __forceinline__ unsigned xb_ld(unsigned* p)              { return __hip_atomic_load(p, __ATOMIC_RELAXED, __HIP_MEMORY_SCOPE_AGENT); }
__device__ __forceinline__ unsigned xb_add(unsigned* p, unsigned v) { return __hip_atomic_fetch_add(p, v, __ATOMIC_RELAXED, __HIP_MEMORY_SCOPE_AGENT); }
__device__ __forceinline__ unsigned xb_xcc_id() { return (unsigned)__builtin_amdgcn_s_getreg((3 << 11) | 20) & 0xFu; }
#define XB_SPIN(cond, bar) do { unsigned _sp = 0; while (cond) { __builtin_amdgcn_s_sleep(1); \
    if ((++_sp & 255u) == 0u) { if (xb_ld(&(bar)[XB_TMO])) break; if (_sp > XB_SPIN_CAP) { atomicAdd(&(bar)[XB_TMO], 1u); break; } } } } while (0)
struct XcdBarrier { unsigned* bar; unsigned x; volatile LAS unsigned* st; };
__device__ __forceinline__ XcdBarrier xcd_barrier_post(unsigned* bar, volatile LAS unsigned* st) {
    XcdBarrier b; b.bar = bar; b.x = xb_xcc_id(); b.st = st;
    if (threadIdx.x == 0) (void)xb_add(&bar[XB_XCNT(b.x)], 1u);
    return b;
}
__device__ __forceinline__ void xcd_barrier_complete(unsigned* bar, unsigned x, unsigned& nloc, unsigned& nx) {
    const unsigned G = gridDim.x * gridDim.y * gridDim.z;
    unsigned sum, cnt, mine, sp = 0u;
    for (;;) {
        sum = 0u; cnt = 0u; mine = 0u;
#pragma unroll 1
        for (unsigned j = 0; j < 16; ++j) { const unsigned c = xb_ld(&bar[XB_XCNT(j)]); sum += c; cnt += (c > 0u) ? 1u : 0u; mine = (j == x) ? c : mine; }
        if (sum == G) break;
        __builtin_amdgcn_s_sleep(1);
        if ((++sp & 255u) == 0u) { if (xb_ld(&bar[XB_TMO])) break; if (sp > XB_SPIN_CAP) { atomicAdd(&bar[XB_TMO], 1u); break; } }
    }
    nloc = mine > 0u ? mine : 1u; nx = cnt > 0u ? cnt : 1u;
}
__device__ __forceinline__ void xcd_barrier(const XcdBarrier& b) {
    asm volatile("s_waitcnt vmcnt(0)" ::: "memory");
    __syncthreads();
    if (threadIdx.x == 0) {
        unsigned* bar = b.bar;
        __builtin_amdgcn_s_waitcnt(0);
        unsigned nloc = b.st[0], nx = b.st[1];
        if (nloc == 0u) { xcd_barrier_complete(bar, b.x, nloc, nx); b.st[0] = nloc; b.st[1] = nx; }
        const unsigned old = xb_add(&bar[XB_XSUB(b.x)], 1u);
        const unsigned gen = old / nloc;
        if (old + 1u == (gen + 1u) * nloc) {
            __builtin_amdgcn_fence(__ATOMIC_RELEASE, "agent");
            asm volatile("s_waitcnt vmcnt(0)" ::: "memory");
            const unsigned og = xb_add(&bar[XB_TOP], 1u);
            const unsigned tg = og / nx;
            if (og + 1u == (tg + 1u) * nx) xb_add(&bar[XB_TOPGEN], 1u);
            else XB_SPIN(xb_ld(&bar[XB_TOPGEN]) == tg, bar);
            __builtin_amdgcn_fence(__ATOMIC_ACQUIRE, "agent");
            xb_add(&bar[XB_XGEN(b.x)], 1u);
            asm volatile("s_waitcnt vmcnt(0)" ::: "memory");
        } else {
            XB_SPIN(xb_ld(&bar[XB_XGEN(b.x)]) == gen, bar);
            __builtin_amdgcn_fence(__ATOMIC_ACQUIRE, "agent");
            asm volatile("s_waitcnt vmcnt(0)" ::: "memory");
        }
    }
    __syncthreads();
}

struct Args { const float* in[29]; float* out; unsigned char* ws; int ph_lo, ph_hi; };
enum { I_X = 0, I_MEM, I_MEM_G, I_MEM_B, I_W_IN, I_SGU_G, I_SGU_B, I_SGU_W, I_SGU_BS, I_POOL_W, I_POOL_S, I_CONV_W, I_CONV_B, I_CONV_G, I_CONV_LB, I_W_KV, I_W_OUT, I_LN1_G, I_LN1_B,
       I_W_R, I_R_BIAS, I_E_G, I_E_U, I_E_D, I_S_G, I_S_U, I_S_D, I_LN2_G, I_LN2_B };

struct Frame {
    LAS unsigned char* lds;
    int tid, lane, wave, vcu, G;
    const Args* a;
    unsigned char* ws;
};

struct ItemDesc { const float* W; bf16_t* WT; bf16_t* WL; const float* GS; int ldw, ldt, k0, n0, drow0; };
constexpr int LI_IN = 3072, LI_OUT = 2048, LI_EX = 64 * 256, LI_SH = 256, LI_PW = 4 * 8, LI_RT = 64;
constexpr int L_ITEMS = LI_IN + LI_OUT + 3 * LI_EX + 3 * LI_SH + LI_PW + LI_RT;
constexpr int KV_ITEMS = 4 * 1024;
constexpr int LI_X = 3 * LI_EX + 3 * LI_SH, LI_S = L_ITEMS - LI_X;
constexpr int Q_TOTAL = NL * L_ITEMS - LI_S;
constexpr int CW_Q = 8192;
constexpr int CW_PD = 10240;
constexpr int Q_CH = 8;
__device__ __forceinline__ ItemDesc item_desc(const Args& A, unsigned char* ws, int l, int r) {
    bf16_t* WT_IN = (bf16_t*)(ws + WS_WT_IN); bf16_t* WT_OUT = (bf16_t*)(ws + WS_WT_OUT);
    bf16_t* WT_GU = (bf16_t*)(ws + WS_WT_GU); bf16_t* WT_D = (bf16_t*)(ws + WS_WT_D); bf16_t* WPT = (bf16_t*)(ws + WS_WPT);
    ItemDesc d; d.WL = nullptr;
    if (r < LI_IN) { const int kb = r / 96, nb = r % 96; d.W = A.in[I_W_IN] + (size_t)l * D * INW; d.ldw = INW; d.WT = WT_IN + (size_t)l * INW * D; d.ldt = D; d.k0 = kb * 64; d.n0 = nb * 32; d.drow0 = nb * 32; return d; } r -= LI_IN;
    if (r < LI_OUT) { const int kb = r / 64, nb = r % 64; d.W = A.in[I_W_OUT] + (size_t)l * D * D; d.ldw = D; d.WT = WT_OUT + (size_t)l * D * D; d.ldt = D; d.k0 = kb * 64; d.n0 = nb * 32; d.drow0 = nb * 32; return d; } r -= LI_OUT;
    if (r < 2 * LI_EX) { const int up = r >= LI_EX; if (up) r -= LI_EX; const int e = r / 256, rem = r % 256, kb = rem / 8, nb = rem % 8, n0 = nb * 32;
        d.W = A.in[up ? I_E_U : I_E_G] + (size_t)(l * NE + e) * D * DE; d.ldw = DE; d.WT = WT_GU + (size_t)(l * NE1 + e) * 512 * D; d.ldt = D; d.k0 = kb * 64; d.n0 = n0; d.drow0 = (n0 >> 7) * 256 + up * 128 + (n0 & 127); return d; } r -= 2 * LI_EX;
    if (r < LI_EX) { const int e = r / 256, rem = r % 256, kb = rem / 64, nb = rem % 64;
        d.W = A.in[I_E_D] + (size_t)(l * NE + e) * DE * D; d.ldw = D; d.WT = WT_D + (size_t)(l * NE1 + e) * D * DE; d.ldt = DE; d.k0 = kb * 64; d.n0 = nb * 32; d.drow0 = nb * 32; return d; } r -= LI_EX;
    if (r < 2 * LI_SH) { const int up = r >= LI_SH; if (up) r -= LI_SH; const int kb = r / 8, nb = r % 8, n0 = nb * 32;
        d.W = A.in[up ? I_S_U : I_S_G] + (size_t)l * D * DE; d.ldw = DE; d.WT = WT_GU + (size_t)(l * NE1 + 64) * 512 * D; d.ldt = D; d.k0 = kb * 64; d.n0 = n0; d.drow0 = (n0 >> 7) * 256 + up * 128 + (n0 & 127); return d; } r -= 2 * LI_SH;
    if (r < LI_SH) { const int kb = r / 64, nb = r % 64; d.W = A.in[I_S_D] + (size_t)l * DE * D; d.ldw = D; d.WT = WT_D + (size_t)(l * NE1 + 64) * D * DE; d.ldt = DE; d.k0 = kb * 64; d.n0 = nb * 32; d.drow0 = nb * 32; return d; } r -= LI_SH;
    if (r < LI_PW) { const int g = r / 8, rem = r % 8, kb = rem / 4, nb = rem % 4; d.W = A.in[I_POOL_W] + (size_t)(l * 4 + g) * 128 * 128; d.ldw = 128; d.WT = WPT + (size_t)(l * 4 + g) * 128 * 128; d.ldt = 128; d.k0 = kb * 64; d.n0 = nb * 32; d.drow0 = nb * 32; return d; } r -= LI_PW;
    { const int kb = r / 2, nb = r % 2; d.W = A.in[I_W_R] + (size_t)l * D * NE; d.ldw = NE; d.WT = (bf16_t*)(ws + WS_WR_HI) + (size_t)l * NE * D; d.WL = (bf16_t*)(ws + WS_WR_LO) + (size_t)l * NE * D; d.GS = A.in[I_LN1_G] + (size_t)l * D; d.ldt = D; d.k0 = kb * 64; d.n0 = nb * 32; d.drow0 = nb * 32; return d; }
}
__device__ __forceinline__ ItemDesc kv_desc(const Args& A, unsigned char* ws, int r) {
    const int mat = r / 1024, rem = r % 1024, kb = rem / 32, nb = rem % 32, n0 = nb * 32; ItemDesc d; d.WL = nullptr;
    d.W = A.in[I_W_KV] + (size_t)mat * D * 1024; d.ldw = 1024; d.WT = (bf16_t*)(ws + (n0 < 512 ? WS_WT_K : WS_WT_V)); d.ldt = D; d.k0 = kb * 64; d.n0 = n0; d.drow0 = mat * 512 + (n0 & 511); return d;
}
__device__ __forceinline__ void item_load(const ItemDesc& d, f32x4 (&v)[8], int lane) {
#pragma unroll
    for (int i = 0; i < 8; ++i) v[i] = __builtin_nontemporal_load((const GAS f32x4*)(d.W + (size_t)(d.k0 + 8 * i + (lane >> 3)) * d.ldw + d.n0 + 4 * (lane & 7)));
}
__device__ __forceinline__ void item_finish(const ItemDesc& d, const f32x4 (&v)[8], LAS float* scr, int lane) {
#pragma unroll
    for (int i = 0; i < 8; ++i) { LAS float* p = scr + (8 * i + (lane >> 3)) * 33 + 4 * (lane & 7); p[0] = v[i][0]; p[1] = v[i][1]; p[2] = v[i][2]; p[3] = v[i][3]; }
    LDS_WAIT(); asm volatile("" ::: "memory");
    const int c = lane & 7;
#pragma unroll
    for (int j = 0; j < 4; ++j) { const int n = (lane >> 3) + 8 * j; const LAS float* s = scr + (8 * c) * 33 + n;
        float x[8]; unsigned h[4];
#pragma unroll
        for (int q = 0; q < 8; ++q) x[q] = s[q * 33];
#pragma unroll
        for (int q = 0; q < 4; ++q) h[q] = cvt_pk_bf16(x[2 * q], x[2 * q + 1]);
        if (!d.WL) __builtin_nontemporal_store((u32x4){h[0], h[1], h[2], h[3]}, (GAS u32x4*)(d.WT + (size_t)(d.drow0 + n) * d.ldt + d.k0 + 8 * c));
        else { unsigned lo[4];
            const int nn = d.drow0 + n, kk = d.k0 + 8 * c; const size_t off = ((size_t)((nn >> 4) * (D / 32) + (kk >> 5)) * 64 + 16 * ((kk & 31) >> 3) + (nn & 15)) * 8;
            const f32x4 g0 = *(const GAS f32x4*)(d.GS + kk), g1 = *(const GAS f32x4*)(d.GS + kk + 4);
            x[0] *= g0[0]; x[1] *= g0[1]; x[2] *= g0[2]; x[3] *= g0[3]; x[4] *= g1[0]; x[5] *= g1[1]; x[6] *= g1[2]; x[7] *= g1[3];
#pragma unroll
            for (int q = 0; q < 4; ++q) h[q] = cvt_pk_bf16(x[2 * q], x[2 * q + 1]);
#pragma unroll
            for (int q = 0; q < 4; ++q) lo[q] = cvt_pk_bf16(x[2 * q] - bf_lo(h[q]), x[2 * q + 1] - bf_hi(h[q]));
            *(GAS u32x4*)(d.WT + off) = (u32x4){h[0], h[1], h[2], h[3]}; *(GAS u32x4*)(d.WL + off) = (u32x4){lo[0], lo[1], lo[2], lo[3]}; } }
    LDS_WAIT(); asm volatile("" ::: "memory");
}
__device__ __forceinline__ int s_item(int s) { return s < LI_IN + LI_OUT ? s : s + LI_X; }
struct GenPrologue { __device__ __forceinline__ ItemDesc operator()(const Args& A, unsigned char* ws, int id) const { return id < LI_S ? item_desc(A, ws, 0, s_item(id)) : kv_desc(A, ws, id - LI_S); } };
struct GenQueue    { __device__ __forceinline__ ItemDesc operator()(const Args& A, unsigned char* ws, int id) const { const int l = id / L_ITEMS, j = id % L_ITEMS;
    return j < LI_X ? item_desc(A, ws, l, LI_IN + LI_OUT + j) : item_desc(A, ws, l + 1, s_item(j - LI_X)); } };
template <class Gen> __device__ __forceinline__ void convert_seq(const Args& A, unsigned char* ws, int first, int end, int stride, LAS float* scr, int lane) {
    if (first >= end) return;
    const Gen gen; ItemDesc d0 = gen(A, ws, first); f32x4 v0[8]; item_load(d0, v0, lane);
#pragma unroll 1
    for (int id = first + stride; id < end; id += stride) { const ItemDesc d1 = gen(A, ws, id); f32x4 v1[8]; item_load(d1, v1, lane); item_finish(d0, v0, scr, lane); d0 = d1;
#pragma unroll
        for (int i = 0; i < 8; ++i) v0[i] = v1[i]; }
    item_finish(d0, v0, scr, lane);
}
template <class Gen> __device__ __forceinline__ void convert_seq4(const Args& A, unsigned char* ws, int first, int end, int stride, LAS float* scr, int lane) {
    const Gen gen; int cur = first;
#define SLOT_FILL(k) do { i##k = cur < end ? cur : -1; cur += stride; if (i##k >= 0) { d##k = gen(A, ws, i##k); item_load(d##k, v##k, lane); } } while (0)
    int i0, i1, i2, i3; ItemDesc d0, d1, d2, d3; f32x4 v0[8], v1[8], v2[8], v3[8];
    SLOT_FILL(0); SLOT_FILL(1); SLOT_FILL(2); SLOT_FILL(3);
#pragma unroll 1
    for (;;) {
        if (i0 < 0) break; item_finish(d0, v0, scr, lane); SLOT_FILL(0);
        if (i1 < 0) break; item_finish(d1, v1, scr, lane); SLOT_FILL(1);
        if (i2 < 0) break; item_finish(d2, v2, scr, lane); SLOT_FILL(2);
        if (i3 < 0) break; item_finish(d3, v3, scr, lane); SLOT_FILL(3);
    }
#undef SLOT_FILL
}
__device__ __forceinline__ void convert_static(Frame& F, int start, int end, int k, int nc) {
    const Args& A = *F.a; LAS float* scr = (LAS float*)(F.lds + F.wave * 16384); const int lane = F.lane; unsigned char* ws = F.ws; const GenQueue gen; int cur = 0;
#define SLOT_FILL(q) do { const int n_ = cur++; int id_ = start + ((((n_ >> 3) * nc + k) * 8 + F.wave) << 3) + (n_ & 7); i##q = id_ < end ? id_ : -1; if (i##q >= 0) { d##q = gen(A, ws, i##q); item_load(d##q, v##q, lane); } } while (0)
    int i0, i1, i2, i3; ItemDesc d0, d1, d2, d3; f32x4 v0[8], v1[8], v2[8], v3[8];
    SLOT_FILL(0); SLOT_FILL(1); SLOT_FILL(2); SLOT_FILL(3);
#pragma unroll 1
    for (;;) {
        if (i0 < 0) break; item_finish(d0, v0, scr, lane); SLOT_FILL(0);
        if (i1 < 0) break; item_finish(d1, v1, scr, lane); SLOT_FILL(1);
        if (i2 < 0) break; item_finish(d2, v2, scr, lane); SLOT_FILL(2);
        if (i3 < 0) break; item_finish(d3, v3, scr, lane); SLOT_FILL(3);
    }
#undef SLOT_FILL
}
__device__ __forceinline__ void convert_fill(Frame& F, int floor, int budget, unsigned* stop = nullptr, unsigned stop_at = 0u) {
    const Args& A = *F.a; LAS float* scr = (LAS float*)(F.lds + F.wave * 16384);
    unsigned* qh = (unsigned*)(F.ws + WS_CTL) + CW_Q;
#pragma unroll 1
    for (int b = 0; b < budget; ++b) {
        if (stop && __builtin_amdgcn_readfirstlane(xb_ld(stop)) >= stop_at) break;
        unsigned st = 0u; if (F.lane == 0) st = __hip_atomic_fetch_add(qh, (unsigned)Q_CH, __ATOMIC_RELAXED, __HIP_MEMORY_SCOPE_AGENT);
        const int s0 = __builtin_amdgcn_readfirstlane((int)st);
        if (s0 >= Q_TOTAL) break;
        const int lo = s0 > floor ? s0 : floor, hi = (s0 + Q_CH) < Q_TOTAL ? (s0 + Q_CH) : Q_TOTAL;
        if (lo >= hi) { ++budget; if (budget > (1 << 20)) break; continue; }
        convert_seq<GenQueue>(A, F.ws, lo, hi, 1, scr, F.lane);
    }
}
__device__ __forceinline__ void convert_fill4(Frame& F, int floor, int budget) {
    const Args& A = *F.a; LAS float* scr = (LAS float*)(F.lds + F.wave * 16384); const int lane = F.lane;
    unsigned* qh = (unsigned*)(F.ws + WS_CTL) + CW_Q; const GenQueue gen;
    int lo = 0, hi = 0, grabs = 0, tries = 0;
#define NEXT_ITEM(id) do { id = -1; \
        while (lo >= hi && grabs < budget && tries < (1 << 16)) { ++tries; unsigned st_ = 0u; if (lane == 0) st_ = __hip_atomic_fetch_add(qh, (unsigned)Q_CH, __ATOMIC_RELAXED, __HIP_MEMORY_SCOPE_AGENT); \
            const int s0_ = __builtin_amdgcn_readfirstlane((int)st_); if (s0_ >= Q_TOTAL) { grabs = budget; break; } \
            lo = s0_ > floor ? s0_ : floor; hi = (s0_ + Q_CH) < Q_TOTAL ? (s0_ + Q_CH) : Q_TOTAL; if (lo < hi) ++grabs; } \
        if (lo < hi) id = lo++; } while (0)
#define SLOT_FILL(k) do { NEXT_ITEM(i##k); if (i##k >= 0) { d##k = gen(A, F.ws, i##k); item_load(d##k, v##k, lane); } } while (0)
    int i0, i1, i2, i3; ItemDesc d0, d1, d2, d3; f32x4 v0[8], v1[8], v2[8], v3[8];
    SLOT_FILL(0); SLOT_FILL(1); SLOT_FILL(2); SLOT_FILL(3);
#pragma unroll 1
    for (;;) {
        if (i0 < 0) break; item_finish(d0, v0, scr, lane); SLOT_FILL(0);
        if (i1 < 0) break; item_finish(d1, v1, scr, lane); SLOT_FILL(1);
        if (i2 < 0) break; item_finish(d2, v2, scr, lane); SLOT_FILL(2);
        if (i3 < 0) break; item_finish(d3, v3, scr, lane); SLOT_FILL(3);
    }
#undef SLOT_FILL
#undef NEXT_ITEM
}
__device__ __forceinline__ void convert_paced(Frame& F, int floor, unsigned* stop, unsigned stop_at) {
    const Args& A = *F.a; LAS float* scr = (LAS float*)(F.lds + F.wave * 16384); const int lane = F.lane;
    unsigned* qh = (unsigned*)(F.ws + WS_CTL) + CW_Q;
    long long tn = (long long)wall_clock64() + F.wave * (PACE / 8); bool stopped = false;
#define PACE_WAIT() do { tn += PACE; long long now_ = (long long)wall_clock64(); if (now_ - tn > 2 * PACE) tn = now_ - 2 * PACE; \
        while (!stopped && now_ < tn) { __builtin_amdgcn_s_sleep(32); stopped = __builtin_amdgcn_readfirstlane(xb_ld(stop)) >= stop_at; now_ = (long long)wall_clock64(); } } while (0)
#pragma unroll 1
    for (int b = 0; b < FILL_CAP; ++b) {
        if (stopped || __builtin_amdgcn_readfirstlane(xb_ld(stop)) >= stop_at) break;
        unsigned st = 0u; if (lane == 0) st = __hip_atomic_fetch_add(qh, (unsigned)Q_CP, __ATOMIC_RELAXED, __HIP_MEMORY_SCOPE_AGENT);
        const int s0 = __builtin_amdgcn_readfirstlane((int)st);
        if (s0 >= Q_TOTAL) break;
        const int lo = s0 > floor ? s0 : floor, hi = (s0 + Q_CP) < Q_TOTAL ? (s0 + Q_CP) : Q_TOTAL;
        if (lo >= hi) continue;
        const GenQueue gen; ItemDesc d0 = gen(A, F.ws, lo); f32x4 v0[8]; item_load(d0, v0, lane);
#pragma unroll 1
        for (int id = lo + 1; id < hi; ++id) { PACE_WAIT(); const ItemDesc d1 = gen(A, F.ws, id); f32x4 v1[8]; item_load(d1, v1, lane); item_finish(d0, v0, scr, lane); d0 = d1;
#pragma unroll
            for (int i = 0; i < 8; ++i) v0[i] = v1[i]; }
        PACE_WAIT(); item_finish(d0, v0, scr, lane);
    }
#undef PACE_WAIT
}
__device__ __forceinline__ void convert_cleanup_at(Frame& F, int start, int upto) {
    const Args& A = *F.a; LAS float* scr = (LAS float*)(F.lds + F.wave * 16384);
    convert_seq<GenQueue>(A, F.ws, start + F.vcu * 8 + F.wave, upto, F.G * 8, scr, F.lane);
}
__device__ __forceinline__ void convert_beside_d_at(Frame& F, int start, int upto) {
    const Args& A = *F.a; LAS float* scr = (LAS float*)(F.lds + 81920 + (F.wave - 4) * 8704);
    convert_seq<GenQueue>(A, F.ws, start + F.vcu * 4 + (F.wave - 4), upto, F.G * 4, scr, F.lane);
}
__device__ __forceinline__ void convert_cleanup(Frame& F, int from, int upto) {
    const Args& A = *F.a; LAS float* scr = (LAS float*)(F.lds + F.wave * 16384);
    unsigned* qh = (unsigned*)(F.ws + WS_CTL) + CW_Q;
    int head = __builtin_amdgcn_readfirstlane((int)__hip_atomic_load(qh, __ATOMIC_RELAXED, __HIP_MEMORY_SCOPE_AGENT)); head = head > from ? head : from;
    convert_seq<GenQueue>(A, F.ws, head + F.vcu * 8 + F.wave, upto, F.G * 8, scr, F.lane);
}

__device__ __forceinline__ void convert_beside_d(Frame& F, int from, int upto) {
    const Args& A = *F.a; LAS float* scr = (LAS float*)(F.lds + 81920 + (F.wave - 4) * 8704);
    unsigned* qh = (unsigned*)(F.ws + WS_CTL) + CW_Q;
    int head = __builtin_amdgcn_readfirstlane((int)__hip_atomic_load(qh, __ATOMIC_RELAXED, __HIP_MEMORY_SCOPE_AGENT)); head = head > from ? head : from;
    convert_seq<GenQueue>(A, F.ws, head + F.vcu * 4 + (F.wave - 4), upto, F.G * 4, scr, F.lane);
}
__device__ __forceinline__ void p0_prologue(Frame& F) {
    const Args& A = *F.a; unsigned char* ws = F.ws;
    LAS float* scr = (LAS float*)(F.lds + F.wave * 16384);
    const int gw = F.vcu * 8 + F.wave, NGW = F.G * 8, lane = F.lane;
    convert_seq<GenPrologue>(A, ws, gw, LI_S + KV_ITEMS, NGW, scr, lane);
    { const int gt = F.vcu * 512 + F.tid, NGT = F.G * 512; bf16_t* SW = (bf16_t*)(ws + WS_SGUW);
      for (int i = gt; i < NL * 4 * 128 * 128 / 8; i += NGT) { const int t = (i >> 4) & 127, s0 = (i & 15) * 8; const f32x4* p = (const f32x4*)(A.in[I_SGU_W] + (size_t)i * 8); const f32x4 a = p[0], b = p[1];
          float v[8] = {a[0], a[1], a[2], a[3], b[0], b[1], b[2], b[3]};
#pragma unroll
          for (int q = 0; q < 8; ++q) v[q] = (s0 + q <= t) ? v[q] : 0.f;
          *(u32x4*)(SW + (size_t)i * 8) = (u32x4){cvt_pk_bf16(v[0], v[1]), cvt_pk_bf16(v[2], v[3]), cvt_pk_bf16(v[4], v[5]), cvt_pk_bf16(v[6], v[7])}; }
      bf16_t* XB = (bf16_t*)(ws + WS_XB);
      static_assert(NTOK * D / 8 % (256 * 512 * 4) == 0, "x -> bf16 unroll");
      for (int i = gt; i < NTOK * D / 8; i += 4 * NGT) { f32x4 a[4], b[4];
#pragma unroll
          for (int q = 0; q < 4; ++q) { const int iq = i + q * NGT; if (iq < NTOK * D / 8) { const GAS f32x4* p = (const GAS f32x4*)(A.in[I_X] + (size_t)iq * 8); a[q] = __builtin_nontemporal_load(p); b[q] = __builtin_nontemporal_load(p + 1); } }
#pragma unroll
          for (int q = 0; q < 4; ++q) { const int iq = i + q * NGT; if (iq < NTOK * D / 8)
              *(GAS u32x4*)(XB + (size_t)iq * 8) = (u32x4){cvt_pk_bf16(a[q][0], a[q][1]), cvt_pk_bf16(a[q][2], a[q][3]), cvt_pk_bf16(b[q][0], b[q][1]), cvt_pk_bf16(b[q][2], b[q][3])}; } } }
    if (F.vcu == 0 && F.tid < 256) *(u32x4*)((bf16_t*)(ws + WS_X1B) + (size_t)NTOK * D + F.tid * 8) = (u32x4){0u, 0u, 0u, 0u};
    if (F.vcu < NL * 16) { const int ll = F.vcu >> 4, sub = F.vcu & 15, e = F.tid & 63, part = F.tid >> 6; LAS float* red = (LAS float*)(F.lds + 12288)  ; float a1 = 0.f, a2 = 0.f;
        const GAS float* Wr = (const GAS float*)(A.in[I_W_R] + (size_t)ll * D * NE); const GAS float* g1 = (const GAS float*)(A.in[I_LN1_G] + (size_t)ll * D); const GAS float* b1 = (const GAS float*)(A.in[I_LN1_B] + (size_t)ll * D);
        const int k0 = sub * 128 + part * 16;
#pragma unroll
        for (int k = 0; k < 16; ++k) { const float wv = Wr[(size_t)(k0 + k) * NE + e]; a1 += g1[k0 + k] * wv; a2 += b1[k0 + k] * wv; }
        red[F.tid] = a1; red[512 + F.tid] = a2; __syncthreads();
        if (F.tid < 128) { const int which = F.tid >> 6, e2 = F.tid & 63; float sum = 0.f;
#pragma unroll
            for (int q = 0; q < 8; ++q) sum += red[which * 512 + q * 64 + e2];
            ((float*)(ws + WS_RCP))[(size_t)F.vcu * 128 + which * 64 + e2] = sum; }
        __syncthreads(); }
    { bf16_t* MN = (bf16_t*)(ws + WS_MEMN);
      for (int m = gw; m < NMEMTOK; m += NGW) { const f32x4* xr = (const f32x4*)(A.in[I_MEM] + (size_t)m * D) + lane; f32x4 v[8]; float s = 0.f;
#pragma unroll
          for (int j = 0; j < 8; ++j) { v[j] = xr[64 * j]; s += (v[j][0] + v[j][1]) + (v[j][2] + v[j][3]); }
          const float mean = wave_sum(s) * (1.f / D); float s2 = 0.f;
#pragma unroll
          for (int j = 0; j < 8; ++j) { v[j] = v[j] - mean; s2 += (v[j][0] * v[j][0] + v[j][1] * v[j][1]) + (v[j][2] * v[j][2] + v[j][3] * v[j][3]); }
          const float rstd = 1.f / sqrtf(wave_sum(s2) * (1.f / D) + LN_EPS);
#pragma unroll
          for (int j = 0; j < 8; ++j) { const f32x4 g = ((const f32x4*)A.in[I_MEM_G])[lane + 64 * j], b = ((const f32x4*)A.in[I_MEM_B])[lane + 64 * j]; const f32x4 o = v[j] * rstd * g + b;
              *(u32x2*)(MN + (size_t)m * D + 4 * lane + 256 * j) = (u32x2){cvt_pk_bf16(o[0], o[1]), cvt_pk_bf16(o[2], o[3])}; } } }
}

typedef f32x4 acc8_t[8];
__device__ __forceinline__ void mixer_sgu(Frame& F, int l, int chunk, int h) {
    const Args& A = *F.a; const int lane = F.lane, w = F.wave, fr = lane & 15, g = lane >> 4, t0 = chunk * 128;
    const bf16_t* HB = (const bf16_t*)(F.ws + WS_HB); bf16_t* MIX = (bf16_t*)(F.ws + WS_MIX); const bf16_t* SW = (const bf16_t*)(F.ws + WS_SGUW) + (size_t)(l * 4 + h) * 128 * 128;
    LAS unsigned char* VT = F.lds;
    const int t = 16 * w + fr;
    bf16x8 af[4]; u32x2 uraw[8];
#pragma unroll
    for (int ks = 0; ks < 4; ++ks) af[ks] = *(const GAS bf16x8*)(SW + (size_t)t * 128 + 32 * ks + 8 * g);
#pragma unroll
    for (int j = 0; j < 8; ++j) uraw[j] = *(const GAS u32x2*)(HB + (size_t)(t0 + t) * INW + h * 128 + 16 * j + 4 * g);
    const float bs = A.in[I_SGU_BS][(size_t)(l * 128 + t) * 4 + h];
    { const float* gp = A.in[I_SGU_G] + l * GW + h * 128 + 8 * fr; const float* bp = A.in[I_SGU_B] + l * GW + h * 128 + 8 * fr;
      const f32x4 g0 = *(const f32x4*)gp, g1 = *(const GAS f32x4*)(gp + 4), b0 = *(const f32x4*)bp, b1 = *(const GAS f32x4*)(bp + 4);
      const float gg[8] = {g0[0], g0[1], g0[2], g0[3], g1[0], g1[1], g1[2], g1[3]}, bb[8] = {b0[0], b0[1], b0[2], b0[3], b1[0], b1[1], b1[2], b1[3]};
      u32x4 raw[4];
#pragma unroll
      for (int p = 0; p < 4; ++p) raw[p] = *(const GAS u32x4*)(HB + (size_t)(t0 + 16 * w + 4 * p + g) * INW + 512 + h * 128 + 8 * fr);
#pragma unroll
      for (int p = 0; p < 4; ++p) { const int tok = 16 * w + 4 * p + g;
          float v[8] = {bf_lo(raw[p].x), bf_hi(raw[p].x), bf_lo(raw[p].y), bf_hi(raw[p].y), bf_lo(raw[p].z), bf_hi(raw[p].z), bf_lo(raw[p].w), bf_hi(raw[p].w)}; float s = 0.f;
#pragma unroll
          for (int q = 0; q < 8; ++q) { v[q] = gelu_tanh_f(v[q]); s += v[q]; }
          const float mean = g16_sum(s) * (1.f / 128.f); float s2 = 0.f;
#pragma unroll
          for (int q = 0; q < 8; ++q) { v[q] -= mean; s2 += v[q] * v[q]; }
          const float rstd = 1.f / sqrtf(g16_sum(s2) * (1.f / 128.f) + LN_EPS);
#pragma unroll
          for (int q = 0; q < 8; q += 2) { const unsigned pk = cvt_pk_bf16(v[q] * rstd * gg[q] + bb[q], v[q + 1] * rstd * gg[q + 1] + bb[q + 1]);
              const int d0 = 8 * fr + q, d1 = d0 + 1;
              *(LAS bf16_t*)(VT + d0 * 256 + ((((tok >> 3) ^ d0 ^ (d0 >> 3)) & 15) << 4) + (tok & 7) * 2) = (bf16_t)(pk & 0xffffu);
              *(LAS bf16_t*)(VT + d1 * 256 + ((((tok >> 3) ^ d1 ^ (d1 >> 3)) & 15) << 4) + (tok & 7) * 2) = (bf16_t)(pk >> 16); } } }
    __syncthreads();
    f32x4 acc[8];
#pragma unroll
    for (int j = 0; j < 8; ++j) acc[j] = (f32x4){0.f, 0.f, 0.f, 0.f};
    const int nks = (w >> 1) + 1;
#pragma unroll
    for (int ks = 0; ks < 4; ++ks) if (ks < nks) {
#pragma unroll
        for (int j = 0; j < 8; ++j) { const int d = 16 * j + fr; const bf16x8 bfr = *(const LAS bf16x8*)(VT + d * 256 + ((((4 * ks + g) ^ d ^ (d >> 3)) & 15) << 4));
            acc[j] = __builtin_amdgcn_mfma_f32_16x16x32_bf16(bfr, af[ks], acc[j], 0, 0, 0); }
    }
#pragma unroll
    for (int j = 0; j < 8; ++j) { const u32x2 raw = uraw[j];
        const float u0 = gelu_tanh_f(bf_lo(raw.x)), u1 = gelu_tanh_f(bf_hi(raw.x)), u2 = gelu_tanh_f(bf_lo(raw.y)), u3 = gelu_tanh_f(bf_hi(raw.y));
        *(GAS u32x2*)(MIX + (size_t)(t0 + t) * D + h * 128 + 16 * j + 4 * g) = (u32x2){cvt_pk_bf16(u0 * (acc[j][0] + bs), u1 * (acc[j][1] + bs)), cvt_pk_bf16(u2 * (acc[j][2] + bs), u3 * (acc[j][3] + bs))}; }
    __syncthreads();
}
__device__ __forceinline__ void mixer_pool(Frame& F, int l, int chunk, int grp) {
    const Args& A = *F.a; const int lane = F.lane, w = F.wave, fr = lane & 15, g = lane >> 4, t0 = chunk * 128, tid = F.tid;
    const bf16_t* HB = (const bf16_t*)(F.ws + WS_HB); bf16_t* MIX = (bf16_t*)(F.ws + WS_MIX); const bf16_t* WP = (const bf16_t*)(F.ws + WS_WPT) + (size_t)(l * 4 + grp) * 128 * 128;
    constexpr int PST = 272;
    LAS unsigned char* PT = F.lds;
    LAS unsigned char* PA = F.lds + 144 * PST;
    const int win = 2 << grp, pos0 = t0 & (SEQ - 1);
    LAS unsigned char* WS = F.lds + 144 * PST + 128 * PST;
    { u32x4 wv4[4];
#pragma unroll
      for (int i = 0; i < 4; ++i) wv4[i] = *(const GAS u32x4*)(WP + (size_t)(tid + 512 * i) * 8);
      for (int i = tid; i < 144 * 16; i += 512) { const int r = i >> 4, cc = i & 15; const int trow = t0 - 16 + r; u32x4 v = (u32x4){0u, 0u, 0u, 0u};
          if (pos0 - 16 + r >= 0) v = *(const GAS u32x4*)(HB + (size_t)trow * INW + 1024 + grp * 128 + 8 * cc);
          *(LAS u32x4*)(PT + r * PST + cc * 16) = v; }
#pragma unroll
      for (int i = 0; i < 4; ++i) { const int id = tid + 512 * i, d = id >> 4, cc = id & 15; *(LAS u32x4*)(WS + d * 256 + ((cc ^ (d & 15)) << 4)) = wv4[i]; } }
    f32x4 scv[8];
#pragma unroll
    for (int j = 0; j < 8; ++j) scv[j] = *(const GAS f32x4*)(A.in[I_POOL_S] + l * GW + grp * 128 + 16 * j + 4 * g);
    __syncthreads();
    for (int i = tid; i < 128 * 16; i += 512) { const int t = i >> 4, cc = i & 15; float s[8] = {0.f, 0.f, 0.f, 0.f, 0.f, 0.f, 0.f, 0.f}; u32x4 cur = (u32x4){0u, 0u, 0u, 0u};
        for (int j = 0; j < win; ++j) { cur = *(const LAS u32x4*)(PT + (t + 16 - win + 1 + j) * PST + cc * 16);
            s[0] += bf_lo(cur.x); s[1] += bf_hi(cur.x); s[2] += bf_lo(cur.y); s[3] += bf_hi(cur.y); s[4] += bf_lo(cur.z); s[5] += bf_hi(cur.z); s[6] += bf_lo(cur.w); s[7] += bf_hi(cur.w); }
        const int pos = pos0 + t; const float inv = 1.0f / (float)((pos + 1) < win ? (pos + 1) : win);
        const float x[8] = {bf_lo(cur.x), bf_hi(cur.x), bf_lo(cur.y), bf_hi(cur.y), bf_lo(cur.z), bf_hi(cur.z), bf_lo(cur.w), bf_hi(cur.w)};
        *(LAS u32x4*)(PA + t * PST + cc * 16) = (u32x4){cvt_pk_bf16(s[0] * inv - x[0], s[1] * inv - x[1]), cvt_pk_bf16(s[2] * inv - x[2], s[3] * inv - x[3]),
                                                        cvt_pk_bf16(s[4] * inv - x[4], s[5] * inv - x[5]), cvt_pk_bf16(s[6] * inv - x[6], s[7] * inv - x[7])}; }
    __syncthreads();
    f32x4 acc[8];
#pragma unroll
    for (int j = 0; j < 8; ++j) acc[j] = (f32x4){0.f, 0.f, 0.f, 0.f};
#pragma unroll
    for (int ks = 0; ks < 4; ++ks) { const bf16x8 af = *(const LAS bf16x8*)(PA + (16 * w + fr) * PST + (32 * ks + 8 * g) * 2);
#pragma unroll
        for (int j = 0; j < 8; ++j) { const bf16x8 bfr = *(const LAS bf16x8*)(WS + (16 * j + fr) * 256 + (((4 * ks + g) ^ fr) << 4));
            acc[j] = __builtin_amdgcn_mfma_f32_16x16x32_bf16(bfr, af, acc[j], 0, 0, 0); } }
    { const int t = 16 * w + fr;
#pragma unroll
      for (int j = 0; j < 8; ++j) { const f32x4 sc = scv[j];
          *(GAS u32x2*)(MIX + (size_t)(t0 + t) * D + 512 + grp * 128 + 16 * j + 4 * g) = (u32x2){cvt_pk_bf16(acc[j][0] * sc[0], acc[j][1] * sc[1]), cvt_pk_bf16(acc[j][2] * sc[2], acc[j][3] * sc[3])}; } }
    __syncthreads();
}
__device__ __forceinline__ void mixer_conv(Frame& F, int l, int chunk, int grp) {
    const Args& A = *F.a; const int lane = F.lane, w = F.wave, fr = lane & 15, g = lane >> 4, t0 = chunk * 128, tid = F.tid;
    const bf16_t* HB = (const bf16_t*)(F.ws + WS_HB); bf16_t* MIX = (bf16_t*)(F.ws + WS_MIX);
    LAS float* GT = (LAS float*)F.lds;
    const int pos0 = t0 & (SEQ - 1);
    for (int i = tid; i < 158 * 16; i += 512) { const int r = i >> 4, cc = i & 15; float o[8] = {0.f, 0.f, 0.f, 0.f, 0.f, 0.f, 0.f, 0.f};
        if (pos0 - 30 + r >= 0) { const bf16_t* rowp = HB + (size_t)(t0 - 30 + r) * INW + grp * 128 + 8 * cc; const u32x4 v = *(const GAS u32x4*)(rowp + 1536), gt = *(const GAS u32x4*)(rowp + 2048);
            o[0] = bf_lo(v.x) * fast_sigmoid(bf_lo(gt.x)); o[1] = bf_hi(v.x) * fast_sigmoid(bf_hi(gt.x)); o[2] = bf_lo(v.y) * fast_sigmoid(bf_lo(gt.y)); o[3] = bf_hi(v.y) * fast_sigmoid(bf_hi(gt.y));
            o[4] = bf_lo(v.z) * fast_sigmoid(bf_lo(gt.z)); o[5] = bf_hi(v.z) * fast_sigmoid(bf_hi(gt.z)); o[6] = bf_lo(v.w) * fast_sigmoid(bf_lo(gt.w)); o[7] = bf_hi(v.w) * fast_sigmoid(bf_hi(gt.w)); }
        *(LAS f32x4*)(GT + r * 128 + 8 * cc) = (f32x4){o[0], o[1], o[2], o[3]}; *(LAS f32x4*)(GT + r * 128 + 8 * cc + 4) = (f32x4){o[4], o[5], o[6], o[7]}; }
    __syncthreads();
    float y[32];
    { const int ch = tid & 127, tg = tid >> 7; float wv[31];
#pragma unroll
      for (int j = 0; j < 31; ++j) wv[j] = A.in[I_CONV_W][(size_t)(l * 31 + j) * GW + grp * 128 + ch];
      const float bias = A.in[I_CONV_B][l * GW + grp * 128 + ch];
      float xin[62];
#pragma unroll
      for (int j = 0; j < 62; ++j) xin[j] = GT[(tg * 32 + j) * 128 + ch];
#pragma unroll
      for (int t = 0; t < 32; ++t) { float s = bias;
#pragma unroll
          for (int j = 0; j < 31; ++j) s += wv[j] * xin[t + j];
          y[t] = s; }
      __syncthreads();
#pragma unroll
      for (int t = 0; t < 32; ++t) GT[(tg * 32 + t) * 128 + ch] = y[t]; }
    __syncthreads();
    { const float* gp = A.in[I_CONV_G] + l * GW + grp * 128 + 8 * fr; const float* bp = A.in[I_CONV_LB] + l * GW + grp * 128 + 8 * fr;
      const f32x4 g0 = *(const f32x4*)gp, g1 = *(const GAS f32x4*)(gp + 4), b0 = *(const f32x4*)bp, b1 = *(const GAS f32x4*)(bp + 4);
      const float gg[8] = {g0[0], g0[1], g0[2], g0[3], g1[0], g1[1], g1[2], g1[3]}, bb[8] = {b0[0], b0[1], b0[2], b0[3], b1[0], b1[1], b1[2], b1[3]};
#pragma unroll
      for (int p = 0; p < 4; ++p) { const int tok = 16 * w + 4 * p + g; const f32x4 a = *(const LAS f32x4*)(GT + tok * 128 + 8 * fr), b = *(const LAS f32x4*)(GT + tok * 128 + 8 * fr + 4);
          float v[8] = {a[0], a[1], a[2], a[3], b[0], b[1], b[2], b[3]}; float s = 0.f;
#pragma unroll
          for (int q = 0; q < 8; ++q) s += v[q];
          const float mean = g16_sum(s) * (1.f / 128.f); float s2 = 0.f;
#pragma unroll
          for (int q = 0; q < 8; ++q) { v[q] -= mean; s2 += v[q] * v[q]; }
          const float rstd = 1.f / sqrtf(g16_sum(s2) * (1.f / 128.f) + LN_EPS);
#pragma unroll
          for (int q = 0; q < 8; ++q) v[q] = silu_f(v[q] * rstd * gg[q] + bb[q]);
          *(GAS u32x4*)(MIX + (size_t)(t0 + tok) * D + 1024 + grp * 128 + 8 * fr) = (u32x4){cvt_pk_bf16(v[0], v[1]), cvt_pk_bf16(v[2], v[3]), cvt_pk_bf16(v[4], v[5]), cvt_pk_bf16(v[6], v[7])}; } }
    __syncthreads();
}
__device__ __forceinline__ void mixer_attn(Frame& F, int l, int chunk, int h) {
    const int lane = F.lane, w = F.wave, fr = lane & 15, g = lane >> 4, t0 = chunk * 128, b = t0 / SEQ, tid = F.tid;
    const bf16_t* HB = (const bf16_t*)(F.ws + WS_HB); bf16_t* MIX = (bf16_t*)(F.ws + WS_MIX);
    const bf16_t* KB = (const bf16_t*)(F.ws + WS_KBUF) + (size_t)(b * 256) * D + l * 512 + h * 128;
    const bf16_t* VTp = (const bf16_t*)(F.ws + WS_VT) + (size_t)(l * 512 + h * 128) * NMEMTOK + b * 256;
    LAS unsigned char* KS = F.lds;
    LAS unsigned char* VS = F.lds + 65536;
    { u32x4 kv[8], vv[8];
#pragma unroll
      for (int i = 0; i < 8; ++i) { const int id = tid + 512 * i; kv[i] = *(const GAS u32x4*)(KB + (size_t)(id >> 4) * D + (id & 15) * 8); vv[i] = *(const GAS u32x4*)(VTp + (size_t)(id >> 5) * NMEMTOK + (id & 31) * 8); }
#pragma unroll
      for (int i = 0; i < 8; ++i) { const int id = tid + 512 * i; const int m = id >> 4, c = id & 15, d = id >> 5, c2 = id & 31;
          *(LAS u32x4*)(KS + m * 256 + ((c ^ (m & 15)) << 4)) = kv[i]; *(LAS u32x4*)(VS + d * 512 + ((c2 ^ (d & 15)) << 4)) = vv[i]; } }
    __syncthreads();
    const int t = 16 * w + fr;
    f32x4 sa[16];
#pragma unroll
    for (int j = 0; j < 16; ++j) sa[j] = (f32x4){0.f, 0.f, 0.f, 0.f};
    bf16x8 qf[4];
#pragma unroll
    for (int ks = 0; ks < 4; ++ks) qf[ks] = *(const GAS bf16x8*)(HB + (size_t)(t0 + t) * INW + 2560 + h * 128 + 32 * ks + 8 * g);
#pragma unroll
    for (int ks = 0; ks < 4; ++ks)
#pragma unroll
        for (int j = 0; j < 16; ++j) { const bf16x8 kf = *(const LAS bf16x8*)(KS + (16 * j + fr) * 256 + (((4 * ks + g) ^ fr) << 4));
            sa[j] = __builtin_amdgcn_mfma_f32_16x16x32_bf16(kf, qf[ks], sa[j], 0, 0, 0); }
    float mx = -3.0e38f;
#pragma unroll
    for (int j = 0; j < 16; ++j) mx = fmaxf(mx, fmaxf(fmaxf(sa[j][0], sa[j][1]), fmaxf(sa[j][2], sa[j][3])));
    mx = fmaxf(mx, __shfl_xor(mx, 16)); mx = fmaxf(mx, __shfl_xor(mx, 32));
    const float sc = 0.08838834764831845f * 1.4426950408889634f; float sum = 0.f;
#pragma unroll
    for (int j = 0; j < 16; ++j)
#pragma unroll
        for (int r = 0; r < 4; ++r) { const float p = __builtin_amdgcn_exp2f((sa[j][r] - mx) * sc); sa[j][r] = p; sum += p; }
    sum += __shfl_xor(sum, 16); sum += __shfl_xor(sum, 32);
    const float inv = 1.0f / sum;
    f32x4 oa[8];
#pragma unroll
    for (int j = 0; j < 8; ++j) oa[j] = (f32x4){0.f, 0.f, 0.f, 0.f};
#pragma unroll
    for (int q = 0; q < 8; ++q) {
        union { bf16x8 v; unsigned u[4]; } pf; pf.u[0] = cvt_pk_bf16(sa[2 * q][0], sa[2 * q][1]); pf.u[1] = cvt_pk_bf16(sa[2 * q][2], sa[2 * q][3]);
        pf.u[2] = cvt_pk_bf16(sa[2 * q + 1][0], sa[2 * q + 1][1]); pf.u[3] = cvt_pk_bf16(sa[2 * q + 1][2], sa[2 * q + 1][3]);
#pragma unroll
        for (int jd = 0; jd < 8; ++jd) {
            const LAS unsigned char* vrow = VS + (16 * jd + fr) * 512 + ((g & 1) << 3);
            union { bf16x8 v; u32x2 u[2]; } vf; vf.u[0] = *(const LAS u32x2*)(vrow + (((4 * q + (g >> 1)) ^ fr) << 4)); vf.u[1] = *(const LAS u32x2*)(vrow + (((4 * q + 2 + (g >> 1)) ^ fr) << 4));
            oa[jd] = __builtin_amdgcn_mfma_f32_16x16x32_bf16(vf.v, pf.v, oa[jd], 0, 0, 0); } }
#pragma unroll
    for (int jd = 0; jd < 8; ++jd)
        *(GAS u32x2*)(MIX + (size_t)(t0 + t) * D + 1536 + h * 128 + 16 * jd + 4 * g) = (u32x2){cvt_pk_bf16(oa[jd][0] * inv, oa[jd][1] * inv), cvt_pk_bf16(oa[jd][2] * inv, oa[jd][3] * inv)};
    __syncthreads();
}

#if PROBE_CLASS >= 0
#define PROBE_SUB(F, cls) do { if (blockIdx.x == 0 && (F).tid == 0) { volatile LAS unsigned* M_ = (volatile LAS unsigned*)((F).lds + LDS_MISC); const unsigned n_ = (unsigned)wall_clock64(); if ((cls) == PROBE_CLASS || PROBE_CLASS == 99) M_[65] += n_ - M_[64]; M_[64] = n_; } } while (0)
#else
#define PROBE_SUB(F, cls) do { } while (0)
#endif
template <int NW> __device__ __forceinline__ void dsync(LAS unsigned* ctr, unsigned& nb, int lane) {
    if constexpr (NW == 8) { asm volatile("s_waitcnt vmcnt(0)" ::: "memory"); __syncthreads(); }
    else { asm volatile("s_waitcnt vmcnt(0) lgkmcnt(0)" ::: "memory"); ++nb;
        if (lane == 0) __hip_atomic_fetch_add(ctr, 1u, __ATOMIC_RELAXED, __HIP_MEMORY_SCOPE_WORKGROUP);
        while (__hip_atomic_load(ctr, __ATOMIC_RELAXED, __HIP_MEMORY_SCOPE_WORKGROUP) < (unsigned)NW * nb) __builtin_amdgcn_s_sleep(1);
        asm volatile("" ::: "memory"); }
}
template <int NW> __device__ __forceinline__ void phase_d(Frame& F, int l) {
    constexpr int TPW = 32 / NW, KW = D / NW;
    const Args& A = *F.a; unsigned char* ws = F.ws; const int lane = F.lane, w = F.wave, tid = F.tid, fr = lane & 15, g = lane >> 4;
    const bf16_t* Y1 = (const bf16_t*)(ws + WS_Y1); bf16_t* X1B = (bf16_t*)(ws + WS_X1B); const float* RC = (const float*)(ws + WS_RC) + l * 128;
    const bf16_t* WRH = (const bf16_t*)(ws + WS_WR_HI) + (size_t)l * NE * D; const bf16_t* WRL = (const bf16_t*)(ws + WS_WR_LO) + (size_t)l * NE * D;
    int* LIST = (int*)(ws + WS_LIST); int* AEP = (int*)(ws + WS_ASG_EP); float* AW = (float*)(ws + WS_ASG_W);
    unsigned* CNT = (unsigned*)(ws + WS_CTL) + CW_CNT + (size_t)l * 64 * CNT_STRIDE;
    LAS float* PL = (LAS float*)F.lds;
    LAS unsigned* HIST = (LAS unsigned*)(F.lds + NW * 32 * 65 * 4);
    LAS float* MS = (LAS float*)(HIST + 128);
    LAS unsigned* ctr = (LAS unsigned*)(F.lds + LDS_MISC) + 16; unsigned nb = 0u;
    for (int blk = F.vcu; blk < NTOK / 32; blk += F.G) {
        const int tok0 = blk * 32;
        if (tid < 128) HIST[tid] = 0u;
        PROBE_SUB(F, 8);
        { constexpr int PF = 2;
          const GAS u32x2* yb = (const GAS u32x2*)(Y1 + (size_t)(tok0 + TPW * w) * D) + lane;
          GAS u32x2* xh = (GAS u32x2*)(X1B + (size_t)(tok0 + TPW * w) * D) + lane;
          u32x2 raw[PF][8]; f32x4 gg[8], bb[8];
#pragma unroll
          for (int q = 0; q < PF; ++q)
#pragma unroll
              for (int j = 0; j < 8; ++j) raw[q][j] = yb[q * (D / 4) + 64 * j];
#pragma unroll
          for (int j = 0; j < 8; ++j) { gg[j] = ((const GAS f32x4*)(A.in[I_LN1_G] + l * D))[lane + 64 * j]; bb[j] = ((const GAS f32x4*)(A.in[I_LN1_B] + l * D))[lane + 64 * j]; }
#pragma unroll
          for (int tt = 0; tt < TPW; ++tt) { f32x4 v[8]; float s = 0.f;
#pragma unroll
              for (int j = 0; j < 8; ++j) { const u32x2 r = raw[tt % PF][j]; v[j] = (f32x4){bf_lo(r.x), bf_hi(r.x), bf_lo(r.y), bf_hi(r.y)}; s += (v[j][0] + v[j][1]) + (v[j][2] + v[j][3]); }
              if (tt + PF < TPW) {
#pragma unroll
                  for (int j = 0; j < 8; ++j) raw[tt % PF][j] = yb[(tt + PF) * (D / 4) + 64 * j]; }
              const float mean = wave_sum(s) * (1.f / D); float s2 = 0.f;
#pragma unroll
              for (int j = 0; j < 8; ++j) { v[j] = v[j] - mean; s2 += (v[j][0] * v[j][0] + v[j][1] * v[j][1]) + (v[j][2] * v[j][2] + v[j][3] * v[j][3]); }
              const float rstd = 1.f / sqrtf(wave_sum(s2) * (1.f / D) + LN_EPS);
              if (lane == 0) { MS[2 * (TPW * w + tt)] = mean; MS[2 * (TPW * w + tt) + 1] = rstd; }
#pragma unroll
              for (int j = 0; j < 8; ++j) { const f32x4 o = v[j] * rstd * gg[j] + bb[j];
                  xh[tt * (D / 4) + 64 * j] = (u32x2){cvt_pk_bf16(o[0], o[1]), cvt_pk_bf16(o[2], o[3])}; } } }
        dsync<NW>(ctr, nb, lane); PROBE_SUB(F, 9);
        { f32x4 acc[2][4];
#pragma unroll
          for (int rb = 0; rb < 2; ++rb)
#pragma unroll
              for (int cb = 0; cb < 4; ++cb) acc[rb][cb] = (f32x4){0.f, 0.f, 0.f, 0.f};
          constexpr int NS = RT_NS, NB = KW / 32;
          int lane_r = lane; asm volatile("" : "+v"(lane_r));
          const int fr_r = lane_r & 15, g_r = lane_r >> 4;
          const GAS bf16x8* pay = (const GAS bf16x8*)(Y1 + (size_t)(tok0 + fr_r) * D + KW * w + 8 * g_r);
          const GAS bf16x8* pbh = (const GAS bf16x8*)WRH + (KW / 32 * w) * 64 + lane_r;                 const GAS bf16x8* pbl = (const GAS bf16x8*)WRL + (KW / 32 * w) * 64 + lane_r;
          bf16x8 ay[NS][2], bh[NS][4], bl[NS][4];
#define RT_LOAD(buf, b) do { const int ko = 4 * (b); \
              _Pragma("unroll") for (int rb = 0; rb < 2; ++rb) ay[buf][rb] = pay[rb * 2 * D + ko]; \
              _Pragma("unroll") for (int cb = 0; cb < 4; ++cb) { bh[buf][cb] = pbh[cb * (D / 32) * 64 + 64 * (b)]; bl[buf][cb] = pbl[cb * (D / 32) * 64 + 64 * (b)]; } } while (0)
#pragma unroll
          for (int b = 0; b < NS - 1; ++b) RT_LOAD(b, b);
#pragma unroll 1
          for (int b0 = 0; b0 < NB; b0 += NS) {
#pragma unroll
              for (int s_ = 0; s_ < NS; ++s_) { const int b = b0 + s_;
                  if (b < NB) {
                      if (b + NS - 1 < NB) RT_LOAD((s_ + NS - 1) % NS, b + NS - 1);
                      __builtin_amdgcn_sched_barrier(0);
#pragma unroll
                      for (int cb = 0; cb < 4; ++cb)
#pragma unroll
                          for (int rb = 0; rb < 2; ++rb) { acc[rb][cb] = __builtin_amdgcn_mfma_f32_16x16x32_bf16(ay[s_][rb], bh[s_][cb], acc[rb][cb], 0, 0, 0);
                              acc[rb][cb] = __builtin_amdgcn_mfma_f32_16x16x32_bf16(ay[s_][rb], bl[s_][cb], acc[rb][cb], 0, 0, 0); }
                      __builtin_amdgcn_sched_barrier(0); } } }
#undef RT_LOAD
#pragma unroll
          for (int rb = 0; rb < 2; ++rb)
#pragma unroll
              for (int cb = 0; cb < 4; ++cb)
#pragma unroll
                  for (int r = 0; r < 4; ++r) PL[(w * 32 + 16 * rb + 4 * g + r) * 65 + 16 * cb + fr] = acc[rb][cb][r]; }
        dsync<NW>(ctr, nb, lane); PROBE_SUB(F, 10);
        int lane_t = lane; asm volatile("" : "+v"(lane_t));
        const int tq = lane_t >> 3, gi = lane_t & 7; const bool act = tq < TPW; const int tl = TPW * w + (act ? tq : 0), tokq = tok0 + tl;
        float sc8[8], mc[8]; unsigned selm = 0u; unsigned loc8[8]; float rsum; int kbase;
        { float lg[8];
#pragma unroll
          for (int i = 0; i < 8; ++i) lg[i] = 0.f;
#pragma unroll
          for (int ww = 0; ww < NW; ++ww)
#pragma unroll
              for (int i = 0; i < 8; ++i) lg[i] += PL[(ww * 32 + tl) * 65 + 8 * gi + i];
          { const float mean = MS[2 * tl], rstd = MS[2 * tl + 1];
            const f32x4 c1a = *(const GAS f32x4*)(RC + 8 * gi), c1b = *(const GAS f32x4*)(RC + 8 * gi + 4), c2a = *(const GAS f32x4*)(RC + 64 + 8 * gi), c2b = *(const GAS f32x4*)(RC + 64 + 8 * gi + 4);
            const float c1[8] = {c1a[0], c1a[1], c1a[2], c1a[3], c1b[0], c1b[1], c1b[2], c1b[3]}, c2[8] = {c2a[0], c2a[1], c2a[2], c2a[3], c2b[0], c2b[1], c2b[2], c2b[3]};
#pragma unroll
            for (int i = 0; i < 8; ++i) lg[i] = rstd * (lg[i] - mean * c1[i]) + c2[i]; }
          const f32x4 rb0 = *(const GAS f32x4*)(A.in[I_R_BIAS] + l * NE + 8 * gi), rb1 = *(const GAS f32x4*)(A.in[I_R_BIAS] + l * NE + 8 * gi + 4);
          const float rb[8] = {rb0[0], rb0[1], rb0[2], rb0[3], rb1[0], rb1[1], rb1[2], rb1[3]};
          float m1 = -INFINITY, m2 = -INFINITY;
#pragma unroll
          for (int i = 0; i < 8; ++i) { sc8[i] = 1.0f / (1.0f + __expf(-lg[i])); mc[i] = sc8[i] + rb[i]; m2 = fmaxf(m2, fminf(m1, mc[i])); m1 = fmaxf(m1, mc[i]); }
          const float gs = m1 + m2; int grank = 0;
#pragma unroll
          for (int j = 1; j < 8; ++j) { const float gv = __shfl_xor(gs, j); grank += (gv > gs || (gv == gs && (gi ^ j) < gi)) ? 1 : 0; }
          if (grank >= 4) {
#pragma unroll
              for (int i = 0; i < 8; ++i) mc[i] = -INFINITY; } }
#pragma unroll 2
        for (int r = 0; r < TOPK; ++r) {
            float bv = mc[0]; int bi = 0;
#pragma unroll
            for (int i = 1; i < 8; ++i) { const bool t_ = mc[i] > bv; bv = t_ ? mc[i] : bv; bi = t_ ? i : bi; }
            float v = bv; int own = gi;
#pragma unroll
            for (int m = 1; m < 8; m <<= 1) { const float ov = __shfl_xor(v, m); const int oo = __shfl_xor(own, m); const bool t_ = (ov > v) || (ov == v && oo < own); v = t_ ? ov : v; own = t_ ? oo : own; }
            const bool mine = own == gi;
#pragma unroll
            for (int i = 0; i < 8; ++i) { const bool h_ = mine && bi == i; mc[i] = h_ ? -INFINITY : mc[i]; selm |= h_ ? (1u << i) : 0u; } }
        { float ps = 0.f;
#pragma unroll
          for (int i = 0; i < 8; ++i) ps += ((selm >> i) & 1u) ? sc8[i] : 0.f;
          ps += __shfl_xor(ps, 1); ps += __shfl_xor(ps, 2); ps += __shfl_xor(ps, 4); rsum = 2.5f / (ps + 1e-20f);
          const int cnt = __popc(selm); int inc = cnt;
#pragma unroll
          for (int m = 1; m < 8; m <<= 1) { const int o = __shfl_up(inc, m); inc += (gi >= m) ? o : 0; }
          kbase = inc - cnt; }
#pragma unroll
        for (int i = 0; i < 8; ++i) { loc8[i] = 0u; if (act && ((selm >> i) & 1u)) loc8[i] = __hip_atomic_fetch_add(&HIST[8 * gi + i], 1u, __ATOMIC_RELAXED, __HIP_MEMORY_SCOPE_WORKGROUP); }
        dsync<NW>(ctr, nb, lane); PROBE_SUB(F, 11);
        if (tid < 64) { const unsigned n = HIST[tid]; HIST[64 + tid] = n ? __hip_atomic_fetch_add(CNT + tid * CNT_STRIDE, n, __ATOMIC_RELAXED, __HIP_MEMORY_SCOPE_AGENT) : 0u; }
        dsync<NW>(ctr, nb, lane);
        int gi2 = gi; asm volatile("" : "+v"(gi2));
#pragma unroll
        for (int i = 0; i < 8; ++i) if (act && ((selm >> i) & 1u)) { const int e = 8 * gi2 + i, k = kbase + __popc(selm & ((1u << i) - 1u)); const unsigned pos = HIST[64 + e] + loc8[i];
            LIST[e * NTOK + pos] = tokq; AEP[tokq * 8 + k] = (int)((unsigned)e << 16 | pos); AW[tokq * 8 + k] = sc8[i] * rsum; }
        if (blk + F.G < NTOK / 32) dsync<NW>(ctr, nb, lane);
        PROBE_SUB(F, 12);
    }
}

__device__ __forceinline__ void build_etab(Frame& F, int l) {
    LAS int* ET = (LAS int*)(F.lds + LDS_ETAB);
    unsigned* CNT = (unsigned*)(F.ws + WS_CTL) + CW_CNT + (size_t)l * 64 * CNT_STRIDE;
    if (F.tid < NE1) ET[F.tid] = F.tid < NE ? (int)__hip_atomic_load(CNT + F.tid * CNT_STRIDE, __ATOMIC_RELAXED, __HIP_MEMORY_SCOPE_AGENT) : NTOK;
    __syncthreads();
    if (F.tid < 64) {
        const int tiles = (ET[F.tid] + 255) >> 8; int inc = tiles;
#pragma unroll
        for (int m = 1; m < 64; m <<= 1) { const int o = __shfl_up(inc, m); inc += (F.tid >= m) ? o : 0; }
        const int exc = inc - tiles; ET[68 + F.tid] = exc; ET[136 + F.tid] = exc * 256;
        if (F.tid == 63) { ET[68 + NE] = inc; ET[136 + NE] = inc * 256; ET[68 + NE1] = inc + ((ET[NE] + 255) >> 8); } }
    __syncthreads();
}
struct ExpertSched {
    LAS const int* UD;
    LAS const unsigned* RT;
    const char* Abase; const char* Bbase; size_t bstride_e, bstride_pn; int arow_bytes, ncol; bool gather;
    __device__ __forceinline__ bool next(int i, pg8::Unit& u) const {
        if (i >= 16) return false; const int e = __builtin_amdgcn_readfirstlane(UD[4 * i]); if (e < 0) return false;
        const int row0 = __builtin_amdgcn_readfirstlane(UD[4 * i + 1]), pn = __builtin_amdgcn_readfirstlane(UD[4 * i + 2]);
        u.A = gather ? Abase : Abase + (size_t)row0 * arow_bytes; u.B = Bbase + (size_t)e * bstride_e + (size_t)pn * bstride_pn; u.row0 = row0; u.col0 = pn * ncol; u.nvalid = __builtin_amdgcn_readfirstlane(UD[4 * i + 3]); u.aux = e; return true;
    }
    __device__ __forceinline__ unsigned rowoff(int i, int r) const { return RT[i * 256 + r]; }
};
__device__ __forceinline__ int phase_role(const Frame& F, int NU, int& Gp) {
    NU = __builtin_amdgcn_readfirstlane(NU);
    if (F.G != 256 || NU <= 0) { Gp = F.G; return F.vcu; }
    const int R = (NU + 255) / 256; int g = (NU + R - 1) / R; g = (g + 7) & ~7; if (g > 256) g = 256; Gp = g;
    const int per = g >> 3, x = F.vcu >> 5, r = F.vcu & 31;
    return r < per ? x * per + r : -1 - (x * (32 - per) + (r - per));
}
__device__ __forceinline__ void build_units(Frame& F, int npn, bool gather, int cp, int Gp) {
    LAS int* ET = (LAS int*)(F.lds + LDS_ETAB); LAS int* UD = (LAS int*)(F.lds + LDS_UDESC); LAS unsigned* RT = (LAS unsigned*)(F.lds + LDS_ROWTAB);
    const int NU = ET[68 + NE1] * npn;
    if (F.tid < 16) { const int U = cp + F.tid * Gp; int e = -1, row0 = 0, pn = 0, nv = 0;
        if (U < NU) { const int tile = U / npn; pn = U % npn; int lo_ = 0, hi_ = NE;
#pragma unroll 1
            while (lo_ < hi_) { const int mid_ = (lo_ + hi_) >> 1; if (ET[68 + mid_ + 1] <= tile) lo_ = mid_ + 1; else hi_ = mid_; }
            e = lo_; const int mt = tile - ET[68 + e]; row0 = ET[136 + e] + 256 * mt; nv = ET[e] - 256 * mt; nv = nv > 256 ? 256 : nv; }
        UD[4 * F.tid] = e; UD[4 * F.tid + 1] = row0; UD[4 * F.tid + 2] = pn; UD[4 * F.tid + 3] = nv; }
    __syncthreads();
    if (gather) { const GAS int* LIST = (const GAS int*)(F.ws + WS_LIST);
#pragma unroll
        for (int i = F.tid; i < 4 * 256; i += 512) { const int ui = i >> 8, r = i & 255; const int e = UD[4 * ui]; unsigned off = 0u;
            if (e >= 0) { const int row0 = UD[4 * ui + 1], nv = UD[4 * ui + 3]; const int lr = row0 - ET[136 + e] + r; int tok = 0;
                tok = NTOK;
                if (r < nv) tok = (e < NE) ? LIST[e * NTOK + lr] : lr;
                off = (unsigned)tok * (unsigned)(D * 2); }
            RT[i] = off; }
        __syncthreads(); }
}

__device__ __forceinline__ void phase_g(Frame& F, int l, int qstart) {
    const Args& A = *F.a; unsigned char* ws = F.ws; const int lane = F.lane;
    if (l + 1 < NL) { convert_cleanup_at(F, qstart, (l + 1) * L_ITEMS); __syncthreads(); }
    LAS const int* SB = (LAS const int*)(F.lds + LDS_ETAB) + 136;
    const bf16_t* X1B = (const bf16_t*)(ws + WS_X1B); const unsigned char* OB = (const unsigned char*)(ws + WS_OB); const int* AEP = (const int*)(ws + WS_ASG_EP); const float* AW = (const float*)(ws + WS_ASG_W);
    float* XO = (l == NL - 1) ? A.out : (float*)nullptr; bf16_t* XB = (bf16_t*)(ws + WS_XB);
    const bf16_t* OSH = (const bf16_t*)(ws + WS_OSH);
    LAS float* YS = (LAS float*)(F.lds + F.wave * 8192);
    int ep_n = 0; float w_n = 0.f;
    { const int tok0 = F.vcu * 8 + F.wave; if (tok0 < NTOK && lane < 8) { ep_n = AEP[tok0 * 8 + lane]; w_n = AW[tok0 * 8 + lane]; } }
    for (int tok = F.vcu * 8 + F.wave; tok < NTOK; tok += F.G * 8) {
        int slot = 0; const float wv = w_n;
        if (lane < 8) slot = SB[ep_n >> 16] + (ep_n & 0xffff);
        { const int tn = tok + F.G * 8; if (tn < NTOK && lane < 8) { ep_n = AEP[tn * 8 + lane]; w_n = AW[tn * 8 + lane]; } }
        float s = 0.f;
        u32x2 ovA[8], ovB[8]; u32x4 xrA, xrB, osA, osB;
#define G_LOADS(ov, xr, os, j) do { xr = *(const u32x4*)(X1B + (size_t)tok * D + 512 * (j) + 8 * lane); os = *(const u32x4*)(OSH + (size_t)tok * D + 512 * (j) + 8 * lane); \
            _Pragma("unroll") for (int k = 0; k < 8; ++k) { const int sl = __builtin_amdgcn_readlane(slot, k); ov[k] = *(const u32x2*)(OB + (size_t)sl * D + 512 * (j) + 8 * lane); } } while (0)
#define G_COMBINE(ov, xr, os, j) do { \
            float y[8] = {ALPHA * bf_lo(xr.x) + bf_lo(os.x), ALPHA * bf_hi(xr.x) + bf_hi(os.x), ALPHA * bf_lo(xr.y) + bf_lo(os.y), ALPHA * bf_hi(xr.y) + bf_hi(os.y), \
                          ALPHA * bf_lo(xr.z) + bf_lo(os.z), ALPHA * bf_hi(xr.z) + bf_hi(os.z), ALPHA * bf_lo(xr.w) + bf_lo(os.w), ALPHA * bf_hi(xr.w) + bf_hi(os.w)}; \
            _Pragma("unroll") for (int k = 0; k < 8; ++k) { const float wk = __int_as_float(__builtin_amdgcn_readlane(__float_as_int(wv), k)) * (1.0f / pg8::O8_SCALE); \
                const f32x2 a = __builtin_amdgcn_cvt_pk_f32_fp8((int)ov[k].x, false), b = __builtin_amdgcn_cvt_pk_f32_fp8((int)ov[k].x, true), \
                            c2 = __builtin_amdgcn_cvt_pk_f32_fp8((int)ov[k].y, false), d2 = __builtin_amdgcn_cvt_pk_f32_fp8((int)ov[k].y, true); \
                y[0] += wk * a.x; y[1] += wk * a.y; y[2] += wk * b.x; y[3] += wk * b.y; y[4] += wk * c2.x; y[5] += wk * c2.y; y[6] += wk * d2.x; y[7] += wk * d2.y; } \
            s += ((y[0] + y[1]) + (y[2] + y[3])) + ((y[4] + y[5]) + (y[6] + y[7])); \
            *(LAS f32x4*)(YS + 512 * (j) + 8 * lane) = (f32x4){y[0], y[1], y[2], y[3]}; *(LAS f32x4*)(YS + 512 * (j) + 8 * lane + 4) = (f32x4){y[4], y[5], y[6], y[7]}; } while (0)
        G_LOADS(ovA, xrA, osA, 0); G_LOADS(ovB, xrB, osB, 1);
        G_COMBINE(ovA, xrA, osA, 0); G_LOADS(ovA, xrA, osA, 2);
        G_COMBINE(ovB, xrB, osB, 1); G_LOADS(ovB, xrB, osB, 3);
        G_COMBINE(ovA, xrA, osA, 2);
        G_COMBINE(ovB, xrB, osB, 3);
#undef G_LOADS
#undef G_COMBINE
        const float mean = wave_sum(s) * (1.f / D); float s2 = 0.f;
#pragma unroll 1
        for (int j = 0; j < 4; ++j) { const f32x4 a = *(const LAS f32x4*)(YS + 512 * j + 8 * lane) - mean, b = *(const LAS f32x4*)(YS + 512 * j + 8 * lane + 4) - mean;
            s2 += ((a[0] * a[0] + a[1] * a[1]) + (a[2] * a[2] + a[3] * a[3])) + ((b[0] * b[0] + b[1] * b[1]) + (b[2] * b[2] + b[3] * b[3])); }
        const float rstd = 1.f / sqrtf(wave_sum(s2) * (1.f / D) + LN_EPS);
#pragma unroll 1
        for (int j = 0; j < 4; ++j) { const f32x4* gp = (const f32x4*)(A.in[I_LN2_G] + l * D + 512 * j + 8 * lane); const f32x4* bp = (const f32x4*)(A.in[I_LN2_B] + l * D + 512 * j + 8 * lane);
            const f32x4 a = *(const LAS f32x4*)(YS + 512 * j + 8 * lane) - mean, b = *(const LAS f32x4*)(YS + 512 * j + 8 * lane + 4) - mean;
            const f32x4 o0 = a * rstd * gp[0] + bp[0], o1 = b * rstd * gp[1] + bp[1];
            if (XO) { f32x4* op = (f32x4*)(XO + (size_t)tok * D + 512 * j + 8 * lane); op[0] = o0; op[1] = o1; }
            if (!XO) *(u32x4*)(XB + (size_t)tok * D + 512 * j + 8 * lane) = (u32x4){cvt_pk_bf16(o0[0], o0[1]), cvt_pk_bf16(o0[2], o0[3]), cvt_pk_bf16(o1[0], o1[1]), cvt_pk_bf16(o1[2], o1[3])}; }
    }
}

constexpr int NPHASE = 2 + 7 * NL;
__global__ void __launch_bounds__(512, 2) mk_fwd(Args args) {
    extern __shared__ __attribute__((aligned(16))) unsigned char lds[];
#define PHASE_FRAME() Frame F; { int tz_ = threadIdx.x; asm volatile("" : "+v"(tz_)); int bz_ = blockIdx.x; asm volatile("" : "+s"(bz_)); unsigned char* wz_ = args.ws; asm volatile("" : "+s"(wz_)); \
        F.lds = (LAS unsigned char*)lds; F.tid = tz_; F.lane = tz_ & 63; F.wave = __builtin_amdgcn_readfirstlane(tz_ >> 6); F.G = gridDim.x; F.vcu = (F.G % 8 == 0) ? (bz_ % 8) * (F.G / 8) + bz_ / 8 : bz_; F.a = &args; F.ws = wz_; } \
        unsigned char* ws = F.ws; const int c = F.vcu; (void)ws; (void)c
    volatile LAS unsigned* MISC = (volatile LAS unsigned*)((LAS unsigned char*)lds + LDS_MISC);
    if (threadIdx.x < 128) MISC[threadIdx.x] = 0u;
    __syncthreads();
    unsigned* ctl = (unsigned*)(args.ws + WS_CTL);
    XcdBarrier bar; bar.bar = ctl + CW_BAR; bar.x = 0; bar.st = nullptr;
    const int lo = args.ph_lo, hi = args.ph_hi;
    if (hi - lo > 1) bar = xcd_barrier_post(ctl + CW_BAR, MISC + 8);
#define IN(k) (lo <= (k) && (k) < hi)
#if PROBE_CLASS >= 0
#define PROBE_MARK(cls) do { if (blockIdx.x == 0 && threadIdx.x == 0) { const unsigned n_ = (unsigned)wall_clock64(); if ((cls) == PROBE_CLASS || PROBE_CLASS == 99) MISC[65] += n_ - MISC[64]; MISC[64] = n_; } } while (0)
    if (blockIdx.x == 0 && threadIdx.x == 0) MISC[64] = (unsigned)wall_clock64();
#define PROBE_CONV_T0() const unsigned tc0_ = (unsigned)wall_clock64()
#define PROBE_CONV_T1(cls) do { if ((cls) == PROBE_CLASS && blockIdx.x == 248 && threadIdx.x == 0) xb_add((unsigned*)(args.ws + WS_CTL) + 12288, (unsigned)wall_clock64() - tc0_); } while (0)
#else
#define PROBE_MARK(cls) do { } while (0)
#define PROBE_CONV_T0() do { } while (0)
#define PROBE_CONV_T1(cls) do { } while (0)
#endif
#define SEAM(k) do { if (IN(k) && IN((k) + 1)) xcd_barrier(bar); } while (0)

    if (IN(0)) { REP_LOOP(REP_P0) { PHASE_FRAME(); p0_prologue(F); } if (IN(2)) xcd_barrier(bar); PROBE_MARK(7); }
    int qh = 0;
    static_assert(MK_ONE_LAUNCH == 1, "static queue");
#pragma unroll 1
    for (int l_ = 0; l_ < NL; ++l_) {
        const int pb = 2 + 7 * l_;
        if (IN(pb + 0)) {
            REP_LOOP(REP_A) {
            PHASE_FRAME(); int l = l_; asm volatile("" : "+s"(l));
            int Gp; const int role = phase_role(F, (NTOK / 256) * (INW / 256), Gp); unsigned* PD = (unsigned*)(ws + WS_CTL) + CW_PD + (pb + 0) * 64;
            if (l == 0 && c == 0) { float sum = 0.f; const float* rp = (const float*)(ws + WS_RCP) + (size_t)(F.tid >> 7) * 16 * 128 + (F.tid & 127);
#pragma unroll
                for (int q = 0; q < 16; ++q) sum += rp[q * 128];
                ((float*)(ws + WS_RC))[F.tid] = sum; }
            const int qsA = qh > l * L_ITEMS ? qh : l * L_ITEMS, ncA = F.G - Gp; int qeA = qsA + ncA * 8 * 8 * (l == 0 ? FILL_A0 : FILL_A); qeA = qeA < Q_TOTAL ? qeA : Q_TOTAL;
            if (role >= 0) {
                pg8::DenseSched S; S.init((const bf16_t*)(ws + WS_XB), (const bf16_t*)(ws + WS_WT_IN) + (size_t)l * INW * D, NTOK, INW, D, Gp, role);
                pg8::EpiStoreBf16 E{(bf16_t*)(ws + WS_HB), INW};
                pg8::gemm_phase<pg8::EpiStoreBf16, pg8::DenseSched, false>(F.lds, D, S, E);
            } else {
                const int k = -1 - role;
                if (l == 0) {
                    { pg8::DenseSched S2; S2.init((const bf16_t*)(ws + WS_MEMN), (const bf16_t*)(ws + WS_WT_K), NMEMTOK, NL * 512, D, F.G, k);
                      pg8::EpiStoreBf16 E2{(bf16_t*)(ws + WS_KBUF), NL * 512};
                      pg8::gemm_phase<pg8::EpiStoreBf16, pg8::DenseSched, false>(F.lds, D, S2, E2); }
                    { pg8::DenseSched S2; S2.init((const bf16_t*)(ws + WS_WT_V), (const bf16_t*)(ws + WS_MEMN), NL * 512, NMEMTOK, D, F.G, k - 32);
                      pg8::EpiStoreBf16 E2{(bf16_t*)(ws + WS_VT), NMEMTOK};
                      pg8::gemm_phase<pg8::EpiStoreBf16, pg8::DenseSched, false>(F.lds, D, S2, E2); }
                    __syncthreads();
                }
#if PACE > 0
                convert_paced(F, l * L_ITEMS, PD, (unsigned)Gp / STOP_DIV + 1u);
#else
                PROBE_CONV_T0(); convert_static(F, qsA, qeA, k, ncA); PROBE_CONV_T1(14);
#endif
            }
            qh = qeA; }
            SEAM(pb + 0); PROBE_MARK(0);
        }
        if (IN(pb + 1)) {
            REP_LOOP(REP_B) { PHASE_FRAME(); int l = l_; asm volatile("" : "+s"(l));
            for (int it = c; it < 256; it += F.G) mixer_sgu(F, l, it >> 2, it & 3);
            for (int it = c; it < 256; it += F.G) mixer_pool(F, l, it >> 2, it & 3);
            for (int it = c; it < 256; it += F.G) mixer_conv(F, l, it >> 2, it & 3);
            for (int it = c; it < 256; it += F.G) mixer_attn(F, l, it >> 2, it & 3); }
            SEAM(pb + 1); PROBE_MARK(1);
        }
        if (IN(pb + 2)) {
            REP_LOOP(REP_C) {
            PHASE_FRAME(); int l = l_; asm volatile("" : "+s"(l));
            pg8::DenseSched S; S.init((const bf16_t*)(ws + WS_MIX), (const bf16_t*)(ws + WS_WT_OUT) + (size_t)l * D * D, NTOK, D, D, F.G, c);
            pg8::EpiResidBf16 E{(bf16_t*)(ws + WS_Y1), l == 0 ? args.in[I_X] : (const float*)nullptr, (const bf16_t*)(ws + WS_XB), D, ALPHA};
            pg8::gemm_phase<pg8::EpiResidBf16, pg8::DenseSched, false>(F.lds, D, S, E); __syncthreads(); }
            SEAM(pb + 2); PROBE_MARK(2);
        }
        if (IN(pb + 3)) { PHASE_FRAME(); int l = l_; asm volatile("" : "+s"(l));
            if (F.G * 32 == NTOK) {
                if (F.tid == 0) ((LAS unsigned*)(F.lds + LDS_MISC))[16] = 0u;
                __syncthreads();
                if (F.wave < 4) phase_d<4>(F, l);
                else {
#if PROBE_CLASS == 13
                    const unsigned t0_ = (unsigned)wall_clock64();
#endif
                    convert_beside_d_at(F, qh > l * L_ITEMS ? qh : l * L_ITEMS, l * L_ITEMS + LI_X);
#if PROBE_CLASS == 13
                    if (blockIdx.x == 0 && F.tid == 256) { volatile LAS unsigned* M_ = (volatile LAS unsigned*)(F.lds + LDS_MISC); M_[65] += (unsigned)wall_clock64() - t0_; }
#endif
                }
            } else { convert_cleanup_at(F, qh > l * L_ITEMS ? qh : l * L_ITEMS, l * L_ITEMS + LI_X); __syncthreads(); phase_d<8>(F, l); }
            if (qh < l * L_ITEMS + LI_X) qh = l * L_ITEMS + LI_X;
            SEAM(pb + 3); PROBE_MARK(3); }
        if (IN(pb + 4)) {
            REP_LOOP(REP_E) {
            PHASE_FRAME(); int l = l_; asm volatile("" : "+s"(l));
            build_etab(F, l);
            int Gp; const int role = phase_role(F, ((LAS const int*)(F.lds + LDS_ETAB))[68 + NE1] * 2, Gp); unsigned* PD = (unsigned*)(ws + WS_CTL) + CW_PD + (pb + 4) * 64;
            const int qsE = qh > l * L_ITEMS + LI_X ? qh : l * L_ITEMS + LI_X, ncE = F.G - Gp; int qeE = qsE + ncE * 8 * 8 * FILL_E; qeE = qeE < Q_TOTAL ? qeE : Q_TOTAL;
            if (role >= 0) {
                build_units(F, 2, true, role, Gp);
                ExpertSched S; S.UD = (LAS const int*)(F.lds + LDS_UDESC); S.RT = (LAS const unsigned*)(F.lds + LDS_ROWTAB);
                S.Abase = (const char*)(ws + WS_X1B); S.Bbase = (const char*)(ws + WS_WT_GU) + (size_t)l * NE1 * 512 * D * 2; S.bstride_e = (size_t)512 * D * 2; S.bstride_pn = (size_t)256 * D * 2; S.arow_bytes = D * 2; S.ncol = 128; S.gather = true;
                pg8::EpiSwiglu E{(bf16_t*)(ws + WS_HE)};
                pg8::gemm_phase<pg8::EpiSwiglu, ExpertSched, true>(F.lds, D, S, E);
            } else {
#if PACE > 0
                convert_paced(F, l * L_ITEMS + LI_X, PD, (unsigned)Gp / STOP_DIV + 1u);
#else
                PROBE_CONV_T0(); convert_static(F, qsE, qeE, -1 - role, ncE); PROBE_CONV_T1(15);
#endif
            }
            __syncthreads(); qh = qeE; }
            SEAM(pb + 4); PROBE_MARK(4);
        }
        if (IN(pb + 5)) {
            REP_LOOP(REP_F) {
            PHASE_FRAME(); int l = l_; asm volatile("" : "+s"(l));
            int Gp; const int role = phase_role(F, ((LAS const int*)(F.lds + LDS_ETAB))[68 + NE1] * 8, Gp); unsigned* PD = (unsigned*)(ws + WS_CTL) + CW_PD + (pb + 5) * 64;
            const int qsF = qh > l * L_ITEMS + LI_X ? qh : l * L_ITEMS + LI_X, ncF = F.G - Gp; int qeF = qsF + ncF * 8 * 8 * FILL_F; qeF = qeF < Q_TOTAL ? qeF : Q_TOTAL;
            if (role >= 0) {
                build_units(F, 8, false, role, Gp);
                ExpertSched S; S.UD = (LAS const int*)(F.lds + LDS_UDESC); S.RT = (LAS const unsigned*)(F.lds + LDS_ROWTAB);
                S.Abase = (const char*)(ws + WS_HE); S.Bbase = (const char*)(ws + WS_WT_D) + (size_t)l * NE1 * D * DE * 2; S.bstride_e = (size_t)D * DE * 2; S.bstride_pn = (size_t)256 * DE * 2; S.arow_bytes = DE * 2; S.ncol = 256; S.gather = false;
                pg8::EpiStoreFp8 E{(unsigned char*)(ws + WS_OB), D, (bf16_t*)(ws + WS_OSH), NE, __builtin_amdgcn_readfirstlane(((LAS const int*)(F.lds + LDS_ETAB))[136 + NE])};
                pg8::gemm_phase<pg8::EpiStoreFp8, ExpertSched, false>(F.lds, DE, S, E);
            } else {
#if PACE > 0
                convert_paced(F, l * L_ITEMS + LI_X, PD, (unsigned)Gp / STOP_DIV + 1u);
#else
                PROBE_CONV_T0(); convert_static(F, qsF, qeF, -1 - role, ncF); PROBE_CONV_T1(16);
#endif
            }
            __syncthreads(); qh = qeF; }
            SEAM(pb + 5); PROBE_MARK(5);
        }
        if (IN(pb + 6)) { REP_LOOP(REP_G) { PHASE_FRAME(); int l = l_; asm volatile("" : "+s"(l)); phase_g(F, l, qh > l * L_ITEMS + LI_X ? qh : l * L_ITEMS + LI_X); __syncthreads(); } if (l_ + 1 < NL && qh < (l_ + 1) * L_ITEMS) qh = (l_ + 1) * L_ITEMS; SEAM(pb + 6); PROBE_MARK(6); }
    }
#if PROBE_CLASS >= 0
    if (blockIdx.x == 0 && threadIdx.x == 0) { const long long t_end = (long long)wall_clock64() + (long long)PROBE_SCALE * (MISC[65] + xb_ld((unsigned*)(args.ws + WS_CTL) + 12288)); while ((long long)wall_clock64() < t_end) __builtin_amdgcn_s_sleep(64); }
#endif
#undef IN
#undef SEAM
}

extern "C" void kernel_launch(void* const* d_in, const int* in_sizes, int n_in, void* d_out, int out_size, void* d_ws, size_t ws_size, hipStream_t stream) {
    static int grid = 0;
    if (grid == 0) {
        if (n_in != 29 || out_size != NTOK * D || ws_size < WS_END) { fprintf(stderr, "kernel_launch: unexpected shapes (n_in %d out %d ws %zu need %zu)\n", n_in, out_size, ws_size, (size_t)WS_END); grid = -1; return; }
        int dev = 0, cus = 0, per_cu = 0;
        if (hipGetDevice(&dev) != hipSuccess || hipDeviceGetAttribute(&cus, hipDeviceAttributeMultiprocessorCount, dev) != hipSuccess) { grid = -1; return; }
        if (hipFuncSetAttribute((const void*)mk_fwd, hipFuncAttributeMaxDynamicSharedMemorySize, LDS_BYTES) != hipSuccess) { fprintf(stderr, "kernel_launch: hipFuncSetAttribute failed\n"); grid = -1; return; }
        if (hipOccupancyMaxActiveBlocksPerMultiprocessor(&per_cu, (const void*)mk_fwd, 512, LDS_BYTES) != hipSuccess || per_cu < 1) fprintf(stderr, "kernel_launch: occupancy query reports %d\n", per_cu);
        (void)hipGetLastError();
        grid = cus;
    }
    if (grid < 0) return;
    (void)hipMemsetAsync((char*)d_ws + WS_CTL, 0, CTL_ZERO_BYTES, stream);
    Args a{};
    for (int i = 0; i < 29; ++i) a.in[i] = (const float*)d_in[i];
    a.out = (float*)d_out; a.ws = (unsigned char*)d_ws;
#if MK_ONE_LAUNCH
    a.ph_lo = 0; a.ph_hi = NPHASE;
    hipLaunchKernelGGL(mk_fwd, dim3(grid), dim3(512), LDS_BYTES, stream, a);
#else
    for (int p = 0; p < NPHASE; ++p) { a.ph_lo = p; a.ph_hi = p + 1; hipLaunchKernelGGL(mk_fwd, dim3(grid), dim3(512), LDS_BYTES, stream, a); }
#endif
}
```
